# Optimizing an MI355X kernel written in HIP

```python
import math
import jax, jax.numpy as jnp
from jax import lax
import numpy as np

D_MODEL = 1024
BATCH = 8
SEQ = 4096
DEPTH = 1

M_HEADS = 4
M_WIDTH = D_MODEL
M_HEAD_DIM = M_WIDTH // M_HEADS
M_CONV = 4
M_CHUNK = 64
S_WIDTH = D_MODEL // 2
S_GROUP = 16
S_GROUPS = S_WIDTH // S_GROUP
S_STATE = 64
FFN_DIM = 2816
FFN_CONV = 3
EPS = 1e-6
IN_SIZES = (M_WIDTH, M_WIDTH, M_HEADS, M_HEADS, S_WIDTH, D_MODEL, D_MODEL)
N_IN = sum(IN_SIZES)

kernel_name = "hybrid_mlstm_s5_gated_merge_convffn"


def rmsnorm(x, g):
    x32 = x.astype(jnp.float32)
    y = x32 * lax.rsqrt(jnp.mean(x32 * x32, axis=-1, keepdims=True) + EPS)
    return (y * g.astype(jnp.float32)).astype(x.dtype)


def causal_dwconv(x, w, b):
    width = w.shape[0]
    L = x.shape[1]
    xp = jnp.pad(x, ((0, 0), (width - 1, 0), (0, 0)))
    return sum(xp[:, k:k + L] * w[k] for k in range(width)) + b


def mlstm_chunkwise(q, k, v, ig, fg):
    Bsz, L, H, Dh = q.shape
    nc = L // M_CHUNK

    def chunks4(t):
        return t.reshape(Bsz, nc, M_CHUNK, H, Dh).transpose(1, 0, 3, 2, 4)

    def chunks3(t):
        return t.reshape(Bsz, nc, M_CHUNK, H).transpose(1, 0, 3, 2)

    li = ig
    lf = jax.nn.log_sigmoid(fg)
    causal = jnp.tril(jnp.ones((M_CHUNK, M_CHUNK), dtype=bool))

    def step(carry, inp):
        C, n, m = carry
        qc, kc, vc, lic, lfc = inp
        b = jnp.cumsum(lfc, axis=-1)
        dmat = jnp.where(causal, b[..., :, None] - b[..., None, :] + lic[..., None, :], -jnp.inf)
        inter = b + m[..., None]
        m_row = jnp.maximum(inter, jnp.max(dmat, axis=-1))
        w_intra = jnp.exp(dmat - m_row[..., None])
        w_inter = jnp.exp(inter - m_row)
        s = jnp.einsum('bhqd,bhkd->bhqk', qc, kc) * w_intra
        num = (w_inter[..., None] * jnp.einsum('bhvd,bhqd->bhqv', C, qc)
               + jnp.einsum('bhqk,bhkv->bhqv', s, vc))
        den = w_inter * jnp.einsum('bhd,bhqd->bhq', n, qc) + jnp.sum(s, axis=-1)
        h = num / jnp.maximum(jnp.abs(den), jnp.exp(-m_row))[..., None]
        b_last = b[..., -1]
        g = b_last[..., None] - b + lic
        m_new = jnp.maximum(b_last + m, jnp.max(g, axis=-1))
        decay = jnp.exp(b_last + m - m_new)
        wk = jnp.exp(g - m_new[..., None])
        C_new = decay[..., None, None] * C + jnp.einsum('bhc,bhcv,bhcd->bhvd', wk, vc, kc)
        n_new = decay[..., None] * n + jnp.einsum('bhc,bhcd->bhd', wk, kc)
        return (C_new, n_new, m_new), h

    init = (jnp.zeros((Bsz, H, Dh, Dh), jnp.float32),
            jnp.zeros((Bsz, H, Dh), jnp.float32),
            jnp.zeros((Bsz, H), jnp.float32))
    _, hs = lax.scan(step, init, (chunks4(q), chunks4(k), chunks4(v), chunks3(li), chunks3(lf)))
    return hs.transpose(1, 0, 3, 2, 4).reshape(Bsz, L, H, Dh)


def mlstm_mixer(xm, om, ig, fg, conv_w, conv_b, wq, wk, wv, head_g, skip):
    Bsz, L, _ = xm.shape
    xc = jax.nn.silu(causal_dwconv(xm, conv_w, conv_b))
    xc_h = xc.reshape(Bsz, L, M_HEADS, M_HEAD_DIM)
    xm_h = xm.reshape(Bsz, L, M_HEADS, M_HEAD_DIM)
    q = jnp.einsum('blhd,hde->blhe', xc_h, wq).astype(jnp.float32)
    k = (jnp.einsum('blhd,hde->blhe', xc_h, wk) * (M_HEAD_DIM ** -0.5)).astype(jnp.float32)
    v = jnp.einsum('blhd,hde->blhe', xm_h, wv).astype(jnp.float32)
    hc = mlstm_chunkwise(q, k, v, ig.astype(jnp.float32), fg.astype(jnp.float32))
    mu = jnp.mean(hc, axis=-1, keepdims=True)
    var = jnp.mean(jnp.square(hc - mu), axis=-1, keepdims=True)
    hn = ((hc - mu) * lax.rsqrt(var + EPS)).reshape(Bsz, L, M_WIDTH) * head_g.astype(jnp.float32)
    out = jax.nn.sigmoid(om.astype(jnp.float32)) * hn + skip.astype(jnp.float32) * xc.astype(jnp.float32)
    return out.astype(xm.dtype)


def _complex_affine_combine(e1, e2):
    a1r, a1i, b1r, b1i = e1
    a2r, a2i, b2r, b2i = e2
    ar = a1r * a2r - a1i * a2i
    ai = a1r * a2i + a1i * a2r
    br = a2r * b1r - a2i * b1i + b2r
    bi = a2r * b1i + a2i * b1r + b2i
    return (ar, ai, br, bi)


def s5_mixer(u, a_re, a_im, log_dt, b_re, b_im, c_re, c_im, d_skip, w_glu, b_glu):
    Bsz, L, _ = u.shape
    f32 = jnp.float32
    u32 = u.astype(f32).reshape(Bsz, L, S_GROUPS, S_GROUP)
    ar, ai = a_re.astype(f32), a_im.astype(f32)
    dt = jnp.exp(log_dt.astype(f32))[:, None]
    mag = jnp.exp(dt * ar)
    abar_re, abar_im = mag * jnp.cos(dt * ai), mag * jnp.sin(dt * ai)
    den = ar * ar + ai * ai
    xr, xi = abar_re - 1.0, abar_im
    r_re = (xr * ar + xi * ai) / den
    r_im = (xi * ar - xr * ai) / den
    br_, bi_ = b_re.astype(f32), b_im.astype(f32)
    bbar_re = r_re[..., None] * br_ - r_im[..., None] * bi_
    bbar_im = r_re[..., None] * bi_ + r_im[..., None] * br_
    bu_re = jnp.einsum('blgc,gpc->blgp', u32, bbar_re)
    bu_im = jnp.einsum('blgc,gpc->blgp', u32, bbar_im)
    a_seq_re = jnp.broadcast_to(abar_re, (1, L, S_GROUPS, S_STATE))
    a_seq_im = jnp.broadcast_to(abar_im, (1, L, S_GROUPS, S_STATE))
    _, _, s_re, s_im = lax.associative_scan(_complex_affine_combine,
                                            (a_seq_re, a_seq_im, bu_re, bu_im), axis=1)
    y = (jnp.einsum('blgp,gcp->blgc', s_re, c_re.astype(f32))
         - jnp.einsum('blgp,gcp->blgc', s_im, c_im.astype(f32))
         + d_skip.astype(f32) * u32)
    y = jax.nn.gelu(y.reshape(Bsz, L, S_WIDTH))
    y = y * jax.nn.sigmoid(y @ w_glu.astype(f32) + b_glu.astype(f32))
    return y.astype(u.dtype)


def setup_inputs(seed: int = 0) -> dict:
    key = jax.random.key(seed)
    ks = jax.random.split(key, 40)
    nrm = lambda k, s, sc: jax.random.normal(k, s, jnp.float32) * sc
    Ld = DEPTH
    x = jax.random.normal(ks[0], (BATCH, SEQ, D_MODEL), jnp.float32)
    mix_norm_g = 1.0 + nrm(ks[1], (Ld, D_MODEL), 0.02)
    w_in = nrm(ks[2], (Ld, D_MODEL, N_IN), D_MODEL ** -0.5)
    b_in = jnp.concatenate([
        nrm(ks[3], (Ld, 2 * M_WIDTH), 0.02),
        nrm(ks[4], (Ld, M_HEADS), 0.1),
        jnp.linspace(3.0, 6.0, M_HEADS)[None, :] + nrm(ks[5], (Ld, M_HEADS), 0.1),
        nrm(ks[6], (Ld, S_WIDTH + 2 * D_MODEL), 0.02)], axis=-1)
    m_conv_w = nrm(ks[7], (Ld, M_CONV, M_WIDTH), M_CONV ** -0.5)
    m_conv_b = nrm(ks[8], (Ld, M_WIDTH), 0.02)
    m_wq = nrm(ks[9], (Ld, M_HEADS, M_HEAD_DIM, M_HEAD_DIM), M_HEAD_DIM ** -0.5)
    m_wk = nrm(ks[10], (Ld, M_HEADS, M_HEAD_DIM, M_HEAD_DIM), M_HEAD_DIM ** -0.5)
    m_wv = nrm(ks[11], (Ld, M_HEADS, M_HEAD_DIM, M_HEAD_DIM), M_HEAD_DIM ** -0.5)
    m_head_g = 1.0 + nrm(ks[12], (Ld, M_WIDTH), 0.02)
    m_skip = 1.0 + nrm(ks[13], (Ld, M_WIDTH), 0.02)
    s_a_re = -0.5 + nrm(ks[14], (Ld, S_GROUPS, S_STATE), 0.01)
    s_a_im = (math.pi * jnp.arange(S_STATE, dtype=jnp.float32))[None, None, :] + nrm(ks[15], (Ld, S_GROUPS, S_STATE), 0.01)
    s_log_dt = jax.random.uniform(ks[16], (Ld, S_GROUPS), jnp.float32, math.log(1e-3), math.log(1e-1))
    s_b_re = nrm(ks[17], (Ld, S_GROUPS, S_STATE, S_GROUP), (2 * S_GROUP) ** -0.5)
    s_b_im = nrm(ks[18], (Ld, S_GROUPS, S_STATE, S_GROUP), (2 * S_GROUP) ** -0.5)
    s_c_re = nrm(ks[19], (Ld, S_GROUPS, S_GROUP, S_STATE), S_STATE ** -0.5)
    s_c_im = nrm(ks[20], (Ld, S_GROUPS, S_GROUP, S_STATE), S_STATE ** -0.5)
    s_d = nrm(ks[21], (Ld, S_GROUPS, S_GROUP), 1.0)
    s_w_glu = nrm(ks[22], (Ld, S_WIDTH, S_WIDTH), S_WIDTH ** -0.5)
    s_b_glu = nrm(ks[23], (Ld, S_WIDTH), 0.02)
    w_branch_a = nrm(ks[24], (Ld, M_WIDTH, D_MODEL), M_WIDTH ** -0.5)
    w_branch_b = nrm(ks[25], (Ld, S_WIDTH, D_MODEL), S_WIDTH ** -0.5)
    w_out = nrm(ks[26], (Ld, D_MODEL, D_MODEL), D_MODEL ** -0.5)
    ffn_norm_g = 1.0 + nrm(ks[27], (Ld, D_MODEL), 0.02)
    w_up = nrm(ks[28], (Ld, D_MODEL, 2 * FFN_DIM), D_MODEL ** -0.5)
    ffn_conv_w = nrm(ks[29], (Ld, FFN_CONV, 2 * FFN_DIM), FFN_CONV ** -0.5)
    ffn_conv_b = nrm(ks[30], (Ld, 2 * FFN_DIM), 0.02)
    w_down = nrm(ks[31], (Ld, FFN_DIM, D_MODEL), FFN_DIM ** -0.5)
    final_norm_g = 1.0 + nrm(ks[32], (D_MODEL,), 0.02)
    return {"x": x, "mix_norm_g": mix_norm_g, "w_in": w_in, "b_in": b_in,
            "m_conv_w": m_conv_w, "m_conv_b": m_conv_b, "m_wq": m_wq, "m_wk": m_wk, "m_wv": m_wv,
            "m_head_g": m_head_g, "m_skip": m_skip,
            "s_a_re": s_a_re, "s_a_im": s_a_im, "s_log_dt": s_log_dt, "s_b_re": s_b_re, "s_b_im": s_b_im,
            "s_c_re": s_c_re, "s_c_im": s_c_im, "s_d": s_d, "s_w_glu": s_w_glu, "s_b_glu": s_b_glu,
            "w_branch_a": w_branch_a, "w_branch_b": w_branch_b, "w_out": w_out,
            "ffn_norm_g": ffn_norm_g, "w_up": w_up, "ffn_conv_w": ffn_conv_w, "ffn_conv_b": ffn_conv_b,
            "w_down": w_down, "final_norm_g": final_norm_g}


def reference(x, mix_norm_g, w_in, b_in, m_conv_w, m_conv_b, m_wq, m_wk, m_wv, m_head_g, m_skip,
              s_a_re, s_a_im, s_log_dt, s_b_re, s_b_im, s_c_re, s_c_im, s_d, s_w_glu, s_b_glu,
              w_branch_a, w_branch_b, w_out, ffn_norm_g, w_up, ffn_conv_w, ffn_conv_b, w_down,
              final_norm_g):
    splits = [int(s) for s in np.cumsum(IN_SIZES)[:-1]]
    for l in range(DEPTH):
        h = rmsnorm(x, mix_norm_g[l])
        proj = h @ w_in[l] + b_in[l]
        xm, om, ig, fg, us, ga, gb = jnp.split(proj, splits, axis=-1)
        a_out = mlstm_mixer(xm, om, ig, fg, m_conv_w[l], m_conv_b[l], m_wq[l], m_wk[l], m_wv[l],
                            m_head_g[l], m_skip[l])
        b_out = s5_mixer(us, s_a_re[l], s_a_im[l], s_log_dt[l], s_b_re[l], s_b_im[l],
                         s_c_re[l], s_c_im[l], s_d[l], s_w_glu[l], s_b_glu[l])
        merged = (jax.nn.sigmoid(ga) * (a_out @ w_branch_a[l])
                  + jax.nn.sigmoid(gb) * (b_out @ w_branch_b[l]))
        x = x + merged @ w_out[l]
        hf = rmsnorm(x, ffn_norm_g[l])
        up = causal_dwconv(hf @ w_up[l], ffn_conv_w[l], ffn_conv_b[l])
        val, gate = jnp.split(up, 2, axis=-1)
        x = x + (jax.nn.silu(gate) * val) @ w_down[l]
    return rmsnorm(x, final_norm_g)
```

```cpp
#include <hip/hip_runtime.h>
#include <hip/hip_cooperative_groups.h>
#include <cstdio>
#include <cstdint>
namespace cg = cooperative_groups;

#define LAS __attribute__((address_space(3)))
typedef unsigned short bf16_t;
typedef short bf16x8 __attribute__((ext_vector_type(8)));
typedef float f32x4 __attribute__((ext_vector_type(4)));
typedef float f32x2 __attribute__((ext_vector_type(2)));
typedef unsigned u32x4 __attribute__((ext_vector_type(4)));
typedef unsigned u32x2 __attribute__((ext_vector_type(2)));

constexpr int T_ = 32768, D_ = 1024, SEQ_ = 4096, NB_ = 8;
constexpr int NH_ = 4, DH_ = 256, NCH_ = 64;
constexpr int SW_ = 512, SG_ = 32, SP_ = 64;
constexpr int F_ = 2816, F2_ = 5632, NIN_ = 4616, NP1_ = 4608;
constexpr float EPS_ = 1e-6f;

constexpr size_t MiB = 1ull << 20, KiB = 1024;
constexpr size_t WS_WIN = 0, WS_WQK = 9 * MiB, WS_WV = 10 * MiB, WS_WGLU = 10 * MiB + 512 * KiB, WS_WA = 11 * MiB, WS_WB = 13 * MiB, WS_WOUT = 14 * MiB,
                 WS_WUP = 16 * MiB, WS_WDN = 27 * MiB;
constexpr size_t WS_S5A = 33 * MiB, WS_S5A64 = WS_S5A + 16 * KiB, WS_S5B = WS_S5A + 32 * KiB;
constexpr size_t WS_RINV1 = 34 * MiB, WS_IG = 34 * MiB + 512 * KiB, WS_FG = 35 * MiB, WS_BIASP = 35 * MiB + 512 * KiB;
constexpr size_t WS_SS1 = 36 * MiB, WS_SS2 = 38 * MiB, WS_E = 40 * MiB;
constexpr size_t R0 = 56 * MiB, R1 = 120 * MiB, R2 = 184 * MiB, R3 = 248 * MiB, R4 = 312 * MiB, R5 = 376 * MiB, R6 = 408 * MiB, R7 = 472 * MiB;
constexpr size_t WS_X1B = 448 * MiB, WS_UH = 56 * MiB, WS_ACT = 232 * MiB;
constexpr int LDS_BYTES = 147456;

struct Params {
    const float* in[30];
    float* out;
    unsigned char* ws;
};

__device__ __forceinline__ unsigned cvt_pk_bf16(float lo, float hi) { unsigned r; asm volatile("v_cvt_pk_bf16_f32 %0, %1, %2" : "=v"(r) : "v"(lo), "v"(hi)); return r; }
__device__ __forceinline__ bf16_t f2bf(float x) { return (bf16_t)(cvt_pk_bf16(x, x) & 0xffffu); }
__device__ __forceinline__ float bf2f(unsigned short u) { return __uint_as_float(((unsigned)u) << 16); }
__device__ __forceinline__ float bflo(unsigned w) { return __uint_as_float(w << 16); }
__device__ __forceinline__ float bfhi(unsigned w) { return __uint_as_float(w & 0xffff0000u); }
__device__ __forceinline__ float sigmoidf_(float x) { return __builtin_amdgcn_rcpf(1.0f + __expf(-x)); }
__device__ __forceinline__ float siluf_(float x) { return x * sigmoidf_(x); }
__device__ __forceinline__ int fresh_tid() { int t = threadIdx.x; asm volatile("" : "+v"(t)); return t; }
__device__ __forceinline__ float wave_sum(float v) {
#pragma unroll
    for (int o = 1; o < 64; o <<= 1) v += __shfl_xor(v, o);
    return v;
}
__device__ __forceinline__ void unpack8(const u32x4 w, float (&f)[8]) {
    f[0] = bflo(w.x); f[1] = bfhi(w.x); f[2] = bflo(w.y); f[3] = bfhi(w.y); f[4] = bflo(w.z); f[5] = bfhi(w.z); f[6] = bflo(w.w); f[7] = bfhi(w.w);
}
__device__ __forceinline__ u32x4 pack8(const float (&f)[8]) {
    u32x4 w; w.x = cvt_pk_bf16(f[0], f[1]); w.y = cvt_pk_bf16(f[2], f[3]); w.z = cvt_pk_bf16(f[4], f[5]); w.w = cvt_pk_bf16(f[6], f[7]); return w;
}

namespace pg8 {
constexpr int BM = 256, BK = 64, HALF = 128, HTB = HALF * BK * 2, STAGE_BYTES = 8 * HTB, NXCD = 8, WGM = 8;
__device__ __forceinline__ int lds_byte(int r, int c) { const int st = (r >> 4) * 2 + (c >> 5), rr = r & 15, cc = c & 31, ob = rr * 64 + cc * 2; return st * 1024 + (ob ^ (((ob >> 9) & 1) << 5)); }
__device__ __forceinline__ void stage_rc(int b, int& R, int& C) { const int st = b / 1024, sb = b % 1024, swz = sb ^ (((sb >> 9) & 1) << 5); R = (st >> 1) * 16 + swz / 64; C = (st & 1) * 32 + (swz % 64) / 2; }
__device__ __forceinline__ int perm32(int rho) { const int n = rho >> 4, i = rho & 15; return 8 * (i >> 2) + 4 * n + (i & 3); }
struct Unit { int pm, pn; };
struct Order {
    int nM, nN, nwg, G, c;
    __device__ __forceinline__ void init(int nM_, int nN_, int G_, int c_) { nM = nM_; nN = nN_; nwg = nM * nN; G = G_; c = c_; }
    __device__ __forceinline__ bool next(int i, Unit& u) const {
        const long L = (long)i * G + c; if (L >= nwg) return false;
        int wgid = (int)L; { const int q = nwg / NXCD, r = nwg % NXCD, xcd = wgid % NXCD, off = wgid / NXCD; wgid = (xcd < r ? xcd * (q + 1) : r * (q + 1) + (xcd - r) * q) + off; }
        const int nig = WGM * nN, gid = wgid / nig, fm = gid * WGM, gsz = (nM - fm) < WGM ? (nM - fm) : WGM;
        u.pm = fm + ((wgid % nig) % gsz); u.pn = (wgid % nig) / gsz; return true;
    }
};
template <class Epi, class Sched>
__device__ __forceinline__ void gemm_phase(LAS unsigned char* lds, const Sched& S, const Epi& E, const int K, const int lda, const int ldb) {
    const int tid = fresh_tid(), wid = __builtin_amdgcn_readfirstlane(tid >> 6), lane = tid & 63, wr = wid >> 2, wc = wid & 3, fr = lane & 15, fq = lane >> 4;
    const int nt = K / BK;
    unsigned voffA[2], voffB[2];
#pragma unroll
    for (int i = 0; i < 2; ++i) { int R, C; stage_rc(tid * 16 + i * 8192, R, C); const int Rb = Epi::PERM ? ((R & ~31) + perm32(R & 31)) : R;
        voffA[i] = (unsigned)(R * lda + C) * 2u; voffB[i] = (unsigned)(Rb * ldb + C) * 2u; }
    const size_t kstep = (size_t)(BK * 2);
    const size_t hstepA = (size_t)HALF * lda * 2, hstepB = (size_t)HALF * ldb * 2;
    const unsigned ldsw = (unsigned)wid * 1024u;
    const int aoff = lds_byte(wr * 64 + fr, fq * 8), boff = lds_byte(wc * 32 + fr, fq * 8);
#define PG8_SA(b, h) (((b) * 2 + (h)) * HTB)
#define PG8_SB(b, h) ((4 + (b) * 2 + (h)) * HTB)
#define PG8_STAGE(bufoff, gbase, voff) do { _Pragma("unroll") for (int _i = 0; _i < 2; ++_i) \
        __builtin_amdgcn_global_load_lds((const unsigned*)((const char*)(gbase) + (voff)[_i]), (LAS unsigned*)(lds + (bufoff) + ldsw + _i * 8192), 16, 0, 0); } while (0)
#define PG8_LDA(dst, b, h) do { _Pragma("unroll") for (int m = 0; m < 4; ++m) _Pragma("unroll") for (int k = 0; k < 2; ++k) dst[m][k] = *(const LAS bf16x8*)(lds + PG8_SA(b, h) + aoff + m * 2048 + k * 1024); } while (0)
#define PG8_LDB(dst, b, h) do { _Pragma("unroll") for (int n = 0; n < 2; ++n) _Pragma("unroll") for (int k = 0; k < 2; ++k) dst[n][k] = *(const LAS bf16x8*)(lds + PG8_SB(b, h) + boff + n * 2048 + k * 1024); } while (0)
#define PG8_MMA(ai, bj, At, Bt) do { __builtin_amdgcn_s_setprio(1); _Pragma("unroll") for (int m = 0; m < 4; ++m) _Pragma("unroll") for (int n = 0; n < 2; ++n) _Pragma("unroll") for (int k = 0; k < 2; ++k) \
        acc[ai][bj][m][n] = __builtin_amdgcn_mfma_f32_16x16x32_bf16(Bt[n][k], At[m][k], acc[ai][bj][m][n], 0, 0, 0); __builtin_amdgcn_s_setprio(0); } while (0)
#define PG8_WAIT_V(n) asm volatile("s_waitcnt vmcnt(" #n ")" ::: "memory")
#define PG8_WAIT_L(n) asm volatile("s_waitcnt lgkmcnt(" #n ")" ::: "memory")
#define PG8_BAR __builtin_amdgcn_s_barrier()
#define PG8_SCHED __builtin_amdgcn_sched_barrier(0)
    Unit cur, nxt; int ui = 0;
    if (!S.next(0, cur)) return;
    f32x4 acc[2][2][4][2];
#pragma unroll
    for (int a = 0; a < 2; ++a)
#pragma unroll
        for (int b = 0; b < 2; ++b)
#pragma unroll
            for (int m = 0; m < 4; ++m)
#pragma unroll
                for (int n = 0; n < 2; ++n) acc[a][b][m][n] = (f32x4){0.f, 0.f, 0.f, 0.f};
    bf16x8 At[4][2], B0[2][2], B1[2][2];
    const char* cA = S.aptr(cur); const char* cB = S.bptr(cur);
    PG8_STAGE(PG8_SB(0, 0), cB, voffB); PG8_STAGE(PG8_SB(0, 1), cB + hstepB, voffB); PG8_STAGE(PG8_SA(0, 0), cA, voffA); PG8_STAGE(PG8_SA(0, 1), cA + hstepA, voffA);
    if (wr == 1) PG8_BAR;
    PG8_WAIT_V(2); PG8_BAR;
    PG8_STAGE(PG8_SB(1, 0), cB + kstep, voffB); PG8_STAGE(PG8_SA(1, 0), cA + kstep, voffA); PG8_STAGE(PG8_SB(1, 1), cB + hstepB + kstep, voffB);
    PG8_WAIT_V(6); PG8_BAR;
    for (;;) {
        const bool has_next = S.next(ui + 1, nxt);
        const char* nA = has_next ? S.aptr(nxt) : cA; const char* nB = has_next ? S.bptr(nxt) : cB;
#pragma unroll 1
        for (int t = 0; t < nt; t += 2) {
            const bool last = (t == nt - 2);
            const char* a1 = cA + (size_t)(t + 1) * kstep;
            const char* a2 = last ? nA : cA + (size_t)(t + 2) * kstep; const char* b2 = last ? nB : cB + (size_t)(t + 2) * kstep;
            const char* a3 = a2 + kstep; const char* b3 = b2 + kstep;
            PG8_LDB(B0, 0, 0); PG8_LDB(B1, 0, 1); PG8_SCHED; PG8_LDA(At, 0, 0); PG8_STAGE(PG8_SA(1, 1), a1 + hstepA, voffA);
            PG8_WAIT_V(8); PG8_WAIT_L(0); PG8_BAR; PG8_MMA(0, 0, At, B0); PG8_MMA(0, 1, At, B1); PG8_BAR; PG8_SCHED;
            PG8_LDA(At, 0, 1); PG8_STAGE(PG8_SB(0, 0), b2, voffB); PG8_STAGE(PG8_SB(0, 1), b2 + hstepB, voffB); PG8_STAGE(PG8_SA(0, 0), a2, voffA);
            PG8_WAIT_V(8); PG8_WAIT_L(0); PG8_BAR; PG8_MMA(1, 0, At, B0); PG8_MMA(1, 1, At, B1); PG8_BAR; PG8_SCHED;
            PG8_LDB(B0, 1, 0); PG8_LDB(B1, 1, 1); PG8_SCHED; PG8_LDA(At, 1, 0); PG8_STAGE(PG8_SA(0, 1), a2 + hstepA, voffA);
            PG8_WAIT_V(8); PG8_WAIT_L(0); PG8_BAR; PG8_MMA(0, 0, At, B0); PG8_MMA(0, 1, At, B1); PG8_BAR; PG8_SCHED;
            PG8_LDA(At, 1, 1); PG8_STAGE(PG8_SB(1, 0), b3, voffB); PG8_STAGE(PG8_SB(1, 1), b3 + hstepB, voffB); PG8_STAGE(PG8_SA(1, 0), a3, voffA);
            PG8_WAIT_V(8); PG8_WAIT_L(0); PG8_BAR; PG8_MMA(1, 0, At, B0); PG8_MMA(1, 1, At, B1); PG8_BAR; PG8_SCHED;
        }
        if (wr == 0) PG8_BAR;
        E(acc, cur, wr, wc, fr, fq);
        if (!has_next) break;
#pragma unroll
        for (int a = 0; a < 2; ++a)
#pragma unroll
            for (int b = 0; b < 2; ++b)
#pragma unroll
                for (int m = 0; m < 4; ++m)
#pragma unroll
                    for (int n = 0; n < 2; ++n) acc[a][b][m][n] = (f32x4){0.f, 0.f, 0.f, 0.f};
        cur = nxt; cA = nA; cB = nB; ++ui;
        if (wr == 1) PG8_BAR;
    }
    PG8_WAIT_V(0);
    PG8_BAR;
#undef PG8_SA
#undef PG8_SB
#undef PG8_STAGE
#undef PG8_LDA
#undef PG8_LDB
#undef PG8_MMA
#undef PG8_WAIT_V
#undef PG8_WAIT_L
#undef PG8_BAR
#undef PG8_SCHED
}
struct PlainSched : Order {
    const char* A; const char* B; size_t astep, bstep;
    __device__ __forceinline__ void set(const void* A_, int lda, const void* B_, int ldb, int nM_, int nN_) { A = (const char*)A_; B = (const char*)B_; astep = (size_t)BM * lda * 2; bstep = (size_t)BM * ldb * 2; init(nM_, nN_, gridDim.x, blockIdx.x); }
    __device__ __forceinline__ const char* aptr(const Unit& u) const { return A + (size_t)u.pm * astep; }
    __device__ __forceinline__ const char* bptr(const Unit& u) const { return B + (size_t)u.pn * bstep; }
};
}
using pg8::Unit;
typedef const f32x4 (&AccRef)[2][2][4][2];

struct EpiProj {
    static constexpr bool PERM = true;
    const float* rinv; const float* bias; bf16_t *xm, *som, *us, *sga, *sgb;
    __device__ __forceinline__ void operator()(AccRef acc, const Unit& u, int wr, int wc, int fr, int fq) const {
        const int pn = u.pn; bf16_t* base; int ldc, colt; bool sig;
        if (pn < 4) { base = xm; ldc = 1024; colt = pn * 256; sig = false; }
        else if (pn < 8) { base = som; ldc = 1024; colt = (pn - 4) * 256; sig = true; }
        else if (pn < 10) { base = us; ldc = 512; colt = (pn - 8) * 256; sig = false; }
        else if (pn < 14) { base = sga; ldc = 1024; colt = (pn - 10) * 256; sig = true; }
        else { base = sgb; ldc = 1024; colt = (pn - 14) * 256; sig = true; }
        const int row0 = u.pm * 256 + wr * 64 + fr, col0 = colt + wc * 32 + 8 * fq, bcol0 = pn * 256 + wc * 32 + 8 * fq;
        f32x4 bv[2][2];
#pragma unroll
        for (int bj = 0; bj < 2; ++bj)
#pragma unroll
            for (int n = 0; n < 2; ++n) bv[bj][n] = *(const f32x4*)(bias + bcol0 + bj * 128 + 4 * n);
#pragma unroll
        for (int ai = 0; ai < 2; ++ai)
#pragma unroll
            for (int m = 0; m < 4; ++m) { const int row = row0 + ai * 128 + m * 16; const float ri = rinv[row]; bf16_t* rowp = base + (size_t)row * ldc + col0;
#pragma unroll
                for (int bj = 0; bj < 2; ++bj) { f32x4 v0 = acc[ai][bj][m][0] * ri + bv[bj][0], v1 = acc[ai][bj][m][1] * ri + bv[bj][1];
                    if (sig) {
#pragma unroll
                        for (int j = 0; j < 4; ++j) { v0[j] = sigmoidf_(v0[j]); v1[j] = sigmoidf_(v1[j]); } }
                    u32x4 w; w.x = cvt_pk_bf16(v0[0], v0[1]); w.y = cvt_pk_bf16(v0[2], v0[3]); w.z = cvt_pk_bf16(v1[0], v1[1]); w.w = cvt_pk_bf16(v1[2], v1[3]);
                    *(u32x4*)(rowp + bj * 128) = w; } }
    }
};
struct EpiQKV {
    static constexpr bool PERM = true;
    bf16_t *qk, *v;
    __device__ __forceinline__ void operator()(AccRef acc, const Unit& u, int wr, int wc, int fr, int fq) const {
        const int head = u.pn & 3, kind = u.pn >> 2; bf16_t* base = (kind < 2) ? qk + (size_t)kind * T_ * 1024 : v;
        const int row0 = u.pm * 256 + wr * 64 + fr, col0 = head * 256 + wc * 32 + 8 * fq;
#pragma unroll
        for (int ai = 0; ai < 2; ++ai)
#pragma unroll
            for (int m = 0; m < 4; ++m) { bf16_t* rowp = base + (size_t)(row0 + ai * 128 + m * 16) * 1024 + col0;
#pragma unroll
                for (int bj = 0; bj < 2; ++bj) { const f32x4 v0 = acc[ai][bj][m][0], v1 = acc[ai][bj][m][1];
                    u32x4 w; w.x = cvt_pk_bf16(v0[0], v0[1]); w.y = cvt_pk_bf16(v0[2], v0[3]); w.z = cvt_pk_bf16(v1[0], v1[1]); w.w = cvt_pk_bf16(v1[2], v1[3]);
                    *(u32x4*)(rowp + bj * 128) = w; } }
    }
};
template <int MODE> struct EpiGate {
    static constexpr bool PERM = true;
    const bf16_t* X; const bf16_t* Y; const float* bias; bf16_t* O; int ldc;
    __device__ __forceinline__ void operator()(AccRef acc, const Unit& u, int wr, int wc, int fr, int fq) const {
        const int row0 = u.pm * 256 + wr * 64 + fr, col0 = u.pn * 256 + wc * 32 + 8 * fq;
        f32x4 bv[2][2];
#pragma unroll
        for (int bj = 0; bj < 2; ++bj)
#pragma unroll
            for (int n = 0; n < 2; ++n) bv[bj][n] = (MODE == 0) ? *(const f32x4*)(bias + col0 + bj * 128 + 4 * n) : (f32x4){0.f, 0.f, 0.f, 0.f};
#pragma unroll
        for (int ai = 0; ai < 2; ++ai)
#pragma unroll
            for (int m = 0; m < 4; ++m) { const size_t off = (size_t)(row0 + ai * 128 + m * 16) * ldc + col0;
#pragma unroll
                for (int bj = 0; bj < 2; ++bj) {
                    float xv[8], a[8], o[8]; unpack8(*(const u32x4*)(X + off + bj * 128), xv);
#pragma unroll
                    for (int j = 0; j < 4; ++j) { a[j] = acc[ai][bj][m][0][j] + bv[bj][0][j]; a[4 + j] = acc[ai][bj][m][1][j] + bv[bj][1][j]; }
                    if (MODE == 0) {
#pragma unroll
                        for (int j = 0; j < 8; ++j) o[j] = xv[j] * sigmoidf_(a[j]); }
                    else if (MODE == 1) {
#pragma unroll
                        for (int j = 0; j < 8; ++j) o[j] = xv[j] * a[j]; }
                    else { float yv[8]; unpack8(*(const u32x4*)(Y + off + bj * 128), yv);
#pragma unroll
                        for (int j = 0; j < 8; ++j) o[j] = xv[j] * a[j] + yv[j]; }
                    *(u32x4*)(O + off + bj * 128) = pack8(o); } }
    }
};
template <bool WB> struct EpiResid {
    static constexpr bool PERM = false;
    const float* Rs; float* Of; bf16_t* Ob; float* ss;
    __device__ __forceinline__ void operator()(AccRef acc, const Unit& u, int wr, int wc, int fr, int fq) const {
        const int row0 = u.pm * 256 + wr * 64 + fr, col0 = u.pn * 256 + wc * 32 + 4 * fq;
#pragma unroll
        for (int ai = 0; ai < 2; ++ai)
#pragma unroll
            for (int m = 0; m < 4; ++m) { const int row = row0 + ai * 128 + m * 16; const size_t off = (size_t)row * 1024 + col0; float s = 0.f;
#pragma unroll
                for (int bj = 0; bj < 2; ++bj)
#pragma unroll
                    for (int n = 0; n < 2; ++n) { const size_t o2 = off + bj * 128 + n * 16; const f32x4 r = *(const f32x4*)(Rs + o2); const f32x4 v = r + acc[ai][bj][m][n];
                        *(f32x4*)(Of + o2) = v; s += (v[0] * v[0] + v[1] * v[1]) + (v[2] * v[2] + v[3] * v[3]);
                        if (WB) { u32x2 w; w.x = cvt_pk_bf16(v[0], v[1]); w.y = cvt_pk_bf16(v[2], v[3]); *(u32x2*)(Ob + o2) = w; } }
                s += __shfl_xor(s, 16); s += __shfl_xor(s, 32);
                if (fq == 0) ss[(size_t)row * 16 + u.pn * 4 + wc] = s; }
    }
};
struct EpiUp {
    static constexpr bool PERM = true;
    const float* ss; bf16_t* U; int row_off;
    __device__ __forceinline__ void operator()(AccRef acc, const Unit& u, int wr, int wc, int fr, int fq) const {
        const int row0 = u.pm * 256 + wr * 64 + fr, col0 = u.pn * 256 + wc * 32 + 8 * fq;
#pragma unroll
        for (int ai = 0; ai < 2; ++ai)
#pragma unroll
            for (int m = 0; m < 4; ++m) { const int row = row0 + ai * 128 + m * 16; const f32x4* sp = (const f32x4*)(ss + (size_t)(row + row_off) * 16);
                const f32x4 s0 = sp[0], s1 = sp[1], s2 = sp[2], s3 = sp[3]; const f32x4 st = (s0 + s1) + (s2 + s3);
                const float ri = rsqrtf(((st[0] + st[1]) + (st[2] + st[3])) * (1.0f / 1024.0f) + EPS_);
                bf16_t* rowp = U + (size_t)row * F2_ + col0;
#pragma unroll
                for (int bj = 0; bj < 2; ++bj) { const f32x4 v0 = acc[ai][bj][m][0] * ri, v1 = acc[ai][bj][m][1] * ri;
                    u32x4 w; w.x = cvt_pk_bf16(v0[0], v0[1]); w.y = cvt_pk_bf16(v0[2], v0[3]); w.z = cvt_pk_bf16(v1[0], v1[1]); w.w = cvt_pk_bf16(v1[2], v1[3]);
                    *(u32x4*)(rowp + bj * 128) = w; } }
    }
};
struct SchedQKV : pg8::Order {
    const char *xc, *xm, *wqk, *wv;
    __device__ __forceinline__ const char* aptr(const Unit& u) const { const int head = u.pn & 3, kind = u.pn >> 2; return (kind < 2 ? xc : xm) + ((size_t)u.pm * 256 * 1024 + head * 256) * 2; }
    __device__ __forceinline__ const char* bptr(const Unit& u) const { const int head = u.pn & 3, kind = u.pn >> 2; return kind < 2 ? wqk + ((size_t)(head * 512 + kind * 256) * 256) * 2 : wv + ((size_t)head * 65536) * 2; }
};

__device__ __forceinline__ void transpose_item(const float* W, int ldw, int c0, const float* kscale, float scale, bf16_t* WT, int ldt, int row_off, LAS float* scr, int kb, int nb, int lane) {
    const int k0 = 64 * kb, n0 = 32 * nb;
#pragma unroll 8
    for (int i = 0; i < 32; ++i) { const int kk = 2 * i + (lane >> 5); float v = W[(size_t)(k0 + kk) * ldw + c0 + n0 + (lane & 31)] * scale; if (kscale) v *= kscale[k0 + kk]; scr[kk * 33 + (lane & 31)] = v; }
    asm volatile("s_waitcnt lgkmcnt(0)" ::: "memory");
    const int c = lane & 7;
#pragma unroll
    for (int j = 0; j < 4; ++j) { const int n = (lane >> 3) + 8 * j; const LAS float* s = scr + (8 * c) * 33 + n;
        u32x4 o; o.x = cvt_pk_bf16(s[0 * 33], s[1 * 33]); o.y = cvt_pk_bf16(s[2 * 33], s[3 * 33]); o.z = cvt_pk_bf16(s[4 * 33], s[5 * 33]); o.w = cvt_pk_bf16(s[6 * 33], s[7 * 33]);
        *(u32x4*)(WT + (size_t)(row_off + n0 + n) * ldt + k0 + 8 * c) = o; }
    asm volatile("s_waitcnt lgkmcnt(0)" ::: "memory");
}

__device__ __forceinline__ void phase0(const Params& p, LAS unsigned char* lds) {
    const int tid = fresh_tid(), lane = tid & 63, wave = tid >> 6;
    const int gw = blockIdx.x * 8 + wave, NGW = gridDim.x * 8;
    unsigned char* ws = p.ws;
    LAS float* scr = (LAS float*)(lds + wave * 8448);
    LAS float* gwt = (LAS float*)(lds + 8 * 8448);
    { const float* g1 = p.in[1]; const float* w_in = p.in[2];
      for (int i = tid; i < 8192; i += 512) { const int j = i & 7, k = i >> 3; gwt[j * 1024 + k] = g1[k] * w_in[(size_t)k * NIN_ + 2048 + j]; } }
    {
        const int nmat = 20;
        int base = 0;
        for (int mi = 0; mi < nmat; ++mi) {
            const float* W; int ldw, c0, ncols, K; const float* ks = nullptr; float sc = 1.f; bf16_t* WT; int ldt, roff = 0;
            if (mi == 0) { W = p.in[2]; ldw = NIN_; c0 = 0; ncols = 2048; K = 1024; ks = p.in[1]; WT = (bf16_t*)(ws + WS_WIN); ldt = 1024; roff = 0; }
            else if (mi == 1) { W = p.in[2]; ldw = NIN_; c0 = 2056; ncols = 2560; K = 1024; ks = p.in[1]; WT = (bf16_t*)(ws + WS_WIN); ldt = 1024; roff = 2048; }
            else if (mi < 6) { const int h = mi - 2; W = p.in[6] + h * 65536; ldw = 256; c0 = 0; ncols = 256; K = 256; WT = (bf16_t*)(ws + WS_WQK) + h * 512 * 256; ldt = 256; roff = 0; }
            else if (mi < 10) { const int h = mi - 6; W = p.in[7] + h * 65536; ldw = 256; c0 = 0; ncols = 256; K = 256; sc = 0.0625f; WT = (bf16_t*)(ws + WS_WQK) + h * 512 * 256; ldt = 256; roff = 256; }
            else if (mi < 14) { const int h = mi - 10; W = p.in[8] + h * 65536; ldw = 256; c0 = 0; ncols = 256; K = 256; WT = (bf16_t*)(ws + WS_WV) + h * 65536; ldt = 256; roff = 0; }
            else if (mi == 14) { W = p.in[19]; ldw = 512; c0 = 0; ncols = 512; K = 512; WT = (bf16_t*)(ws + WS_WGLU); ldt = 512; }
            else if (mi == 15) { W = p.in[21]; ldw = 1024; c0 = 0; ncols = 1024; K = 1024; WT = (bf16_t*)(ws + WS_WA); ldt = 1024; }
            else if (mi == 16) { W = p.in[22]; ldw = 1024; c0 = 0; ncols = 1024; K = 512; WT = (bf16_t*)(ws + WS_WB); ldt = 512; }
            else if (mi == 17) { W = p.in[23]; ldw = 1024; c0 = 0; ncols = 1024; K = 1024; WT = (bf16_t*)(ws + WS_WOUT); ldt = 1024; }
            else if (mi == 18) { W = p.in[25]; ldw = F2_; c0 = 0; ncols = F2_; K = 1024; ks = p.in[24]; WT = (bf16_t*)(ws + WS_WUP); ldt = 1024; }
            else { W = p.in[28]; ldw = 1024; c0 = 0; ncols = 1024; K = F_; WT = (bf16_t*)(ws + WS_WDN); ldt = F_; }
            const int nblk = ncols / 32, nit = (K / 64) * nblk;
            int it = gw - (base % NGW); if (it < 0) it += NGW;
            for (; it < nit; it += NGW) transpose_item(W, ldw, c0, ks, sc, WT, ldt, roff, scr, it / nblk, it % nblk, lane);
            base += nit;
        }
    }
    {
        const int gt = blockIdx.x * 512 + tid;
        if (gt < SG_ * SP_) {
            const int g = gt >> 6;
            const float ar = p.in[11][gt], ai = p.in[12][gt], dt = expf(p.in[13][g]);
            const float mag = expf(dt * ar); float sn, cs; sincosf(dt * ai, &sn, &cs);
            const float abr = mag * cs, abi = mag * sn;
            const float den = ar * ar + ai * ai, xr = abr - 1.0f, xi = abi;
            const float rre = (xr * ar + xi * ai) / den, rim = (xi * ar - xr * ai) / den;
            float* A = (float*)(ws + WS_S5A); float* A64 = (float*)(ws + WS_S5A64); float* Bb = (float*)(ws + WS_S5B);
            A[gt * 2] = abr; A[gt * 2 + 1] = abi;
            float pr = abr, pi = abi;
#pragma unroll
            for (int i = 0; i < 6; ++i) { const float nr = pr * pr - pi * pi, ni = 2.f * pr * pi; pr = nr; pi = ni; }
            A64[gt * 2] = pr; A64[gt * 2 + 1] = pi;
            const float* bre = p.in[14] + (size_t)gt * 16; const float* bim = p.in[15] + (size_t)gt * 16;
            for (int c = 0; c < 16; ++c) { const float br = bre[c], bi = bim[c]; Bb[((size_t)gt * 16 + c) * 2] = rre * br - rim * bi; Bb[((size_t)gt * 16 + c) * 2 + 1] = rre * bi + rim * br; }
        }
    }
    {
        float* bp = (float*)(ws + WS_BIASP); const float* b_in = p.in[3];
        for (int i = blockIdx.x * 512 + tid; i < NP1_; i += gridDim.x * 512) bp[i] = b_in[i < 2048 ? i : i + 8];
    }
    __syncthreads();
    {
        const float* x = p.in[0]; const float* b_in = p.in[3];
        bf16_t* xb = (bf16_t*)(ws + R0); float* rinv1 = (float*)(ws + WS_RINV1); float* ig = (float*)(ws + WS_IG); float* fg = (float*)(ws + WS_FG);
        for (int row = gw; row < T_; row += NGW) {
            const f32x4* xr = (const f32x4*)(x + (size_t)row * 1024) + lane;
            f32x4 v[4]; float s = 0.f;
#pragma unroll
            for (int j = 0; j < 4; ++j) { v[j] = xr[64 * j]; s += (v[j][0] * v[j][0] + v[j][1] * v[j][1]) + (v[j][2] * v[j][2] + v[j][3] * v[j][3]); }
            float d[8];
#pragma unroll
            for (int g = 0; g < 8; ++g) { float a = 0.f;
#pragma unroll
                for (int j = 0; j < 4; ++j) { const f32x4 w = *(const LAS f32x4*)(gwt + g * 1024 + 256 * j + 4 * lane); a += (v[j][0] * w[0] + v[j][1] * w[1]) + (v[j][2] * w[2] + v[j][3] * w[3]); }
                d[g] = a; }
            s = wave_sum(s);
#pragma unroll
            for (int g = 0; g < 8; ++g) d[g] = wave_sum(d[g]);
            const float ri = rsqrtf(s * (1.0f / 1024.0f) + EPS_);
            u32x2* o8 = (u32x2*)(xb + (size_t)row * 1024) + lane;
#pragma unroll
            for (int j = 0; j < 4; ++j) { u32x2 w; w.x = cvt_pk_bf16(v[j][0], v[j][1]); w.y = cvt_pk_bf16(v[j][2], v[j][3]); o8[64 * j] = w; }
            if (lane == 0) rinv1[row] = ri;
            if (lane < 8) { float val = d[0];
#pragma unroll
                for (int g = 1; g < 8; ++g) val = (lane == g) ? d[g] : val;
                val = val * ri + b_in[2048 + lane];
                if (lane < 4) ig[(size_t)row * 4 + lane] = val; else fg[(size_t)row * 4 + lane - 4] = val; }
        }
    }
}

__device__ __forceinline__ void phase_conv_m(const Params& p) {
    const bf16_t* xm = (const bf16_t*)(p.ws + R1); bf16_t* xc = (bf16_t*)(p.ws + R0);
    const float* cw = p.in[4]; const float* cb = p.in[5];
    const int total = (T_ / 16) * 128;
    for (int idx = blockIdx.x * 512 + fresh_tid(); idx < total; idx += gridDim.x * 512) {
        const int cgi = idx & 127, tb = idx >> 7, c0 = cgi * 8, t0 = tb * 16;
        float w[4][8], b[8];
#pragma unroll
        for (int k = 0; k < 4; ++k) { const f32x4 a = *(const f32x4*)(cw + k * 1024 + c0), bb = *(const f32x4*)(cw + k * 1024 + c0 + 4);
#pragma unroll
            for (int j = 0; j < 4; ++j) { w[k][j] = a[j]; w[k][4 + j] = bb[j]; } }
        { const f32x4 a = *(const f32x4*)(cb + c0), bb = *(const f32x4*)(cb + c0 + 4);
#pragma unroll
          for (int j = 0; j < 4; ++j) { b[j] = a[j]; b[4 + j] = bb[j]; } }
        float r0[8], r1[8], r2[8], r3[8];
        const bool head = (t0 & (SEQ_ - 1)) == 0;
        if (head) {
#pragma unroll
            for (int j = 0; j < 8; ++j) { r0[j] = 0.f; r1[j] = 0.f; r2[j] = 0.f; } }
        else { unpack8(*(const u32x4*)(xm + (size_t)(t0 - 3) * 1024 + c0), r0); unpack8(*(const u32x4*)(xm + (size_t)(t0 - 2) * 1024 + c0), r1); unpack8(*(const u32x4*)(xm + (size_t)(t0 - 1) * 1024 + c0), r2); }
#pragma unroll 4
        for (int i = 0; i < 16; ++i) {
            unpack8(*(const u32x4*)(xm + (size_t)(t0 + i) * 1024 + c0), r3);
            float o[8];
#pragma unroll
            for (int j = 0; j < 8; ++j) { const float y = b[j] + w[0][j] * r0[j] + w[1][j] * r1[j] + w[2][j] * r2[j] + w[3][j] * r3[j]; o[j] = siluf_(y); }
            *(u32x4*)(xc + (size_t)(t0 + i) * 1024 + c0) = pack8(o);
#pragma unroll
            for (int j = 0; j < 8; ++j) { r0[j] = r1[j]; r1[j] = r2[j]; r2[j] = r3[j]; }
        }
    }
}

constexpr int ML_KT = 0, ML_VT = 36864, ML_VTW = 43776, ML_SW = 50688, ML_CB = 59904, ML_SC = 85248;
__device__ __forceinline__ void phase_mlstm(const Params& p, LAS unsigned char* lds) {
    const int tid = fresh_tid(), lane = tid & 63, w = __builtin_amdgcn_readfirstlane(tid >> 6), qi = w & 3, half = w >> 2, lr = lane & 15, lg = lane >> 4;
    const bf16_t* Q = (const bf16_t*)p.out; const bf16_t* Kk = (const bf16_t*)p.out + (size_t)T_ * 1024; const bf16_t* V = (const bf16_t*)(p.ws + R6);
    bf16_t* HC = (bf16_t*)(p.ws + R1);
    const float* IG = (const float*)(p.ws + WS_IG); const float* FG = (const float*)(p.ws + WS_FG);
    LAS bf16_t* kT = (LAS bf16_t*)(lds + ML_KT);
    LAS bf16_t* vT = (LAS bf16_t*)(lds + ML_VT);
    LAS bf16_t* vTw = (LAS bf16_t*)(lds + ML_VTW);
    LAS bf16_t* Sw = (LAS bf16_t*)(lds + ML_SW);
    LAS bf16_t* Cb = (LAS bf16_t*)(lds + ML_CB);
    LAS float* sc_a = (LAS float*)(lds + ML_SC);
    LAS float* sc_M = sc_a + 64, *sc_wi = sc_a + 128, *sc_emr = sc_a + 192, *sc_wk = sc_a + 256, *sc_den = sc_a + 320, *sc_misc = sc_a + 384;
    for (int item = blockIdx.x; item < 256; item += gridDim.x) {
        const int bh = item & 31, vs = item >> 5, b = bh >> 2, h = bh & 3;
        const size_t tok0 = (size_t)b * SEQ_;
        __syncthreads();
        for (int i = tid; i < 48 * 264 / 2; i += 512) ((LAS unsigned*)Cb)[i] = 0u;
        for (int i = tid; i < 2 * 48 * 72 / 2; i += 512) ((LAS unsigned*)vT)[i] = 0u;
        f32x4 Cacc[2][3];
#pragma unroll
        for (int a = 0; a < 2; ++a)
#pragma unroll
            for (int c = 0; c < 3; ++c) Cacc[a][c] = (f32x4){0.f, 0.f, 0.f, 0.f};
        float m_run = 0.f;
        __syncthreads();
        for (int ch = 0; ch < NCH_; ++ch) {
            const size_t tc0 = tok0 + (size_t)ch * 64;
            bf16x8 qf[8], kf[2][8];
            { const bf16_t* qp = Q + (tc0 + 16 * qi + lr) * 1024 + h * 256 + 8 * lg;
#pragma unroll
              for (int ks = 0; ks < 8; ++ks) qf[ks] = *(const bf16x8*)(qp + 32 * ks); }
#pragma unroll
            for (int jj = 0; jj < 2; ++jj) { const bf16_t* kp = Kk + (tc0 + 16 * (2 * half + jj) + lr) * 1024 + h * 256 + 8 * lg;
#pragma unroll
                for (int ks = 0; ks < 8; ++ks) kf[jj][ks] = *(const bf16x8*)(kp + 32 * ks); }
            u32x4 vreg = (u32x4){0u, 0u, 0u, 0u};
            if (tid < 256) vreg = *(const u32x4*)(V + (tc0 + (tid >> 2)) * 1024 + h * 256 + vs * 32 + (tid & 3) * 8);
            if (w == 0) {
                const float fgv = FG[(tc0 + lane) * 4 + h], li = IG[(tc0 + lane) * 4 + h];
                const float lf = fminf(fgv, 0.f) - log1pf(expf(-fabsf(fgv)));
                float bc = lf;
#pragma unroll
                for (int o = 1; o < 64; o <<= 1) { const float t = __shfl_up(bc, o); if (lane >= o) bc += t; }
                const float a = li - bc; float pm = a;
#pragma unroll
                for (int o = 1; o < 64; o <<= 1) { const float t = __shfl_up(pm, o); if (lane >= o) pm = fmaxf(pm, t); }
                const float Mq = fmaxf(m_run, pm);
                const float M63 = __shfl(Mq, 63), b63 = __shfl(bc, 63);
                sc_a[lane] = a; sc_M[lane] = Mq; sc_wi[lane] = expf(m_run - Mq); sc_emr[lane] = expf(-(bc + Mq)); sc_wk[lane] = expf(a - M63);
                if (lane == 0) { sc_misc[0] = expf(m_run - M63); sc_misc[1] = b63 + M63; }
            }
            f32x4 St[2];
#pragma unroll
            for (int jj = 0; jj < 2; ++jj) { St[jj] = (f32x4){0.f, 0.f, 0.f, 0.f};
#pragma unroll
                for (int ks = 0; ks < 8; ++ks) St[jj] = __builtin_amdgcn_mfma_f32_16x16x32_bf16(kf[jj][ks], qf[ks], St[jj], 0, 0, 0); }
#pragma unroll
            for (int jj = 0; jj < 2; ++jj)
#pragma unroll
                for (int k2 = 0; k2 < 2; ++k2) {
                    bf16x8 fragv = kf[jj][0];
#pragma unroll
                    for (int ks = 1; ks < 8; ++ks) if (ks == 2 * qi + k2) fragv = kf[jj][ks];
                    const int c = 16 * (2 * half + jj) + lr, d0 = 32 * (2 * qi + k2) + 8 * lg;
#pragma unroll
                    for (int j = 0; j < 8; ++j) kT[(d0 + j) * 72 + c] = (bf16_t)fragv[j];
                }
            __syncthreads();
            const float decay = sc_misc[0], m_new = sc_misc[1];
#pragma unroll
            for (int jj = 0; jj < 2; ++jj) { const int kt = 2 * half + jj; const int qtok = 16 * qi + lr, k0 = 16 * kt + 4 * lg; const float Mq = sc_M[qtok];
                float o[4];
#pragma unroll
                for (int r = 0; r < 4; ++r) { const int ktok = k0 + r; const float wgt = (ktok <= qtok) ? expf(sc_a[ktok] - Mq) : 0.f; o[r] = St[jj][r] * wgt; }
                u32x2 pk; pk.x = cvt_pk_bf16(o[0], o[1]); pk.y = cvt_pk_bf16(o[2], o[3]);
                *(LAS u32x2*)(Sw + qtok * 72 + k0) = pk; }
            if (tid < 256) { const int c = tid >> 2, v0 = (tid & 3) * 8; float vv[8]; unpack8(vreg, vv); const float wkc = sc_wk[c];
#pragma unroll
                for (int j = 0; j < 8; ++j) { vT[(v0 + j) * 72 + c] = f2bf(vv[j]); vTw[(v0 + j) * 72 + c] = f2bf(vv[j] * wkc); } }
            else if (tid < 320) { const int c = tid - 256; vT[32 * 72 + c] = (bf16_t)0x3f80; vTw[32 * 72 + c] = f2bf(sc_wk[c]); }
            __syncthreads();
            f32x4 num[2]; num[0] = (f32x4){0.f, 0.f, 0.f, 0.f}; num[1] = (f32x4){0.f, 0.f, 0.f, 0.f};
            const int nvt = half == 0 ? 2 : 1, vt0 = half == 0 ? 0 : 2;
#pragma unroll
            for (int i = 0; i < 2; ++i) if (i < nvt) {
                const int vn = vt0 + i;
#pragma unroll
                for (int ks = 0; ks < 8; ++ks) { const bf16x8 cf = *(const LAS bf16x8*)(Cb + (16 * vn + lr) * 264 + 32 * ks + 8 * lg);
                    num[i] = __builtin_amdgcn_mfma_f32_16x16x32_bf16(qf[ks], cf, num[i], 0, 0, 0); }
#pragma unroll
                for (int r = 0; r < 4; ++r) num[i][r] *= sc_wi[16 * qi + 4 * lg + r];
#pragma unroll
                for (int k2 = 0; k2 < 2; ++k2) { const bf16x8 sf = *(const LAS bf16x8*)(Sw + (16 * qi + lr) * 72 + 32 * k2 + 8 * lg);
                    const bf16x8 vf = *(const LAS bf16x8*)(vT + (16 * vn + lr) * 72 + 32 * k2 + 8 * lg);
                    num[i] = __builtin_amdgcn_mfma_f32_16x16x32_bf16(sf, vf, num[i], 0, 0, 0); }
            }
            if (half == 1 && lr == 0) {
#pragma unroll
                for (int r = 0; r < 4; ++r) sc_den[16 * qi + 4 * lg + r] = num[0][r]; }
#pragma unroll
            for (int dm = 0; dm < 2; ++dm) {
                bf16x8 kf2[2];
#pragma unroll
                for (int k2 = 0; k2 < 2; ++k2) kf2[k2] = *(const LAS bf16x8*)(kT + (32 * w + 16 * dm + lr) * 72 + 32 * k2 + 8 * lg);
#pragma unroll
                for (int vn = 0; vn < 3; ++vn) { f32x4 c = Cacc[dm][vn] * decay;
#pragma unroll
                    for (int k2 = 0; k2 < 2; ++k2) { const bf16x8 vf = *(const LAS bf16x8*)(vTw + (16 * vn + lr) * 72 + 32 * k2 + 8 * lg);
                        c = __builtin_amdgcn_mfma_f32_16x16x32_bf16(kf2[k2], vf, c, 0, 0, 0); }
                    Cacc[dm][vn] = c; }
            }
            __syncthreads();
            if (half == 0) {
#pragma unroll
                for (int i = 0; i < 2; ++i)
#pragma unroll
                    for (int r = 0; r < 4; ++r) { const int qt = 16 * qi + 4 * lg + r; const float dn = fmaxf(fabsf(sc_den[qt]), sc_emr[qt]);
                        HC[(tc0 + qt) * 1024 + h * 256 + vs * 32 + 16 * i + lr] = f2bf(num[i][r] / dn); }
            }
#pragma unroll
            for (int dm = 0; dm < 2; ++dm)
#pragma unroll
                for (int vn = 0; vn < 3; ++vn) { const f32x4 c = Cacc[dm][vn]; u32x2 pk; pk.x = cvt_pk_bf16(c[0], c[1]); pk.y = cvt_pk_bf16(c[2], c[3]);
                    *(LAS u32x2*)(Cb + (16 * vn + lr) * 264 + 32 * w + 16 * dm + 4 * lg) = pk; }
            m_run = m_new;
            __syncthreads();
        }
    }
}

__device__ __forceinline__ void phase_aout(const Params& p) {
    const int tid = fresh_tid(), lane = tid & 63, gw = blockIdx.x * 8 + (tid >> 6), NGW = gridDim.x * 8;
    const bf16_t* HC = (const bf16_t*)(p.ws + R1); const bf16_t* SOM = (const bf16_t*)(p.ws + R2); const bf16_t* XC = (const bf16_t*)(p.ws + R0);
    bf16_t* AO = (bf16_t*)(p.ws + R6);
    const float* hg = p.in[9]; const float* sk = p.in[10];
    for (int t = gw; t < T_; t += NGW) {
#pragma unroll
        for (int h = 0; h < 4; ++h) {
            const size_t off = (size_t)t * 1024 + h * 256 + 4 * lane;
            const u32x2 hw = *(const u32x2*)(HC + off), ow = *(const u32x2*)(SOM + off), xw = *(const u32x2*)(XC + off);
            const f32x4 g4 = *(const f32x4*)(hg + h * 256 + 4 * lane), s4 = *(const f32x4*)(sk + h * 256 + 4 * lane);
            float hv[4] = {bflo(hw.x), bfhi(hw.x), bflo(hw.y), bfhi(hw.y)};
            const float ov[4] = {bflo(ow.x), bfhi(ow.x), bflo(ow.y), bfhi(ow.y)}, xv[4] = {bflo(xw.x), bfhi(xw.x), bflo(xw.y), bfhi(xw.y)};
            const float mu = wave_sum((hv[0] + hv[1]) + (hv[2] + hv[3])) * (1.0f / 256.0f);
#pragma unroll
            for (int j = 0; j < 4; ++j) hv[j] -= mu;
            const float var = wave_sum((hv[0] * hv[0] + hv[1] * hv[1]) + (hv[2] * hv[2] + hv[3] * hv[3])) * (1.0f / 256.0f);
            const float rs = rsqrtf(var + EPS_);
            float o[4];
#pragma unroll
            for (int j = 0; j < 4; ++j) o[j] = ov[j] * (hv[j] * rs * g4[j]) + s4[j] * xv[j];
            u32x2 wv; wv.x = cvt_pk_bf16(o[0], o[1]); wv.y = cvt_pk_bf16(o[2], o[3]);
            *(u32x2*)(AO + off) = wv;
        }
    }
}

template <bool PASS_C>
__device__ __forceinline__ void phase_s5(const Params& p, LAS unsigned char* lds) {
    const int tid = fresh_tid(), lane = tid & 63, wave = tid >> 6, gw = blockIdx.x * 8 + wave, NGW = gridDim.x * 8;
    const bf16_t* US = (const bf16_t*)(p.ws + R5);
    const float* A = (const float*)(p.ws + WS_S5A); const float* A64 = (const float*)(p.ws + WS_S5A64); const float* Bb = (const float*)(p.ws + WS_S5B);
    float* E = (float*)(p.ws + WS_E);
    bf16_t* YB = (bf16_t*)(p.ws + R7);
    LAS float* stash = (LAS float*)(lds + wave * 8448);
    for (int item = gw; item < NB_ * NCH_ * SG_; item += NGW) {
        const int g = item & 31, ch = (item >> 5) & 63, b = item >> 11;
        const int gp = g * 64 + lane;
        const size_t tok0 = (size_t)b * SEQ_ + (size_t)ch * 64;
        float bbr[16], bbi[16];
#pragma unroll
        for (int c4 = 0; c4 < 8; ++c4) { const f32x4 v = *(const f32x4*)(Bb + (size_t)gp * 32 + 4 * c4); bbr[2 * c4] = v[0]; bbi[2 * c4] = v[1]; bbr[2 * c4 + 1] = v[2]; bbi[2 * c4 + 1] = v[3]; }
        const float ar = A[gp * 2], ai = A[gp * 2 + 1];
        const u32x4 ua = *(const u32x4*)(US + (tok0 + lane) * 512 + g * 16), ub = *(const u32x4*)(US + (tok0 + lane) * 512 + g * 16 + 8);
        float sr = 0.f, si = 0.f;
        float bk[32];
        if (PASS_C) {
            const float a64r = A64[gp * 2], a64i = A64[gp * 2 + 1];
            const f32x2* Ep = (const f32x2*)E + ((size_t)(b * 64) * 32 + g) * 64 + lane;
            for (int j = 0; j < ch; ++j) { const f32x2 e = Ep[(size_t)j * 32 * 64]; const float nr = a64r * sr - a64i * si + e.x, ni = a64r * si + a64i * sr + e.y; sr = nr; si = ni; }
            const float* cre = p.in[16] + ((size_t)g * 16 + (lane & 15)) * 64 + (lane >> 4); const float* cim = p.in[17] + ((size_t)g * 16 + (lane & 15)) * 64 + (lane >> 4);
#pragma unroll
            for (int kk = 0; kk < 16; ++kk) { bk[kk] = cre[4 * kk]; bk[16 + kk] = -cim[4 * kk]; }
        }
        for (int tb = 0; tb < 4; ++tb) {
#pragma unroll 4
            for (int tt = 0; tt < 16; ++tt) {
                const int t = tb * 16 + tt;
                const unsigned w0 = __builtin_amdgcn_readlane(ua.x, t), w1 = __builtin_amdgcn_readlane(ua.y, t), w2 = __builtin_amdgcn_readlane(ua.z, t), w3 = __builtin_amdgcn_readlane(ua.w, t);
                const unsigned w4 = __builtin_amdgcn_readlane(ub.x, t), w5 = __builtin_amdgcn_readlane(ub.y, t), w6 = __builtin_amdgcn_readlane(ub.z, t), w7 = __builtin_amdgcn_readlane(ub.w, t);
                const float u[16] = {bflo(w0), bfhi(w0), bflo(w1), bfhi(w1), bflo(w2), bfhi(w2), bflo(w3), bfhi(w3), bflo(w4), bfhi(w4), bflo(w5), bfhi(w5), bflo(w6), bfhi(w6), bflo(w7), bfhi(w7)};
                float br = 0.f, bi = 0.f;
#pragma unroll
                for (int c = 0; c < 16; ++c) { br += u[c] * bbr[c]; bi += u[c] * bbi[c]; }
                const float nr = ar * sr - ai * si + br, ni = ar * si + ai * sr + bi; sr = nr; si = ni;
                if (PASS_C) { stash[tt * 132 + lane] = sr; stash[tt * 132 + 64 + lane] = si; }
            }
            if (PASS_C) {
                asm volatile("s_waitcnt lgkmcnt(0)" ::: "memory");
                f32x4 y = (f32x4){0.f, 0.f, 0.f, 0.f};
#pragma unroll
                for (int kk = 0; kk < 32; ++kk) { const float a = stash[(lane & 15) * 132 + 4 * kk + (lane >> 4)]; y = __builtin_amdgcn_mfma_f32_16x16x4f32(a, bk[kk], y, 0, 0, 0); }
                const int c = lane & 15; const float dsk = p.in[18][g * 16 + c];
#pragma unroll
                for (int r = 0; r < 4; ++r) { const size_t tok = tok0 + tb * 16 + 4 * (lane >> 4) + r; const float uu = bf2f(US[tok * 512 + g * 16 + c]);
                    const float v = y[r] + dsk * uu;
                    const float z = 0.7978845608f * (v + 0.044715f * v * v * v); const float th = 1.0f - 2.0f * __builtin_amdgcn_rcpf(1.0f + __expf(2.0f * z));
                    YB[tok * 512 + g * 16 + c] = f2bf(0.5f * v * (1.0f + th)); }
                asm volatile("s_waitcnt lgkmcnt(0)" ::: "memory");
            }
        }
        if (!PASS_C) { f32x2 e; e.x = sr; e.y = si; ((f32x2*)E)[((size_t)(b * 64 + ch) * 32 + g) * 64 + lane] = e; }
    }
}

__device__ __forceinline__ void phase_ffn_act(const Params& p, int half) {
    const bf16_t* U = (const bf16_t*)(p.ws + WS_UH); bf16_t* ACT = (bf16_t*)(p.ws + WS_ACT) + (size_t)half * 16384 * F_;
    const float* cw = p.in[26]; const float* cb = p.in[27];
    const int total = (16384 / 16) * 352;
    for (int idx = blockIdx.x * 512 + fresh_tid(); idx < total; idx += gridDim.x * 512) {
        const int fg = idx % 352, tb = idx / 352, f0 = fg * 8, t0 = tb * 16;
        float wv[3][8], wg[3][8], bvv[8], bgg[8];
#pragma unroll
        for (int k = 0; k < 3; ++k) { const f32x4 a = *(const f32x4*)(cw + k * F2_ + f0), b = *(const f32x4*)(cw + k * F2_ + f0 + 4), c = *(const f32x4*)(cw + k * F2_ + F_ + f0), d = *(const f32x4*)(cw + k * F2_ + F_ + f0 + 4);
#pragma unroll
            for (int j = 0; j < 4; ++j) { wv[k][j] = a[j]; wv[k][4 + j] = b[j]; wg[k][j] = c[j]; wg[k][4 + j] = d[j]; } }
        { const f32x4 a = *(const f32x4*)(cb + f0), b = *(const f32x4*)(cb + f0 + 4), c = *(const f32x4*)(cb + F_ + f0), d = *(const f32x4*)(cb + F_ + f0 + 4);
#pragma unroll
          for (int j = 0; j < 4; ++j) { bvv[j] = a[j]; bvv[4 + j] = b[j]; bgg[j] = c[j]; bgg[4 + j] = d[j]; } }
        float v0[8], v1[8], v2[8], g0[8], g1[8], g2[8];
        const bool head = (t0 & (SEQ_ - 1)) == 0;
        if (head) {
#pragma unroll
            for (int j = 0; j < 8; ++j) { v0[j] = 0.f; v1[j] = 0.f; g0[j] = 0.f; g1[j] = 0.f; } }
        else { unpack8(*(const u32x4*)(U + (size_t)(t0 - 2) * F2_ + f0), v0); unpack8(*(const u32x4*)(U + (size_t)(t0 - 1) * F2_ + f0), v1);
               unpack8(*(const u32x4*)(U + (size_t)(t0 - 2) * F2_ + F_ + f0), g0); unpack8(*(const u32x4*)(U + (size_t)(t0 - 1) * F2_ + F_ + f0), g1); }
#pragma unroll 4
        for (int i = 0; i < 16; ++i) {
            unpack8(*(const u32x4*)(U + (size_t)(t0 + i) * F2_ + f0), v2); unpack8(*(const u32x4*)(U + (size_t)(t0 + i) * F2_ + F_ + f0), g2);
            float o[8];
#pragma unroll
            for (int j = 0; j < 8; ++j) { const float val = bvv[j] + wv[0][j] * v0[j] + wv[1][j] * v1[j] + wv[2][j] * v2[j]; const float gt = bgg[j] + wg[0][j] * g0[j] + wg[1][j] * g1[j] + wg[2][j] * g2[j]; o[j] = siluf_(gt) * val; }
            *(u32x4*)(ACT + (size_t)(t0 + i) * F_ + f0) = pack8(o);
#pragma unroll
            for (int j = 0; j < 8; ++j) { v0[j] = v1[j]; v1[j] = v2[j]; g0[j] = g1[j]; g1[j] = g2[j]; }
        }
    }
}

__device__ __forceinline__ void phase_final(const Params& p) {
    const int tid = fresh_tid(), lane = tid & 63, gw = blockIdx.x * 8 + (tid >> 6), NGW = gridDim.x * 8;
    const float* ss = (const float*)(p.ws + WS_SS2); const float* gf = p.in[29];
    for (int row = gw; row < T_; row += NGW) {
        const float sv = (lane < 16) ? ss[(size_t)row * 16 + lane] : 0.f;
        const float ri = rsqrtf(wave_sum(sv) * (1.0f / 1024.0f) + EPS_);
        f32x4* xr = (f32x4*)(p.out + (size_t)row * 1024) + lane;
#pragma unroll
        for (int j = 0; j < 4; ++j) { const f32x4 g4 = *((const f32x4*)gf + lane + 64 * j); f32x4 v = xr[64 * j]; v = v * ri * g4; xr[64 * j] = v; }
    }
}

#ifndef PHASE_MASK
#define PHASE_MASK 0xffffffffu
#endif
#define PH(k) ((PHASE_MASK >> (k)) & 1u)
__global__ void __launch_bounds__(512, 2) fwd_megakernel(Params p) {
    extern __shared__ __attribute__((aligned(16))) unsigned char lds_raw[];
    LAS unsigned char* lds = (LAS unsigned char*)lds_raw;
    cg::grid_group grid = cg::this_grid();
    unsigned char* ws = p.ws;
    bf16_t* dq = (bf16_t*)p.out;
    if (PH(0)) phase0(p, lds);
    grid.sync();
    if (PH(1)) { pg8::PlainSched S; S.set(ws + R0, 1024, ws + WS_WIN, 1024, T_ / 256, NP1_ / 256);
      EpiProj E{(const float*)(ws + WS_RINV1), (const float*)(ws + WS_BIASP), (bf16_t*)(ws + R1), (bf16_t*)(ws + R2), (bf16_t*)(ws + R5), (bf16_t*)(ws + R3), (bf16_t*)(ws + R4)};
      pg8::gemm_phase(lds, S, E, 1024, 1024, 1024); }
    grid.sync();
    if (PH(2)) phase_conv_m(p);
    grid.sync();
    if (PH(3)) { SchedQKV S; S.init(T_ / 256, 12, gridDim.x, blockIdx.x); S.xc = (const char*)(ws + R0); S.xm = (const char*)(ws + R1); S.wqk = (const char*)(ws + WS_WQK); S.wv = (const char*)(ws + WS_WV);
      EpiQKV E{dq, (bf16_t*)(ws + R6)};
      pg8::gemm_phase(lds, S, E, 256, 1024, 256); }
    grid.sync();
    if (PH(4)) phase_mlstm(p, lds);
    grid.sync();
    if (PH(5)) phase_aout(p);
    if (PH(6)) phase_s5<false>(p, lds);
    grid.sync();
    if (PH(7)) phase_s5<true>(p, lds);
    grid.sync();
    if (PH(8)) { pg8::PlainSched S; S.set(ws + R7, 512, ws + WS_WGLU, 512, T_ / 256, 2);
      EpiGate<0> E{(const bf16_t*)(ws + R7), nullptr, p.in[20], dq, 512};
      pg8::gemm_phase(lds, S, E, 512, 512, 512); }
    grid.sync();
    if (PH(9)) { pg8::PlainSched S; S.set(dq, 512, ws + WS_WB, 512, T_ / 256, 4);
      EpiGate<1> E{(const bf16_t*)(ws + R4), nullptr, nullptr, (bf16_t*)(ws + R1), 1024};
      pg8::gemm_phase(lds, S, E, 512, 512, 512); }
    grid.sync();
    if (PH(10)) { pg8::PlainSched S; S.set(ws + R6, 1024, ws + WS_WA, 1024, T_ / 256, 4);
      EpiGate<2> E{(const bf16_t*)(ws + R3), (const bf16_t*)(ws + R1), nullptr, (bf16_t*)(ws + R0), 1024};
      pg8::gemm_phase(lds, S, E, 1024, 1024, 1024); }
    grid.sync();
    if (PH(11)) { pg8::PlainSched S; S.set(ws + R0, 1024, ws + WS_WOUT, 1024, T_ / 256, 4);
      EpiResid<true> E{p.in[0], p.out, (bf16_t*)(ws + WS_X1B), (float*)(ws + WS_SS1)};
      pg8::gemm_phase(lds, S, E, 1024, 1024, 1024); }
    grid.sync();
    for (int half = 0; half < 2; ++half) {
        if (PH(12)) { pg8::PlainSched S; S.set(ws + WS_X1B + (size_t)half * 16384 * 1024 * 2, 1024, ws + WS_WUP, 1024, 64, F2_ / 256);
          EpiUp E{(const float*)(ws + WS_SS1), (bf16_t*)(ws + WS_UH), half * 16384};
          pg8::gemm_phase(lds, S, E, 1024, 1024, 1024); }
        grid.sync();
        if (PH(13)) phase_ffn_act(p, half);
        grid.sync();
    }
    if (PH(14)) { pg8::PlainSched S; S.set(ws + WS_ACT, F_, ws + WS_WDN, F_, T_ / 256, 4);
      EpiResid<false> E{p.out, p.out, nullptr, (float*)(ws + WS_SS2)};
      pg8::gemm_phase(lds, S, E, F_, F_, F_); }
    grid.sync();
    if (PH(15)) phase_final(p);
}

extern "C" void kernel_launch(void* const* d_in, const int* in_sizes, int n_in, void* d_out, int out_size, void* d_ws, size_t ws_size, hipStream_t stream) {
    static int grid_blocks = 0;
    if (!grid_blocks) {
        int dev = 0, cus = 0, per_cu = 0;
        (void)hipGetDevice(&dev);
        (void)hipDeviceGetAttribute(&cus, hipDeviceAttributeMultiprocessorCount, dev);
        (void)hipFuncSetAttribute((const void*)fwd_megakernel, hipFuncAttributeMaxDynamicSharedMemorySize, LDS_BYTES);
        (void)hipOccupancyMaxActiveBlocksPerMultiprocessor(&per_cu, (const void*)fwd_megakernel, 512, LDS_BYTES);
        if (per_cu < 1) { fprintf(stderr, "kernel_launch: occupancy query returned %d\n", per_cu); }
        grid_blocks = cus;
        if (n_in != 30 || out_size != T_ * D_ || ws_size < 512 * MiB) fprintf(stderr, "kernel_launch: unexpected sizes n_in=%d out=%d ws=%zu\n", n_in, out_size, ws_size);
    }
    Params p{};
    for (int i = 0; i < 30; ++i) p.in[i] = (const float*)d_in[i];
    p.out = (float*)d_out; p.ws = (unsigned char*)d_ws;
    void* args[] = {&p};
    hipError_t e = hipLaunchCooperativeKernel((void*)fwd_megakernel, dim3(grid_blocks), dim3(512), args, LDS_BYTES, stream);
    if (e != hipSuccess) fprintf(stderr, "cooperative launch failed: %s (grid %d)\n", hipGetErrorString(e), grid_blocks);
}
```

```cpp
#include <hip/hip_runtime.h>
#include <hip/hip_cooperative_groups.h>
#include <cstdio>
#include <cstdint>
namespace cg = cooperative_groups;

#define LAS __attribute__((address_space(3)))
typedef unsigned short bf16_t;
typedef short bf16x8 __attribute__((ext_vector_type(8)));
typedef float f32x4 __attribute__((ext_vector_type(4)));
typedef float f32x2 __attribute__((ext_vector_type(2)));
typedef unsigned u32x4 __attribute__((ext_vector_type(4)));
typedef unsigned u32x2 __attribute__((ext_vector_type(2)));

constexpr int T_ = 32768, D_ = 1024, SEQ_ = 4096, NB_ = 8;
constexpr int NH_ = 4, DH_ = 256, NCH_ = 64;
constexpr int SW_ = 512, SG_ = 32, SP_ = 64;
constexpr int F_ = 2816, F2_ = 5632, NIN_ = 4616, NP1_ = 4608;
constexpr float EPS_ = 1e-6f;

constexpr size_t MiB = 1ull << 20, KiB = 1024;
constexpr size_t WS_WIN = 0, WS_WQK = 9 * MiB, WS_WV = 10 * MiB, WS_WGLU = 10 * MiB + 512 * KiB, WS_WA = 11 * MiB, WS_WB = 13 * MiB, WS_WOUT = 14 * MiB,
                 WS_WUP = 16 * MiB, WS_WDN = 27 * MiB;
constexpr size_t WS_S5A = 33 * MiB, WS_S5A64 = WS_S5A + 16 * KiB, WS_S5B = WS_S5A + 32 * KiB;
constexpr size_t WS_RINV1 = 34 * MiB, WS_IG = 34 * MiB + 512 * KiB, WS_FG = 35 * MiB, WS_BIASP = 35 * MiB + 512 * KiB;
constexpr size_t WS_BAR = 49 * MiB;
constexpr size_t WS_SS1 = 36 * MiB, WS_SS2 = 38 * MiB, WS_E = 40 * MiB;
constexpr size_t R0 = 56 * MiB, R1 = 120 * MiB, R2 = 184 * MiB, R3 = 248 * MiB, R4 = 312 * MiB, R5 = 376 * MiB, R6 = 408 * MiB, R7 = 472 * MiB;
constexpr size_t WS_X1B = 448 * MiB, WS_UH = 56 * MiB, WS_ACT = 232 * MiB;
constexpr int LDS_BYTES = 147456;

struct Params {
    const float* in[30];
    float* out;
    unsigned char* ws;
};

__device__ __forceinline__ unsigned cvt_pk_bf16(float lo, float hi) { unsigned r; asm volatile("v_cvt_pk_bf16_f32 %0, %1, %2" : "=v"(r) : "v"(lo), "v"(hi)); return r; }
__device__ __forceinline__ bf16_t f2bf(float x) { return (bf16_t)(cvt_pk_bf16(x, x) & 0xffffu); }
__device__ __forceinline__ float bf2f(unsigned short u) { return __uint_as_float(((unsigned)u) << 16); }
__device__ __forceinline__ float bflo(unsigned w) { return __uint_as_float(w << 16); }
__device__ __forceinline__ float bfhi(unsigned w) { return __uint_as_float(w & 0xffff0000u); }
__device__ __forceinline__ float sigmoidf_(float x) { return __builtin_amdgcn_rcpf(1.0f + __expf(-x)); }
__device__ __forceinline__ float siluf_(float x) { return x * sigmoidf_(x); }
__device__ __forceinline__ int fresh_tid() { int t = threadIdx.x; asm volatile("" : "+v"(t)); return t; }
__device__ __forceinline__ float wave_sum(float v) {
#pragma unroll
    for (int o = 1; o < 64; o <<= 1) v += __shfl_xor(v, o);
    return v;
}
__device__ __forceinline__ void unpack8(const u32x4 w, float (&f)[8]) {
    f[0] = bflo(w.x); f[1] = bfhi(w.x); f[2] = bflo(w.y); f[3] = bfhi(w.y); f[4] = bflo(w.z); f[5] = bfhi(w.z); f[6] = bflo(w.w); f[7] = bfhi(w.w);
}
__device__ __forceinline__ u32x4 pack8(const float (&f)[8]) {
    u32x4 w; w.x = cvt_pk_bf16(f[0], f[1]); w.y = cvt_pk_bf16(f[2], f[3]); w.z = cvt_pk_bf16(f[4], f[5]); w.w = cvt_pk_bf16(f[6], f[7]); return w;
}


#define XB_TMO      128
#define XB_XCNT(j)  (256  + 64 * (j))
#define XB_XSUB(j)  (1280 + 64 * (j))
#define XB_XGEN(j)  (2304 + 64 * (j))
#define XB_TOP      3328
#define XB_TOPGEN   3392
#define XCD_BAR_WORDS 3456
#define XB_SPIN_CAP (1u << 18)
__device__ __forceinline__ unsigned xb_ld(unsigned* p)              { return __hip_atomic_load(p, __ATOMIC_RELAXED, __HIP_MEMORY_SCOPE_AGENT); }
__device__ __forceinline__ unsigned xb_add(unsigned* p, unsigned v) { return __hip_atomic_fetch_add(p, v, __ATOMIC_RELAXED, __HIP_MEMORY_SCOPE_AGENT); }
__device__ __forceinline__ unsigned xb_xcc_id() { return (unsigned)__builtin_amdgcn_s_getreg((3 << 11) | 20) & 0xFu; }
#define XB_SPIN(cond, bar) do { unsigned _sp = 0; while (cond) { __builtin_amdgcn_s_sleep(1); \
    if ((++_sp & 255u) == 0u) { if (xb_ld(&(bar)[XB_TMO])) break; if (_sp > XB_SPIN_CAP) { atomicAdd(&(bar)[XB_TMO], 1u); break; } } } } while (0)
struct XcdBarrier { unsigned* bar; unsigned x; volatile LAS unsigned* st; };
__device__ __forceinline__ XcdBarrier xcd_barrier_post(unsigned* bar, volatile LAS unsigned* st) {
    XcdBarrier b; b.bar = bar; b.x = xb_xcc_id(); b.st = st;
    if (threadIdx.x == 0) (void)xb_add(&bar[XB_XCNT(b.x)], 1u);
    return b;
}
__device__ __forceinline__ void xcd_barrier_complete(unsigned* bar, unsigned x, unsigned& nloc, unsigned& nx) {
    const unsigned G = gridDim.x * gridDim.y * gridDim.z;
    unsigned sum, cnt, mine, sp = 0u;
    for (;;) {
        sum = 0u; cnt = 0u; mine = 0u;
#pragma unroll
        for (unsigned j = 0; j < 16; ++j) { const unsigned c = xb_ld(&bar[XB_XCNT(j)]); sum += c; cnt += (c > 0u) ? 1u : 0u; mine = (j == x) ? c : mine; }
        if (sum == G) break;
        __builtin_amdgcn_s_sleep(1);
        if ((++sp & 255u) == 0u) { if (xb_ld(&bar[XB_TMO])) break; if (sp > XB_SPIN_CAP) { atomicAdd(&bar[XB_TMO], 1u); break; } }
    }
    nloc = mine > 0u ? mine : 1u; nx = cnt > 0u ? cnt : 1u;
}
__device__ __forceinline__ void xcd_barrier(const XcdBarrier& b) {
    asm volatile("s_waitcnt vmcnt(0)" ::: "memory");
    __syncthreads();
    if (threadIdx.x == 0) {
        unsigned* bar = b.bar;
        __builtin_amdgcn_s_waitcnt(0);
        unsigned nloc = b.st[0], nx = b.st[1];
        if (nloc == 0u) { xcd_barrier_complete(bar, b.x, nloc, nx); b.st[0] = nloc; b.st[1] = nx; }
        const unsigned old = xb_add(&bar[XB_XSUB(b.x)], 1u);
        const unsigned gen = old / nloc;
        if (old + 1u == (gen + 1u) * nloc) {
            __builtin_amdgcn_fence(__ATOMIC_RELEASE, "agent");
            asm volatile("s_waitcnt vmcnt(0)" ::: "memory");
            const unsigned og = xb_add(&bar[XB_TOP], 1u);
            const unsigned tg = og / nx;
            if (og + 1u == (tg + 1u) * nx) xb_add(&bar[XB_TOPGEN], 1u);
            else XB_SPIN(xb_ld(&bar[XB_TOPGEN]) == tg, bar);
            __builtin_amdgcn_fence(__ATOMIC_ACQUIRE, "agent");
            xb_add(&bar[XB_XGEN(b.x)], 1u);
            asm volatile("s_waitcnt vmcnt(0)" ::: "memory");
        } else {
            XB_SPIN(xb_ld(&bar[XB_XGEN(b.x)]) == gen, bar);
            __builtin_amdgcn_fence(__ATOMIC_ACQUIRE, "agent");
            asm volatile("s_waitcnt vmcnt(0)" ::: "memory");
        }
    }
    __syncthreads();
}

namespace pg8 {
constexpr int BM = 256, BK = 64, HALF = 128, HTB = HALF * BK * 2, STAGE_BYTES = 8 * HTB, NXCD = 8, WGM = 8;
__device__ __forceinline__ int lds_byte(int r, int c) { const int st = (r >> 4) * 2 + (c >> 5), rr = r & 15, cc = c & 31, ob = rr * 64 + cc * 2; return st * 1024 + (ob ^ (((ob >> 9) & 1) << 5)); }
__device__ __forceinline__ void stage_rc(int b, int& R, int& C) { const int st = b / 1024, sb = b % 1024, swz = sb ^ (((sb >> 9) & 1) << 5); R = (st >> 1) * 16 + swz / 64; C = (st & 1) * 32 + (swz % 64) / 2; }
__device__ __forceinline__ int perm32(int rho) { const int n = rho >> 4, i = rho & 15; return 8 * (i >> 2) + 4 * n + (i & 3); }
struct Unit { int pm, pn; };
struct Order {
    int nM, nN, nwg, G, c;
    __device__ __forceinline__ void init(int nM_, int nN_, int G_, int c_) { nM = nM_; nN = nN_; nwg = nM * nN; G = G_; c = c_; }
    __device__ __forceinline__ bool next(int i, Unit& u) const {
        const long L = (long)i * G + c; if (L >= nwg) return false;
        int wgid = (int)L; { const int q = nwg / NXCD, r = nwg % NXCD, xcd = wgid % NXCD, off = wgid / NXCD; wgid = (xcd < r ? xcd * (q + 1) : r * (q + 1) + (xcd - r) * q) + off; }
        const int nig = WGM * nN, gid = wgid / nig, fm = gid * WGM, gsz = (nM - fm) < WGM ? (nM - fm) : WGM;
        u.pm = fm + ((wgid % nig) % gsz); u.pn = (wgid % nig) / gsz; return true;
    }
};
template <class Epi, class Sched>
__device__ __forceinline__ void gemm_phase(LAS unsigned char* lds, const Sched& S, const Epi& E, const int K, const int lda, const int ldb) {
    const int tid = fresh_tid(), wid = __builtin_amdgcn_readfirstlane(tid >> 6), lane = tid & 63, wr = wid >> 2, wc = wid & 3, fr = lane & 15, fq = lane >> 4;
    const int nt = K / BK;
    unsigned voffA[2], voffB[2];
#pragma unroll
    for (int i = 0; i < 2; ++i) { int R, C; stage_rc(tid * 16 + i * 8192, R, C); const int Rb = Epi::PERM ? ((R & ~31) + perm32(R & 31)) : R;
        voffA[i] = (unsigned)(R * lda + C) * 2u; voffB[i] = (unsigned)(Rb * ldb + C) * 2u; }
    const size_t kstep = (size_t)(BK * 2);
    const size_t hstepA = (size_t)HALF * lda * 2, hstepB = (size_t)HALF * ldb * 2;
    const unsigned ldsw = (unsigned)wid * 1024u;
    const int aoff = lds_byte(wr * 64 + fr, fq * 8), boff = lds_byte(wc * 32 + fr, fq * 8);
#define PG8_SA(b, h) (((b) * 2 + (h)) * HTB)
#define PG8_SB(b, h) ((4 + (b) * 2 + (h)) * HTB)
#define PG8_STAGE(bufoff, gbase, voff) do { _Pragma("unroll") for (int _i = 0; _i < 2; ++_i) \
        __builtin_amdgcn_global_load_lds((const unsigned*)((const char*)(gbase) + (voff)[_i]), (LAS unsigned*)(lds + (bufoff) + ldsw + _i * 8192), 16, 0, 0); } while (0)
#define PG8_LDA(dst, b, h) do { _Pragma("unroll") for (int m = 0; m < 4; ++m) _Pragma("unroll") for (int k = 0; k < 2; ++k) dst[m][k] = *(const LAS bf16x8*)(lds + PG8_SA(b, h) + aoff + m * 2048 + k * 1024); } while (0)
#define PG8_LDB(dst, b, h) do { _Pragma("unroll") for (int n = 0; n < 2; ++n) _Pragma("unroll") for (int k = 0; k < 2; ++k) dst[n][k] = *(const LAS bf16x8*)(lds + PG8_SB(b, h) + boff + n * 2048 + k * 1024); } while (0)
#define PG8_MMA(ai, bj, At, Bt) do { __builtin_amdgcn_s_setprio(1); _Pragma("unroll") for (int m = 0; m < 4; ++m) _Pragma("unroll") for (int n = 0; n < 2; ++n) _Pragma("unroll") for (int k = 0; k < 2; ++k) \
        acc[ai][bj][m][n] = __builtin_amdgcn_mfma_f32_16x16x32_bf16(Bt[n][k], At[m][k], acc[ai][bj][m][n], 0, 0, 0); __builtin_amdgcn_s_setprio(0); } while (0)
#define PG8_WAIT_V(n) asm volatile("s_waitcnt vmcnt(" #n ")" ::: "memory")
#define PG8_WAIT_L(n) asm volatile("s_waitcnt lgkmcnt(" #n ")" ::: "memory")
#define PG8_BAR __builtin_amdgcn_s_barrier()
#define PG8_SCHED __builtin_amdgcn_sched_barrier(0)
    Unit cur, nxt; int ui = 0;
    if (!S.next(0, cur)) return;
    f32x4 acc[2][2][4][2];
#pragma unroll
    for (int a = 0; a < 2; ++a)
#pragma unroll
        for (int b = 0; b < 2; ++b)
#pragma unroll
            for (int m = 0; m < 4; ++m)
#pragma unroll
                for (int n = 0; n < 2; ++n) acc[a][b][m][n] = (f32x4){0.f, 0.f, 0.f, 0.f};
    bf16x8 At[4][2], B0[2][2], B1[2][2];
    const char* cA = S.aptr(cur); const char* cB = S.bptr(cur);
    PG8_STAGE(PG8_SB(0, 0), cB, voffB); PG8_STAGE(PG8_SB(0, 1), cB + hstepB, voffB); PG8_STAGE(PG8_SA(0, 0), cA, voffA); PG8_STAGE(PG8_SA(0, 1), cA + hstepA, voffA);
    if (wr == 1) PG8_BAR;
    PG8_WAIT_V(2); PG8_BAR;
    PG8_STAGE(PG8_SB(1, 0), cB + kstep, voffB); PG8_STAGE(PG8_SA(1, 0), cA + kstep, voffA); PG8_STAGE(PG8_SB(1, 1), cB + hstepB + kstep, voffB);
    PG8_WAIT_V(6); PG8_BAR;
    for (;;) {
        const bool has_next = S.next(ui + 1, nxt);
        const char* nA = has_next ? S.aptr(nxt) : cA; const char* nB = has_next ? S.bptr(nxt) : cB;
#pragma unroll 1
        for (int t = 0; t < nt; t += 2) {
            const bool last = (t == nt - 2);
            const char* a1 = cA + (size_t)(t + 1) * kstep;
            const char* a2 = last ? nA : cA + (size_t)(t + 2) * kstep; const char* b2 = last ? nB : cB + (size_t)(t + 2) * kstep;
            const char* a3 = a2 + kstep; const char* b3 = b2 + kstep;
            PG8_LDB(B0, 0, 0); PG8_LDB(B1, 0, 1); PG8_SCHED; PG8_LDA(At, 0, 0); PG8_STAGE(PG8_SA(1, 1), a1 + hstepA, voffA);
            PG8_WAIT_V(8); PG8_WAIT_L(0); PG8_BAR; PG8_MMA(0, 0, At, B0); PG8_MMA(0, 1, At, B1); PG8_BAR; PG8_SCHED;
            PG8_LDA(At, 0, 1); PG8_STAGE(PG8_SB(0, 0), b2, voffB); PG8_STAGE(PG8_SB(0, 1), b2 + hstepB, voffB); PG8_STAGE(PG8_SA(0, 0), a2, voffA);
            PG8_WAIT_V(8); PG8_WAIT_L(0); PG8_BAR; PG8_MMA(1, 0, At, B0); PG8_MMA(1, 1, At, B1); PG8_BAR; PG8_SCHED;
            PG8_LDB(B0, 1, 0); PG8_LDB(B1, 1, 1); PG8_SCHED; PG8_LDA(At, 1, 0); PG8_STAGE(PG8_SA(0, 1), a2 + hstepA, voffA);
            PG8_WAIT_V(8); PG8_WAIT_L(0); PG8_BAR; PG8_MMA(0, 0, At, B0); PG8_MMA(0, 1, At, B1); PG8_BAR; PG8_SCHED;
            PG8_LDA(At, 1, 1); PG8_STAGE(PG8_SB(1, 0), b3, voffB); PG8_STAGE(PG8_SB(1, 1), b3 + hstepB, voffB); PG8_STAGE(PG8_SA(1, 0), a3, voffA);
            PG8_WAIT_V(8); PG8_WAIT_L(0); PG8_BAR; PG8_MMA(1, 0, At, B0); PG8_MMA(1, 1, At, B1); PG8_BAR; PG8_SCHED;
        }
        if (wr == 0) PG8_BAR;
        E(acc, cur, wr, wc, fr, fq);
        if (!has_next) break;
#pragma unroll
        for (int a = 0; a < 2; ++a)
#pragma unroll
            for (int b = 0; b < 2; ++b)
#pragma unroll
                for (int m = 0; m < 4; ++m)
#pragma unroll
                    for (int n = 0; n < 2; ++n) acc[a][b][m][n] = (f32x4){0.f, 0.f, 0.f, 0.f};
        cur = nxt; cA = nA; cB = nB; ++ui;
        if (wr == 1) PG8_BAR;
    }
    PG8_WAIT_V(0);
    PG8_BAR;
#undef PG8_SA
#undef PG8_SB
#undef PG8_STAGE
#undef PG8_LDA
#undef PG8_LDB
#undef PG8_MMA
#undef PG8_WAIT_V
#undef PG8_WAIT_L
#undef PG8_BAR
#undef PG8_SCHED
}
struct PlainSched : Order {
    const char* A; const char* B; size_t astep, bstep;
    __device__ __forceinline__ void set(const void* A_, int lda, const void* B_, int ldb, int nM_, int nN_) { A = (const char*)A_; B = (const char*)B_; astep = (size_t)BM * lda * 2; bstep = (size_t)BM * ldb * 2; init(nM_, nN_, gridDim.x, blockIdx.x); }
    __device__ __forceinline__ const char* aptr(const Unit& u) const { return A + (size_t)u.pm * astep; }
    __device__ __forceinline__ const char* bptr(const Unit& u) const { return B + (size_t)u.pn * bstep; }
};
}
using pg8::Unit;
typedef const f32x4 (&AccRef)[2][2][4][2];

struct EpiProj {
    static constexpr bool PERM = true;
    const float* rinv; const float* bias; bf16_t *xm, *som, *us, *sga, *sgb;
    __device__ __forceinline__ void operator()(AccRef acc, const Unit& u, int wr, int wc, int fr, int fq) const {
        const int pn = u.pn; bf16_t* base; int ldc, colt; bool sig;
        if (pn < 4) { base = xm; ldc = 1024; colt = pn * 256; sig = false; }
        else if (pn < 8) { base = som; ldc = 1024; colt = (pn - 4) * 256; sig = true; }
        else if (pn < 10) { base = us; ldc = 512; colt = (pn - 8) * 256; sig = false; }
        else if (pn < 14) { base = sga; ldc = 1024; colt = (pn - 10) * 256; sig = true; }
        else { base = sgb; ldc = 1024; colt = (pn - 14) * 256; sig = true; }
        const int row0 = u.pm * 256 + wr * 64 + fr, col0 = colt + wc * 32 + 8 * fq, bcol0 = pn * 256 + wc * 32 + 8 * fq;
        f32x4 bv[2][2];
#pragma unroll
        for (int bj = 0; bj < 2; ++bj)
#pragma unroll
            for (int n = 0; n < 2; ++n) bv[bj][n] = *(const f32x4*)(bias + bcol0 + bj * 128 + 4 * n);
#pragma unroll
        for (int ai = 0; ai < 2; ++ai)
#pragma unroll
            for (int m = 0; m < 4; ++m) { const int row = row0 + ai * 128 + m * 16; const float ri = rinv[row]; bf16_t* rowp = base + (size_t)row * ldc + col0;
#pragma unroll
                for (int bj = 0; bj < 2; ++bj) { f32x4 v0 = acc[ai][bj][m][0] * ri + bv[bj][0], v1 = acc[ai][bj][m][1] * ri + bv[bj][1];
                    if (sig) {
#pragma unroll
                        for (int j = 0; j < 4; ++j) { v0[j] = sigmoidf_(v0[j]); v1[j] = sigmoidf_(v1[j]); } }
                    u32x4 w; w.x = cvt_pk_bf16(v0[0], v0[1]); w.y = cvt_pk_bf16(v0[2], v0[3]); w.z = cvt_pk_bf16(v1[0], v1[1]); w.w = cvt_pk_bf16(v1[2], v1[3]);
                    *(u32x4*)(rowp + bj * 128) = w; } }
    }
};
struct EpiQKV {
    static constexpr bool PERM = true;
    bf16_t *qk, *v;
    __device__ __forceinline__ void operator()(AccRef acc, const Unit& u, int wr, int wc, int fr, int fq) const {
        const int head = u.pn & 3, kind = u.pn >> 2; bf16_t* base = (kind < 2) ? qk + (size_t)kind * T_ * 1024 : v;
        const int row0 = u.pm * 256 + wr * 64 + fr, col0 = head * 256 + wc * 32 + 8 * fq;
#pragma unroll
        for (int ai = 0; ai < 2; ++ai)
#pragma unroll
            for (int m = 0; m < 4; ++m) { bf16_t* rowp = base + (size_t)(row0 + ai * 128 + m * 16) * 1024 + col0;
#pragma unroll
                for (int bj = 0; bj < 2; ++bj) { const f32x4 v0 = acc[ai][bj][m][0], v1 = acc[ai][bj][m][1];
                    u32x4 w; w.x = cvt_pk_bf16(v0[0], v0[1]); w.y = cvt_pk_bf16(v0[2], v0[3]); w.z = cvt_pk_bf16(v1[0], v1[1]); w.w = cvt_pk_bf16(v1[2], v1[3]);
                    *(u32x4*)(rowp + bj * 128) = w; } }
    }
};
template <int MODE> struct EpiGate {
    static constexpr bool PERM = true;
    const bf16_t* X; const bf16_t* Y; const float* bias; bf16_t* O; int ldc;
    __device__ __forceinline__ void operator()(AccRef acc, const Unit& u, int wr, int wc, int fr, int fq) const {
        const int row0 = u.pm * 256 + wr * 64 + fr, col0 = u.pn * 256 + wc * 32 + 8 * fq;
        f32x4 bv[2][2];
#pragma unroll
        for (int bj = 0; bj < 2; ++bj)
#pragma unroll
            for (int n = 0; n < 2; ++n) bv[bj][n] = (MODE == 0) ? *(const f32x4*)(bias + col0 + bj * 128 + 4 * n) : (f32x4){0.f, 0.f, 0.f, 0.f};
#pragma unroll
        for (int ai = 0; ai < 2; ++ai)
#pragma unroll
            for (int m = 0; m < 4; ++m) { const size_t off = (size_t)(row0 + ai * 128 + m * 16) * ldc + col0;
#pragma unroll
                for (int bj = 0; bj < 2; ++bj) {
                    float xv[8], a[8], o[8]; unpack8(*(const u32x4*)(X + off + bj * 128), xv);
#pragma unroll
                    for (int j = 0; j < 4; ++j) { a[j] = acc[ai][bj][m][0][j] + bv[bj][0][j]; a[4 + j] = acc[ai][bj][m][1][j] + bv[bj][1][j]; }
                    if (MODE == 0) {
#pragma unroll
                        for (int j = 0; j < 8; ++j) o[j] = xv[j] * sigmoidf_(a[j]); }
                    else if (MODE == 1) {
#pragma unroll
                        for (int j = 0; j < 8; ++j) o[j] = xv[j] * a[j]; }
                    else { float yv[8]; unpack8(*(const u32x4*)(Y + off + bj * 128), yv);
#pragma unroll
                        for (int j = 0; j < 8; ++j) o[j] = xv[j] * a[j] + yv[j]; }
                    *(u32x4*)(O + off + bj * 128) = pack8(o); } }
    }
};
template <bool WB> struct EpiResid {
    static constexpr bool PERM = false;
    const float* Rs; float* Of; bf16_t* Ob; float* ss;
    __device__ __forceinline__ void operator()(AccRef acc, const Unit& u, int wr, int wc, int fr, int fq) const {
        const int row0 = u.pm * 256 + wr * 64 + fr, col0 = u.pn * 256 + wc * 32 + 4 * fq;
#pragma unroll
        for (int ai = 0; ai < 2; ++ai)
#pragma unroll
            for (int m = 0; m < 4; ++m) { const int row = row0 + ai * 128 + m * 16; const size_t off = (size_t)row * 1024 + col0; float s = 0.f;
#pragma unroll
                for (int bj = 0; bj < 2; ++bj)
#pragma unroll
                    for (int n = 0; n < 2; ++n) { const size_t o2 = off + bj * 128 + n * 16; const f32x4 r = *(const f32x4*)(Rs + o2); const f32x4 v = r + acc[ai][bj][m][n];
                        *(f32x4*)(Of + o2) = v; s += (v[0] * v[0] + v[1] * v[1]) + (v[2] * v[2] + v[3] * v[3]);
                        if (WB) { u32x2 w; w.x = cvt_pk_bf16(v[0], v[1]); w.y = cvt_pk_bf16(v[2], v[3]); *(u32x2*)(Ob + o2) = w; } }
                s += __shfl_xor(s, 16); s += __shfl_xor(s, 32);
                if (fq == 0) ss[(size_t)row * 16 + u.pn * 4 + wc] = s; }
    }
};
struct EpiUp {
    static constexpr bool PERM = true;
    const float* ss; bf16_t* U; int row_off;
    __device__ __forceinline__ void operator()(AccRef acc, const Unit& u, int wr, int wc, int fr, int fq) const {
        const int row0 = u.pm * 256 + wr * 64 + fr, col0 = u.pn * 256 + wc * 32 + 8 * fq;
#pragma unroll
        for (int ai = 0; ai < 2; ++ai)
#pragma unroll
            for (int m = 0; m < 4; ++m) { const int row = row0 + ai * 128 + m * 16; const f32x4* sp = (const f32x4*)(ss + (size_t)(row + row_off) * 16);
                const f32x4 s0 = sp[0], s1 = sp[1], s2 = sp[2], s3 = sp[3]; const f32x4 st = (s0 + s1) + (s2 + s3);
                const float ri = rsqrtf(((st[0] + st[1]) + (st[2] + st[3])) * (1.0f / 1024.0f) + EPS_);
                bf16_t* rowp = U + (size_t)row * F2_ + col0;
#pragma unroll
                for (int bj = 0; bj < 2; ++bj) { const f32x4 v0 = acc[ai][bj][m][0] * ri, v1 = acc[ai][bj][m][1] * ri;
                    u32x4 w; w.x = cvt_pk_bf16(v0[0], v0[1]); w.y = cvt_pk_bf16(v0[2], v0[3]); w.z = cvt_pk_bf16(v1[0], v1[1]); w.w = cvt_pk_bf16(v1[2], v1[3]);
                    *(u32x4*)(rowp + bj * 128) = w; } }
    }
};
struct SchedQKV : pg8::Order {
    const char *xc, *xm, *wqk, *wv;
    __device__ __forceinline__ const char* aptr(const Unit& u) const { const int head = u.pn & 3, kind = u.pn >> 2; return (kind < 2 ? xc : xm) + ((size_t)u.pm * 256 * 1024 + head * 256) * 2; }
    __device__ __forceinline__ const char* bptr(const Unit& u) const { const int head = u.pn & 3, kind = u.pn >> 2; return kind < 2 ? wqk + ((size_t)(head * 512 + kind * 256) * 256) * 2 : wv + ((size_t)head * 65536) * 2; }
};

__device__ __forceinline__ void transpose_item(const float* W, int ldw, int c0, const float* kscale, float scale, bf16_t* WT, int ldt, int row_off, LAS float* scr, int kb, int nb, int lane) {
    const int k0 = 64 * kb, n0 = 32 * nb;
#pragma unroll 8
    for (int i = 0; i < 32; ++i) { const int kk = 2 * i + (lane >> 5); float v = W[(size_t)(k0 + kk) * ldw + c0 + n0 + (lane & 31)] * scale; if (kscale) v *= kscale[k0 + kk]; scr[kk * 33 + (lane & 31)] = v; }
    asm volatile("s_waitcnt lgkmcnt(0)" ::: "memory");
    const int c = lane & 7;
#pragma unroll
    for (int j = 0; j < 4; ++j) { const int n = (lane >> 3) + 8 * j; const LAS float* s = scr + (8 * c) * 33 + n;
        u32x4 o; o.x = cvt_pk_bf16(s[0 * 33], s[1 * 33]); o.y = cvt_pk_bf16(s[2 * 33], s[3 * 33]); o.z = cvt_pk_bf16(s[4 * 33], s[5 * 33]); o.w = cvt_pk_bf16(s[6 * 33], s[7 * 33]);
        *(u32x4*)(WT + (size_t)(row_off + n0 + n) * ldt + k0 + 8 * c) = o; }
    asm volatile("s_waitcnt lgkmcnt(0)" ::: "memory");
}

__device__ __forceinline__ void phase0(const Params& p, LAS unsigned char* lds) {
    const int tid = fresh_tid(), lane = tid & 63, wave = tid >> 6;
    const int gw = blockIdx.x * 8 + wave, NGW = gridDim.x * 8;
    unsigned char* ws = p.ws;
    LAS float* scr = (LAS float*)(lds + wave * 8448);
    LAS float* gwt = (LAS float*)(lds + 8 * 8448);
    { const float* g1 = p.in[1]; const float* w_in = p.in[2];
      for (int i = tid; i < 8192; i += 512) { const int j = i & 7, k = i >> 3; gwt[j * 1024 + k] = g1[k] * w_in[(size_t)k * NIN_ + 2048 + j]; } }
    {
        const int nmat = 20;
        int base = 0;
        for (int mi = 0; mi < nmat; ++mi) {
            const float* W; int ldw, c0, ncols, K; const float* ks = nullptr; float sc = 1.f; bf16_t* WT; int ldt, roff = 0;
            if (mi == 0) { W = p.in[2]; ldw = NIN_; c0 = 0; ncols = 2048; K = 1024; ks = p.in[1]; WT = (bf16_t*)(ws + WS_WIN); ldt = 1024; roff = 0; }
            else if (mi == 1) { W = p.in[2]; ldw = NIN_; c0 = 2056; ncols = 2560; K = 1024; ks = p.in[1]; WT = (bf16_t*)(ws + WS_WIN); ldt = 1024; roff = 2048; }
            else if (mi < 6) { const int h = mi - 2; W = p.in[6] + h * 65536; ldw = 256; c0 = 0; ncols = 256; K = 256; WT = (bf16_t*)(ws + WS_WQK) + h * 512 * 256; ldt = 256; roff = 0; }
            else if (mi < 10) { const int h = mi - 6; W = p.in[7] + h * 65536; ldw = 256; c0 = 0; ncols = 256; K = 256; sc = 0.0625f; WT = (bf16_t*)(ws + WS_WQK) + h * 512 * 256; ldt = 256; roff = 256; }
            else if (mi < 14) { const int h = mi - 10; W = p.in[8] + h * 65536; ldw = 256; c0 = 0; ncols = 256; K = 256; WT = (bf16_t*)(ws + WS_WV) + h * 65536; ldt = 256; roff = 0; }
            else if (mi == 14) { W = p.in[19]; ldw = 512; c0 = 0; ncols = 512; K = 512; WT = (bf16_t*)(ws + WS_WGLU); ldt = 512; }
            else if (mi == 15) { W = p.in[21]; ldw = 1024; c0 = 0; ncols = 1024; K = 1024; WT = (bf16_t*)(ws + WS_WA); ldt = 1024; }
            else if (mi == 16) { W = p.in[22]; ldw = 1024; c0 = 0; ncols = 1024; K = 512; WT = (bf16_t*)(ws + WS_WB); ldt = 512; }
            else if (mi == 17) { W = p.in[23]; ldw = 1024; c0 = 0; ncols = 1024; K = 1024; WT = (bf16_t*)(ws + WS_WOUT); ldt = 1024; }
            else if (mi == 18) { W = p.in[25]; ldw = F2_; c0 = 0; ncols = F2_; K = 1024; ks = p.in[24]; WT = (bf16_t*)(ws + WS_WUP); ldt = 1024; }
            else { W = p.in[28]; ldw = 1024; c0 = 0; ncols = 1024; K = F_; WT = (bf16_t*)(ws + WS_WDN); ldt = F_; }
            const int nblk = ncols / 32, nit = (K / 64) * nblk;
            int it = gw - (base % NGW); if (it < 0) it += NGW;
            for (; it < nit; it += NGW) transpose_item(W, ldw, c0, ks, sc, WT, ldt, roff, scr, it / nblk, it % nblk, lane);
            base += nit;
        }
    }
    {
        const int gt = blockIdx.x * 512 + tid;
        if (gt < SG_ * SP_) {
            const int g = gt >> 6;
            const float ar = p.in[11][gt], ai = p.in[12][gt], dt = expf(p.in[13][g]);
            const float mag = expf(dt * ar); float sn, cs; sincosf(dt * ai, &sn, &cs);
            const float abr = mag * cs, abi = mag * sn;
            const float den = ar * ar + ai * ai, xr = abr - 1.0f, xi = abi;
            const float rre = (xr * ar + xi * ai) / den, rim = (xi * ar - xr * ai) / den;
            float* A = (float*)(ws + WS_S5A); float* A64 = (float*)(ws + WS_S5A64); float* Bb = (float*)(ws + WS_S5B);
            A[gt * 2] = abr; A[gt * 2 + 1] = abi;
            float pr = abr, pi = abi;
#pragma unroll
            for (int i = 0; i < 6; ++i) { const float nr = pr * pr - pi * pi, ni = 2.f * pr * pi; pr = nr; pi = ni; }
            A64[gt * 2] = pr; A64[gt * 2 + 1] = pi;
            const float* bre = p.in[14] + (size_t)gt * 16; const float* bim = p.in[15] + (size_t)gt * 16;
            for (int c = 0; c < 16; ++c) { const float br = bre[c], bi = bim[c]; Bb[((size_t)gt * 16 + c) * 2] = rre * br - rim * bi; Bb[((size_t)gt * 16 + c) * 2 + 1] = rre * bi + rim * br; }
        }
    }
    {
        float* bp = (float*)(ws + WS_BIASP); const float* b_in = p.in[3];
        for (int i = blockIdx.x * 512 + tid; i < NP1_; i += gridDim.x * 512) bp[i] = b_in[i < 2048 ? i : i + 8];
    }
    __syncthreads();
    {
        const float* x = p.in[0]; const float* b_in = p.in[3];
        bf16_t* xb = (bf16_t*)(ws + R0); float* rinv1 = (float*)(ws + WS_RINV1); float* ig = (float*)(ws + WS_IG); float* fg = (float*)(ws + WS_FG);
        for (int row = gw; row < T_; row += NGW) {
            const f32x4* xr = (const f32x4*)(x + (size_t)row * 1024) + lane;
            f32x4 v[4]; float s = 0.f;
#pragma unroll
            for (int j = 0; j < 4; ++j) { v[j] = xr[64 * j]; s += (v[j][0] * v[j][0] + v[j][1] * v[j][1]) + (v[j][2] * v[j][2] + v[j][3] * v[j][3]); }
            float d[8];
#pragma unroll
            for (int g = 0; g < 8; ++g) { float a = 0.f;
#pragma unroll
                for (int j = 0; j < 4; ++j) { const f32x4 w = *(const LAS f32x4*)(gwt + g * 1024 + 256 * j + 4 * lane); a += (v[j][0] * w[0] + v[j][1] * w[1]) + (v[j][2] * w[2] + v[j][3] * w[3]); }
                d[g] = a; }
            s = wave_sum(s);
#pragma unroll
            for (int g = 0; g < 8; ++g) d[g] = wave_sum(d[g]);
            const float ri = rsqrtf(s * (1.0f / 1024.0f) + EPS_);
            u32x2* o8 = (u32x2*)(xb + (size_t)row * 1024) + lane;
#pragma unroll
            for (int j = 0; j < 4; ++j) { u32x2 w; w.x = cvt_pk_bf16(v[j][0], v[j][1]); w.y = cvt_pk_bf16(v[j][2], v[j][3]); o8[64 * j] = w; }
            if (lane == 0) rinv1[row] = ri;
            if (lane < 8) { float val = d[0];
#pragma unroll
                for (int g = 1; g < 8; ++g) val = (lane == g) ? d[g] : val;
                val = val * ri + b_in[2048 + lane];
                if (lane < 4) ig[(size_t)row * 4 + lane] = val; else fg[(size_t)row * 4 + lane - 4] = val; }
        }
    }
}

__device__ __forceinline__ void phase_conv_m(const Params& p) {
    const bf16_t* xm = (const bf16_t*)(p.ws + R1); bf16_t* xc = (bf16_t*)(p.ws + R0);
    const float* cw = p.in[4]; const float* cb = p.in[5];
    const int total = (T_ / 16) * 128;
    for (int idx = blockIdx.x * 512 + fresh_tid(); idx < total; idx += gridDim.x * 512) {
        const int cgi = idx & 127, tb = idx >> 7, c0 = cgi * 8, t0 = tb * 16;
        float w[4][8], b[8];
#pragma unroll
        for (int k = 0; k < 4; ++k) { const f32x4 a = *(const f32x4*)(cw + k * 1024 + c0), bb = *(const f32x4*)(cw + k * 1024 + c0 + 4);
#pragma unroll
            for (int j = 0; j < 4; ++j) { w[k][j] = a[j]; w[k][4 + j] = bb[j]; } }
        { const f32x4 a = *(const f32x4*)(cb + c0), bb = *(const f32x4*)(cb + c0 + 4);
#pragma unroll
          for (int j = 0; j < 4; ++j) { b[j] = a[j]; b[4 + j] = bb[j]; } }
        float r0[8], r1[8], r2[8], r3[8];
        const bool head = (t0 & (SEQ_ - 1)) == 0;
        if (head) {
#pragma unroll
            for (int j = 0; j < 8; ++j) { r0[j] = 0.f; r1[j] = 0.f; r2[j] = 0.f; } }
        else { unpack8(*(const u32x4*)(xm + (size_t)(t0 - 3) * 1024 + c0), r0); unpack8(*(const u32x4*)(xm + (size_t)(t0 - 2) * 1024 + c0), r1); unpack8(*(const u32x4*)(xm + (size_t)(t0 - 1) * 1024 + c0), r2); }
#pragma unroll 4
        for (int i = 0; i < 16; ++i) {
            unpack8(*(const u32x4*)(xm + (size_t)(t0 + i) * 1024 + c0), r3);
            float o[8];
#pragma unroll
            for (int j = 0; j < 8; ++j) { const float y = b[j] + w[0][j] * r0[j] + w[1][j] * r1[j] + w[2][j] * r2[j] + w[3][j] * r3[j]; o[j] = siluf_(y); }
            *(u32x4*)(xc + (size_t)(t0 + i) * 1024 + c0) = pack8(o);
#pragma unroll
            for (int j = 0; j < 8; ++j) { r0[j] = r1[j]; r1[j] = r2[j]; r2[j] = r3[j]; }
        }
    }
}

constexpr int ML_KT = 0, ML_VT = 36864, ML_VTW = 43776, ML_SW = 50688, ML_CB = 59904, ML_SC = 85248;
__device__ __forceinline__ void phase_mlstm(const Params& p, LAS unsigned char* lds) {
    const int tid = fresh_tid(), lane = tid & 63, w = __builtin_amdgcn_readfirstlane(tid >> 6), qi = w & 3, half = w >> 2, lr = lane & 15, lg = lane >> 4;
    const bf16_t* Q = (const bf16_t*)p.out; const bf16_t* Kk = (const bf16_t*)p.out + (size_t)T_ * 1024; const bf16_t* V = (const bf16_t*)(p.ws + R6);
    bf16_t* HC = (bf16_t*)(p.ws + R1);
    const float* IG = (const float*)(p.ws + WS_IG); const float* FG = (const float*)(p.ws + WS_FG);
    LAS bf16_t* kT = (LAS bf16_t*)(lds + ML_KT);
    LAS bf16_t* vT = (LAS bf16_t*)(lds + ML_VT);
    LAS bf16_t* vTw = (LAS bf16_t*)(lds + ML_VTW);
    LAS bf16_t* Sw = (LAS bf16_t*)(lds + ML_SW);
    LAS bf16_t* Cb = (LAS bf16_t*)(lds + ML_CB);
    LAS float* sc_a = (LAS float*)(lds + ML_SC);
    LAS float* sc_M = sc_a + 64, *sc_wi = sc_a + 128, *sc_emr = sc_a + 192, *sc_wk = sc_a + 256, *sc_den = sc_a + 320, *sc_misc = sc_a + 384;
    for (int item = blockIdx.x; item < 256; item += gridDim.x) {
        const int bh = item & 31, vs = item >> 5, b = bh >> 2, h = bh & 3;
        const size_t tok0 = (size_t)b * SEQ_;
        __syncthreads();
        for (int i = tid; i < 48 * 264 / 2; i += 512) ((LAS unsigned*)Cb)[i] = 0u;
        for (int i = tid; i < 2 * 48 * 72 / 2; i += 512) ((LAS unsigned*)vT)[i] = 0u;
        f32x4 Cacc[2][3];
#pragma unroll
        for (int a = 0; a < 2; ++a)
#pragma unroll
            for (int c = 0; c < 3; ++c) Cacc[a][c] = (f32x4){0.f, 0.f, 0.f, 0.f};
        float m_run = 0.f;
        __syncthreads();
        for (int ch = 0; ch < NCH_; ++ch) {
            const size_t tc0 = tok0 + (size_t)ch * 64;
            bf16x8 qf[8], kf[2][8];
            { const bf16_t* qp = Q + (tc0 + 16 * qi + lr) * 1024 + h * 256 + 8 * lg;
#pragma unroll
              for (int ks = 0; ks < 8; ++ks) qf[ks] = *(const bf16x8*)(qp + 32 * ks); }
#pragma unroll
            for (int jj = 0; jj < 2; ++jj) { const bf16_t* kp = Kk + (tc0 + 16 * (2 * half + jj) + lr) * 1024 + h * 256 + 8 * lg;
#pragma unroll
                for (int ks = 0; ks < 8; ++ks) kf[jj][ks] = *(const bf16x8*)(kp + 32 * ks); }
            u32x4 vreg = (u32x4){0u, 0u, 0u, 0u};
            if (tid < 256) vreg = *(const u32x4*)(V + (tc0 + (tid >> 2)) * 1024 + h * 256 + vs * 32 + (tid & 3) * 8);
            if (w == 0) {
                const float fgv = FG[(tc0 + lane) * 4 + h], li = IG[(tc0 + lane) * 4 + h];
                const float lf = fminf(fgv, 0.f) - log1pf(expf(-fabsf(fgv)));
                float bc = lf;
#pragma unroll
                for (int o = 1; o < 64; o <<= 1) { const float t = __shfl_up(bc, o); if (lane >= o) bc += t; }
                const float a = li - bc; float pm = a;
#pragma unroll
                for (int o = 1; o < 64; o <<= 1) { const float t = __shfl_up(pm, o); if (lane >= o) pm = fmaxf(pm, t); }
                const float Mq = fmaxf(m_run, pm);
                const float M63 = __shfl(Mq, 63), b63 = __shfl(bc, 63);
                sc_a[lane] = a; sc_M[lane] = Mq; sc_wi[lane] = expf(m_run - Mq); sc_emr[lane] = expf(-(bc + Mq)); sc_wk[lane] = expf(a - M63);
                if (lane == 0) { sc_misc[0] = expf(m_run - M63); sc_misc[1] = b63 + M63; }
            }
            f32x4 St[2];
#pragma unroll
            for (int jj = 0; jj < 2; ++jj) { St[jj] = (f32x4){0.f, 0.f, 0.f, 0.f};
#pragma unroll
                for (int ks = 0; ks < 8; ++ks) St[jj] = __builtin_amdgcn_mfma_f32_16x16x32_bf16(kf[jj][ks], qf[ks], St[jj], 0, 0, 0); }
#pragma unroll
            for (int jj = 0; jj < 2; ++jj)
#pragma unroll
                for (int k2 = 0; k2 < 2; ++k2) {
                    bf16x8 fragv = kf[jj][0];
#pragma unroll
                    for (int ks = 1; ks < 8; ++ks) if (ks == 2 * qi + k2) fragv = kf[jj][ks];
                    const int c = 16 * (2 * half + jj) + lr, d0 = 32 * (2 * qi + k2) + 8 * lg;
#pragma unroll
                    for (int j = 0; j < 8; ++j) kT[(d0 + j) * 72 + c] = (bf16_t)fragv[j];
                }
            __syncthreads();
            const float decay = sc_misc[0], m_new = sc_misc[1];
#pragma unroll
            for (int jj = 0; jj < 2; ++jj) { const int kt = 2 * half + jj; const int qtok = 16 * qi + lr, k0 = 16 * kt + 4 * lg; const float Mq = sc_M[qtok];
                float o[4];
#pragma unroll
                for (int r = 0; r < 4; ++r) { const int ktok = k0 + r; const float wgt = (ktok <= qtok) ? expf(sc_a[ktok] - Mq) : 0.f; o[r] = St[jj][r] * wgt; }
                u32x2 pk; pk.x = cvt_pk_bf16(o[0], o[1]); pk.y = cvt_pk_bf16(o[2], o[3]);
                *(LAS u32x2*)(Sw + qtok * 72 + k0) = pk; }
            if (tid < 256) { const int c = tid >> 2, v0 = (tid & 3) * 8; float vv[8]; unpack8(vreg, vv); const float wkc = sc_wk[c];
#pragma unroll
                for (int j = 0; j < 8; ++j) { vT[(v0 + j) * 72 + c] = f2bf(vv[j]); vTw[(v0 + j) * 72 + c] = f2bf(vv[j] * wkc); } }
            else if (tid < 320) { const int c = tid - 256; vT[32 * 72 + c] = (bf16_t)0x3f80; vTw[32 * 72 + c] = f2bf(sc_wk[c]); }
            __syncthreads();
            f32x4 num[2]; num[0] = (f32x4){0.f, 0.f, 0.f, 0.f}; num[1] = (f32x4){0.f, 0.f, 0.f, 0.f};
            const int nvt = half == 0 ? 2 : 1, vt0 = half == 0 ? 0 : 2;
#pragma unroll
            for (int i = 0; i < 2; ++i) if (i < nvt) {
                const int vn = vt0 + i;
#pragma unroll
                for (int ks = 0; ks < 8; ++ks) { const bf16x8 cf = *(const LAS bf16x8*)(Cb + (16 * vn + lr) * 264 + 32 * ks + 8 * lg);
                    num[i] = __builtin_amdgcn_mfma_f32_16x16x32_bf16(qf[ks], cf, num[i], 0, 0, 0); }
#pragma unroll
                for (int r = 0; r < 4; ++r) num[i][r] *= sc_wi[16 * qi + 4 * lg + r];
#pragma unroll
                for (int k2 = 0; k2 < 2; ++k2) { const bf16x8 sf = *(const LAS bf16x8*)(Sw + (16 * qi + lr) * 72 + 32 * k2 + 8 * lg);
                    const bf16x8 vf = *(const LAS bf16x8*)(vT + (16 * vn + lr) * 72 + 32 * k2 + 8 * lg);
                    num[i] = __builtin_amdgcn_mfma_f32_16x16x32_bf16(sf, vf, num[i], 0, 0, 0); }
            }
            if (half == 1 && lr == 0) {
#pragma unroll
                for (int r = 0; r < 4; ++r) sc_den[16 * qi + 4 * lg + r] = num[0][r]; }
#pragma unroll
            for (int dm = 0; dm < 2; ++dm) {
                bf16x8 kf2[2];
#pragma unroll
                for (int k2 = 0; k2 < 2; ++k2) kf2[k2] = *(const LAS bf16x8*)(kT + (32 * w + 16 * dm + lr) * 72 + 32 * k2 + 8 * lg);
#pragma unroll
                for (int vn = 0; vn < 3; ++vn) { f32x4 c = Cacc[dm][vn] * decay;
#pragma unroll
                    for (int k2 = 0; k2 < 2; ++k2) { const bf16x8 vf = *(const LAS bf16x8*)(vTw + (16 * vn + lr) * 72 + 32 * k2 + 8 * lg);
                        c = __builtin_amdgcn_mfma_f32_16x16x32_bf16(kf2[k2], vf, c, 0, 0, 0); }
                    Cacc[dm][vn] = c; }
            }
            __syncthreads();
            if (half == 0) {
#pragma unroll
                for (int i = 0; i < 2; ++i)
#pragma unroll
                    for (int r = 0; r < 4; ++r) { const int qt = 16 * qi + 4 * lg + r; const float dn = fmaxf(fabsf(sc_den[qt]), sc_emr[qt]);
                        HC[(tc0 + qt) * 1024 + h * 256 + vs * 32 + 16 * i + lr] = f2bf(num[i][r] / dn); }
            }
#pragma unroll
            for (int dm = 0; dm < 2; ++dm)
#pragma unroll
                for (int vn = 0; vn < 3; ++vn) { const f32x4 c = Cacc[dm][vn]; u32x2 pk; pk.x = cvt_pk_bf16(c[0], c[1]); pk.y = cvt_pk_bf16(c[2], c[3]);
                    *(LAS u32x2*)(Cb + (16 * vn + lr) * 264 + 32 * w + 16 * dm + 4 * lg) = pk; }
            m_run = m_new;
            __syncthreads();
        }
    }
}

__device__ __forceinline__ void phase_aout(const Params& p) {
    const int tid = fresh_tid(), lane = tid & 63, gw = blockIdx.x * 8 + (tid >> 6), NGW = gridDim.x * 8;
    const bf16_t* HC = (const bf16_t*)(p.ws + R1); const bf16_t* SOM = (const bf16_t*)(p.ws + R2); const bf16_t* XC = (const bf16_t*)(p.ws + R0);
    bf16_t* AO = (bf16_t*)(p.ws + R6);
    const float* hg = p.in[9]; const float* sk = p.in[10];
    for (int t = gw; t < T_; t += NGW) {
#pragma unroll
        for (int h = 0; h < 4; ++h) {
            const size_t off = (size_t)t * 1024 + h * 256 + 4 * lane;
            const u32x2 hw = *(const u32x2*)(HC + off), ow = *(const u32x2*)(SOM + off), xw = *(const u32x2*)(XC + off);
            const f32x4 g4 = *(const f32x4*)(hg + h * 256 + 4 * lane), s4 = *(const f32x4*)(sk + h * 256 + 4 * lane);
            float hv[4] = {bflo(hw.x), bfhi(hw.x), bflo(hw.y), bfhi(hw.y)};
            const float ov[4] = {bflo(ow.x), bfhi(ow.x), bflo(ow.y), bfhi(ow.y)}, xv[4] = {bflo(xw.x), bfhi(xw.x), bflo(xw.y), bfhi(xw.y)};
            const float mu = wave_sum((hv[0] + hv[1]) + (hv[2] + hv[3])) * (1.0f / 256.0f);
#pragma unroll
            for (int j = 0; j < 4; ++j) hv[j] -= mu;
            const float var = wave_sum((hv[0] * hv[0] + hv[1] * hv[1]) + (hv[2] * hv[2] + hv[3] * hv[3])) * (1.0f / 256.0f);
            const float rs = rsqrtf(var + EPS_);
            float o[4];
#pragma unroll
            for (int j = 0; j < 4; ++j) o[j] = ov[j] * (hv[j] * rs * g4[j]) + s4[j] * xv[j];
            u32x2 wv; wv.x = cvt_pk_bf16(o[0], o[1]); wv.y = cvt_pk_bf16(o[2], o[3]);
            *(u32x2*)(AO + off) = wv;
        }
    }
}

template <bool PASS_C>
__device__ __forceinline__ void phase_s5(const Params& p, LAS unsigned char* lds) {
    const int tid = fresh_tid(), lane = tid & 63, wave = tid >> 6, gw = blockIdx.x * 8 + wave, NGW = gridDim.x * 8;
    const bf16_t* US = (const bf16_t*)(p.ws + R5);
    const float* A = (const float*)(p.ws + WS_S5A); const float* A64 = (const float*)(p.ws + WS_S5A64); const float* Bb = (const float*)(p.ws + WS_S5B);
    float* E = (float*)(p.ws + WS_E);
    bf16_t* YB = (bf16_t*)(p.ws + R7);
    LAS float* stash = (LAS float*)(lds + wave * 8448);
    for (int item = gw; item < NB_ * NCH_ * SG_; item += NGW) {
        const int g = item & 31, ch = (item >> 5) & 63, b = item >> 11;
        const int gp = g * 64 + lane;
        const size_t tok0 = (size_t)b * SEQ_ + (size_t)ch * 64;
        float bbr[16], bbi[16];
#pragma unroll
        for (int c4 = 0; c4 < 8; ++c4) { const f32x4 v = *(const f32x4*)(Bb + (size_t)gp * 32 + 4 * c4); bbr[2 * c4] = v[0]; bbi[2 * c4] = v[1]; bbr[2 * c4 + 1] = v[2]; bbi[2 * c4 + 1] = v[3]; }
        const float ar = A[gp * 2], ai = A[gp * 2 + 1];
        const u32x4 ua = *(const u32x4*)(US + (tok0 + lane) * 512 + g * 16), ub = *(const u32x4*)(US + (tok0 + lane) * 512 + g * 16 + 8);
        float sr = 0.f, si = 0.f;
        float bk[32];
        if (PASS_C) {
            const float a64r = A64[gp * 2], a64i = A64[gp * 2 + 1];
            const f32x2* Ep = (const f32x2*)E + ((size_t)(b * 64) * 32 + g) * 64 + lane;
            for (int j = 0; j < ch; ++j) { const f32x2 e = Ep[(size_t)j * 32 * 64]; const float nr = a64r * sr - a64i * si + e.x, ni = a64r * si + a64i * sr + e.y; sr = nr; si = ni; }
            const float* cre = p.in[16] + ((size_t)g * 16 + (lane & 15)) * 64 + (lane >> 4); const float* cim = p.in[17] + ((size_t)g * 16 + (lane & 15)) * 64 + (lane >> 4);
#pragma unroll
            for (int kk = 0; kk < 16; ++kk) { bk[kk] = cre[4 * kk]; bk[16 + kk] = -cim[4 * kk]; }
        }
        for (int tb = 0; tb < 4; ++tb) {
#pragma unroll 4
            for (int tt = 0; tt < 16; ++tt) {
                const int t = tb * 16 + tt;
                const unsigned w0 = __builtin_amdgcn_readlane(ua.x, t), w1 = __builtin_amdgcn_readlane(ua.y, t), w2 = __builtin_amdgcn_readlane(ua.z, t), w3 = __builtin_amdgcn_readlane(ua.w, t);
                const unsigned w4 = __builtin_amdgcn_readlane(ub.x, t), w5 = __builtin_amdgcn_readlane(ub.y, t), w6 = __builtin_amdgcn_readlane(ub.z, t), w7 = __builtin_amdgcn_readlane(ub.w, t);
                const float u[16] = {bflo(w0), bfhi(w0), bflo(w1), bfhi(w1), bflo(w2), bfhi(w2), bflo(w3), bfhi(w3), bflo(w4), bfhi(w4), bflo(w5), bfhi(w5), bflo(w6), bfhi(w6), bflo(w7), bfhi(w7)};
                float br = 0.f, bi = 0.f;
#pragma unroll
                for (int c = 0; c < 16; ++c) { br += u[c] * bbr[c]; bi += u[c] * bbi[c]; }
                const float nr = ar * sr - ai * si + br, ni = ar * si + ai * sr + bi; sr = nr; si = ni;
                if (PASS_C) { stash[tt * 132 + lane] = sr; stash[tt * 132 + 64 + lane] = si; }
            }
            if (PASS_C) {
                asm volatile("s_waitcnt lgkmcnt(0)" ::: "memory");
                f32x4 y = (f32x4){0.f, 0.f, 0.f, 0.f};
#pragma unroll
                for (int kk = 0; kk < 32; ++kk) { const float a = stash[(lane & 15) * 132 + 4 * kk + (lane >> 4)]; y = __builtin_amdgcn_mfma_f32_16x16x4f32(a, bk[kk], y, 0, 0, 0); }
                const int c = lane & 15; const float dsk = p.in[18][g * 16 + c];
#pragma unroll
                for (int r = 0; r < 4; ++r) { const size_t tok = tok0 + tb * 16 + 4 * (lane >> 4) + r; const float uu = bf2f(US[tok * 512 + g * 16 + c]);
                    const float v = y[r] + dsk * uu;
                    const float z = 0.7978845608f * (v + 0.044715f * v * v * v); const float th = 1.0f - 2.0f * __builtin_amdgcn_rcpf(1.0f + __expf(2.0f * z));
                    YB[tok * 512 + g * 16 + c] = f2bf(0.5f * v * (1.0f + th)); }
                asm volatile("s_waitcnt lgkmcnt(0)" ::: "memory");
            }
        }
        if (!PASS_C) { f32x2 e; e.x = sr; e.y = si; ((f32x2*)E)[((size_t)(b * 64 + ch) * 32 + g) * 64 + lane] = e; }
    }
}

__device__ __forceinline__ void phase_ffn_act(const Params& p, int half) {
    const bf16_t* U = (const bf16_t*)(p.ws + WS_UH); bf16_t* ACT = (bf16_t*)(p.ws + WS_ACT) + (size_t)half * 16384 * F_;
    const float* cw = p.in[26]; const float* cb = p.in[27];
    const int total = (16384 / 16) * 352;
    for (int idx = blockIdx.x * 512 + fresh_tid(); idx < total; idx += gridDim.x * 512) {
        const int fg = idx % 352, tb = idx / 352, f0 = fg * 8, t0 = tb * 16;
        float wv[3][8], wg[3][8], bvv[8], bgg[8];
#pragma unroll
        for (int k = 0; k < 3; ++k) { const f32x4 a = *(const f32x4*)(cw + k * F2_ + f0), b = *(const f32x4*)(cw + k * F2_ + f0 + 4), c = *(const f32x4*)(cw + k * F2_ + F_ + f0), d = *(const f32x4*)(cw + k * F2_ + F_ + f0 + 4);
#pragma unroll
            for (int j = 0; j < 4; ++j) { wv[k][j] = a[j]; wv[k][4 + j] = b[j]; wg[k][j] = c[j]; wg[k][4 + j] = d[j]; } }
        { const f32x4 a = *(const f32x4*)(cb + f0), b = *(const f32x4*)(cb + f0 + 4), c = *(const f32x4*)(cb + F_ + f0), d = *(const f32x4*)(cb + F_ + f0 + 4);
#pragma unroll
          for (int j = 0; j < 4; ++j) { bvv[j] = a[j]; bvv[4 + j] = b[j]; bgg[j] = c[j]; bgg[4 + j] = d[j]; } }
        float v0[8], v1[8], v2[8], g0[8], g1[8], g2[8];
        const bool head = (t0 & (SEQ_ - 1)) == 0;
        if (head) {
#pragma unroll
            for (int j = 0; j < 8; ++j) { v0[j] = 0.f; v1[j] = 0.f; g0[j] = 0.f; g1[j] = 0.f; } }
        else { unpack8(*(const u32x4*)(U + (size_t)(t0 - 2) * F2_ + f0), v0); unpack8(*(const u32x4*)(U + (size_t)(t0 - 1) * F2_ + f0), v1);
               unpack8(*(const u32x4*)(U + (size_t)(t0 - 2) * F2_ + F_ + f0), g0); unpack8(*(const u32x4*)(U + (size_t)(t0 - 1) * F2_ + F_ + f0), g1); }
#pragma unroll 4
        for (int i = 0; i < 16; ++i) {
            unpack8(*(const u32x4*)(U + (size_t)(t0 + i) * F2_ + f0), v2); unpack8(*(const u32x4*)(U + (size_t)(t0 + i) * F2_ + F_ + f0), g2);
            float o[8];
#pragma unroll
            for (int j = 0; j < 8; ++j) { const float val = bvv[j] + wv[0][j] * v0[j] + wv[1][j] * v1[j] + wv[2][j] * v2[j]; const float gt = bgg[j] + wg[0][j] * g0[j] + wg[1][j] * g1[j] + wg[2][j] * g2[j]; o[j] = siluf_(gt) * val; }
            *(u32x4*)(ACT + (size_t)(t0 + i) * F_ + f0) = pack8(o);
#pragma unroll
            for (int j = 0; j < 8; ++j) { v0[j] = v1[j]; v1[j] = v2[j]; g0[j] = g1[j]; g1[j] = g2[j]; }
        }
    }
}

__device__ __forceinline__ void phase_final(const Params& p) {
    const int tid = fresh_tid(), lane = tid & 63, gw = blockIdx.x * 8 + (tid >> 6), NGW = gridDim.x * 8;
    const float* ss = (const float*)(p.ws + WS_SS2); const float* gf = p.in[29];
    for (int row = gw; row < T_; row += NGW) {
        const float sv = (lane < 16) ? ss[(size_t)row * 16 + lane] : 0.f;
        const float ri = rsqrtf(wave_sum(sv) * (1.0f / 1024.0f) + EPS_);
        f32x4* xr = (f32x4*)(p.out + (size_t)row * 1024) + lane;
#pragma unroll
        for (int j = 0; j < 4; ++j) { const f32x4 g4 = *((const f32x4*)gf + lane + 64 * j); f32x4 v = xr[64 * j]; v = v * ri * g4; xr[64 * j] = v; }
    }
}

#ifndef PHASE_MASK
#define PHASE_MASK 0xffffffffu
#endif
#define PH(k) ((PHASE_MASK >> (k)) & 1u)
#ifndef REP_MASK
#define REP_MASK 0u
#endif
#define REPS(k) for (int rep_ = 0; rep_ < 1 + (int)((REP_MASK >> (k)) & 1u); ++rep_)
__global__ void __launch_bounds__(512, 2) fwd_megakernel(Params p) {
    extern __shared__ __attribute__((aligned(16))) unsigned char lds_raw[];
    LAS unsigned char* lds = (LAS unsigned char*)lds_raw;
    cg::grid_group grid = cg::this_grid();
    unsigned char* ws = p.ws;
    bf16_t* dq = (bf16_t*)p.out;
    volatile LAS unsigned* bst = (volatile LAS unsigned*)(lds + LDS_BYTES - 64);
    if (threadIdx.x < 2) bst[threadIdx.x] = 0u;
    if (blockIdx.x == 0) { unsigned* bw = (unsigned*)(ws + WS_BAR); for (int i = threadIdx.x; i < XCD_BAR_WORDS; i += 512) bw[i] = 0u; }
    __syncthreads();
    REPS(0) if (PH(0)) phase0(p, lds);
    grid.sync();
    const XcdBarrier xbar = xcd_barrier_post((unsigned*)(ws + WS_BAR), bst);
    REPS(1) if (PH(1)) { pg8::PlainSched S; S.set(ws + R0, 1024, ws + WS_WIN, 1024, T_ / 256, NP1_ / 256);
      EpiProj E{(const float*)(ws + WS_RINV1), (const float*)(ws + WS_BIASP), (bf16_t*)(ws + R1), (bf16_t*)(ws + R2), (bf16_t*)(ws + R5), (bf16_t*)(ws + R3), (bf16_t*)(ws + R4)};
      pg8::gemm_phase(lds, S, E, 1024, 1024, 1024); }
    xcd_barrier(xbar);
    REPS(2) if (PH(2)) phase_conv_m(p);
    xcd_barrier(xbar);
    REPS(3) if (PH(3)) { SchedQKV S; S.init(T_ / 256, 12, gridDim.x, blockIdx.x); S.xc = (const char*)(ws + R0); S.xm = (const char*)(ws + R1); S.wqk = (const char*)(ws + WS_WQK); S.wv = (const char*)(ws + WS_WV);
      EpiQKV E{dq, (bf16_t*)(ws + R6)};
      pg8::gemm_phase(lds, S, E, 256, 1024, 256); }
    xcd_barrier(xbar);
    REPS(4) if (PH(4)) phase_mlstm(p, lds);
    xcd_barrier(xbar);
    REPS(5) if (PH(5)) phase_aout(p);
    REPS(6) if (PH(6)) phase_s5<false>(p, lds);
    xcd_barrier(xbar);
    REPS(7) if (PH(7)) phase_s5<true>(p, lds);
    xcd_barrier(xbar);
    REPS(8) if (PH(8)) { pg8::PlainSched S; S.set(ws + R7, 512, ws + WS_WGLU, 512, T_ / 256, 2);
      EpiGate<0> E{(const bf16_t*)(ws + R7), nullptr, p.in[20], dq, 512};
      pg8::gemm_phase(lds, S, E, 512, 512, 512); }
    xcd_barrier(xbar);
    REPS(9) if (PH(9)) { pg8::PlainSched S; S.set(dq, 512, ws + WS_WB, 512, T_ / 256, 4);
      EpiGate<1> E{(const bf16_t*)(ws + R4), nullptr, nullptr, (bf16_t*)(ws + R1), 1024};
      pg8::gemm_phase(lds, S, E, 512, 512, 512); }
    xcd_barrier(xbar);
    REPS(10) if (PH(10)) { pg8::PlainSched S; S.set(ws + R6, 1024, ws + WS_WA, 1024, T_ / 256, 4);
      EpiGate<2> E{(const bf16_t*)(ws + R3), (const bf16_t*)(ws + R1), nullptr, (bf16_t*)(ws + R0), 1024};
      pg8::gemm_phase(lds, S, E, 1024, 1024, 1024); }
    xcd_barrier(xbar);
    REPS(11) if (PH(11)) { pg8::PlainSched S; S.set(ws + R0, 1024, ws + WS_WOUT, 1024, T_ / 256, 4);
      EpiResid<true> E{p.in[0], p.out, (bf16_t*)(ws + WS_X1B), (float*)(ws + WS_SS1)};
      pg8::gemm_phase(lds, S, E, 1024, 1024, 1024); }
    xcd_barrier(xbar);
    for (int half = 0; half < 2; ++half) {
        REPS(12) if (PH(12)) { pg8::PlainSched S; S.set(ws + WS_X1B + (size_t)half * 16384 * 1024 * 2, 1024, ws + WS_WUP, 1024, 64, F2_ / 256);
          EpiUp E{(const float*)(ws + WS_SS1), (bf16_t*)(ws + WS_UH), half * 16384};
          pg8::gemm_phase(lds, S, E, 1024, 1024, 1024); }
        xcd_barrier(xbar);
        REPS(13) if (PH(13)) phase_ffn_act(p, half);
        xcd_barrier(xbar);
    }
    REPS(14) if (PH(14)) { pg8::PlainSched S; S.set(ws + WS_ACT, F_, ws + WS_WDN, F_, T_ / 256, 4);
      EpiResid<false> E{p.out, (rep_ + 1 < 1 + (int)((REP_MASK >> 14) & 1u)) ? (float*)(ws + WS_UH) : p.out, nullptr, (float*)(ws + WS_SS2)};
      pg8::gemm_phase(lds, S, E, F_, F_, F_); }
    xcd_barrier(xbar);
    REPS(15) if (PH(15)) phase_final(p);
}

extern "C" void kernel_launch(void* const* d_in, const int* in_sizes, int n_in, void* d_out, int out_size, void* d_ws, size_t ws_size, hipStream_t stream) {
    static int grid_blocks = 0;
    if (!grid_blocks) {
        int dev = 0, cus = 0, per_cu = 0;
        (void)hipGetDevice(&dev);
        (void)hipDeviceGetAttribute(&cus, hipDeviceAttributeMultiprocessorCount, dev);
        (void)hipFuncSetAttribute((const void*)fwd_megakernel, hipFuncAttributeMaxDynamicSharedMemorySize, LDS_BYTES);
        (void)hipOccupancyMaxActiveBlocksPerMultiprocessor(&per_cu, (const void*)fwd_megakernel, 512, LDS_BYTES);
        if (per_cu < 1) { fprintf(stderr, "kernel_launch: occupancy query returned %d\n", per_cu); }
        grid_blocks = cus;
        if (n_in != 30 || out_size != T_ * D_ || ws_size < 512 * MiB) fprintf(stderr, "kernel_launch: unexpected sizes n_in=%d out=%d ws=%zu\n", n_in, out_size, ws_size);
    }
    Params p{};
    for (int i = 0; i < 30; ++i) p.in[i] = (const float*)d_in[i];
    p.out = (float*)d_out; p.ws = (unsigned char*)d_ws;
    void* args[] = {&p};
    hipError_t e = hipLaunchCooperativeKernel((void*)fwd_megakernel, dim3(grid_blocks), dim3(512), args, LDS_BYTES, stream);
    if (e != hipSuccess) fprintf(stderr, "cooperative launch failed: %s (grid %d)\n", hipGetErrorString(e), grid_blocks);
}
```

```cpp
#include <hip/hip_runtime.h>
#include <hip/hip_cooperative_groups.h>
#include <cstdio>
#include <cstdint>
namespace cg = cooperative_groups;

#define LAS __attribute__((address_space(3)))
typedef unsigned short bf16_t;
typedef short bf16x8 __attribute__((ext_vector_type(8)));
typedef float f32x4 __attribute__((ext_vector_type(4)));
typedef float f32x2 __attribute__((ext_vector_type(2)));
typedef unsigned u32x4 __attribute__((ext_vector_type(4)));
typedef unsigned u32x2 __attribute__((ext_vector_type(2)));

constexpr int T_ = 32768, D_ = 1024, SEQ_ = 4096, NB_ = 8;
constexpr int NH_ = 4, DH_ = 256, NCH_ = 64;
constexpr int SW_ = 512, SG_ = 32, SP_ = 64;
constexpr int F_ = 2816, F2_ = 5632, NIN_ = 4616, NP1_ = 4608;
constexpr float EPS_ = 1e-6f;

constexpr size_t MiB = 1ull << 20, KiB = 1024;
constexpr size_t WS_WIN = 0, WS_WQK = 9 * MiB, WS_WV = 10 * MiB, WS_WGLU = 10 * MiB + 512 * KiB, WS_WA = 11 * MiB, WS_WB = 13 * MiB, WS_WOUT = 14 * MiB,
                 WS_WUP = 16 * MiB, WS_WDN = 27 * MiB;
constexpr size_t WS_S5A = 33 * MiB, WS_S5A64 = WS_S5A + 16 * KiB, WS_S5B = WS_S5A + 32 * KiB;
constexpr size_t WS_RINV1 = 34 * MiB, WS_IG = 34 * MiB + 512 * KiB, WS_FG = 35 * MiB, WS_BIASP = 35 * MiB + 512 * KiB;
constexpr size_t WS_BAR = 49 * MiB;
constexpr size_t WS_SS1 = 36 * MiB, WS_SS2 = 38 * MiB, WS_E = 40 * MiB;
constexpr size_t R0 = 56 * MiB, R1 = 120 * MiB, R2 = 184 * MiB, R3 = 248 * MiB, R4 = 312 * MiB, R5 = 376 * MiB, R6 = 408 * MiB, R7 = 472 * MiB;
constexpr size_t WS_X1B = 448 * MiB, WS_UH = 56 * MiB, WS_ACT = 232 * MiB;
constexpr int LDS_BYTES = 147456;

struct Params {
    const float* in[30];
    float* out;
    unsigned char* ws;
};

__device__ __forceinline__ unsigned cvt_pk_bf16(float lo, float hi) { unsigned r; asm volatile("v_cvt_pk_bf16_f32 %0, %1, %2" : "=v"(r) : "v"(lo), "v"(hi)); return r; }
__device__ __forceinline__ bf16_t f2bf(float x) { return (bf16_t)(cvt_pk_bf16(x, x) & 0xffffu); }
__device__ __forceinline__ float bf2f(unsigned short u) { return __uint_as_float(((unsigned)u) << 16); }
__device__ __forceinline__ float bflo(unsigned w) { return __uint_as_float(w << 16); }
__device__ __forceinline__ float bfhi(unsigned w) { return __uint_as_float(w & 0xffff0000u); }
__device__ __forceinline__ float sigmoidf_(float x) { return __builtin_amdgcn_rcpf(1.0f + __expf(-x)); }
__device__ __forceinline__ float siluf_(float x) { return x * sigmoidf_(x); }
__device__ __forceinline__ int fresh_tid() { int t = threadIdx.x; asm volatile("" : "+v"(t)); return t; }
__device__ __forceinline__ float wave_sum(float v) {
#pragma unroll
    for (int o = 1; o < 64; o <<= 1) v += __shfl_xor(v, o);
    return v;
}
__device__ __forceinline__ void unpack8(const u32x4 w, float (&f)[8]) {
    f[0] = bflo(w.x); f[1] = bfhi(w.x); f[2] = bflo(w.y); f[3] = bfhi(w.y); f[4] = bflo(w.z); f[5] = bfhi(w.z); f[6] = bflo(w.w); f[7] = bfhi(w.w);
}
__device__ __forceinline__ u32x4 pack8(const float (&f)[8]) {
    u32x4 w; w.x = cvt_pk_bf16(f[0], f[1]); w.y = cvt_pk_bf16(f[2], f[3]); w.z = cvt_pk_bf16(f[4], f[5]); w.w = cvt_pk_bf16(f[6], f[7]); return w;
}


#define XB_TMO      128
#define XB_XCNT(j)  (256  + 64 * (j))
#define XB_XSUB(j)  (1280 + 64 * (j))
#define XB_XGEN(j)  (2304 + 64 * (j))
#define XB_TOP      3328
#define XB_TOPGEN   3392
#define XCD_BAR_WORDS 3456
#define XB_SPIN_CAP (1u << 18)
__device__ __forceinline__ unsigned xb_ld(unsigned* p)              { return __hip_atomic_load(p, __ATOMIC_RELAXED, __HIP_MEMORY_SCOPE_AGENT); }
__device__ __forceinline__ unsigned xb_add(unsigned* p, unsigned v) { return __hip_atomic_fetch_add(p, v, __ATOMIC_RELAXED, __HIP_MEMORY_SCOPE_AGENT); }
__device__ __forceinline__ unsigned xb_xcc_id() { return (unsigned)__builtin_amdgcn_s_getreg((3 << 11) | 20) & 0xFu; }
#define XB_SPIN(cond, bar) do { unsigned _sp = 0; while (cond) { __builtin_amdgcn_s_sleep(1); \
    if ((++_sp & 255u) == 0u) { if (xb_ld(&(bar)[XB_TMO])) break; if (_sp > XB_SPIN_CAP) { atomicAdd(&(bar)[XB_TMO], 1u); break; } } } } while (0)
struct XcdBarrier { unsigned* bar; unsigned x; volatile LAS unsigned* st; };
__device__ __forceinline__ XcdBarrier xcd_barrier_post(unsigned* bar, volatile LAS unsigned* st) {
    XcdBarrier b; b.bar = bar; b.x = xb_xcc_id(); b.st = st;
    if (threadIdx.x == 0) (void)xb_add(&bar[XB_XCNT(b.x)], 1u);
    return b;
}
__device__ __forceinline__ void xcd_barrier_complete(unsigned* bar, unsigned x, unsigned& nloc, unsigned& nx) {
    const unsigned G = gridDim.x * gridDim.y * gridDim.z;
    unsigned sum, cnt, mine, sp = 0u;
    for (;;) {
        sum = 0u; cnt = 0u; mine = 0u;
#pragma unroll
        for (unsigned j = 0; j < 16; ++j) { const unsigned c = xb_ld(&bar[XB_XCNT(j)]); sum += c; cnt += (c > 0u) ? 1u : 0u; mine = (j == x) ? c : mine; }
        if (sum == G) break;
        __builtin_amdgcn_s_sleep(1);
        if ((++sp & 255u) == 0u) { if (xb_ld(&bar[XB_TMO])) break; if (sp > XB_SPIN_CAP) { atomicAdd(&bar[XB_TMO], 1u); break; } }
    }
    nloc = mine > 0u ? mine : 1u; nx = cnt > 0u ? cnt : 1u;
}
__device__ __forceinline__ void xcd_barrier(const XcdBarrier& b) {
    asm volatile("s_waitcnt vmcnt(0)" ::: "memory");
    __syncthreads();
    if (threadIdx.x == 0) {
        unsigned* bar = b.bar;
        __builtin_amdgcn_s_waitcnt(0);
        unsigned nloc = b.st[0], nx = b.st[1];
        if (nloc == 0u) { xcd_barrier_complete(bar, b.x, nloc, nx); b.st[0] = nloc; b.st[1] = nx; }
        const unsigned old = xb_add(&bar[XB_XSUB(b.x)], 1u);
        const unsigned gen = old / nloc;
        if (old + 1u == (gen + 1u) * nloc) {
            __builtin_amdgcn_fence(__ATOMIC_RELEASE, "agent");
            asm volatile("s_waitcnt vmcnt(0)" ::: "memory");
            const unsigned og = xb_add(&bar[XB_TOP], 1u);
            const unsigned tg = og / nx;
            if (og + 1u == (tg + 1u) * nx) xb_add(&bar[XB_TOPGEN], 1u);
            else XB_SPIN(xb_ld(&bar[XB_TOPGEN]) == tg, bar);
            __builtin_amdgcn_fence(__ATOMIC_ACQUIRE, "agent");
            xb_add(&bar[XB_XGEN(b.x)], 1u);
            asm volatile("s_waitcnt vmcnt(0)" ::: "memory");
        } else {
            XB_SPIN(xb_ld(&bar[XB_XGEN(b.x)]) == gen, bar);
            __builtin_amdgcn_fence(__ATOMIC_ACQUIRE, "agent");
            asm volatile("s_waitcnt vmcnt(0)" ::: "memory");
        }
    }
    __syncthreads();
}

namespace pg8 {
constexpr int BM = 256, BK = 64, HALF = 128, HTB = HALF * BK * 2, STAGE_BYTES = 8 * HTB, NXCD = 8, WGM = 8;
__device__ __forceinline__ int lds_byte(int r, int c) { const int st = (r >> 4) * 2 + (c >> 5), rr = r & 15, cc = c & 31, ob = rr * 64 + cc * 2; return st * 1024 + (ob ^ (((ob >> 9) & 1) << 5)); }
__device__ __forceinline__ void stage_rc(int b, int& R, int& C) { const int st = b / 1024, sb = b % 1024, swz = sb ^ (((sb >> 9) & 1) << 5); R = (st >> 1) * 16 + swz / 64; C = (st & 1) * 32 + (swz % 64) / 2; }
__device__ __forceinline__ int perm32(int rho) { const int n = rho >> 4, i = rho & 15; return 8 * (i >> 2) + 4 * n + (i & 3); }
struct Unit { int pm, pn; };
struct Order {
    int nM, nN, nwg, G, c;
    __device__ __forceinline__ void init(int nM_, int nN_, int G_, int c_) { nM = nM_; nN = nN_; nwg = nM * nN; G = G_; c = c_; }
    __device__ __forceinline__ bool next(int i, Unit& u) const {
        const long L = (long)i * G + c; if (L >= nwg) return false;
        int wgid = (int)L; { const int q = nwg / NXCD, r = nwg % NXCD, xcd = wgid % NXCD, off = wgid / NXCD; wgid = (xcd < r ? xcd * (q + 1) : r * (q + 1) + (xcd - r) * q) + off; }
        const int nig = WGM * nN, gid = wgid / nig, fm = gid * WGM, gsz = (nM - fm) < WGM ? (nM - fm) : WGM;
        u.pm = fm + ((wgid % nig) % gsz); u.pn = (wgid % nig) / gsz; return true;
    }
};
template <class Epi, class Sched>
__device__ __forceinline__ void gemm_phase(LAS unsigned char* lds, const Sched& S, const Epi& E, const int K, const int lda, const int ldb) {
    const int tid = fresh_tid(), wid = __builtin_amdgcn_readfirstlane(tid >> 6), lane = tid & 63, wr = wid >> 2, wc = wid & 3, fr = lane & 15, fq = lane >> 4;
    const int nt = K / BK;
    unsigned voffA[2], voffB[2];
#pragma unroll
    for (int i = 0; i < 2; ++i) { int R, C; stage_rc(tid * 16 + i * 8192, R, C); const int Rb = Epi::PERM ? ((R & ~31) + perm32(R & 31)) : R;
        voffA[i] = (unsigned)(R * lda + C) * 2u; voffB[i] = (unsigned)(Rb * ldb + C) * 2u; }
    const size_t kstep = (size_t)(BK * 2);
    const size_t hstepA = (size_t)HALF * lda * 2, hstepB = (size_t)HALF * ldb * 2;
    const unsigned ldsw = (unsigned)wid * 1024u;
    const int aoff = lds_byte(wr * 64 + fr, fq * 8), boff = lds_byte(wc * 32 + fr, fq * 8);
#define PG8_SA(b, h) (((b) * 2 + (h)) * HTB)
#define PG8_SB(b, h) ((4 + (b) * 2 + (h)) * HTB)
#define PG8_STAGE(bufoff, gbase, voff) do { _Pragma("unroll") for (int _i = 0; _i < 2; ++_i) \
        __builtin_amdgcn_global_load_lds((const unsigned*)((const char*)(gbase) + (voff)[_i]), (LAS unsigned*)(lds + (bufoff) + ldsw + _i * 8192), 16, 0, 0); } while (0)
#define PG8_LDA(dst, b, h) do { _Pragma("unroll") for (int m = 0; m < 4; ++m) _Pragma("unroll") for (int k = 0; k < 2; ++k) dst[m][k] = *(const LAS bf16x8*)(lds + PG8_SA(b, h) + aoff + m * 2048 + k * 1024); } while (0)
#define PG8_LDB(dst, b, h) do { _Pragma("unroll") for (int n = 0; n < 2; ++n) _Pragma("unroll") for (int k = 0; k < 2; ++k) dst[n][k] = *(const LAS bf16x8*)(lds + PG8_SB(b, h) + boff + n * 2048 + k * 1024); } while (0)
#define PG8_MMA(ai, bj, At, Bt) do { __builtin_amdgcn_s_setprio(1); _Pragma("unroll") for (int m = 0; m < 4; ++m) _Pragma("unroll") for (int n = 0; n < 2; ++n) _Pragma("unroll") for (int k = 0; k < 2; ++k) \
        acc[ai][bj][m][n] = __builtin_amdgcn_mfma_f32_16x16x32_bf16(Bt[n][k], At[m][k], acc[ai][bj][m][n], 0, 0, 0); __builtin_amdgcn_s_setprio(0); } while (0)
#define PG8_WAIT_V(n) asm volatile("s_waitcnt vmcnt(" #n ")" ::: "memory")
#define PG8_WAIT_L(n) asm volatile("s_waitcnt lgkmcnt(" #n ")" ::: "memory")
#define PG8_BAR __builtin_amdgcn_s_barrier()
#define PG8_SCHED __builtin_amdgcn_sched_barrier(0)
    Unit cur, nxt; int ui = 0;
    if (!S.next(0, cur)) return;
    f32x4 acc[2][2][4][2];
#pragma unroll
    for (int a = 0; a < 2; ++a)
#pragma unroll
        for (int b = 0; b < 2; ++b)
#pragma unroll
            for (int m = 0; m < 4; ++m)
#pragma unroll
                for (int n = 0; n < 2; ++n) acc[a][b][m][n] = (f32x4){0.f, 0.f, 0.f, 0.f};
    bf16x8 At[4][2], B0[2][2], B1[2][2];
    const char* cA = S.aptr(cur); const char* cB = S.bptr(cur);
    PG8_STAGE(PG8_SB(0, 0), cB, voffB); PG8_STAGE(PG8_SB(0, 1), cB + hstepB, voffB); PG8_STAGE(PG8_SA(0, 0), cA, voffA); PG8_STAGE(PG8_SA(0, 1), cA + hstepA, voffA);
    if (wr == 1) PG8_BAR;
    PG8_WAIT_V(2); PG8_BAR;
    PG8_STAGE(PG8_SB(1, 0), cB + kstep, voffB); PG8_STAGE(PG8_SA(1, 0), cA + kstep, voffA); PG8_STAGE(PG8_SB(1, 1), cB + hstepB + kstep, voffB);
    PG8_WAIT_V(6); PG8_BAR;
    for (;;) {
        const bool has_next = S.next(ui + 1, nxt);
        const char* nA = has_next ? S.aptr(nxt) : cA; const char* nB = has_next ? S.bptr(nxt) : cB;
#pragma unroll 1
        for (int t = 0; t < nt; t += 2) {
            const bool last = (t == nt - 2);
            const char* a1 = cA + (size_t)(t + 1) * kstep;
            const char* a2 = last ? nA : cA + (size_t)(t + 2) * kstep; const char* b2 = last ? nB : cB + (size_t)(t + 2) * kstep;
            const char* a3 = a2 + kstep; const char* b3 = b2 + kstep;
            PG8_LDB(B0, 0, 0); PG8_LDB(B1, 0, 1); PG8_SCHED; PG8_LDA(At, 0, 0); PG8_STAGE(PG8_SA(1, 1), a1 + hstepA, voffA);
            PG8_WAIT_V(8); PG8_WAIT_L(0); PG8_BAR; PG8_MMA(0, 0, At, B0); PG8_MMA(0, 1, At, B1); PG8_BAR; PG8_SCHED;
            PG8_LDA(At, 0, 1); PG8_STAGE(PG8_SB(0, 0), b2, voffB); PG8_STAGE(PG8_SB(0, 1), b2 + hstepB, voffB); PG8_STAGE(PG8_SA(0, 0), a2, voffA);
            PG8_WAIT_V(8); PG8_WAIT_L(0); PG8_BAR; PG8_MMA(1, 0, At, B0); PG8_MMA(1, 1, At, B1); PG8_BAR; PG8_SCHED;
            PG8_LDB(B0, 1, 0); PG8_LDB(B1, 1, 1); PG8_SCHED; PG8_LDA(At, 1, 0); PG8_STAGE(PG8_SA(0, 1), a2 + hstepA, voffA);
            PG8_WAIT_V(8); PG8_WAIT_L(0); PG8_BAR; PG8_MMA(0, 0, At, B0); PG8_MMA(0, 1, At, B1); PG8_BAR; PG8_SCHED;
            PG8_LDA(At, 1, 1); PG8_STAGE(PG8_SB(1, 0), b3, voffB); PG8_STAGE(PG8_SB(1, 1), b3 + hstepB, voffB); PG8_STAGE(PG8_SA(1, 0), a3, voffA);
            PG8_WAIT_V(8); PG8_WAIT_L(0); PG8_BAR; PG8_MMA(1, 0, At, B0); PG8_MMA(1, 1, At, B1); PG8_BAR; PG8_SCHED;
        }
        if (wr == 0) PG8_BAR;
        E(acc, cur, wr, wc, fr, fq);
        if (!has_next) break;
#pragma unroll
        for (int a = 0; a < 2; ++a)
#pragma unroll
            for (int b = 0; b < 2; ++b)
#pragma unroll
                for (int m = 0; m < 4; ++m)
#pragma unroll
                    for (int n = 0; n < 2; ++n) acc[a][b][m][n] = (f32x4){0.f, 0.f, 0.f, 0.f};
        cur = nxt; cA = nA; cB = nB; ++ui;
        if (wr == 1) PG8_BAR;
    }
    PG8_WAIT_V(0);
    PG8_BAR;
#undef PG8_SA
#undef PG8_SB
#undef PG8_STAGE
#undef PG8_LDA
#undef PG8_LDB
#undef PG8_MMA
#undef PG8_WAIT_V
#undef PG8_WAIT_L
#undef PG8_BAR
#undef PG8_SCHED
}
struct PlainSched : Order {
    const char* A; const char* B; size_t astep, bstep;
    __device__ __forceinline__ void set(const void* A_, int lda, const void* B_, int ldb, int nM_, int nN_) { A = (const char*)A_; B = (const char*)B_; astep = (size_t)BM * lda * 2; bstep = (size_t)BM * ldb * 2; init(nM_, nN_, gridDim.x, blockIdx.x); }
    __device__ __forceinline__ const char* aptr(const Unit& u) const { return A + (size_t)u.pm * astep; }
    __device__ __forceinline__ const char* bptr(const Unit& u) const { return B + (size_t)u.pn * bstep; }
};
}
using pg8::Unit;
typedef const f32x4 (&AccRef)[2][2][4][2];

struct EpiProj {
    static constexpr bool PERM = true;
    const float* rinv; const float* bias; bf16_t *xm, *som, *us, *sga, *sgb;
    __device__ __forceinline__ void operator()(AccRef acc, const Unit& u, int wr, int wc, int fr, int fq) const {
        const int pn = u.pn; bf16_t* base; int ldc, colt; bool sig;
        if (pn < 4) { base = xm; ldc = 1024; colt = pn * 256; sig = false; }
        else if (pn < 8) { base = som; ldc = 1024; colt = (pn - 4) * 256; sig = true; }
        else if (pn < 10) { base = us; ldc = 512; colt = (pn - 8) * 256; sig = false; }
        else if (pn < 14) { base = sga; ldc = 1024; colt = (pn - 10) * 256; sig = true; }
        else { base = sgb; ldc = 1024; colt = (pn - 14) * 256; sig = true; }
        const int row0 = u.pm * 256 + wr * 64 + fr, col0 = colt + wc * 32 + 8 * fq, bcol0 = pn * 256 + wc * 32 + 8 * fq;
        f32x4 bv[2][2];
#pragma unroll
        for (int bj = 0; bj < 2; ++bj)
#pragma unroll
            for (int n = 0; n < 2; ++n) bv[bj][n] = *(const f32x4*)(bias + bcol0 + bj * 128 + 4 * n);
#pragma unroll
        for (int ai = 0; ai < 2; ++ai)
#pragma unroll
            for (int m = 0; m < 4; ++m) { const int row = row0 + ai * 128 + m * 16; const float ri = rinv[row]; bf16_t* rowp = base + (size_t)row * ldc + col0;
#pragma unroll
                for (int bj = 0; bj < 2; ++bj) { f32x4 v0 = acc[ai][bj][m][0] * ri + bv[bj][0], v1 = acc[ai][bj][m][1] * ri + bv[bj][1];
                    if (sig) {
#pragma unroll
                        for (int j = 0; j < 4; ++j) { v0[j] = sigmoidf_(v0[j]); v1[j] = sigmoidf_(v1[j]); } }
                    u32x4 w; w.x = cvt_pk_bf16(v0[0], v0[1]); w.y = cvt_pk_bf16(v0[2], v0[3]); w.z = cvt_pk_bf16(v1[0], v1[1]); w.w = cvt_pk_bf16(v1[2], v1[3]);
                    *(u32x4*)(rowp + bj * 128) = w; } }
    }
};
struct EpiQKV {
    static constexpr bool PERM = true;
    bf16_t *qk, *v;
    __device__ __forceinline__ void operator()(AccRef acc, const Unit& u, int wr, int wc, int fr, int fq) const {
        const int head = u.pn & 3, kind = u.pn >> 2; bf16_t* base = (kind < 2) ? qk + (size_t)kind * T_ * 1024 : v;
        const int row0 = u.pm * 256 + wr * 64 + fr, col0 = head * 256 + wc * 32 + 8 * fq;
#pragma unroll
        for (int ai = 0; ai < 2; ++ai)
#pragma unroll
            for (int m = 0; m < 4; ++m) { bf16_t* rowp = base + (size_t)(row0 + ai * 128 + m * 16) * 1024 + col0;
#pragma unroll
                for (int bj = 0; bj < 2; ++bj) { const f32x4 v0 = acc[ai][bj][m][0], v1 = acc[ai][bj][m][1];
                    u32x4 w; w.x = cvt_pk_bf16(v0[0], v0[1]); w.y = cvt_pk_bf16(v0[2], v0[3]); w.z = cvt_pk_bf16(v1[0], v1[1]); w.w = cvt_pk_bf16(v1[2], v1[3]);
                    *(u32x4*)(rowp + bj * 128) = w; } }
    }
};
template <int MODE> struct EpiGate {
    static constexpr bool PERM = true;
    const bf16_t* X; const bf16_t* Y; const float* bias; bf16_t* O; int ldc;
    __device__ __forceinline__ void operator()(AccRef acc, const Unit& u, int wr, int wc, int fr, int fq) const {
        const int row0 = u.pm * 256 + wr * 64 + fr, col0 = u.pn * 256 + wc * 32 + 8 * fq;
        f32x4 bv[2][2];
#pragma unroll
        for (int bj = 0; bj < 2; ++bj)
#pragma unroll
            for (int n = 0; n < 2; ++n) bv[bj][n] = (MODE == 0) ? *(const f32x4*)(bias + col0 + bj * 128 + 4 * n) : (f32x4){0.f, 0.f, 0.f, 0.f};
#pragma unroll
        for (int ai = 0; ai < 2; ++ai)
#pragma unroll
            for (int m = 0; m < 4; ++m) { const size_t off = (size_t)(row0 + ai * 128 + m * 16) * ldc + col0;
#pragma unroll
                for (int bj = 0; bj < 2; ++bj) {
                    float xv[8], a[8], o[8]; unpack8(*(const u32x4*)(X + off + bj * 128), xv);
#pragma unroll
                    for (int j = 0; j < 4; ++j) { a[j] = acc[ai][bj][m][0][j] + bv[bj][0][j]; a[4 + j] = acc[ai][bj][m][1][j] + bv[bj][1][j]; }
                    if (MODE == 0) {
#pragma unroll
                        for (int j = 0; j < 8; ++j) o[j] = xv[j] * sigmoidf_(a[j]); }
                    else if (MODE == 1) {
#pragma unroll
                        for (int j = 0; j < 8; ++j) o[j] = xv[j] * a[j]; }
                    else { float yv[8]; unpack8(*(const u32x4*)(Y + off + bj * 128), yv);
#pragma unroll
                        for (int j = 0; j < 8; ++j) o[j] = xv[j] * a[j] + yv[j]; }
                    *(u32x4*)(O + off + bj * 128) = pack8(o); } }
    }
};
template <bool WB> struct EpiResid {
    static constexpr bool PERM = false;
    const float* Rs; float* Of; bf16_t* Ob; float* ss;
    __device__ __forceinline__ void operator()(AccRef acc, const Unit& u, int wr, int wc, int fr, int fq) const {
        const int row0 = u.pm * 256 + wr * 64 + fr, col0 = u.pn * 256 + wc * 32 + 4 * fq;
#pragma unroll
        for (int ai = 0; ai < 2; ++ai)
#pragma unroll
            for (int m = 0; m < 4; ++m) { const int row = row0 + ai * 128 + m * 16; const size_t off = (size_t)row * 1024 + col0; float s = 0.f;
#pragma unroll
                for (int bj = 0; bj < 2; ++bj)
#pragma unroll
                    for (int n = 0; n < 2; ++n) { const size_t o2 = off + bj * 128 + n * 16; const f32x4 r = *(const f32x4*)(Rs + o2); const f32x4 v = r + acc[ai][bj][m][n];
                        *(f32x4*)(Of + o2) = v; s += (v[0] * v[0] + v[1] * v[1]) + (v[2] * v[2] + v[3] * v[3]);
                        if (WB) { u32x2 w; w.x = cvt_pk_bf16(v[0], v[1]); w.y = cvt_pk_bf16(v[2], v[3]); *(u32x2*)(Ob + o2) = w; } }
                s += __shfl_xor(s, 16); s += __shfl_xor(s, 32);
                if (fq == 0) ss[(size_t)row * 16 + u.pn * 4 + wc] = s; }
    }
};
struct EpiUp {
    static constexpr bool PERM = true;
    const float* ss; bf16_t* U; int row_off;
    __device__ __forceinline__ void operator()(AccRef acc, const Unit& u, int wr, int wc, int fr, int fq) const {
        const int row0 = u.pm * 256 + wr * 64 + fr, col0 = u.pn * 256 + wc * 32 + 8 * fq;
#pragma unroll
        for (int ai = 0; ai < 2; ++ai)
#pragma unroll
            for (int m = 0; m < 4; ++m) { const int row = row0 + ai * 128 + m * 16; const f32x4* sp = (const f32x4*)(ss + (size_t)(row + row_off) * 16);
                const f32x4 s0 = sp[0], s1 = sp[1], s2 = sp[2], s3 = sp[3]; const f32x4 st = (s0 + s1) + (s2 + s3);
                const float ri = rsqrtf(((st[0] + st[1]) + (st[2] + st[3])) * (1.0f / 1024.0f) + EPS_);
                bf16_t* rowp = U + (size_t)row * F2_ + col0;
#pragma unroll
                for (int bj = 0; bj < 2; ++bj) { const f32x4 v0 = acc[ai][bj][m][0] * ri, v1 = acc[ai][bj][m][1] * ri;
                    u32x4 w; w.x = cvt_pk_bf16(v0[0], v0[1]); w.y = cvt_pk_bf16(v0[2], v0[3]); w.z = cvt_pk_bf16(v1[0], v1[1]); w.w = cvt_pk_bf16(v1[2], v1[3]);
                    *(u32x4*)(rowp + bj * 128) = w; } }
    }
};
struct SchedQKV : pg8::Order {
    const char *xc, *xm, *wqk, *wv;
    __device__ __forceinline__ const char* aptr(const Unit& u) const { const int head = u.pn & 3, kind = u.pn >> 2; return (kind < 2 ? xc : xm) + ((size_t)u.pm * 256 * 1024 + head * 256) * 2; }
    __device__ __forceinline__ const char* bptr(const Unit& u) const { const int head = u.pn & 3, kind = u.pn >> 2; return kind < 2 ? wqk + ((size_t)(head * 512 + kind * 256) * 256) * 2 : wv + ((size_t)head * 65536) * 2; }
};

__device__ __forceinline__ void transpose_item(const float* W, int ldw, int c0, const float* kscale, float scale, bf16_t* WT, int ldt, int row_off, LAS float* scr, int kb, int nb, int lane) {
    const int k0 = 64 * kb, n0 = 32 * nb;
#pragma unroll 8
    for (int i = 0; i < 32; ++i) { const int kk = 2 * i + (lane >> 5); float v = W[(size_t)(k0 + kk) * ldw + c0 + n0 + (lane & 31)] * scale; if (kscale) v *= kscale[k0 + kk]; scr[kk * 33 + (lane & 31)] = v; }
    asm volatile("s_waitcnt lgkmcnt(0)" ::: "memory");
    const int c = lane & 7;
#pragma unroll
    for (int j = 0; j < 4; ++j) { const int n = (lane >> 3) + 8 * j; const LAS float* s = scr + (8 * c) * 33 + n;
        u32x4 o; o.x = cvt_pk_bf16(s[0 * 33], s[1 * 33]); o.y = cvt_pk_bf16(s[2 * 33], s[3 * 33]); o.z = cvt_pk_bf16(s[4 * 33], s[5 * 33]); o.w = cvt_pk_bf16(s[6 * 33], s[7 * 33]);
        *(u32x4*)(WT + (size_t)(row_off + n0 + n) * ldt + k0 + 8 * c) = o; }
    asm volatile("s_waitcnt lgkmcnt(0)" ::: "memory");
}

__device__ __forceinline__ void phase0(const Params& p, LAS unsigned char* lds) {
    const int tid = fresh_tid(), lane = tid & 63, wave = tid >> 6;
    const int gw = blockIdx.x * 8 + wave, NGW = gridDim.x * 8;
    unsigned char* ws = p.ws;
    LAS float* scr = (LAS float*)(lds + wave * 8448);
    LAS float* gwt = (LAS float*)(lds + 8 * 8448);
    { const float* g1 = p.in[1]; const float* w_in = p.in[2];
      for (int i = tid; i < 8192; i += 512) { const int j = i & 7, k = i >> 3; gwt[j * 1024 + k] = g1[k] * w_in[(size_t)k * NIN_ + 2048 + j]; } }
    {
        const int nmat = 20;
        int base = 0;
        for (int mi = 0; mi < nmat; ++mi) {
            const float* W; int ldw, c0, ncols, K; const float* ks = nullptr; float sc = 1.f; bf16_t* WT; int ldt, roff = 0;
            if (mi == 0) { W = p.in[2]; ldw = NIN_; c0 = 0; ncols = 2048; K = 1024; ks = p.in[1]; WT = (bf16_t*)(ws + WS_WIN); ldt = 1024; roff = 0; }
            else if (mi == 1) { W = p.in[2]; ldw = NIN_; c0 = 2056; ncols = 2560; K = 1024; ks = p.in[1]; WT = (bf16_t*)(ws + WS_WIN); ldt = 1024; roff = 2048; }
            else if (mi < 6) { const int h = mi - 2; W = p.in[6] + h * 65536; ldw = 256; c0 = 0; ncols = 256; K = 256; WT = (bf16_t*)(ws + WS_WQK) + h * 512 * 256; ldt = 256; roff = 0; }
            else if (mi < 10) { const int h = mi - 6; W = p.in[7] + h * 65536; ldw = 256; c0 = 0; ncols = 256; K = 256; sc = 0.0625f; WT = (bf16_t*)(ws + WS_WQK) + h * 512 * 256; ldt = 256; roff = 256; }
            else if (mi < 14) { const int h = mi - 10; W = p.in[8] + h * 65536; ldw = 256; c0 = 0; ncols = 256; K = 256; WT = (bf16_t*)(ws + WS_WV) + h * 65536; ldt = 256; roff = 0; }
            else if (mi == 14) { W = p.in[19]; ldw = 512; c0 = 0; ncols = 512; K = 512; WT = (bf16_t*)(ws + WS_WGLU); ldt = 512; }
            else if (mi == 15) { W = p.in[21]; ldw = 1024; c0 = 0; ncols = 1024; K = 1024; WT = (bf16_t*)(ws + WS_WA); ldt = 1024; }
            else if (mi == 16) { W = p.in[22]; ldw = 1024; c0 = 0; ncols = 1024; K = 512; WT = (bf16_t*)(ws + WS_WB); ldt = 512; }
            else if (mi == 17) { W = p.in[23]; ldw = 1024; c0 = 0; ncols = 1024; K = 1024; WT = (bf16_t*)(ws + WS_WOUT); ldt = 1024; }
            else if (mi == 18) { W = p.in[25]; ldw = F2_; c0 = 0; ncols = F2_; K = 1024; ks = p.in[24]; WT = (bf16_t*)(ws + WS_WUP); ldt = 1024; }
            else { W = p.in[28]; ldw = 1024; c0 = 0; ncols = 1024; K = F_; WT = (bf16_t*)(ws + WS_WDN); ldt = F_; }
            const int nblk = ncols / 32, nit = (K / 64) * nblk;
            int it = gw - (base % NGW); if (it < 0) it += NGW;
            for (; it < nit; it += NGW) transpose_item(W, ldw, c0, ks, sc, WT, ldt, roff, scr, it / nblk, it % nblk, lane);
            base += nit;
        }
    }
    {
        const int gt = blockIdx.x * 512 + tid;
        if (gt < SG_ * SP_) {
            const int g = gt >> 6;
            const float ar = p.in[11][gt], ai = p.in[12][gt], dt = expf(p.in[13][g]);
            const float mag = expf(dt * ar); float sn, cs; sincosf(dt * ai, &sn, &cs);
            const float abr = mag * cs, abi = mag * sn;
            const float den = ar * ar + ai * ai, xr = abr - 1.0f, xi = abi;
            const float rre = (xr * ar + xi * ai) / den, rim = (xi * ar - xr * ai) / den;
            float* A = (float*)(ws + WS_S5A); float* A64 = (float*)(ws + WS_S5A64); float* Bb = (float*)(ws + WS_S5B);
            A[gt * 2] = abr; A[gt * 2 + 1] = abi;
            float pr = abr, pi = abi;
#pragma unroll
            for (int i = 0; i < 6; ++i) { const float nr = pr * pr - pi * pi, ni = 2.f * pr * pi; pr = nr; pi = ni; }
            A64[gt * 2] = pr; A64[gt * 2 + 1] = pi;
            const float* bre = p.in[14] + (size_t)gt * 16; const float* bim = p.in[15] + (size_t)gt * 16;
            for (int c = 0; c < 16; ++c) { const float br = bre[c], bi = bim[c]; Bb[((size_t)gt * 16 + c) * 2] = rre * br - rim * bi; Bb[((size_t)gt * 16 + c) * 2 + 1] = rre * bi + rim * br; }
        }
    }
    {
        float* bp = (float*)(ws + WS_BIASP); const float* b_in = p.in[3];
        for (int i = blockIdx.x * 512 + tid; i < NP1_; i += gridDim.x * 512) bp[i] = b_in[i < 2048 ? i : i + 8];
    }
    __syncthreads();
    {
        const float* x = p.in[0]; const float* b_in = p.in[3];
        bf16_t* xb = (bf16_t*)(ws + R0); float* rinv1 = (float*)(ws + WS_RINV1); float* ig = (float*)(ws + WS_IG); float* fg = (float*)(ws + WS_FG);
        for (int row = gw; row < T_; row += NGW) {
            const f32x4* xr = (const f32x4*)(x + (size_t)row * 1024) + lane;
            f32x4 v[4]; float s = 0.f;
#pragma unroll
            for (int j = 0; j < 4; ++j) { v[j] = xr[64 * j]; s += (v[j][0] * v[j][0] + v[j][1] * v[j][1]) + (v[j][2] * v[j][2] + v[j][3] * v[j][3]); }
            float d[8];
#pragma unroll
            for (int g = 0; g < 8; ++g) { float a = 0.f;
#pragma unroll
                for (int j = 0; j < 4; ++j) { const f32x4 w = *(const LAS f32x4*)(gwt + g * 1024 + 256 * j + 4 * lane); a += (v[j][0] * w[0] + v[j][1] * w[1]) + (v[j][2] * w[2] + v[j][3] * w[3]); }
                d[g] = a; }
            s = wave_sum(s);
#pragma unroll
            for (int g = 0; g < 8; ++g) d[g] = wave_sum(d[g]);
            const float ri = rsqrtf(s * (1.0f / 1024.0f) + EPS_);
            u32x2* o8 = (u32x2*)(xb + (size_t)row * 1024) + lane;
#pragma unroll
            for (int j = 0; j < 4; ++j) { u32x2 w; w.x = cvt_pk_bf16(v[j][0], v[j][1]); w.y = cvt_pk_bf16(v[j][2], v[j][3]); o8[64 * j] = w; }
            if (lane == 0) rinv1[row] = ri;
            if (lane < 8) { float val = d[0];
#pragma unroll
                for (int g = 1; g < 8; ++g) val = (lane == g) ? d[g] : val;
                val = val * ri + b_in[2048 + lane];
                if (lane < 4) ig[(size_t)row * 4 + lane] = val; else fg[(size_t)row * 4 + lane - 4] = val; }
        }
    }
}

__device__ __forceinline__ void phase_conv_m(const Params& p) {
    const bf16_t* xm = (const bf16_t*)(p.ws + R1); bf16_t* xc = (bf16_t*)(p.ws + R0);
    const float* cw = p.in[4]; const float* cb = p.in[5];
    const int total = (T_ / 16) * 128;
    for (int idx = blockIdx.x * 512 + fresh_tid(); idx < total; idx += gridDim.x * 512) {
        const int cgi = idx & 127, tb = idx >> 7, c0 = cgi * 8, t0 = tb * 16;
        float w[4][8], b[8];
#pragma unroll
        for (int k = 0; k < 4; ++k) { const f32x4 a = *(const f32x4*)(cw + k * 1024 + c0), bb = *(const f32x4*)(cw + k * 1024 + c0 + 4);
#pragma unroll
            for (int j = 0; j < 4; ++j) { w[k][j] = a[j]; w[k][4 + j] = bb[j]; } }
        { const f32x4 a = *(const f32x4*)(cb + c0), bb = *(const f32x4*)(cb + c0 + 4);
#pragma unroll
          for (int j = 0; j < 4; ++j) { b[j] = a[j]; b[4 + j] = bb[j]; } }
        float r0[8], r1[8], r2[8], r3[8];
        const bool head = (t0 & (SEQ_ - 1)) == 0;
        if (head) {
#pragma unroll
            for (int j = 0; j < 8; ++j) { r0[j] = 0.f; r1[j] = 0.f; r2[j] = 0.f; } }
        else { unpack8(*(const u32x4*)(xm + (size_t)(t0 - 3) * 1024 + c0), r0); unpack8(*(const u32x4*)(xm + (size_t)(t0 - 2) * 1024 + c0), r1); unpack8(*(const u32x4*)(xm + (size_t)(t0 - 1) * 1024 + c0), r2); }
#pragma unroll 4
        for (int i = 0; i < 16; ++i) {
            unpack8(*(const u32x4*)(xm + (size_t)(t0 + i) * 1024 + c0), r3);
            float o[8];
#pragma unroll
            for (int j = 0; j < 8; ++j) { const float y = b[j] + w[0][j] * r0[j] + w[1][j] * r1[j] + w[2][j] * r2[j] + w[3][j] * r3[j]; o[j] = siluf_(y); }
            *(u32x4*)(xc + (size_t)(t0 + i) * 1024 + c0) = pack8(o);
#pragma unroll
            for (int j = 0; j < 8; ++j) { r0[j] = r1[j]; r1[j] = r2[j]; r2[j] = r3[j]; }
        }
    }
}

constexpr int ML_KT = 0, ML_VT = 36864, ML_VTW = 43776, ML_SW = 50688, ML_CB = 59904, ML_SC = 85248;
__device__ __forceinline__ void phase_mlstm(const Params& p, LAS unsigned char* lds) {
    const int tid = fresh_tid(), lane = tid & 63, w = __builtin_amdgcn_readfirstlane(tid >> 6), qi = w & 3, half = w >> 2, lr = lane & 15, lg = lane >> 4;
    const bf16_t* Q = (const bf16_t*)p.out; const bf16_t* Kk = (const bf16_t*)p.out + (size_t)T_ * 1024; const bf16_t* V = (const bf16_t*)(p.ws + R6);
    bf16_t* HC = (bf16_t*)(p.ws + R1);
    const float* IG = (const float*)(p.ws + WS_IG); const float* FG = (const float*)(p.ws + WS_FG);
    LAS bf16_t* kT = (LAS bf16_t*)(lds + ML_KT);
    LAS bf16_t* vT = (LAS bf16_t*)(lds + ML_VT);
    LAS bf16_t* vTw = (LAS bf16_t*)(lds + ML_VTW);
    LAS bf16_t* Sw = (LAS bf16_t*)(lds + ML_SW);
    LAS bf16_t* Cb = (LAS bf16_t*)(lds + ML_CB);
    LAS float* sc_a = (LAS float*)(lds + ML_SC);
    LAS float* sc_M = sc_a + 64, *sc_wi = sc_a + 128, *sc_emr = sc_a + 192, *sc_wk = sc_a + 256, *sc_den = sc_a + 320, *sc_misc = sc_a + 384;
    for (int item = blockIdx.x; item < 256; item += gridDim.x) {
        const int bh = item & 31, vs = item >> 5, b = bh >> 2, h = bh & 3;
        const size_t tok0 = (size_t)b * SEQ_;
        __syncthreads();
        for (int i = tid; i < 48 * 264 / 2; i += 512) ((LAS unsigned*)Cb)[i] = 0u;
        for (int i = tid; i < 2 * 48 * 72 / 2; i += 512) ((LAS unsigned*)vT)[i] = 0u;
        f32x4 Cacc[2][3];
#pragma unroll
        for (int a = 0; a < 2; ++a)
#pragma unroll
            for (int c = 0; c < 3; ++c) Cacc[a][c] = (f32x4){0.f, 0.f, 0.f, 0.f};
        float m_run = 0.f;
        __syncthreads();
        for (int ch = 0; ch < NCH_; ++ch) {
            const size_t tc0 = tok0 + (size_t)ch * 64;
            bf16x8 qf[8], kf[2][8];
            { const bf16_t* qp = Q + (tc0 + 16 * qi + lr) * 1024 + h * 256 + 8 * lg;
#pragma unroll
              for (int ks = 0; ks < 8; ++ks) qf[ks] = *(const bf16x8*)(qp + 32 * ks); }
#pragma unroll
            for (int jj = 0; jj < 2; ++jj) { const bf16_t* kp = Kk + (tc0 + 16 * (2 * half + jj) + lr) * 1024 + h * 256 + 8 * lg;
#pragma unroll
                for (int ks = 0; ks < 8; ++ks) kf[jj][ks] = *(const bf16x8*)(kp + 32 * ks); }
            u32x4 vreg = (u32x4){0u, 0u, 0u, 0u};
            if (tid < 256) vreg = *(const u32x4*)(V + (tc0 + (tid >> 2)) * 1024 + h * 256 + vs * 32 + (tid & 3) * 8);
            if (w == 0) {
                const float fgv = FG[(tc0 + lane) * 4 + h], li = IG[(tc0 + lane) * 4 + h];
                const float lf = fminf(fgv, 0.f) - log1pf(expf(-fabsf(fgv)));
                float bc = lf;
#pragma unroll
                for (int o = 1; o < 64; o <<= 1) { const float t = __shfl_up(bc, o); if (lane >= o) bc += t; }
                const float a = li - bc; float pm = a;
#pragma unroll
                for (int o = 1; o < 64; o <<= 1) { const float t = __shfl_up(pm, o); if (lane >= o) pm = fmaxf(pm, t); }
                const float Mq = fmaxf(m_run, pm);
                const float M63 = __shfl(Mq, 63), b63 = __shfl(bc, 63);
                sc_a[lane] = a; sc_M[lane] = Mq; sc_wi[lane] = expf(m_run - Mq); sc_emr[lane] = expf(-(bc + Mq)); sc_wk[lane] = expf(a - M63);
                if (lane == 0) { sc_misc[0] = expf(m_run - M63); sc_misc[1] = b63 + M63; }
            }
            f32x4 St[2];
#pragma unroll
            for (int jj = 0; jj < 2; ++jj) { St[jj] = (f32x4){0.f, 0.f, 0.f, 0.f};
#pragma unroll
                for (int ks = 0; ks < 8; ++ks) St[jj] = __builtin_amdgcn_mfma_f32_16x16x32_bf16(kf[jj][ks], qf[ks], St[jj], 0, 0, 0); }
#pragma unroll
            for (int jj = 0; jj < 2; ++jj)
#pragma unroll
                for (int k2 = 0; k2 < 2; ++k2) {
                    bf16x8 fragv = kf[jj][0];
#pragma unroll
                    for (int ks = 1; ks < 8; ++ks) if (ks == 2 * qi + k2) fragv = kf[jj][ks];
                    const int c = 16 * (2 * half + jj) + lr, d0 = 32 * (2 * qi + k2) + 8 * lg;
#pragma unroll
                    for (int j = 0; j < 8; ++j) kT[(d0 + j) * 72 + c] = (bf16_t)fragv[j];
                }
            __syncthreads();
            const float decay = sc_misc[0], m_new = sc_misc[1];
#pragma unroll
            for (int jj = 0; jj < 2; ++jj) { const int kt = 2 * half + jj; const int qtok = 16 * qi + lr, k0 = 16 * kt + 4 * lg; const float Mq = sc_M[qtok];
                float o[4];
#pragma unroll
                for (int r = 0; r < 4; ++r) { const int ktok = k0 + r; const float wgt = (ktok <= qtok) ? expf(sc_a[ktok] - Mq) : 0.f; o[r] = St[jj][r] * wgt; }
                u32x2 pk; pk.x = cvt_pk_bf16(o[0], o[1]); pk.y = cvt_pk_bf16(o[2], o[3]);
                *(LAS u32x2*)(Sw + qtok * 72 + k0) = pk; }
            if (tid < 256) { const int c = tid >> 2, v0 = (tid & 3) * 8; float vv[8]; unpack8(vreg, vv); const float wkc = sc_wk[c];
#pragma unroll
                for (int j = 0; j < 8; ++j) { vT[(v0 + j) * 72 + c] = f2bf(vv[j]); vTw[(v0 + j) * 72 + c] = f2bf(vv[j] * wkc); } }
            else if (tid < 320) { const int c = tid - 256; vT[32 * 72 + c] = (bf16_t)0x3f80; vTw[32 * 72 + c] = f2bf(sc_wk[c]); }
            __syncthreads();
            f32x4 num[2]; num[0] = (f32x4){0.f, 0.f, 0.f, 0.f}; num[1] = (f32x4){0.f, 0.f, 0.f, 0.f};
            const int nvt = half == 0 ? 2 : 1, vt0 = half == 0 ? 0 : 2;
#pragma unroll
            for (int i = 0; i < 2; ++i) if (i < nvt) {
                const int vn = vt0 + i;
#pragma unroll
                for (int ks = 0; ks < 8; ++ks) { const bf16x8 cf = *(const LAS bf16x8*)(Cb + (16 * vn + lr) * 264 + 32 * ks + 8 * lg);
                    num[i] = __builtin_amdgcn_mfma_f32_16x16x32_bf16(qf[ks], cf, num[i], 0, 0, 0); }
#pragma unroll
                for (int r = 0; r < 4; ++r) num[i][r] *= sc_wi[16 * qi + 4 * lg + r];
#pragma unroll
                for (int k2 = 0; k2 < 2; ++k2) { const bf16x8 sf = *(const LAS bf16x8*)(Sw + (16 * qi + lr) * 72 + 32 * k2 + 8 * lg);
                    const bf16x8 vf = *(const LAS bf16x8*)(vT + (16 * vn + lr) * 72 + 32 * k2 + 8 * lg);
                    num[i] = __builtin_amdgcn_mfma_f32_16x16x32_bf16(sf, vf, num[i], 0, 0, 0); }
            }
            if (half == 1 && lr == 0) {
#pragma unroll
                for (int r = 0; r < 4; ++r) sc_den[16 * qi + 4 * lg + r] = num[0][r]; }
#pragma unroll
            for (int dm = 0; dm < 2; ++dm) {
                bf16x8 kf2[2];
#pragma unroll
                for (int k2 = 0; k2 < 2; ++k2) kf2[k2] = *(const LAS bf16x8*)(kT + (32 * w + 16 * dm + lr) * 72 + 32 * k2 + 8 * lg);
#pragma unroll
                for (int vn = 0; vn < 3; ++vn) { f32x4 c = Cacc[dm][vn] * decay;
#pragma unroll
                    for (int k2 = 0; k2 < 2; ++k2) { const bf16x8 vf = *(const LAS bf16x8*)(vTw + (16 * vn + lr) * 72 + 32 * k2 + 8 * lg);
                        c = __builtin_amdgcn_mfma_f32_16x16x32_bf16(kf2[k2], vf, c, 0, 0, 0); }
                    Cacc[dm][vn] = c; }
            }
            __syncthreads();
            if (half == 0) {
#pragma unroll
                for (int i = 0; i < 2; ++i)
#pragma unroll
                    for (int r = 0; r < 4; ++r) { const int qt = 16 * qi + 4 * lg + r; const float dn = fmaxf(fabsf(sc_den[qt]), sc_emr[qt]);
                        HC[(tc0 + qt) * 1024 + h * 256 + vs * 32 + 16 * i + lr] = f2bf(num[i][r] / dn); }
            }
#pragma unroll
            for (int dm = 0; dm < 2; ++dm)
#pragma unroll
                for (int vn = 0; vn < 3; ++vn) { const f32x4 c = Cacc[dm][vn]; u32x2 pk; pk.x = cvt_pk_bf16(c[0], c[1]); pk.y = cvt_pk_bf16(c[2], c[3]);
                    *(LAS u32x2*)(Cb + (16 * vn + lr) * 264 + 32 * w + 16 * dm + 4 * lg) = pk; }
            m_run = m_new;
            __syncthreads();
        }
    }
}

__device__ __forceinline__ void phase_aout(const Params& p) {
    const int tid = fresh_tid(), lane = tid & 63, gw = blockIdx.x * 8 + (tid >> 6), NGW = gridDim.x * 8;
    const bf16_t* HC = (const bf16_t*)(p.ws + R1); const bf16_t* SOM = (const bf16_t*)(p.ws + R2); const bf16_t* XC = (const bf16_t*)(p.ws + R0);
    bf16_t* AO = (bf16_t*)(p.ws + R6);
    const float* hg = p.in[9]; const float* sk = p.in[10];
    for (int t = gw; t < T_; t += NGW) {
#pragma unroll
        for (int h = 0; h < 4; ++h) {
            const size_t off = (size_t)t * 1024 + h * 256 + 4 * lane;
            const u32x2 hw = *(const u32x2*)(HC + off), ow = *(const u32x2*)(SOM + off), xw = *(const u32x2*)(XC + off);
            const f32x4 g4 = *(const f32x4*)(hg + h * 256 + 4 * lane), s4 = *(const f32x4*)(sk + h * 256 + 4 * lane);
            float hv[4] = {bflo(hw.x), bfhi(hw.x), bflo(hw.y), bfhi(hw.y)};
            const float ov[4] = {bflo(ow.x), bfhi(ow.x), bflo(ow.y), bfhi(ow.y)}, xv[4] = {bflo(xw.x), bfhi(xw.x), bflo(xw.y), bfhi(xw.y)};
            const float mu = wave_sum((hv[0] + hv[1]) + (hv[2] + hv[3])) * (1.0f / 256.0f);
#pragma unroll
            for (int j = 0; j < 4; ++j) hv[j] -= mu;
            const float var = wave_sum((hv[0] * hv[0] + hv[1] * hv[1]) + (hv[2] * hv[2] + hv[3] * hv[3])) * (1.0f / 256.0f);
            const float rs = rsqrtf(var + EPS_);
            float o[4];
#pragma unroll
            for (int j = 0; j < 4; ++j) o[j] = ov[j] * (hv[j] * rs * g4[j]) + s4[j] * xv[j];
            u32x2 wv; wv.x = cvt_pk_bf16(o[0], o[1]); wv.y = cvt_pk_bf16(o[2], o[3]);
            *(u32x2*)(AO + off) = wv;
        }
    }
}

__device__ __forceinline__ void s5_load_utile(const bf16_t* US, size_t tok0, int g, int lane, LAS float* uf) {
    const u32x4 ua = *(const u32x4*)(US + (tok0 + lane) * 512 + g * 16), ub = *(const u32x4*)(US + (tok0 + lane) * 512 + g * 16 + 8);
    float f[8]; unpack8(ua, f);
    *(LAS f32x4*)(uf + lane * 16) = (f32x4){f[0], f[1], f[2], f[3]}; *(LAS f32x4*)(uf + lane * 16 + 4) = (f32x4){f[4], f[5], f[6], f[7]};
    unpack8(ub, f);
    *(LAS f32x4*)(uf + lane * 16 + 8) = (f32x4){f[0], f[1], f[2], f[3]}; *(LAS f32x4*)(uf + lane * 16 + 12) = (f32x4){f[4], f[5], f[6], f[7]};
}
__device__ __forceinline__ void s5_step(const LAS float* urow, const f32x2 (&bb)[16], float ar, float ai, float& sr, float& si) {
    const f32x4 u0 = *(const LAS f32x4*)(urow), u1 = *(const LAS f32x4*)(urow + 4), u2 = *(const LAS f32x4*)(urow + 8), u3 = *(const LAS f32x4*)(urow + 12);
    f32x2 a0 = bb[0] * u0[0], a1 = bb[1] * u0[1], a2 = bb[2] * u0[2], a3 = bb[3] * u0[3];
    a0 += bb[4] * u1[0]; a1 += bb[5] * u1[1]; a2 += bb[6] * u1[2]; a3 += bb[7] * u1[3];
    a0 += bb[8] * u2[0]; a1 += bb[9] * u2[1]; a2 += bb[10] * u2[2]; a3 += bb[11] * u2[3];
    a0 += bb[12] * u3[0]; a1 += bb[13] * u3[1]; a2 += bb[14] * u3[2]; a3 += bb[15] * u3[3];
    const f32x2 bu = (a0 + a1) + (a2 + a3);
    const float nr = ar * sr - ai * si + bu.x, ni = ar * si + ai * sr + bu.y; sr = nr; si = ni;
}
__device__ __forceinline__ void phase_s5(const Params& p, LAS unsigned char* lds) {
    const int tid = fresh_tid(), lane = tid & 63, wave = __builtin_amdgcn_readfirstlane(tid >> 6);
    const bf16_t* US = (const bf16_t*)(p.ws + R5);
    const float* A = (const float*)(p.ws + WS_S5A); const float* Bb = (const float*)(p.ws + WS_S5B);
    bf16_t* YB = (bf16_t*)(p.ws + R7);
    LAS float* uf = (LAS float*)(lds + wave * 12800);
    LAS float* stash = (LAS float*)(lds + wave * 12800 + 4096);
    LAS float* Eb = (LAS float*)(lds + 8 * 12800);
    for (int item = blockIdx.x; item < NB_ * SG_; item += gridDim.x) {
        const int b = item & 7, g = item >> 3, gp = g * 64 + lane;
        f32x2 bb[16];
#pragma unroll
        for (int c4 = 0; c4 < 8; ++c4) { const f32x4 v = *(const f32x4*)(Bb + (size_t)gp * 32 + 4 * c4); bb[2 * c4] = (f32x2){v[0], v[1]}; bb[2 * c4 + 1] = (f32x2){v[2], v[3]}; }
        const float ar = A[gp * 2], ai = A[gp * 2 + 1];
        const size_t tokw = (size_t)b * SEQ_ + (size_t)wave * 512;
        float sr = 0.f, si = 0.f;
        for (int cc = 0; cc < 8; ++cc) {
            s5_load_utile(US, tokw + cc * 64, g, lane, uf);
#pragma unroll 4
            for (int t = 0; t < 64; ++t) s5_step(uf + t * 16, bb, ar, ai, sr, si);
        }
        Eb[(wave * 64 + lane) * 2] = sr; Eb[(wave * 64 + lane) * 2 + 1] = si;
        __syncthreads();
        float pr = ar, pi = ai;
#pragma unroll
        for (int i = 0; i < 9; ++i) { const float nr = pr * pr - pi * pi, ni = 2.f * pr * pi; pr = nr; pi = ni; }
        sr = 0.f; si = 0.f;
        for (int j = 0; j < wave; ++j) { const float er = Eb[(j * 64 + lane) * 2], ei = Eb[(j * 64 + lane) * 2 + 1]; const float nr = pr * sr - pi * si + er, ni = pr * si + pi * sr + ei; sr = nr; si = ni; }
        float bk[32];
        { const float* cre = p.in[16] + ((size_t)g * 16 + (lane & 15)) * 64 + (lane >> 4); const float* cim = p.in[17] + ((size_t)g * 16 + (lane & 15)) * 64 + (lane >> 4);
#pragma unroll
          for (int kk = 0; kk < 16; ++kk) { bk[kk] = cre[4 * kk]; bk[16 + kk] = -cim[4 * kk]; } }
        const int c = lane & 15; const float dsk = p.in[18][g * 16 + c];
        for (int cc = 0; cc < 8; ++cc) {
            const size_t tok0 = tokw + cc * 64;
            s5_load_utile(US, tok0, g, lane, uf);
            for (int tb = 0; tb < 4; ++tb) {
#pragma unroll 4
                for (int tt = 0; tt < 16; ++tt) { s5_step(uf + (tb * 16 + tt) * 16, bb, ar, ai, sr, si); stash[tt * 132 + lane] = sr; stash[tt * 132 + 64 + lane] = si; }
                f32x4 y = (f32x4){0.f, 0.f, 0.f, 0.f};
#pragma unroll
                for (int kk = 0; kk < 32; ++kk) { const float a = stash[(lane & 15) * 132 + 4 * kk + (lane >> 4)]; y = __builtin_amdgcn_mfma_f32_16x16x4f32(a, bk[kk], y, 0, 0, 0); }
#pragma unroll
                for (int r = 0; r < 4; ++r) { const int tl = tb * 16 + 4 * (lane >> 4) + r; const float uu = uf[tl * 16 + c];
                    const float v = y[r] + dsk * uu;
                    const float z = 0.7978845608f * (v + 0.044715f * v * v * v); const float th = 1.0f - 2.0f * __builtin_amdgcn_rcpf(1.0f + __expf(2.0f * z));
                    YB[(tok0 + tl) * 512 + g * 16 + c] = f2bf(0.5f * v * (1.0f + th)); }
            }
        }
        __syncthreads();
    }
}

__device__ __forceinline__ void phase_ffn_act(const Params& p, int half) {
    const bf16_t* U = (const bf16_t*)(p.ws + WS_UH); bf16_t* ACT = (bf16_t*)(p.ws + WS_ACT) + (size_t)half * 16384 * F_;
    const float* cw = p.in[26]; const float* cb = p.in[27];
    const int total = (16384 / 16) * 352;
    for (int idx = blockIdx.x * 512 + fresh_tid(); idx < total; idx += gridDim.x * 512) {
        const int fg = idx % 352, tb = idx / 352, f0 = fg * 8, t0 = tb * 16;
        float wv[3][8], wg[3][8], bvv[8], bgg[8];
#pragma unroll
        for (int k = 0; k < 3; ++k) { const f32x4 a = *(const f32x4*)(cw + k * F2_ + f0), b = *(const f32x4*)(cw + k * F2_ + f0 + 4), c = *(const f32x4*)(cw + k * F2_ + F_ + f0), d = *(const f32x4*)(cw + k * F2_ + F_ + f0 + 4);
#pragma unroll
            for (int j = 0; j < 4; ++j) { wv[k][j] = a[j]; wv[k][4 + j] = b[j]; wg[k][j] = c[j]; wg[k][4 + j] = d[j]; } }
        { const f32x4 a = *(const f32x4*)(cb + f0), b = *(const f32x4*)(cb + f0 + 4), c = *(const f32x4*)(cb + F_ + f0), d = *(const f32x4*)(cb + F_ + f0 + 4);
#pragma unroll
          for (int j = 0; j < 4; ++j) { bvv[j] = a[j]; bvv[4 + j] = b[j]; bgg[j] = c[j]; bgg[4 + j] = d[j]; } }
        float v0[8], v1[8], v2[8], g0[8], g1[8], g2[8];
        const bool head = (t0 & (SEQ_ - 1)) == 0;
        if (head) {
#pragma unroll
            for (int j = 0; j < 8; ++j) { v0[j] = 0.f; v1[j] = 0.f; g0[j] = 0.f; g1[j] = 0.f; } }
        else { unpack8(*(const u32x4*)(U + (size_t)(t0 - 2) * F2_ + f0), v0); unpack8(*(const u32x4*)(U + (size_t)(t0 - 1) * F2_ + f0), v1);
               unpack8(*(const u32x4*)(U + (size_t)(t0 - 2) * F2_ + F_ + f0), g0); unpack8(*(const u32x4*)(U + (size_t)(t0 - 1) * F2_ + F_ + f0), g1); }
#pragma unroll 4
        for (int i = 0; i < 16; ++i) {
            unpack8(*(const u32x4*)(U + (size_t)(t0 + i) * F2_ + f0), v2); unpack8(*(const u32x4*)(U + (size_t)(t0 + i) * F2_ + F_ + f0), g2);
            float o[8];
#pragma unroll
            for (int j = 0; j < 8; ++j) { const float val = bvv[j] + wv[0][j] * v0[j] + wv[1][j] * v1[j] + wv[2][j] * v2[j]; const float gt = bgg[j] + wg[0][j] * g0[j] + wg[1][j] * g1[j] + wg[2][j] * g2[j]; o[j] = siluf_(gt) * val; }
            *(u32x4*)(ACT + (size_t)(t0 + i) * F_ + f0) = pack8(o);
#pragma unroll
            for (int j = 0; j < 8; ++j) { v0[j] = v1[j]; v1[j] = v2[j]; g0[j] = g1[j]; g1[j] = g2[j]; }
        }
    }
}

__device__ __forceinline__ void phase_final(const Params& p) {
    const int tid = fresh_tid(), lane = tid & 63, gw = blockIdx.x * 8 + (tid >> 6), NGW = gridDim.x * 8;
    const float* ss = (const float*)(p.ws + WS_SS2); const float* gf = p.in[29];
    for (int row = gw; row < T_; row += NGW) {
        const float sv = (lane < 16) ? ss[(size_t)row * 16 + lane] : 0.f;
        const float ri = rsqrtf(wave_sum(sv) * (1.0f / 1024.0f) + EPS_);
        f32x4* xr = (f32x4*)(p.out + (size_t)row * 1024) + lane;
#pragma unroll
        for (int j = 0; j < 4; ++j) { const f32x4 g4 = *((const f32x4*)gf + lane + 64 * j); f32x4 v = xr[64 * j]; v = v * ri * g4; xr[64 * j] = v; }
    }
}

#ifndef PHASE_MASK
#define PHASE_MASK 0xffffffffu
#endif
#define PH(k) ((PHASE_MASK >> (k)) & 1u)
#ifndef REP_MASK
#define REP_MASK 0u
#endif
#define REPS(k) for (int rep_ = 0; rep_ < 1 + (int)((REP_MASK >> (k)) & 1u); ++rep_)
__global__ void __launch_bounds__(512, 2) fwd_megakernel(Params p) {
    extern __shared__ __attribute__((aligned(16))) unsigned char lds_raw[];
    LAS unsigned char* lds = (LAS unsigned char*)lds_raw;
    cg::grid_group grid = cg::this_grid();
    unsigned char* ws = p.ws;
    bf16_t* dq = (bf16_t*)p.out;
    volatile LAS unsigned* bst = (volatile LAS unsigned*)(lds + LDS_BYTES - 64);
    if (threadIdx.x < 2) bst[threadIdx.x] = 0u;
    if (blockIdx.x == 0) { unsigned* bw = (unsigned*)(ws + WS_BAR); for (int i = threadIdx.x; i < XCD_BAR_WORDS; i += 512) bw[i] = 0u; }
    __syncthreads();
    REPS(0) if (PH(0)) phase0(p, lds);
    grid.sync();
    const XcdBarrier xbar = xcd_barrier_post((unsigned*)(ws + WS_BAR), bst);
    REPS(1) if (PH(1)) { pg8::PlainSched S; S.set(ws + R0, 1024, ws + WS_WIN, 1024, T_ / 256, NP1_ / 256);
      EpiProj E{(const float*)(ws + WS_RINV1), (const float*)(ws + WS_BIASP), (bf16_t*)(ws + R1), (bf16_t*)(ws + R2), (bf16_t*)(ws + R5), (bf16_t*)(ws + R3), (bf16_t*)(ws + R4)};
      pg8::gemm_phase(lds, S, E, 1024, 1024, 1024); }
    xcd_barrier(xbar);
    REPS(2) if (PH(2)) phase_conv_m(p);
    xcd_barrier(xbar);
    REPS(3) if (PH(3)) { SchedQKV S; S.init(T_ / 256, 12, gridDim.x, blockIdx.x); S.xc = (const char*)(ws + R0); S.xm = (const char*)(ws + R1); S.wqk = (const char*)(ws + WS_WQK); S.wv = (const char*)(ws + WS_WV);
      EpiQKV E{dq, (bf16_t*)(ws + R6)};
      pg8::gemm_phase(lds, S, E, 256, 1024, 256); }
    xcd_barrier(xbar);
    REPS(4) if (PH(4)) phase_mlstm(p, lds);
    xcd_barrier(xbar);
    REPS(5) if (PH(5)) phase_aout(p);
    REPS(6) if (PH(6)) phase_s5(p, lds);
    xcd_barrier(xbar);
    REPS(8) if (PH(8)) { pg8::PlainSched S; S.set(ws + R7, 512, ws + WS_WGLU, 512, T_ / 256, 2);
      EpiGate<0> E{(const bf16_t*)(ws + R7), nullptr, p.in[20], dq, 512};
      pg8::gemm_phase(lds, S, E, 512, 512, 512); }
    xcd_barrier(xbar);
    REPS(9) if (PH(9)) { pg8::PlainSched S; S.set(dq, 512, ws + WS_WB, 512, T_ / 256, 4);
      EpiGate<1> E{(const bf16_t*)(ws + R4), nullptr, nullptr, (bf16_t*)(ws + R1), 1024};
      pg8::gemm_phase(lds, S, E, 512, 512, 512); }
    xcd_barrier(xbar);
    REPS(10) if (PH(10)) { pg8::PlainSched S; S.set(ws + R6, 1024, ws + WS_WA, 1024, T_ / 256, 4);
      EpiGate<2> E{(const bf16_t*)(ws + R3), (const bf16_t*)(ws + R1), nullptr, (bf16_t*)(ws + R0), 1024};
      pg8::gemm_phase(lds, S, E, 1024, 1024, 1024); }
    xcd_barrier(xbar);
    REPS(11) if (PH(11)) { pg8::PlainSched S; S.set(ws + R0, 1024, ws + WS_WOUT, 1024, T_ / 256, 4);
      EpiResid<true> E{p.in[0], p.out, (bf16_t*)(ws + WS_X1B), (float*)(ws + WS_SS1)};
      pg8::gemm_phase(lds, S, E, 1024, 1024, 1024); }
    xcd_barrier(xbar);
    for (int half = 0; half < 2; ++half) {
        REPS(12) if (PH(12)) { pg8::PlainSched S; S.set(ws + WS_X1B + (size_t)half * 16384 * 1024 * 2, 1024, ws + WS_WUP, 1024, 64, F2_ / 256);
          EpiUp E{(const float*)(ws + WS_SS1), (bf16_t*)(ws + WS_UH), half * 16384};
          pg8::gemm_phase(lds, S, E, 1024, 1024, 1024); }
        xcd_barrier(xbar);
        REPS(13) if (PH(13)) phase_ffn_act(p, half);
        xcd_barrier(xbar);
    }
    REPS(14) if (PH(14)) { pg8::PlainSched S; S.set(ws + WS_ACT, F_, ws + WS_WDN, F_, T_ / 256, 4);
      EpiResid<false> E{p.out, (rep_ + 1 < 1 + (int)((REP_MASK >> 14) & 1u)) ? (float*)(ws + WS_UH) : p.out, nullptr, (float*)(ws + WS_SS2)};
      pg8::gemm_phase(lds, S, E, F_, F_, F_); }
    xcd_barrier(xbar);
    REPS(15) if (PH(15)) phase_final(p);
}

extern "C" void kernel_launch(void* const* d_in, const int* in_sizes, int n_in, void* d_out, int out_size, void* d_ws, size_t ws_size, hipStream_t stream) {
    static int grid_blocks = 0;
    if (!grid_blocks) {
        int dev = 0, cus = 0, per_cu = 0;
        (void)hipGetDevice(&dev);
        (void)hipDeviceGetAttribute(&cus, hipDeviceAttributeMultiprocessorCount, dev);
        (void)hipFuncSetAttribute((const void*)fwd_megakernel, hipFuncAttributeMaxDynamicSharedMemorySize, LDS_BYTES);
        (void)hipOccupancyMaxActiveBlocksPerMultiprocessor(&per_cu, (const void*)fwd_megakernel, 512, LDS_BYTES);
        if (per_cu < 1) { fprintf(stderr, "kernel_launch: occupancy query returned %d\n", per_cu); }
        grid_blocks = cus;
        if (n_in != 30 || out_size != T_ * D_ || ws_size < 512 * MiB) fprintf(stderr, "kernel_launch: unexpected sizes n_in=%d out=%d ws=%zu\n", n_in, out_size, ws_size);
    }
    Params p{};
    for (int i = 0; i < 30; ++i) p.in[i] = (const float*)d_in[i];
    p.out = (float*)d_out; p.ws = (unsigned char*)d_ws;
    void* args[] = {&p};
    hipError_t e = hipLaunchCooperativeKernel((void*)fwd_megakernel, dim3(grid_blocks), dim3(512), args, LDS_BYTES, stream);
    if (e != hipSuccess) fprintf(stderr, "cooperative launch failed: %s (grid %d)\n", hipGetErrorString(e), grid_blocks);
}
```

```cpp
#include <hip/hip_runtime.h>
#include <hip/hip_cooperative_groups.h>
#include <cstdio>
#include <cstdint>
namespace cg = cooperative_groups;

#define LAS __attribute__((address_space(3)))
typedef unsigned short bf16_t;
typedef short bf16x8 __attribute__((ext_vector_type(8)));
typedef float f32x4 __attribute__((ext_vector_type(4)));
typedef float f32x2 __attribute__((ext_vector_type(2)));
typedef unsigned u32x4 __attribute__((ext_vector_type(4)));
typedef unsigned u32x2 __attribute__((ext_vector_type(2)));

constexpr int T_ = 32768, D_ = 1024, SEQ_ = 4096, NB_ = 8;
constexpr int NH_ = 4, DH_ = 256, NCH_ = 64;
constexpr int SW_ = 512, SG_ = 32, SP_ = 64;
constexpr int F_ = 2816, F2_ = 5632, NIN_ = 4616, NP1_ = 4608;
constexpr float EPS_ = 1e-6f;

constexpr size_t MiB = 1ull << 20, KiB = 1024;
constexpr size_t WS_WIN = 0, WS_WQK = 9 * MiB, WS_WV = 10 * MiB, WS_WGLU = 10 * MiB + 512 * KiB, WS_WA = 11 * MiB, WS_WB = 13 * MiB, WS_WOUT = 14 * MiB,
                 WS_WUP = 16 * MiB, WS_WDN = 27 * MiB;
constexpr size_t WS_S5A = 33 * MiB, WS_S5A64 = WS_S5A + 16 * KiB, WS_S5B = WS_S5A + 32 * KiB;
constexpr size_t WS_RINV1 = 34 * MiB, WS_IG = 34 * MiB + 512 * KiB, WS_FG = 35 * MiB, WS_BIASP = 35 * MiB + 512 * KiB;
constexpr size_t WS_GS = 50 * MiB;
constexpr size_t WS_BAR = 49 * MiB;
constexpr size_t WS_SS1 = 36 * MiB, WS_SS2 = 38 * MiB, WS_E = 40 * MiB;
constexpr size_t R0 = 56 * MiB, R1 = 120 * MiB, R2 = 184 * MiB, R3 = 248 * MiB, R4 = 312 * MiB, R5 = 376 * MiB, R6 = 408 * MiB, R7 = 472 * MiB;
constexpr size_t WS_X1B = 448 * MiB, WS_UH = 56 * MiB, WS_ACT = 232 * MiB;
constexpr int LDS_BYTES = 147456;

struct Params {
    const float* in[30];
    float* out;
    unsigned char* ws;
};

__device__ __forceinline__ unsigned cvt_pk_bf16(float lo, float hi) { unsigned r; asm volatile("v_cvt_pk_bf16_f32 %0, %1, %2" : "=v"(r) : "v"(lo), "v"(hi)); return r; }
__device__ __forceinline__ bf16_t f2bf(float x) { return (bf16_t)(cvt_pk_bf16(x, x) & 0xffffu); }
__device__ __forceinline__ float bf2f(unsigned short u) { return __uint_as_float(((unsigned)u) << 16); }
__device__ __forceinline__ float bflo(unsigned w) { return __uint_as_float(w << 16); }
__device__ __forceinline__ float bfhi(unsigned w) { return __uint_as_float(w & 0xffff0000u); }
__device__ __forceinline__ float sigmoidf_(float x) { return __builtin_amdgcn_rcpf(1.0f + __expf(-x)); }
__device__ __forceinline__ float siluf_(float x) { return x * sigmoidf_(x); }
__device__ __forceinline__ int fresh_tid() { int t = threadIdx.x; asm volatile("" : "+v"(t)); return t; }
__device__ __forceinline__ float wave_sum(float v) {
#pragma unroll
    for (int o = 1; o < 64; o <<= 1) v += __shfl_xor(v, o);
    return v;
}
__device__ __forceinline__ void unpack8(const u32x4 w, float (&f)[8]) {
    f[0] = bflo(w.x); f[1] = bfhi(w.x); f[2] = bflo(w.y); f[3] = bfhi(w.y); f[4] = bflo(w.z); f[5] = bfhi(w.z); f[6] = bflo(w.w); f[7] = bfhi(w.w);
}
__device__ __forceinline__ u32x4 pack8(const float (&f)[8]) {
    u32x4 w; w.x = cvt_pk_bf16(f[0], f[1]); w.y = cvt_pk_bf16(f[2], f[3]); w.z = cvt_pk_bf16(f[4], f[5]); w.w = cvt_pk_bf16(f[6], f[7]); return w;
}


#define XB_TMO      128
#define XB_XCNT(j)  (256  + 64 * (j))
#define XB_XSUB(j)  (1280 + 64 * (j))
#define XB_XGEN(j)  (2304 + 64 * (j))
#define XB_TOP      3328
#define XB_TOPGEN   3392
#define XCD_BAR_WORDS 3456
#define XB_SPIN_CAP (1u << 18)
__device__ __forceinline__ unsigned xb_ld(unsigned* p)              { return __hip_atomic_load(p, __ATOMIC_RELAXED, __HIP_MEMORY_SCOPE_AGENT); }
__device__ __forceinline__ unsigned xb_add(unsigned* p, unsigned v) { return __hip_atomic_fetch_add(p, v, __ATOMIC_RELAXED, __HIP_MEMORY_SCOPE_AGENT); }
__device__ __forceinline__ unsigned xb_xcc_id() { return (unsigned)__builtin_amdgcn_s_getreg((3 << 11) | 20) & 0xFu; }
#define XB_SPIN(cond, bar) do { unsigned _sp = 0; while (cond) { __builtin_amdgcn_s_sleep(1); \
    if ((++_sp & 255u) == 0u) { if (xb_ld(&(bar)[XB_TMO])) break; if (_sp > XB_SPIN_CAP) { atomicAdd(&(bar)[XB_TMO], 1u); break; } } } } while (0)
struct XcdBarrier { unsigned* bar; unsigned x; volatile LAS unsigned* st; };
__device__ __forceinline__ XcdBarrier xcd_barrier_post(unsigned* bar, volatile LAS unsigned* st) {
    XcdBarrier b; b.bar = bar; b.x = xb_xcc_id(); b.st = st;
    if (threadIdx.x == 0) (void)xb_add(&bar[XB_XCNT(b.x)], 1u);
    return b;
}
__device__ __forceinline__ void xcd_barrier_complete(unsigned* bar, unsigned x, unsigned& nloc, unsigned& nx) {
    const unsigned G = gridDim.x * gridDim.y * gridDim.z;
    unsigned sum, cnt, mine, sp = 0u;
    for (;;) {
        sum = 0u; cnt = 0u; mine = 0u;
#pragma unroll
        for (unsigned j = 0; j < 16; ++j) { const unsigned c = xb_ld(&bar[XB_XCNT(j)]); sum += c; cnt += (c > 0u) ? 1u : 0u; mine = (j == x) ? c : mine; }
        if (sum == G) break;
        __builtin_amdgcn_s_sleep(1);
        if ((++sp & 255u) == 0u) { if (xb_ld(&bar[XB_TMO])) break; if (sp > XB_SPIN_CAP) { atomicAdd(&bar[XB_TMO], 1u); break; } }
    }
    nloc = mine > 0u ? mine : 1u; nx = cnt > 0u ? cnt : 1u;
}
__device__ __forceinline__ void xcd_barrier(const XcdBarrier& b) {
    asm volatile("s_waitcnt vmcnt(0)" ::: "memory");
    __syncthreads();
    if (threadIdx.x == 0) {
        unsigned* bar = b.bar;
        __builtin_amdgcn_s_waitcnt(0);
        unsigned nloc = b.st[0], nx = b.st[1];
        if (nloc == 0u) { xcd_barrier_complete(bar, b.x, nloc, nx); b.st[0] = nloc; b.st[1] = nx; }
        const unsigned old = xb_add(&bar[XB_XSUB(b.x)], 1u);
        const unsigned gen = old / nloc;
        if (old + 1u == (gen + 1u) * nloc) {
            __builtin_amdgcn_fence(__ATOMIC_RELEASE, "agent");
            asm volatile("s_waitcnt vmcnt(0)" ::: "memory");
            const unsigned og = xb_add(&bar[XB_TOP], 1u);
            const unsigned tg = og / nx;
            if (og + 1u == (tg + 1u) * nx) xb_add(&bar[XB_TOPGEN], 1u);
            else XB_SPIN(xb_ld(&bar[XB_TOPGEN]) == tg, bar);
            __builtin_amdgcn_fence(__ATOMIC_ACQUIRE, "agent");
            xb_add(&bar[XB_XGEN(b.x)], 1u);
            asm volatile("s_waitcnt vmcnt(0)" ::: "memory");
        } else {
            XB_SPIN(xb_ld(&bar[XB_XGEN(b.x)]) == gen, bar);
            __builtin_amdgcn_fence(__ATOMIC_ACQUIRE, "agent");
            asm volatile("s_waitcnt vmcnt(0)" ::: "memory");
        }
    }
    __syncthreads();
}

namespace pg8 {
constexpr int BM = 256, BK = 64, HALF = 128, HTB = HALF * BK * 2, STAGE_BYTES = 8 * HTB, NXCD = 8, WGM = 8;
__device__ __forceinline__ int lds_byte(int r, int c) { const int st = (r >> 4) * 2 + (c >> 5), rr = r & 15, cc = c & 31, ob = rr * 64 + cc * 2; return st * 1024 + (ob ^ (((ob >> 9) & 1) << 5)); }
__device__ __forceinline__ void stage_rc(int b, int& R, int& C) { const int st = b / 1024, sb = b % 1024, swz = sb ^ (((sb >> 9) & 1) << 5); R = (st >> 1) * 16 + swz / 64; C = (st & 1) * 32 + (swz % 64) / 2; }
__device__ __forceinline__ int perm32(int rho) { const int n = rho >> 4, i = rho & 15; return 8 * (i >> 2) + 4 * n + (i & 3); }
struct Unit { int pm, pn; };
struct Order {
    int nM, nN, nwg, G, c;
    __device__ __forceinline__ void init(int nM_, int nN_, int G_, int c_) { nM = nM_; nN = nN_; nwg = nM * nN; G = G_; c = c_; }
    __device__ __forceinline__ bool next(int i, Unit& u) const {
        const long L = (long)i * G + c; if (L >= nwg) return false;
        int wgid = (int)L; { const int q = nwg / NXCD, r = nwg % NXCD, xcd = wgid % NXCD, off = wgid / NXCD; wgid = (xcd < r ? xcd * (q + 1) : r * (q + 1) + (xcd - r) * q) + off; }
        const int nig = WGM * nN, gid = wgid / nig, fm = gid * WGM, gsz = (nM - fm) < WGM ? (nM - fm) : WGM;
        u.pm = fm + ((wgid % nig) % gsz); u.pn = (wgid % nig) / gsz; return true;
    }
};
template <class Epi, class Sched>
__device__ __forceinline__ void gemm_phase(LAS unsigned char* lds, const Sched& S, const Epi& E, const int K, const int lda, const int ldb) {
    const int tid = fresh_tid(), wid = __builtin_amdgcn_readfirstlane(tid >> 6), lane = tid & 63, wr = wid >> 2, wc = wid & 3, fr = lane & 15, fq = lane >> 4;
    const int nt = K / BK;
    unsigned voffA[2], voffB[2];
#pragma unroll
    for (int i = 0; i < 2; ++i) { int R, C; stage_rc(tid * 16 + i * 8192, R, C); const int Rb = Epi::PERM ? ((R & ~31) + perm32(R & 31)) : R;
        voffA[i] = (unsigned)(R * lda + C) * 2u; voffB[i] = (unsigned)(Rb * ldb + C) * 2u; }
    const size_t kstep = (size_t)(BK * 2);
    const size_t hstepA = (size_t)HALF * lda * 2, hstepB = (size_t)HALF * ldb * 2;
    const unsigned ldsw = (unsigned)wid * 1024u;
    const int aoff = lds_byte(wr * 64 + fr, fq * 8), boff = lds_byte(wc * 32 + fr, fq * 8);
#define PG8_SA(b, h) (((b) * 2 + (h)) * HTB)
#define PG8_SB(b, h) ((4 + (b) * 2 + (h)) * HTB)
#define PG8_STAGE(bufoff, gbase, voff) do { _Pragma("unroll") for (int _i = 0; _i < 2; ++_i) \
        __builtin_amdgcn_global_load_lds((const unsigned*)((const char*)(gbase) + (voff)[_i]), (LAS unsigned*)(lds + (bufoff) + ldsw + _i * 8192), 16, 0, 0); } while (0)
#define PG8_LDA(dst, b, h) do { _Pragma("unroll") for (int m = 0; m < 4; ++m) _Pragma("unroll") for (int k = 0; k < 2; ++k) dst[m][k] = *(const LAS bf16x8*)(lds + PG8_SA(b, h) + aoff + m * 2048 + k * 1024); } while (0)
#define PG8_LDB(dst, b, h) do { _Pragma("unroll") for (int n = 0; n < 2; ++n) _Pragma("unroll") for (int k = 0; k < 2; ++k) dst[n][k] = *(const LAS bf16x8*)(lds + PG8_SB(b, h) + boff + n * 2048 + k * 1024); } while (0)
#define PG8_MMA(ai, bj, At, Bt) do { __builtin_amdgcn_s_setprio(1); _Pragma("unroll") for (int m = 0; m < 4; ++m) _Pragma("unroll") for (int n = 0; n < 2; ++n) _Pragma("unroll") for (int k = 0; k < 2; ++k) \
        acc[ai][bj][m][n] = __builtin_amdgcn_mfma_f32_16x16x32_bf16(Bt[n][k], At[m][k], acc[ai][bj][m][n], 0, 0, 0); __builtin_amdgcn_s_setprio(0); } while (0)
#define PG8_WAIT_V(n) asm volatile("s_waitcnt vmcnt(" #n ")" ::: "memory")
#define PG8_WAIT_L(n) asm volatile("s_waitcnt lgkmcnt(" #n ")" ::: "memory")
#define PG8_BAR __builtin_amdgcn_s_barrier()
#define PG8_SCHED __builtin_amdgcn_sched_barrier(0)
    Unit cur, nxt; int ui = 0;
    if (!S.next(0, cur)) return;
    f32x4 acc[2][2][4][2];
#pragma unroll
    for (int a = 0; a < 2; ++a)
#pragma unroll
        for (int b = 0; b < 2; ++b)
#pragma unroll
            for (int m = 0; m < 4; ++m)
#pragma unroll
                for (int n = 0; n < 2; ++n) acc[a][b][m][n] = (f32x4){0.f, 0.f, 0.f, 0.f};
    bf16x8 At[4][2], B0[2][2], B1[2][2];
    const char* cA = S.aptr(cur); const char* cB = S.bptr(cur);
    PG8_STAGE(PG8_SB(0, 0), cB, voffB); PG8_STAGE(PG8_SB(0, 1), cB + hstepB, voffB); PG8_STAGE(PG8_SA(0, 0), cA, voffA); PG8_STAGE(PG8_SA(0, 1), cA + hstepA, voffA);
    if (wr == 1) PG8_BAR;
    PG8_WAIT_V(2); PG8_BAR;
    PG8_STAGE(PG8_SB(1, 0), cB + kstep, voffB); PG8_STAGE(PG8_SA(1, 0), cA + kstep, voffA); PG8_STAGE(PG8_SB(1, 1), cB + hstepB + kstep, voffB);
    PG8_WAIT_V(6); PG8_BAR;
    for (;;) {
        const bool has_next = S.next(ui + 1, nxt);
        const char* nA = has_next ? S.aptr(nxt) : cA; const char* nB = has_next ? S.bptr(nxt) : cB;
#pragma unroll 1
        for (int t = 0; t < nt; t += 2) {
            const bool last = (t == nt - 2);
            const char* a1 = cA + (size_t)(t + 1) * kstep;
            const char* a2 = last ? nA : cA + (size_t)(t + 2) * kstep; const char* b2 = last ? nB : cB + (size_t)(t + 2) * kstep;
            const char* a3 = a2 + kstep; const char* b3 = b2 + kstep;
            PG8_LDB(B0, 0, 0); PG8_LDB(B1, 0, 1); PG8_SCHED; PG8_LDA(At, 0, 0); PG8_STAGE(PG8_SA(1, 1), a1 + hstepA, voffA);
            PG8_WAIT_V(8); PG8_WAIT_L(0); PG8_BAR; PG8_MMA(0, 0, At, B0); PG8_MMA(0, 1, At, B1); PG8_BAR; PG8_SCHED;
            PG8_LDA(At, 0, 1); PG8_STAGE(PG8_SB(0, 0), b2, voffB); PG8_STAGE(PG8_SB(0, 1), b2 + hstepB, voffB); PG8_STAGE(PG8_SA(0, 0), a2, voffA);
            PG8_WAIT_V(8); PG8_WAIT_L(0); PG8_BAR; PG8_MMA(1, 0, At, B0); PG8_MMA(1, 1, At, B1); PG8_BAR; PG8_SCHED;
            PG8_LDB(B0, 1, 0); PG8_LDB(B1, 1, 1); PG8_SCHED; PG8_LDA(At, 1, 0); PG8_STAGE(PG8_SA(0, 1), a2 + hstepA, voffA);
            PG8_WAIT_V(8); PG8_WAIT_L(0); PG8_BAR; PG8_MMA(0, 0, At, B0); PG8_MMA(0, 1, At, B1); PG8_BAR; PG8_SCHED;
            PG8_LDA(At, 1, 1); PG8_STAGE(PG8_SB(1, 0), b3, voffB); PG8_STAGE(PG8_SB(1, 1), b3 + hstepB, voffB); PG8_STAGE(PG8_SA(1, 0), a3, voffA);
            PG8_WAIT_V(8); PG8_WAIT_L(0); PG8_BAR; PG8_MMA(1, 0, At, B0); PG8_MMA(1, 1, At, B1); PG8_BAR; PG8_SCHED;
        }
        if (wr == 0) PG8_BAR;
        E(acc, cur, wr, wc, fr, fq);
        if (!has_next) break;
#pragma unroll
        for (int a = 0; a < 2; ++a)
#pragma unroll
            for (int b = 0; b < 2; ++b)
#pragma unroll
                for (int m = 0; m < 4; ++m)
#pragma unroll
                    for (int n = 0; n < 2; ++n) acc[a][b][m][n] = (f32x4){0.f, 0.f, 0.f, 0.f};
        cur = nxt; cA = nA; cB = nB; ++ui;
        if (wr == 1) PG8_BAR;
    }
    PG8_WAIT_V(0);
    PG8_BAR;
#undef PG8_SA
#undef PG8_SB
#undef PG8_STAGE
#undef PG8_LDA
#undef PG8_LDB
#undef PG8_MMA
#undef PG8_WAIT_V
#undef PG8_WAIT_L
#undef PG8_BAR
#undef PG8_SCHED
}
struct PlainSched : Order {
    const char* A; const char* B; size_t astep, bstep;
    __device__ __forceinline__ void set(const void* A_, int lda, const void* B_, int ldb, int nM_, int nN_) { A = (const char*)A_; B = (const char*)B_; astep = (size_t)BM * lda * 2; bstep = (size_t)BM * ldb * 2; init(nM_, nN_, gridDim.x, blockIdx.x); }
    __device__ __forceinline__ const char* aptr(const Unit& u) const { return A + (size_t)u.pm * astep; }
    __device__ __forceinline__ const char* bptr(const Unit& u) const { return B + (size_t)u.pn * bstep; }
};
}
using pg8::Unit;
typedef const f32x4 (&AccRef)[2][2][4][2];

struct EpiProj {
    static constexpr bool PERM = true;
    const float* rinv; const float* bias; bf16_t *xm, *som, *us, *sga, *sgb;
    __device__ __forceinline__ void operator()(AccRef acc, const Unit& u, int wr, int wc, int fr, int fq) const {
        const int pn = u.pn; bf16_t* base; int ldc, colt; bool sig;
        if (pn < 4) { base = xm; ldc = 1024; colt = pn * 256; sig = false; }
        else if (pn < 8) { base = som; ldc = 1024; colt = (pn - 4) * 256; sig = true; }
        else if (pn < 10) { base = us; ldc = 512; colt = (pn - 8) * 256; sig = false; }
        else if (pn < 14) { base = sga; ldc = 1024; colt = (pn - 10) * 256; sig = true; }
        else { base = sgb; ldc = 1024; colt = (pn - 14) * 256; sig = true; }
        const int row0 = u.pm * 256 + wr * 64 + fr, col0 = colt + wc * 32 + 8 * fq, bcol0 = pn * 256 + wc * 32 + 8 * fq;
        f32x4 bv[2][2];
#pragma unroll
        for (int bj = 0; bj < 2; ++bj)
#pragma unroll
            for (int n = 0; n < 2; ++n) bv[bj][n] = *(const f32x4*)(bias + bcol0 + bj * 128 + 4 * n);
#pragma unroll
        for (int ai = 0; ai < 2; ++ai)
#pragma unroll
            for (int m = 0; m < 4; ++m) { const int row = row0 + ai * 128 + m * 16; const float ri = rinv[row]; bf16_t* rowp = base + (size_t)row * ldc + col0;
#pragma unroll
                for (int bj = 0; bj < 2; ++bj) { f32x4 v0 = acc[ai][bj][m][0] * ri + bv[bj][0], v1 = acc[ai][bj][m][1] * ri + bv[bj][1];
                    if (sig) {
#pragma unroll
                        for (int j = 0; j < 4; ++j) { v0[j] = sigmoidf_(v0[j]); v1[j] = sigmoidf_(v1[j]); } }
                    u32x4 w; w.x = cvt_pk_bf16(v0[0], v0[1]); w.y = cvt_pk_bf16(v0[2], v0[3]); w.z = cvt_pk_bf16(v1[0], v1[1]); w.w = cvt_pk_bf16(v1[2], v1[3]);
                    *(u32x4*)(rowp + bj * 128) = w; } }
    }
};
struct EpiQKV {
    static constexpr bool PERM = true;
    bf16_t *qk, *v;
    __device__ __forceinline__ void operator()(AccRef acc, const Unit& u, int wr, int wc, int fr, int fq) const {
        const int head = u.pn & 3, kind = u.pn >> 2; bf16_t* base = (kind < 2) ? qk + (size_t)kind * T_ * 1024 : v;
        const int row0 = u.pm * 256 + wr * 64 + fr, col0 = head * 256 + wc * 32 + 8 * fq;
#pragma unroll
        for (int ai = 0; ai < 2; ++ai)
#pragma unroll
            for (int m = 0; m < 4; ++m) { bf16_t* rowp = base + (size_t)(row0 + ai * 128 + m * 16) * 1024 + col0;
#pragma unroll
                for (int bj = 0; bj < 2; ++bj) { const f32x4 v0 = acc[ai][bj][m][0], v1 = acc[ai][bj][m][1];
                    u32x4 w; w.x = cvt_pk_bf16(v0[0], v0[1]); w.y = cvt_pk_bf16(v0[2], v0[3]); w.z = cvt_pk_bf16(v1[0], v1[1]); w.w = cvt_pk_bf16(v1[2], v1[3]);
                    *(u32x4*)(rowp + bj * 128) = w; } }
    }
};
template <int MODE> struct EpiGate {
    static constexpr bool PERM = true;
    const bf16_t* X; const bf16_t* Y; const float* bias; bf16_t* O; int ldc;
    __device__ __forceinline__ void operator()(AccRef acc, const Unit& u, int wr, int wc, int fr, int fq) const {
        const int row0 = u.pm * 256 + wr * 64 + fr, col0 = u.pn * 256 + wc * 32 + 8 * fq;
        f32x4 bv[2][2];
#pragma unroll
        for (int bj = 0; bj < 2; ++bj)
#pragma unroll
            for (int n = 0; n < 2; ++n) bv[bj][n] = (MODE == 0) ? *(const f32x4*)(bias + col0 + bj * 128 + 4 * n) : (f32x4){0.f, 0.f, 0.f, 0.f};
#pragma unroll
        for (int ai = 0; ai < 2; ++ai)
#pragma unroll
            for (int m = 0; m < 4; ++m) { const size_t off = (size_t)(row0 + ai * 128 + m * 16) * ldc + col0;
#pragma unroll
                for (int bj = 0; bj < 2; ++bj) {
                    float xv[8], a[8], o[8]; unpack8(*(const u32x4*)(X + off + bj * 128), xv);
#pragma unroll
                    for (int j = 0; j < 4; ++j) { a[j] = acc[ai][bj][m][0][j] + bv[bj][0][j]; a[4 + j] = acc[ai][bj][m][1][j] + bv[bj][1][j]; }
                    if (MODE == 0) {
#pragma unroll
                        for (int j = 0; j < 8; ++j) o[j] = xv[j] * sigmoidf_(a[j]); }
                    else if (MODE == 1) {
#pragma unroll
                        for (int j = 0; j < 8; ++j) o[j] = xv[j] * a[j]; }
                    else { float yv[8]; unpack8(*(const u32x4*)(Y + off + bj * 128), yv);
#pragma unroll
                        for (int j = 0; j < 8; ++j) o[j] = xv[j] * a[j] + yv[j]; }
                    *(u32x4*)(O + off + bj * 128) = pack8(o); } }
    }
};
template <bool WB> struct EpiResid {
    static constexpr bool PERM = false;
    const float* Rs; float* Of; bf16_t* Ob; float* ss;
    __device__ __forceinline__ void operator()(AccRef acc, const Unit& u, int wr, int wc, int fr, int fq) const {
        const int row0 = u.pm * 256 + wr * 64 + fr, col0 = u.pn * 256 + wc * 32 + 4 * fq;
#pragma unroll
        for (int ai = 0; ai < 2; ++ai)
#pragma unroll
            for (int m = 0; m < 4; ++m) { const int row = row0 + ai * 128 + m * 16; const size_t off = (size_t)row * 1024 + col0; float s = 0.f;
#pragma unroll
                for (int bj = 0; bj < 2; ++bj)
#pragma unroll
                    for (int n = 0; n < 2; ++n) { const size_t o2 = off + bj * 128 + n * 16; const f32x4 r = *(const f32x4*)(Rs + o2); const f32x4 v = r + acc[ai][bj][m][n];
                        *(f32x4*)(Of + o2) = v; s += (v[0] * v[0] + v[1] * v[1]) + (v[2] * v[2] + v[3] * v[3]);
                        if (WB) { u32x2 w; w.x = cvt_pk_bf16(v[0], v[1]); w.y = cvt_pk_bf16(v[2], v[3]); *(u32x2*)(Ob + o2) = w; } }
                s += __shfl_xor(s, 16); s += __shfl_xor(s, 32);
                if (fq == 0) ss[(size_t)row * 16 + u.pn * 4 + wc] = s; }
    }
};
struct EpiUp {
    static constexpr bool PERM = true;
    const float* ss; bf16_t* U; int row_off;
    __device__ __forceinline__ void operator()(AccRef acc, const Unit& u, int wr, int wc, int fr, int fq) const {
        const int row0 = u.pm * 256 + wr * 64 + fr, col0 = u.pn * 256 + wc * 32 + 8 * fq;
#pragma unroll
        for (int ai = 0; ai < 2; ++ai)
#pragma unroll
            for (int m = 0; m < 4; ++m) { const int row = row0 + ai * 128 + m * 16; const f32x4* sp = (const f32x4*)(ss + (size_t)(row + row_off) * 16);
                const f32x4 s0 = sp[0], s1 = sp[1], s2 = sp[2], s3 = sp[3]; const f32x4 st = (s0 + s1) + (s2 + s3);
                const float ri = rsqrtf(((st[0] + st[1]) + (st[2] + st[3])) * (1.0f / 1024.0f) + EPS_);
                bf16_t* rowp = U + (size_t)row * F2_ + col0;
#pragma unroll
                for (int bj = 0; bj < 2; ++bj) { const f32x4 v0 = acc[ai][bj][m][0] * ri, v1 = acc[ai][bj][m][1] * ri;
                    u32x4 w; w.x = cvt_pk_bf16(v0[0], v0[1]); w.y = cvt_pk_bf16(v0[2], v0[3]); w.z = cvt_pk_bf16(v1[0], v1[1]); w.w = cvt_pk_bf16(v1[2], v1[3]);
                    *(u32x4*)(rowp + bj * 128) = w; } }
    }
};
struct SchedQKV : pg8::Order {
    const char *xc, *xm, *wqk, *wv;
    __device__ __forceinline__ const char* aptr(const Unit& u) const { const int head = u.pn & 3, kind = u.pn >> 2; return (kind < 2 ? xc : xm) + ((size_t)u.pm * 256 * 1024 + head * 256) * 2; }
    __device__ __forceinline__ const char* bptr(const Unit& u) const { const int head = u.pn & 3, kind = u.pn >> 2; return kind < 2 ? wqk + ((size_t)(head * 512 + kind * 256) * 256) * 2 : wv + ((size_t)head * 65536) * 2; }
};

__device__ __forceinline__ void transpose_item(const float* W, int ldw, int c0, const float* kscale, float scale, bf16_t* WT, int ldt, int row_off, LAS float* scr, int kb, int nb, int lane) {
    const int k0 = 64 * kb, n0 = 32 * nb;
#pragma unroll 8
    for (int i = 0; i < 32; ++i) { const int kk = 2 * i + (lane >> 5); float v = W[(size_t)(k0 + kk) * ldw + c0 + n0 + (lane & 31)] * scale; if (kscale) v *= kscale[k0 + kk]; scr[kk * 33 + (lane & 31)] = v; }
    asm volatile("s_waitcnt lgkmcnt(0)" ::: "memory");
    const int c = lane & 7;
#pragma unroll
    for (int j = 0; j < 4; ++j) { const int n = (lane >> 3) + 8 * j; const LAS float* s = scr + (8 * c) * 33 + n;
        u32x4 o; o.x = cvt_pk_bf16(s[0 * 33], s[1 * 33]); o.y = cvt_pk_bf16(s[2 * 33], s[3 * 33]); o.z = cvt_pk_bf16(s[4 * 33], s[5 * 33]); o.w = cvt_pk_bf16(s[6 * 33], s[7 * 33]);
        *(u32x4*)(WT + (size_t)(row_off + n0 + n) * ldt + k0 + 8 * c) = o; }
    asm volatile("s_waitcnt lgkmcnt(0)" ::: "memory");
}

__device__ __forceinline__ void phase0(const Params& p, LAS unsigned char* lds) {
    const int tid = fresh_tid(), lane = tid & 63, wave = tid >> 6;
    const int gw = blockIdx.x * 8 + wave, NGW = gridDim.x * 8;
    unsigned char* ws = p.ws;
    LAS float* scr = (LAS float*)(lds + wave * 8448);
    LAS float* gwt = (LAS float*)(lds + 8 * 8448);
    { const float* g1 = p.in[1]; const float* w_in = p.in[2];
      for (int i = tid; i < 8192; i += 512) { const int j = i & 7, k = i >> 3; gwt[j * 1024 + k] = g1[k] * w_in[(size_t)k * NIN_ + 2048 + j]; } }
    {
        const int nmat = 20;
        int base = 0;
        for (int mi = 0; mi < nmat; ++mi) {
            const float* W; int ldw, c0, ncols, K; const float* ks = nullptr; float sc = 1.f; bf16_t* WT; int ldt, roff = 0;
            if (mi == 0) { W = p.in[2]; ldw = NIN_; c0 = 0; ncols = 2048; K = 1024; ks = p.in[1]; WT = (bf16_t*)(ws + WS_WIN); ldt = 1024; roff = 0; }
            else if (mi == 1) { W = p.in[2]; ldw = NIN_; c0 = 2056; ncols = 2560; K = 1024; ks = p.in[1]; WT = (bf16_t*)(ws + WS_WIN); ldt = 1024; roff = 2048; }
            else if (mi < 6) { const int h = mi - 2; W = p.in[6] + h * 65536; ldw = 256; c0 = 0; ncols = 256; K = 256; WT = (bf16_t*)(ws + WS_WQK) + h * 512 * 256; ldt = 256; roff = 0; }
            else if (mi < 10) { const int h = mi - 6; W = p.in[7] + h * 65536; ldw = 256; c0 = 0; ncols = 256; K = 256; sc = 0.0625f; WT = (bf16_t*)(ws + WS_WQK) + h * 512 * 256; ldt = 256; roff = 256; }
            else if (mi < 14) { const int h = mi - 10; W = p.in[8] + h * 65536; ldw = 256; c0 = 0; ncols = 256; K = 256; WT = (bf16_t*)(ws + WS_WV) + h * 65536; ldt = 256; roff = 0; }
            else if (mi == 14) { W = p.in[19]; ldw = 512; c0 = 0; ncols = 512; K = 512; WT = (bf16_t*)(ws + WS_WGLU); ldt = 512; }
            else if (mi == 15) { W = p.in[21]; ldw = 1024; c0 = 0; ncols = 1024; K = 1024; WT = (bf16_t*)(ws + WS_WA); ldt = 1024; }
            else if (mi == 16) { W = p.in[22]; ldw = 1024; c0 = 0; ncols = 1024; K = 512; WT = (bf16_t*)(ws + WS_WB); ldt = 512; }
            else if (mi == 17) { W = p.in[23]; ldw = 1024; c0 = 0; ncols = 1024; K = 1024; WT = (bf16_t*)(ws + WS_WOUT); ldt = 1024; }
            else if (mi == 18) { W = p.in[25]; ldw = F2_; c0 = 0; ncols = F2_; K = 1024; ks = p.in[24]; WT = (bf16_t*)(ws + WS_WUP); ldt = 1024; }
            else { W = p.in[28]; ldw = 1024; c0 = 0; ncols = 1024; K = F_; WT = (bf16_t*)(ws + WS_WDN); ldt = F_; }
            const int nblk = ncols / 32, nit = (K / 64) * nblk;
            int it = gw - (base % NGW); if (it < 0) it += NGW;
            for (; it < nit; it += NGW) transpose_item(W, ldw, c0, ks, sc, WT, ldt, roff, scr, it / nblk, it % nblk, lane);
            base += nit;
        }
    }
    {
        const int gt = blockIdx.x * 512 + tid;
        if (gt < SG_ * SP_) {
            const int g = gt >> 6;
            const float ar = p.in[11][gt], ai = p.in[12][gt], dt = expf(p.in[13][g]);
            const float mag = expf(dt * ar); float sn, cs; sincosf(dt * ai, &sn, &cs);
            const float abr = mag * cs, abi = mag * sn;
            const float den = ar * ar + ai * ai, xr = abr - 1.0f, xi = abi;
            const float rre = (xr * ar + xi * ai) / den, rim = (xi * ar - xr * ai) / den;
            float* A = (float*)(ws + WS_S5A); float* A64 = (float*)(ws + WS_S5A64); float* Bb = (float*)(ws + WS_S5B);
            A[gt * 2] = abr; A[gt * 2 + 1] = abi;
            float pr = abr, pi = abi;
#pragma unroll
            for (int i = 0; i < 6; ++i) { const float nr = pr * pr - pi * pi, ni = 2.f * pr * pi; pr = nr; pi = ni; }
            A64[gt * 2] = pr; A64[gt * 2 + 1] = pi;
            const float* bre = p.in[14] + (size_t)gt * 16; const float* bim = p.in[15] + (size_t)gt * 16;
            for (int c = 0; c < 16; ++c) { const float br = bre[c], bi = bim[c]; Bb[((size_t)gt * 16 + c) * 2] = rre * br - rim * bi; Bb[((size_t)gt * 16 + c) * 2 + 1] = rre * bi + rim * br; }
        }
    }
    {
        float* bp = (float*)(ws + WS_BIASP); const float* b_in = p.in[3];
        for (int i = blockIdx.x * 512 + tid; i < NP1_; i += gridDim.x * 512) bp[i] = b_in[i < 2048 ? i : i + 8];
    }
    __syncthreads();
    {
        const float* x = p.in[0]; const float* b_in = p.in[3];
        bf16_t* xb = (bf16_t*)(ws + R0); float* rinv1 = (float*)(ws + WS_RINV1); float* ig = (float*)(ws + WS_IG); float* fg = (float*)(ws + WS_FG);
        for (int row = gw; row < T_; row += NGW) {
            const f32x4* xr = (const f32x4*)(x + (size_t)row * 1024) + lane;
            f32x4 v[4]; float s = 0.f;
#pragma unroll
            for (int j = 0; j < 4; ++j) { v[j] = xr[64 * j]; s += (v[j][0] * v[j][0] + v[j][1] * v[j][1]) + (v[j][2] * v[j][2] + v[j][3] * v[j][3]); }
            float d[8];
#pragma unroll
            for (int g = 0; g < 8; ++g) { float a = 0.f;
#pragma unroll
                for (int j = 0; j < 4; ++j) { const f32x4 w = *(const LAS f32x4*)(gwt + g * 1024 + 256 * j + 4 * lane); a += (v[j][0] * w[0] + v[j][1] * w[1]) + (v[j][2] * w[2] + v[j][3] * w[3]); }
                d[g] = a; }
            s = wave_sum(s);
#pragma unroll
            for (int g = 0; g < 8; ++g) d[g] = wave_sum(d[g]);
            const float ri = rsqrtf(s * (1.0f / 1024.0f) + EPS_);
            u32x2* o8 = (u32x2*)(xb + (size_t)row * 1024) + lane;
#pragma unroll
            for (int j = 0; j < 4; ++j) { u32x2 w; w.x = cvt_pk_bf16(v[j][0], v[j][1]); w.y = cvt_pk_bf16(v[j][2], v[j][3]); o8[64 * j] = w; }
            if (lane == 0) rinv1[row] = ri;
            if (lane < 8) { float val = d[0];
#pragma unroll
                for (int g = 1; g < 8; ++g) val = (lane == g) ? d[g] : val;
                val = val * ri + b_in[2048 + lane];
                if (lane < 4) ig[(size_t)row * 4 + lane] = val; else fg[(size_t)row * 4 + lane - 4] = val; }
        }
    }
}

__device__ __forceinline__ void phase_conv_m(const Params& p) {
    const bf16_t* xm = (const bf16_t*)(p.ws + R1); bf16_t* xc = (bf16_t*)(p.ws + R0);
    const float* cw = p.in[4]; const float* cb = p.in[5];
    const int total = (T_ / 16) * 128;
    for (int idx = blockIdx.x * 512 + fresh_tid(); idx < total; idx += gridDim.x * 512) {
        const int cgi = idx & 127, tb = idx >> 7, c0 = cgi * 8, t0 = tb * 16;
        float w[4][8], b[8];
#pragma unroll
        for (int k = 0; k < 4; ++k) { const f32x4 a = *(const f32x4*)(cw + k * 1024 + c0), bb = *(const f32x4*)(cw + k * 1024 + c0 + 4);
#pragma unroll
            for (int j = 0; j < 4; ++j) { w[k][j] = a[j]; w[k][4 + j] = bb[j]; } }
        { const f32x4 a = *(const f32x4*)(cb + c0), bb = *(const f32x4*)(cb + c0 + 4);
#pragma unroll
          for (int j = 0; j < 4; ++j) { b[j] = a[j]; b[4 + j] = bb[j]; } }
        float r0[8], r1[8], r2[8], r3[8];
        const bool head = (t0 & (SEQ_ - 1)) == 0;
        if (head) {
#pragma unroll
            for (int j = 0; j < 8; ++j) { r0[j] = 0.f; r1[j] = 0.f; r2[j] = 0.f; } }
        else { unpack8(*(const u32x4*)(xm + (size_t)(t0 - 3) * 1024 + c0), r0); unpack8(*(const u32x4*)(xm + (size_t)(t0 - 2) * 1024 + c0), r1); unpack8(*(const u32x4*)(xm + (size_t)(t0 - 1) * 1024 + c0), r2); }
#pragma unroll 4
        for (int i = 0; i < 16; ++i) {
            unpack8(*(const u32x4*)(xm + (size_t)(t0 + i) * 1024 + c0), r3);
            float o[8];
#pragma unroll
            for (int j = 0; j < 8; ++j) { const float y = b[j] + w[0][j] * r0[j] + w[1][j] * r1[j] + w[2][j] * r2[j] + w[3][j] * r3[j]; o[j] = siluf_(y); }
            *(u32x4*)(xc + (size_t)(t0 + i) * 1024 + c0) = pack8(o);
#pragma unroll
            for (int j = 0; j < 8; ++j) { r0[j] = r1[j]; r1[j] = r2[j]; r2[j] = r3[j]; }
        }
    }
}

__device__ __forceinline__ void phase_gates(const Params& p, LAS unsigned char* lds) {
    const int tid = fresh_tid(), lane = tid & 63, wave = __builtin_amdgcn_readfirstlane(tid >> 6);
    const float* IG = (const float*)(p.ws + WS_IG); const float* FG = (const float*)(p.ws + WS_FG); float* GS = (float*)(p.ws + WS_GS);
    LAS float* LB = (LAS float*)lds; LAS float* LC = LB + 64; LAS float* Lm = LB + 128;
    for (int item = blockIdx.x; item < 32; item += gridDim.x) {
        const int b = item >> 2, h = item & 3;
        float av[8], bv[8], pv[8];
#pragma unroll
        for (int cc = 0; cc < 8; ++cc) {
            const int ch = wave * 8 + cc; const size_t t = (size_t)b * SEQ_ + ch * 64 + lane;
            const float fgv = FG[t * 4 + h], li = IG[t * 4 + h];
            const float lf = fminf(fgv, 0.f) - log1pf(expf(-fabsf(fgv)));
            float bc = lf;
#pragma unroll
            for (int o = 1; o < 64; o <<= 1) { const float x = __shfl_up(bc, o); if (lane >= o) bc += x; }
            const float a = li - bc; float pm = a;
#pragma unroll
            for (int o = 1; o < 64; o <<= 1) { const float x = __shfl_up(pm, o); if (lane >= o) pm = fmaxf(pm, x); }
            av[cc] = a; bv[cc] = bc; pv[cc] = pm;
            if (lane == 63) { LB[ch] = bc; LC[ch] = bc + pm; }
        }
        __syncthreads();
        if (tid == 0) { float m = 0.f; for (int j = 0; j < 64; ++j) { Lm[j] = m; m = fmaxf(m + LB[j], LC[j]); } }
        __syncthreads();
#pragma unroll
        for (int cc = 0; cc < 8; ++cc) {
            const int ch = wave * 8 + cc; const float m = Lm[ch];
            const float Mq = fmaxf(m, pv[cc]); const float M63 = __shfl(Mq, 63);
            float* gs = GS + ((size_t)item * 64 + ch) * 384;
            gs[lane] = av[cc]; gs[64 + lane] = Mq; gs[128 + lane] = expf(m - Mq); gs[192 + lane] = expf(-(bv[cc] + Mq)); gs[256 + lane] = expf(av[cc] - M63);
            if (lane == 0) gs[320] = expf(m - M63);
        }
        __syncthreads();
    }
}

constexpr int ML_KT = 0, ML_VT = 36864, ML_VTW = 43776, ML_SW = 50688, ML_CB = 59904, ML_SC = 85248;
__device__ __forceinline__ void phase_mlstm(const Params& p, LAS unsigned char* lds) {
    const int tid = fresh_tid(), lane = tid & 63, w = __builtin_amdgcn_readfirstlane(tid >> 6), qi = w & 3, half = w >> 2, lr = lane & 15, lg = lane >> 4;
    const bf16_t* Q = (const bf16_t*)p.out; const bf16_t* Kk = (const bf16_t*)p.out + (size_t)T_ * 1024; const bf16_t* V = (const bf16_t*)(p.ws + R6);
    bf16_t* HC = (bf16_t*)(p.ws + R1);
    const float* GS = (const float*)(p.ws + WS_GS);
    LAS bf16_t* kT = (LAS bf16_t*)(lds + ML_KT);
    LAS bf16_t* vT = (LAS bf16_t*)(lds + ML_VT);
    LAS bf16_t* vTw = (LAS bf16_t*)(lds + ML_VTW);
    LAS bf16_t* Sw = (LAS bf16_t*)(lds + ML_SW);
    LAS bf16_t* Cb = (LAS bf16_t*)(lds + ML_CB);
    LAS float* sc_den = (LAS float*)(lds + ML_SC);
    for (int item = blockIdx.x; item < 256; item += gridDim.x) {
        const int bh = item & 31, vs = item >> 5, b = bh >> 2, h = bh & 3;
        const size_t tok0 = (size_t)b * SEQ_;
        __syncthreads();
        for (int i = tid; i < 48 * 264 / 2; i += 512) ((LAS unsigned*)Cb)[i] = 0u;
        for (int i = tid; i < 2 * 48 * 72 / 2; i += 512) ((LAS unsigned*)vT)[i] = 0u;
        f32x4 Cacc[2][3];
#pragma unroll
        for (int a_ = 0; a_ < 2; ++a_)
#pragma unroll
            for (int c_ = 0; c_ < 3; ++c_) Cacc[a_][c_] = (f32x4){0.f, 0.f, 0.f, 0.f};
        bf16x8 qf[8], kf[2][8]; u32x4 vreg = (u32x4){0u, 0u, 0u, 0u};
        float sMq, swi, semr, swk = 0.f, sdecay; f32x4 sa[2];
        const int vsel = tid < 256 ? (tid >> 2) : (tid < 320 ? tid - 256 : 0);
#define ML_LOAD_K(tc0_) do { _Pragma("unroll") for (int jj = 0; jj < 2; ++jj) { const bf16_t* kp = Kk + ((tc0_) + 16 * (2 * half + jj) + lr) * 1024 + h * 256 + 8 * lg; \
            _Pragma("unroll") for (int ks = 0; ks < 8; ++ks) kf[jj][ks] = *(const bf16x8*)(kp + 32 * ks); } } while (0)
#define ML_LOAD_Q(tc0_) do { const bf16_t* qp = Q + ((tc0_) + 16 * qi + lr) * 1024 + h * 256 + 8 * lg; \
            _Pragma("unroll") for (int ks = 0; ks < 8; ++ks) qf[ks] = *(const bf16x8*)(qp + 32 * ks); } while (0)
        { const size_t tc0 = tok0; ML_LOAD_K(tc0); ML_LOAD_Q(tc0);
          if (tid < 256) vreg = *(const u32x4*)(V + (tc0 + (tid >> 2)) * 1024 + h * 256 + vs * 32 + (tid & 3) * 8);
          const float* gs = GS + ((size_t)bh * 64) * 384;
          sMq = gs[64 + 16 * qi + lr]; swi = gs[128 + 16 * qi + lr]; semr = gs[192 + 16 * qi + lr]; swk = gs[256 + vsel]; sdecay = gs[320];
          sa[0] = *(const f32x4*)(gs + 16 * (2 * half) + 4 * lg); sa[1] = *(const f32x4*)(gs + 16 * (2 * half + 1) + 4 * lg); }
        __syncthreads();
        for (int ch = 0; ch < NCH_; ++ch) {
            const size_t tc0 = tok0 + (size_t)ch * 64;
            const int chn = ch + 1 < NCH_ ? ch + 1 : ch; const size_t tcn = tok0 + (size_t)chn * 64;
            const float* gsn = GS + ((size_t)bh * 64 + chn) * 384;
            f32x4 St[2];
#pragma unroll
            for (int jj = 0; jj < 2; ++jj) { St[jj] = (f32x4){0.f, 0.f, 0.f, 0.f};
#pragma unroll
                for (int ks = 0; ks < 8; ++ks) St[jj] = __builtin_amdgcn_mfma_f32_16x16x32_bf16(kf[jj][ks], qf[ks], St[jj], 0, 0, 0); }
#pragma unroll
            for (int jj = 0; jj < 2; ++jj) { const int kt = 2 * half + jj; const int qtok = 16 * qi + lr, k0 = 16 * kt + 4 * lg;
                float o[4];
#pragma unroll
                for (int r = 0; r < 4; ++r) { const float wgt = (k0 + r <= qtok) ? __expf(sa[jj][r] - sMq) : 0.f; o[r] = St[jj][r] * wgt; }
                u32x2 pk; pk.x = cvt_pk_bf16(o[0], o[1]); pk.y = cvt_pk_bf16(o[2], o[3]);
                *(LAS u32x2*)(Sw + qtok * 72 + k0) = pk; }
#pragma unroll
            for (int jj = 0; jj < 2; ++jj)
#pragma unroll
                for (int k2 = 0; k2 < 2; ++k2) {
                    bf16x8 fragv = kf[jj][0];
#pragma unroll
                    for (int ks = 1; ks < 8; ++ks) if (ks == 2 * qi + k2) fragv = kf[jj][ks];
                    const int c = 16 * (2 * half + jj) + lr, d0 = 32 * (2 * qi + k2) + 8 * lg;
#pragma unroll
                    for (int j = 0; j < 8; ++j) kT[(d0 + j) * 72 + c] = (bf16_t)fragv[j];
                }
            if (tid < 256) { const int c = tid >> 2, v0 = (tid & 3) * 8; float vv[8]; unpack8(vreg, vv);
#pragma unroll
                for (int j = 0; j < 8; ++j) { vT[(v0 + j) * 72 + c] = f2bf(vv[j]); vTw[(v0 + j) * 72 + c] = f2bf(vv[j] * swk); } }
            else if (tid < 320) { const int c = tid - 256; vT[32 * 72 + c] = (bf16_t)0x3f80; vTw[32 * 72 + c] = f2bf(swk); }
            ML_LOAD_K(tcn);
            if (tid < 256) vreg = *(const u32x4*)(V + (tcn + (tid >> 2)) * 1024 + h * 256 + vs * 32 + (tid & 3) * 8);
            const float nMq = gsn[64 + 16 * qi + lr], nwk = gsn[256 + vsel];
            const f32x4 nsa0 = *(const f32x4*)(gsn + 16 * (2 * half) + 4 * lg), nsa1 = *(const f32x4*)(gsn + 16 * (2 * half + 1) + 4 * lg);
            __syncthreads();
            f32x4 num[2]; num[0] = (f32x4){0.f, 0.f, 0.f, 0.f}; num[1] = (f32x4){0.f, 0.f, 0.f, 0.f};
            const int nvt = half == 0 ? 2 : 1, vt0 = half == 0 ? 0 : 2;
#pragma unroll
            for (int i = 0; i < 2; ++i) if (i < nvt) {
                const int vn = vt0 + i;
#pragma unroll
                for (int ks = 0; ks < 8; ++ks) { const bf16x8 cf = *(const LAS bf16x8*)(Cb + (16 * vn + lr) * 264 + 32 * ks + 8 * lg);
                    num[i] = __builtin_amdgcn_mfma_f32_16x16x32_bf16(cf, qf[ks], num[i], 0, 0, 0); }
                num[i] *= swi;
#pragma unroll
                for (int k2 = 0; k2 < 2; ++k2) { const bf16x8 sf = *(const LAS bf16x8*)(Sw + (16 * qi + lr) * 72 + 32 * k2 + 8 * lg);
                    const bf16x8 vf = *(const LAS bf16x8*)(vT + (16 * vn + lr) * 72 + 32 * k2 + 8 * lg);
                    num[i] = __builtin_amdgcn_mfma_f32_16x16x32_bf16(vf, sf, num[i], 0, 0, 0); }
            }
            if (half == 1 && lg == 0) sc_den[16 * qi + lr] = num[0][0];
            ML_LOAD_Q(tcn);
            const float nwi = gsn[128 + 16 * qi + lr], nemr = gsn[192 + 16 * qi + lr], ndecay = gsn[320];
#pragma unroll
            for (int dm = 0; dm < 2; ++dm) {
                bf16x8 kf2[2];
#pragma unroll
                for (int k2 = 0; k2 < 2; ++k2) kf2[k2] = *(const LAS bf16x8*)(kT + (32 * w + 16 * dm + lr) * 72 + 32 * k2 + 8 * lg);
#pragma unroll
                for (int vn = 0; vn < 3; ++vn) { f32x4 c = Cacc[dm][vn] * sdecay;
#pragma unroll
                    for (int k2 = 0; k2 < 2; ++k2) { const bf16x8 vf = *(const LAS bf16x8*)(vTw + (16 * vn + lr) * 72 + 32 * k2 + 8 * lg);
                        c = __builtin_amdgcn_mfma_f32_16x16x32_bf16(kf2[k2], vf, c, 0, 0, 0); }
                    Cacc[dm][vn] = c; }
            }
            __syncthreads();
            if (half == 0) {
                const float dn = __builtin_amdgcn_rcpf(fmaxf(fabsf(sc_den[16 * qi + lr]), semr));
#pragma unroll
                for (int i = 0; i < 2; ++i) { u32x2 pk; pk.x = cvt_pk_bf16(num[i][0] * dn, num[i][1] * dn); pk.y = cvt_pk_bf16(num[i][2] * dn, num[i][3] * dn);
                    *(u32x2*)(HC + (tc0 + 16 * qi + lr) * 1024 + h * 256 + vs * 32 + 16 * i + 4 * lg) = pk; }
            }
#pragma unroll
            for (int dm = 0; dm < 2; ++dm)
#pragma unroll
                for (int vn = 0; vn < 3; ++vn) { const f32x4 c = Cacc[dm][vn]; u32x2 pk; pk.x = cvt_pk_bf16(c[0], c[1]); pk.y = cvt_pk_bf16(c[2], c[3]);
                    *(LAS u32x2*)(Cb + (16 * vn + lr) * 264 + 32 * w + 16 * dm + 4 * lg) = pk; }
            sMq = nMq; swk = nwk; sa[0] = nsa0; sa[1] = nsa1; swi = nwi; semr = nemr; sdecay = ndecay;
        }
#undef ML_LOAD_K
#undef ML_LOAD_Q
    }
}

__device__ __forceinline__ void phase_aout(const Params& p) {
    const int tid = fresh_tid(), lane = tid & 63, gw = blockIdx.x * 8 + (tid >> 6), NGW = gridDim.x * 8;
    const bf16_t* HC = (const bf16_t*)(p.ws + R1); const bf16_t* SOM = (const bf16_t*)(p.ws + R2); const bf16_t* XC = (const bf16_t*)(p.ws + R0);
    bf16_t* AO = (bf16_t*)(p.ws + R6);
    const float* hg = p.in[9]; const float* sk = p.in[10];
    for (int t = gw; t < T_; t += NGW) {
#pragma unroll
        for (int h = 0; h < 4; ++h) {
            const size_t off = (size_t)t * 1024 + h * 256 + 4 * lane;
            const u32x2 hw = *(const u32x2*)(HC + off), ow = *(const u32x2*)(SOM + off), xw = *(const u32x2*)(XC + off);
            const f32x4 g4 = *(const f32x4*)(hg + h * 256 + 4 * lane), s4 = *(const f32x4*)(sk + h * 256 + 4 * lane);
            float hv[4] = {bflo(hw.x), bfhi(hw.x), bflo(hw.y), bfhi(hw.y)};
            const float ov[4] = {bflo(ow.x), bfhi(ow.x), bflo(ow.y), bfhi(ow.y)}, xv[4] = {bflo(xw.x), bfhi(xw.x), bflo(xw.y), bfhi(xw.y)};
            const float mu = wave_sum((hv[0] + hv[1]) + (hv[2] + hv[3])) * (1.0f / 256.0f);
#pragma unroll
            for (int j = 0; j < 4; ++j) hv[j] -= mu;
            const float var = wave_sum((hv[0] * hv[0] + hv[1] * hv[1]) + (hv[2] * hv[2] + hv[3] * hv[3])) * (1.0f / 256.0f);
            const float rs = rsqrtf(var + EPS_);
            float o[4];
#pragma unroll
            for (int j = 0; j < 4; ++j) o[j] = ov[j] * (hv[j] * rs * g4[j]) + s4[j] * xv[j];
            u32x2 wv; wv.x = cvt_pk_bf16(o[0], o[1]); wv.y = cvt_pk_bf16(o[2], o[3]);
            *(u32x2*)(AO + off) = wv;
        }
    }
}

__device__ __forceinline__ void s5_load_utile(const bf16_t* US, size_t tok0, int g, int lane, LAS float* uf) {
    const u32x4 ua = *(const u32x4*)(US + (tok0 + lane) * 512 + g * 16), ub = *(const u32x4*)(US + (tok0 + lane) * 512 + g * 16 + 8);
    float f[8]; unpack8(ua, f);
    *(LAS f32x4*)(uf + lane * 16) = (f32x4){f[0], f[1], f[2], f[3]}; *(LAS f32x4*)(uf + lane * 16 + 4) = (f32x4){f[4], f[5], f[6], f[7]};
    unpack8(ub, f);
    *(LAS f32x4*)(uf + lane * 16 + 8) = (f32x4){f[0], f[1], f[2], f[3]}; *(LAS f32x4*)(uf + lane * 16 + 12) = (f32x4){f[4], f[5], f[6], f[7]};
}
__device__ __forceinline__ void s5_step(const LAS float* urow, const f32x2 (&bb)[16], float ar, float ai, float& sr, float& si) {
    const f32x4 u0 = *(const LAS f32x4*)(urow), u1 = *(const LAS f32x4*)(urow + 4), u2 = *(const LAS f32x4*)(urow + 8), u3 = *(const LAS f32x4*)(urow + 12);
    f32x2 a0 = bb[0] * u0[0], a1 = bb[1] * u0[1], a2 = bb[2] * u0[2], a3 = bb[3] * u0[3];
    a0 += bb[4] * u1[0]; a1 += bb[5] * u1[1]; a2 += bb[6] * u1[2]; a3 += bb[7] * u1[3];
    a0 += bb[8] * u2[0]; a1 += bb[9] * u2[1]; a2 += bb[10] * u2[2]; a3 += bb[11] * u2[3];
    a0 += bb[12] * u3[0]; a1 += bb[13] * u3[1]; a2 += bb[14] * u3[2]; a3 += bb[15] * u3[3];
    const f32x2 bu = (a0 + a1) + (a2 + a3);
    const float nr = ar * sr - ai * si + bu.x, ni = ar * si + ai * sr + bu.y; sr = nr; si = ni;
}
__device__ __forceinline__ void phase_s5(const Params& p, LAS unsigned char* lds) {
    const int tid = fresh_tid(), lane = tid & 63, wave = __builtin_amdgcn_readfirstlane(tid >> 6);
    const bf16_t* US = (const bf16_t*)(p.ws + R5);
    const float* A = (const float*)(p.ws + WS_S5A); const float* Bb = (const float*)(p.ws + WS_S5B);
    bf16_t* YB = (bf16_t*)(p.ws + R7);
    LAS float* uf = (LAS float*)(lds + wave * 12800);
    LAS float* stash = (LAS float*)(lds + wave * 12800 + 4096);
    LAS float* Eb = (LAS float*)(lds + 8 * 12800);
    for (int item = blockIdx.x; item < NB_ * SG_; item += gridDim.x) {
        const int b = item & 7, g = item >> 3, gp = g * 64 + lane;
        f32x2 bb[16];
#pragma unroll
        for (int c4 = 0; c4 < 8; ++c4) { const f32x4 v = *(const f32x4*)(Bb + (size_t)gp * 32 + 4 * c4); bb[2 * c4] = (f32x2){v[0], v[1]}; bb[2 * c4 + 1] = (f32x2){v[2], v[3]}; }
        const float ar = A[gp * 2], ai = A[gp * 2 + 1];
        const size_t tokw = (size_t)b * SEQ_ + (size_t)wave * 512;
        float sr = 0.f, si = 0.f;
        for (int cc = 0; cc < 8; ++cc) {
            s5_load_utile(US, tokw + cc * 64, g, lane, uf);
#pragma unroll 4
            for (int t = 0; t < 64; ++t) s5_step(uf + t * 16, bb, ar, ai, sr, si);
        }
        Eb[(wave * 64 + lane) * 2] = sr; Eb[(wave * 64 + lane) * 2 + 1] = si;
        __syncthreads();
        float pr = ar, pi = ai;
#pragma unroll
        for (int i = 0; i < 9; ++i) { const float nr = pr * pr - pi * pi, ni = 2.f * pr * pi; pr = nr; pi = ni; }
        sr = 0.f; si = 0.f;
        for (int j = 0; j < wave; ++j) { const float er = Eb[(j * 64 + lane) * 2], ei = Eb[(j * 64 + lane) * 2 + 1]; const float nr = pr * sr - pi * si + er, ni = pr * si + pi * sr + ei; sr = nr; si = ni; }
        float bk[32];
        { const float* cre = p.in[16] + ((size_t)g * 16 + (lane & 15)) * 64 + (lane >> 4); const float* cim = p.in[17] + ((size_t)g * 16 + (lane & 15)) * 64 + (lane >> 4);
#pragma unroll
          for (int kk = 0; kk < 16; ++kk) { bk[kk] = cre[4 * kk]; bk[16 + kk] = -cim[4 * kk]; } }
        const int c = lane & 15; const float dsk = p.in[18][g * 16 + c];
        for (int cc = 0; cc < 8; ++cc) {
            const size_t tok0 = tokw + cc * 64;
            s5_load_utile(US, tok0, g, lane, uf);
            for (int tb = 0; tb < 4; ++tb) {
#pragma unroll 4
                for (int tt = 0; tt < 16; ++tt) { s5_step(uf + (tb * 16 + tt) * 16, bb, ar, ai, sr, si); stash[tt * 132 + lane] = sr; stash[tt * 132 + 64 + lane] = si; }
                f32x4 y = (f32x4){0.f, 0.f, 0.f, 0.f};
#pragma unroll
                for (int kk = 0; kk < 32; ++kk) { const float a = stash[(lane & 15) * 132 + 4 * kk + (lane >> 4)]; y = __builtin_amdgcn_mfma_f32_16x16x4f32(a, bk[kk], y, 0, 0, 0); }
#pragma unroll
                for (int r = 0; r < 4; ++r) { const int tl = tb * 16 + 4 * (lane >> 4) + r; const float uu = uf[tl * 16 + c];
                    const float v = y[r] + dsk * uu;
                    const float z = 0.7978845608f * (v + 0.044715f * v * v * v); const float th = 1.0f - 2.0f * __builtin_amdgcn_rcpf(1.0f + __expf(2.0f * z));
                    YB[(tok0 + tl) * 512 + g * 16 + c] = f2bf(0.5f * v * (1.0f + th)); }
            }
        }
        __syncthreads();
    }
}

__device__ __forceinline__ void phase_ffn_act(const Params& p, int half) {
    const bf16_t* U = (const bf16_t*)(p.ws + WS_UH); bf16_t* ACT = (bf16_t*)(p.ws + WS_ACT) + (size_t)half * 16384 * F_;
    const float* cw = p.in[26]; const float* cb = p.in[27];
    const int total = (16384 / 16) * 352;
    for (int idx = blockIdx.x * 512 + fresh_tid(); idx < total; idx += gridDim.x * 512) {
        const int fg = idx % 352, tb = idx / 352, f0 = fg * 8, t0 = tb * 16;
        float wv[3][8], wg[3][8], bvv[8], bgg[8];
#pragma unroll
        for (int k = 0; k < 3; ++k) { const f32x4 a = *(const f32x4*)(cw + k * F2_ + f0), b = *(const f32x4*)(cw + k * F2_ + f0 + 4), c = *(const f32x4*)(cw + k * F2_ + F_ + f0), d = *(const f32x4*)(cw + k * F2_ + F_ + f0 + 4);
#pragma unroll
            for (int j = 0; j < 4; ++j) { wv[k][j] = a[j]; wv[k][4 + j] = b[j]; wg[k][j] = c[j]; wg[k][4 + j] = d[j]; } }
        { const f32x4 a = *(const f32x4*)(cb + f0), b = *(const f32x4*)(cb + f0 + 4), c = *(const f32x4*)(cb + F_ + f0), d = *(const f32x4*)(cb + F_ + f0 + 4);
#pragma unroll
          for (int j = 0; j < 4; ++j) { bvv[j] = a[j]; bvv[4 + j] = b[j]; bgg[j] = c[j]; bgg[4 + j] = d[j]; } }
        float v0[8], v1[8], v2[8], g0[8], g1[8], g2[8];
        const bool head = (t0 & (SEQ_ - 1)) == 0;
        if (head) {
#pragma unroll
            for (int j = 0; j < 8; ++j) { v0[j] = 0.f; v1[j] = 0.f; g0[j] = 0.f; g1[j] = 0.f; } }
        else { unpack8(*(const u32x4*)(U + (size_t)(t0 - 2) * F2_ + f0), v0); unpack8(*(const u32x4*)(U + (size_t)(t0 - 1) * F2_ + f0), v1);
               unpack8(*(const u32x4*)(U + (size_t)(t0 - 2) * F2_ + F_ + f0), g0); unpack8(*(const u32x4*)(U + (size_t)(t0 - 1) * F2_ + F_ + f0), g1); }
#pragma unroll 4
        for (int i = 0; i < 16; ++i) {
            unpack8(*(const u32x4*)(U + (size_t)(t0 + i) * F2_ + f0), v2); unpack8(*(const u32x4*)(U + (size_t)(t0 + i) * F2_ + F_ + f0), g2);
            float o[8];
#pragma unroll
            for (int j = 0; j < 8; ++j) { const float val = bvv[j] + wv[0][j] * v0[j] + wv[1][j] * v1[j] + wv[2][j] * v2[j]; const float gt = bgg[j] + wg[0][j] * g0[j] + wg[1][j] * g1[j] + wg[2][j] * g2[j]; o[j] = siluf_(gt) * val; }
            *(u32x4*)(ACT + (size_t)(t0 + i) * F_ + f0) = pack8(o);
#pragma unroll
            for (int j = 0; j < 8; ++j) { v0[j] = v1[j]; v1[j] = v2[j]; g0[j] = g1[j]; g1[j] = g2[j]; }
        }
    }
}

__device__ __forceinline__ void phase_final(const Params& p) {
    const int tid = fresh_tid(), lane = tid & 63, gw = blockIdx.x * 8 + (tid >> 6), NGW = gridDim.x * 8;
    const float* ss = (const float*)(p.ws + WS_SS2); const float* gf = p.in[29];
    for (int row = gw; row < T_; row += NGW) {
        const float sv = (lane < 16) ? ss[(size_t)row * 16 + lane] : 0.f;
        const float ri = rsqrtf(wave_sum(sv) * (1.0f / 1024.0f) + EPS_);
        f32x4* xr = (f32x4*)(p.out + (size_t)row * 1024) + lane;
#pragma unroll
        for (int j = 0; j < 4; ++j) { const f32x4 g4 = *((const f32x4*)gf + lane + 64 * j); f32x4 v = xr[64 * j]; v = v * ri * g4; xr[64 * j] = v; }
    }
}

#ifndef PHASE_MASK
#define PHASE_MASK 0xffffffffu
#endif
#define PH(k) ((PHASE_MASK >> (k)) & 1u)
#ifndef REP_MASK
#define REP_MASK 0u
#endif
#define REPS(k) for (int rep_ = 0; rep_ < 1 + (int)((REP_MASK >> (k)) & 1u); ++rep_)
__global__ void __launch_bounds__(512, 2) fwd_megakernel(Params p) {
    extern __shared__ __attribute__((aligned(16))) unsigned char lds_raw[];
    LAS unsigned char* lds = (LAS unsigned char*)lds_raw;
    cg::grid_group grid = cg::this_grid();
    unsigned char* ws = p.ws;
    bf16_t* dq = (bf16_t*)p.out;
    volatile LAS unsigned* bst = (volatile LAS unsigned*)(lds + LDS_BYTES - 64);
    if (threadIdx.x < 2) bst[threadIdx.x] = 0u;
    if (blockIdx.x == 0) { unsigned* bw = (unsigned*)(ws + WS_BAR); for (int i = threadIdx.x; i < XCD_BAR_WORDS; i += 512) bw[i] = 0u; }
    __syncthreads();
    REPS(0) if (PH(0)) phase0(p, lds);
    grid.sync();
    const XcdBarrier xbar = xcd_barrier_post((unsigned*)(ws + WS_BAR), bst);
    REPS(1) if (PH(1)) { pg8::PlainSched S; S.set(ws + R0, 1024, ws + WS_WIN, 1024, T_ / 256, NP1_ / 256);
      EpiProj E{(const float*)(ws + WS_RINV1), (const float*)(ws + WS_BIASP), (bf16_t*)(ws + R1), (bf16_t*)(ws + R2), (bf16_t*)(ws + R5), (bf16_t*)(ws + R3), (bf16_t*)(ws + R4)};
      pg8::gemm_phase(lds, S, E, 1024, 1024, 1024); }
    xcd_barrier(xbar);
    REPS(2) if (PH(2)) { phase_gates(p, lds); phase_conv_m(p); }
    xcd_barrier(xbar);
    REPS(3) if (PH(3)) { SchedQKV S; S.init(T_ / 256, 12, gridDim.x, blockIdx.x); S.xc = (const char*)(ws + R0); S.xm = (const char*)(ws + R1); S.wqk = (const char*)(ws + WS_WQK); S.wv = (const char*)(ws + WS_WV);
      EpiQKV E{dq, (bf16_t*)(ws + R6)};
      pg8::gemm_phase(lds, S, E, 256, 1024, 256); }
    xcd_barrier(xbar);
    REPS(4) if (PH(4)) phase_mlstm(p, lds);
    xcd_barrier(xbar);
    REPS(5) if (PH(5)) phase_aout(p);
    REPS(6) if (PH(6)) phase_s5(p, lds);
    xcd_barrier(xbar);
    REPS(8) if (PH(8)) { pg8::PlainSched S; S.set(ws + R7, 512, ws + WS_WGLU, 512, T_ / 256, 2);
      EpiGate<0> E{(const bf16_t*)(ws + R7), nullptr, p.in[20], dq, 512};
      pg8::gemm_phase(lds, S, E, 512, 512, 512); }
    xcd_barrier(xbar);
    REPS(9) if (PH(9)) { pg8::PlainSched S; S.set(dq, 512, ws + WS_WB, 512, T_ / 256, 4);
      EpiGate<1> E{(const bf16_t*)(ws + R4), nullptr, nullptr, (bf16_t*)(ws + R1), 1024};
      pg8::gemm_phase(lds, S, E, 512, 512, 512); }
    xcd_barrier(xbar);
    REPS(10) if (PH(10)) { pg8::PlainSched S; S.set(ws + R6, 1024, ws + WS_WA, 1024, T_ / 256, 4);
      EpiGate<2> E{(const bf16_t*)(ws + R3), (const bf16_t*)(ws + R1), nullptr, (bf16_t*)(ws + R0), 1024};
      pg8::gemm_phase(lds, S, E, 1024, 1024, 1024); }
    xcd_barrier(xbar);
    REPS(11) if (PH(11)) { pg8::PlainSched S; S.set(ws + R0, 1024, ws + WS_WOUT, 1024, T_ / 256, 4);
      EpiResid<true> E{p.in[0], p.out, (bf16_t*)(ws + WS_X1B), (float*)(ws + WS_SS1)};
      pg8::gemm_phase(lds, S, E, 1024, 1024, 1024); }
    xcd_barrier(xbar);
    for (int half = 0; half < 2; ++half) {
        REPS(12) if (PH(12)) { pg8::PlainSched S; S.set(ws + WS_X1B + (size_t)half * 16384 * 1024 * 2, 1024, ws + WS_WUP, 1024, 64, F2_ / 256);
          EpiUp E{(const float*)(ws + WS_SS1), (bf16_t*)(ws + WS_UH), half * 16384};
          pg8::gemm_phase(lds, S, E, 1024, 1024, 1024); }
        xcd_barrier(xbar);
        REPS(13) if (PH(13)) phase_ffn_act(p, half);
        xcd_barrier(xbar);
    }
    REPS(14) if (PH(14)) { pg8::PlainSched S; S.set(ws + WS_ACT, F_, ws + WS_WDN, F_, T_ / 256, 4);
      EpiResid<false> E{p.out, (rep_ + 1 < 1 + (int)((REP_MASK >> 14) & 1u)) ? (float*)(ws + WS_UH) : p.out, nullptr, (float*)(ws + WS_SS2)};
      pg8::gemm_phase(lds, S, E, F_, F_, F_); }
    xcd_barrier(xbar);
    REPS(15) if (PH(15)) phase_final(p);
}

extern "C" void kernel_launch(void* const* d_in, const int* in_sizes, int n_in, void* d_out, int out_size, void* d_ws, size_t ws_size, hipStream_t stream) {
    static int grid_blocks = 0;
    if (!grid_blocks) {
        int dev = 0, cus = 0, per_cu = 0;
        (void)hipGetDevice(&dev);
        (void)hipDeviceGetAttribute(&cus, hipDeviceAttributeMultiprocessorCount, dev);
        (void)hipFuncSetAttribute((const void*)fwd_megakernel, hipFuncAttributeMaxDynamicSharedMemorySize, LDS_BYTES);
        (void)hipOccupancyMaxActiveBlocksPerMultiprocessor(&per_cu, (const void*)fwd_megakernel, 512, LDS_BYTES);
        if (per_cu < 1) { fprintf(stderr, "kernel_launch: occupancy query returned %d\n", per_cu); }
        grid_blocks = cus;
        if (n_in != 30 || out_size != T_ * D_ || ws_size < 512 * MiB) fprintf(stderr, "kernel_launch: unexpected sizes n_in=%d out=%d ws=%zu\n", n_in, out_size, ws_size);
    }
    Params p{};
    for (int i = 0; i < 30; ++i) p.in[i] = (const float*)d_in[i];
    p.out = (float*)d_out; p.ws = (unsigned char*)d_ws;
    void* args[] = {&p};
    hipError_t e = hipLaunchCooperativeKernel((void*)fwd_megakernel, dim3(grid_blocks), dim3(512), args, LDS_BYTES, stream);
    if (e != hipSuccess) fprintf(stderr, "cooperative launch failed: %s (grid %d)\n", hipGetErrorString(e), grid_blocks);
}
```

```cpp
#include <hip/hip_runtime.h>
#include <hip/hip_cooperative_groups.h>
#include <cstdio>
#include <cstdint>
namespace cg = cooperative_groups;

#define LAS __attribute__((address_space(3)))
typedef unsigned short bf16_t;
typedef short bf16x8 __attribute__((ext_vector_type(8)));
typedef float f32x4 __attribute__((ext_vector_type(4)));
typedef float f32x2 __attribute__((ext_vector_type(2)));
typedef unsigned u32x4 __attribute__((ext_vector_type(4)));
typedef unsigned u32x2 __attribute__((ext_vector_type(2)));

constexpr int T_ = 32768, D_ = 1024, SEQ_ = 4096, NB_ = 8;
constexpr int NH_ = 4, DH_ = 256, NCH_ = 64;
constexpr int SW_ = 512, SG_ = 32, SP_ = 64;
constexpr int F_ = 2816, F2_ = 5632, NIN_ = 4616, NP1_ = 4608;
constexpr float EPS_ = 1e-6f;

constexpr size_t MiB = 1ull << 20, KiB = 1024;
constexpr size_t WS_WIN = 0, WS_WQK = 9 * MiB, WS_WV = 10 * MiB, WS_WGLU = 10 * MiB + 512 * KiB, WS_WA = 11 * MiB, WS_WB = 13 * MiB, WS_WOUT = 14 * MiB,
                 WS_WUP = 16 * MiB, WS_WDN = 27 * MiB;
constexpr size_t WS_S5A = 33 * MiB, WS_S5BT = WS_S5A + 32 * KiB, WS_S5CT = WS_S5A + 192 * KiB;
constexpr size_t WS_RINV1 = 34 * MiB, WS_IG = 34 * MiB + 512 * KiB, WS_FG = 35 * MiB, WS_BIASP = 35 * MiB + 512 * KiB;
constexpr size_t WS_GS = 50 * MiB;
constexpr size_t WS_BAR = 49 * MiB;
constexpr size_t WS_SS1 = 36 * MiB, WS_SS2 = 38 * MiB, WS_E = 40 * MiB;
constexpr size_t R0 = 56 * MiB, R1 = 120 * MiB, R2 = 184 * MiB, R3 = 248 * MiB, R4 = 312 * MiB, R5 = 376 * MiB, R6 = 408 * MiB, R7 = 472 * MiB;
constexpr size_t WS_X1B = 448 * MiB, WS_UH = 56 * MiB, WS_ACT = 232 * MiB;
constexpr int LDS_BYTES = 147456;

struct Params {
    const float* in[30];
    float* out;
    unsigned char* ws;
};

__device__ __forceinline__ unsigned cvt_pk_bf16(float lo, float hi) { unsigned r; asm volatile("v_cvt_pk_bf16_f32 %0, %1, %2" : "=v"(r) : "v"(lo), "v"(hi)); return r; }
__device__ __forceinline__ bf16_t f2bf(float x) { return (bf16_t)(cvt_pk_bf16(x, x) & 0xffffu); }
__device__ __forceinline__ float bf2f(unsigned short u) { return __uint_as_float(((unsigned)u) << 16); }
__device__ __forceinline__ float bflo(unsigned w) { return __uint_as_float(w << 16); }
__device__ __forceinline__ float bfhi(unsigned w) { return __uint_as_float(w & 0xffff0000u); }
__device__ __forceinline__ float sigmoidf_(float x) { return __builtin_amdgcn_rcpf(1.0f + __expf(-x)); }
__device__ __forceinline__ float siluf_(float x) { return x * sigmoidf_(x); }
__device__ __forceinline__ int fresh_tid() { int t = threadIdx.x; asm volatile("" : "+v"(t)); return t; }
__device__ __forceinline__ float wave_sum(float v) {
#pragma unroll
    for (int o = 1; o < 64; o <<= 1) v += __shfl_xor(v, o);
    return v;
}
__device__ __forceinline__ void unpack8(const u32x4 w, float (&f)[8]) {
    f[0] = bflo(w.x); f[1] = bfhi(w.x); f[2] = bflo(w.y); f[3] = bfhi(w.y); f[4] = bflo(w.z); f[5] = bfhi(w.z); f[6] = bflo(w.w); f[7] = bfhi(w.w);
}
__device__ __forceinline__ u32x4 pack8(const float (&f)[8]) {
    u32x4 w; w.x = cvt_pk_bf16(f[0], f[1]); w.y = cvt_pk_bf16(f[2], f[3]); w.z = cvt_pk_bf16(f[4], f[5]); w.w = cvt_pk_bf16(f[6], f[7]); return w;
}


#define XB_TMO      128
#define XB_XCNT(j)  (256  + 64 * (j))
#define XB_XSUB(j)  (1280 + 64 * (j))
#define XB_XGEN(j)  (2304 + 64 * (j))
#define XB_TOP      3328
#define XB_TOPGEN   3392
#define XCD_BAR_WORDS 3456
#define XB_SPIN_CAP (1u << 18)
__device__ __forceinline__ unsigned xb_ld(unsigned* p)              { return __hip_atomic_load(p, __ATOMIC_RELAXED, __HIP_MEMORY_SCOPE_AGENT); }
__device__ __forceinline__ unsigned xb_add(unsigned* p, unsigned v) { return __hip_atomic_fetch_add(p, v, __ATOMIC_RELAXED, __HIP_MEMORY_SCOPE_AGENT); }
__device__ __forceinline__ unsigned xb_xcc_id() { return (unsigned)__builtin_amdgcn_s_getreg((3 << 11) | 20) & 0xFu; }
#define XB_SPIN(cond, bar) do { unsigned _sp = 0; while (cond) { __builtin_amdgcn_s_sleep(1); \
    if ((++_sp & 255u) == 0u) { if (xb_ld(&(bar)[XB_TMO])) break; if (_sp > XB_SPIN_CAP) { atomicAdd(&(bar)[XB_TMO], 1u); break; } } } } while (0)
struct XcdBarrier { unsigned* bar; unsigned x; volatile LAS unsigned* st; };
__device__ __forceinline__ XcdBarrier xcd_barrier_post(unsigned* bar, volatile LAS unsigned* st) {
    XcdBarrier b; b.bar = bar; b.x = xb_xcc_id(); b.st = st;
    if (threadIdx.x == 0) (void)xb_add(&bar[XB_XCNT(b.x)], 1u);
    return b;
}
__device__ __forceinline__ void xcd_barrier_complete(unsigned* bar, unsigned x, unsigned& nloc, unsigned& nx) {
    const unsigned G = gridDim.x * gridDim.y * gridDim.z;
    unsigned sum, cnt, mine, sp = 0u;
    for (;;) {
        sum = 0u; cnt = 0u; mine = 0u;
#pragma unroll
        for (unsigned j = 0; j < 16; ++j) { const unsigned c = xb_ld(&bar[XB_XCNT(j)]); sum += c; cnt += (c > 0u) ? 1u : 0u; mine = (j == x) ? c : mine; }
        if (sum == G) break;
        __builtin_amdgcn_s_sleep(1);
        if ((++sp & 255u) == 0u) { if (xb_ld(&bar[XB_TMO])) break; if (sp > XB_SPIN_CAP) { atomicAdd(&bar[XB_TMO], 1u); break; } }
    }
    nloc = mine > 0u ? mine : 1u; nx = cnt > 0u ? cnt : 1u;
}
__device__ __forceinline__ void xcd_barrier(const XcdBarrier& b) {
    asm volatile("s_waitcnt vmcnt(0)" ::: "memory");
    __syncthreads();
    if (threadIdx.x == 0) {
        unsigned* bar = b.bar;
        __builtin_amdgcn_s_waitcnt(0);
        unsigned nloc = b.st[0], nx = b.st[1];
        if (nloc == 0u) { xcd_barrier_complete(bar, b.x, nloc, nx); b.st[0] = nloc; b.st[1] = nx; }
        const unsigned old = xb_add(&bar[XB_XSUB(b.x)], 1u);
        const unsigned gen = old / nloc;
        if (old + 1u == (gen + 1u) * nloc) {
            __builtin_amdgcn_fence(__ATOMIC_RELEASE, "agent");
            asm volatile("s_waitcnt vmcnt(0)" ::: "memory");
            const unsigned og = xb_add(&bar[XB_TOP], 1u);
            const unsigned tg = og / nx;
            if (og + 1u == (tg + 1u) * nx) xb_add(&bar[XB_TOPGEN], 1u);
            else XB_SPIN(xb_ld(&bar[XB_TOPGEN]) == tg, bar);
            __builtin_amdgcn_fence(__ATOMIC_ACQUIRE, "agent");
            xb_add(&bar[XB_XGEN(b.x)], 1u);
            asm volatile("s_waitcnt vmcnt(0)" ::: "memory");
        } else {
            XB_SPIN(xb_ld(&bar[XB_XGEN(b.x)]) == gen, bar);
            __builtin_amdgcn_fence(__ATOMIC_ACQUIRE, "agent");
            asm volatile("s_waitcnt vmcnt(0)" ::: "memory");
        }
    }
    __syncthreads();
}

namespace pg8 {
constexpr int BM = 256, BK = 64, HALF = 128, HTB = HALF * BK * 2, STAGE_BYTES = 8 * HTB, NXCD = 8, WGM = 8;
__device__ __forceinline__ int lds_byte(int r, int c) { const int st = (r >> 4) * 2 + (c >> 5), rr = r & 15, cc = c & 31, ob = rr * 64 + cc * 2; return st * 1024 + (ob ^ (((ob >> 9) & 1) << 5)); }
__device__ __forceinline__ void stage_rc(int b, int& R, int& C) { const int st = b / 1024, sb = b % 1024, swz = sb ^ (((sb >> 9) & 1) << 5); R = (st >> 1) * 16 + swz / 64; C = (st & 1) * 32 + (swz % 64) / 2; }
__device__ __forceinline__ int perm32(int rho) { const int n = rho >> 4, i = rho & 15; return 8 * (i >> 2) + 4 * n + (i & 3); }
struct Unit { int pm, pn; };
struct Order {
    int nM, nN, nwg, G, c;
    __device__ __forceinline__ void init(int nM_, int nN_, int G_, int c_) { nM = nM_; nN = nN_; nwg = nM * nN; G = G_; c = c_; }
    __device__ __forceinline__ bool next(int i, Unit& u) const {
        const long L = (long)i * G + c; if (L >= nwg) return false;
        int wgid = (int)L; { const int q = nwg / NXCD, r = nwg % NXCD, xcd = wgid % NXCD, off = wgid / NXCD; wgid = (xcd < r ? xcd * (q + 1) : r * (q + 1) + (xcd - r) * q) + off; }
        const int nig = WGM * nN, gid = wgid / nig, fm = gid * WGM, gsz = (nM - fm) < WGM ? (nM - fm) : WGM;
        u.pm = fm + ((wgid % nig) % gsz); u.pn = (wgid % nig) / gsz; return true;
    }
};
template <class Epi, class Sched>
__device__ __forceinline__ void gemm_phase(LAS unsigned char* lds, const Sched& S, const Epi& E, const int K, const int lda, const int ldb) {
    const int tid = fresh_tid(), wid = __builtin_amdgcn_readfirstlane(tid >> 6), lane = tid & 63, wr = wid >> 2, wc = wid & 3, fr = lane & 15, fq = lane >> 4;
    const int nt = K / BK;
    unsigned voffA[2], voffB[2];
#pragma unroll
    for (int i = 0; i < 2; ++i) { int R, C; stage_rc(tid * 16 + i * 8192, R, C); const int Rb = Epi::PERM ? ((R & ~31) + perm32(R & 31)) : R;
        voffA[i] = (unsigned)(R * lda + C) * 2u; voffB[i] = (unsigned)(Rb * ldb + C) * 2u; }
    const size_t kstep = (size_t)(BK * 2);
    const size_t hstepA = (size_t)HALF * lda * 2, hstepB = (size_t)HALF * ldb * 2;
    const unsigned ldsw = (unsigned)wid * 1024u;
    const int aoff = lds_byte(wr * 64 + fr, fq * 8), boff = lds_byte(wc * 32 + fr, fq * 8);
#define PG8_SA(b, h) (((b) * 2 + (h)) * HTB)
#define PG8_SB(b, h) ((4 + (b) * 2 + (h)) * HTB)
#define PG8_STAGE(bufoff, gbase, voff) do { _Pragma("unroll") for (int _i = 0; _i < 2; ++_i) \
        __builtin_amdgcn_global_load_lds((const unsigned*)((const char*)(gbase) + (voff)[_i]), (LAS unsigned*)(lds + (bufoff) + ldsw + _i * 8192), 16, 0, 0); } while (0)
#define PG8_LDA(dst, b, h) do { _Pragma("unroll") for (int m = 0; m < 4; ++m) _Pragma("unroll") for (int k = 0; k < 2; ++k) dst[m][k] = *(const LAS bf16x8*)(lds + PG8_SA(b, h) + aoff + m * 2048 + k * 1024); } while (0)
#define PG8_LDB(dst, b, h) do { _Pragma("unroll") for (int n = 0; n < 2; ++n) _Pragma("unroll") for (int k = 0; k < 2; ++k) dst[n][k] = *(const LAS bf16x8*)(lds + PG8_SB(b, h) + boff + n * 2048 + k * 1024); } while (0)
#define PG8_MMA(ai, bj, At, Bt) do { __builtin_amdgcn_s_setprio(1); _Pragma("unroll") for (int m = 0; m < 4; ++m) _Pragma("unroll") for (int n = 0; n < 2; ++n) _Pragma("unroll") for (int k = 0; k < 2; ++k) \
        acc[ai][bj][m][n] = __builtin_amdgcn_mfma_f32_16x16x32_bf16(Bt[n][k], At[m][k], acc[ai][bj][m][n], 0, 0, 0); __builtin_amdgcn_s_setprio(0); } while (0)
#define PG8_WAIT_V(n) asm volatile("s_waitcnt vmcnt(" #n ")" ::: "memory")
#define PG8_WAIT_L(n) asm volatile("s_waitcnt lgkmcnt(" #n ")" ::: "memory")
#define PG8_BAR __builtin_amdgcn_s_barrier()
#define PG8_SCHED __builtin_amdgcn_sched_barrier(0)
    Unit cur, nxt; int ui = 0;
    if (!S.next(0, cur)) return;
    f32x4 acc[2][2][4][2];
#pragma unroll
    for (int a = 0; a < 2; ++a)
#pragma unroll
        for (int b = 0; b < 2; ++b)
#pragma unroll
            for (int m = 0; m < 4; ++m)
#pragma unroll
                for (int n = 0; n < 2; ++n) acc[a][b][m][n] = (f32x4){0.f, 0.f, 0.f, 0.f};
    bf16x8 At[4][2], B0[2][2], B1[2][2];
    const char* cA = S.aptr(cur); const char* cB = S.bptr(cur);
    PG8_STAGE(PG8_SB(0, 0), cB, voffB); PG8_STAGE(PG8_SB(0, 1), cB + hstepB, voffB); PG8_STAGE(PG8_SA(0, 0), cA, voffA); PG8_STAGE(PG8_SA(0, 1), cA + hstepA, voffA);
    if (wr == 1) PG8_BAR;
    PG8_WAIT_V(2); PG8_BAR;
    PG8_STAGE(PG8_SB(1, 0), cB + kstep, voffB); PG8_STAGE(PG8_SA(1, 0), cA + kstep, voffA); PG8_STAGE(PG8_SB(1, 1), cB + hstepB + kstep, voffB);
    PG8_WAIT_V(6); PG8_BAR;
    for (;;) {
        const bool has_next = S.next(ui + 1, nxt);
        const char* nA = has_next ? S.aptr(nxt) : cA; const char* nB = has_next ? S.bptr(nxt) : cB;
#pragma unroll 1
        for (int t = 0; t < nt; t += 2) {
            const bool last = (t == nt - 2);
            const char* a1 = cA + (size_t)(t + 1) * kstep;
            const char* a2 = last ? nA : cA + (size_t)(t + 2) * kstep; const char* b2 = last ? nB : cB + (size_t)(t + 2) * kstep;
            const char* a3 = a2 + kstep; const char* b3 = b2 + kstep;
            PG8_LDB(B0, 0, 0); PG8_LDB(B1, 0, 1); PG8_SCHED; PG8_LDA(At, 0, 0); PG8_STAGE(PG8_SA(1, 1), a1 + hstepA, voffA);
            PG8_WAIT_V(8); PG8_WAIT_L(0); PG8_BAR; PG8_MMA(0, 0, At, B0); PG8_MMA(0, 1, At, B1); PG8_BAR; PG8_SCHED;
            PG8_LDA(At, 0, 1); PG8_STAGE(PG8_SB(0, 0), b2, voffB); PG8_STAGE(PG8_SB(0, 1), b2 + hstepB, voffB); PG8_STAGE(PG8_SA(0, 0), a2, voffA);
            PG8_WAIT_V(8); PG8_WAIT_L(0); PG8_BAR; PG8_MMA(1, 0, At, B0); PG8_MMA(1, 1, At, B1); PG8_BAR; PG8_SCHED;
            PG8_LDB(B0, 1, 0); PG8_LDB(B1, 1, 1); PG8_SCHED; PG8_LDA(At, 1, 0); PG8_STAGE(PG8_SA(0, 1), a2 + hstepA, voffA);
            PG8_WAIT_V(8); PG8_WAIT_L(0); PG8_BAR; PG8_MMA(0, 0, At, B0); PG8_MMA(0, 1, At, B1); PG8_BAR; PG8_SCHED;
            PG8_LDA(At, 1, 1); PG8_STAGE(PG8_SB(1, 0), b3, voffB); PG8_STAGE(PG8_SB(1, 1), b3 + hstepB, voffB); PG8_STAGE(PG8_SA(1, 0), a3, voffA);
            PG8_WAIT_V(8); PG8_WAIT_L(0); PG8_BAR; PG8_MMA(1, 0, At, B0); PG8_MMA(1, 1, At, B1); PG8_BAR; PG8_SCHED;
        }
        if (wr == 0) PG8_BAR;
        E(acc, cur, wr, wc, fr, fq);
        if (!has_next) break;
#pragma unroll
        for (int a = 0; a < 2; ++a)
#pragma unroll
            for (int b = 0; b < 2; ++b)
#pragma unroll
                for (int m = 0; m < 4; ++m)
#pragma unroll
                    for (int n = 0; n < 2; ++n) acc[a][b][m][n] = (f32x4){0.f, 0.f, 0.f, 0.f};
        cur = nxt; cA = nA; cB = nB; ++ui;
        if (wr == 1) PG8_BAR;
    }
    PG8_WAIT_V(0);
    PG8_BAR;
#undef PG8_SA
#undef PG8_SB
#undef PG8_STAGE
#undef PG8_LDA
#undef PG8_LDB
#undef PG8_MMA
#undef PG8_WAIT_V
#undef PG8_WAIT_L
#undef PG8_BAR
#undef PG8_SCHED
}
struct PlainSched : Order {
    const char* A; const char* B; size_t astep, bstep;
    __device__ __forceinline__ void set(const void* A_, int lda, const void* B_, int ldb, int nM_, int nN_) { A = (const char*)A_; B = (const char*)B_; astep = (size_t)BM * lda * 2; bstep = (size_t)BM * ldb * 2; init(nM_, nN_, gridDim.x, blockIdx.x); }
    __device__ __forceinline__ const char* aptr(const Unit& u) const { return A + (size_t)u.pm * astep; }
    __device__ __forceinline__ const char* bptr(const Unit& u) const { return B + (size_t)u.pn * bstep; }
};
}
using pg8::Unit;
typedef const f32x4 (&AccRef)[2][2][4][2];

struct EpiProj {
    static constexpr bool PERM = true;
    const float* rinv; const float* bias; bf16_t *xm, *som, *us, *sga, *sgb;
    __device__ __forceinline__ void operator()(AccRef acc, const Unit& u, int wr, int wc, int fr, int fq) const {
        const int pn = u.pn; bf16_t* base; int ldc, colt; bool sig;
        if (pn < 4) { base = xm; ldc = 1024; colt = pn * 256; sig = false; }
        else if (pn < 8) { base = som; ldc = 1024; colt = (pn - 4) * 256; sig = true; }
        else if (pn < 10) { base = us; ldc = 512; colt = (pn - 8) * 256; sig = false; }
        else if (pn < 14) { base = sga; ldc = 1024; colt = (pn - 10) * 256; sig = true; }
        else { base = sgb; ldc = 1024; colt = (pn - 14) * 256; sig = true; }
        const int row0 = u.pm * 256 + wr * 64 + fr, col0 = colt + wc * 32 + 8 * fq, bcol0 = pn * 256 + wc * 32 + 8 * fq;
        f32x4 bv[2][2];
#pragma unroll
        for (int bj = 0; bj < 2; ++bj)
#pragma unroll
            for (int n = 0; n < 2; ++n) bv[bj][n] = *(const f32x4*)(bias + bcol0 + bj * 128 + 4 * n);
#pragma unroll
        for (int ai = 0; ai < 2; ++ai)
#pragma unroll
            for (int m = 0; m < 4; ++m) { const int row = row0 + ai * 128 + m * 16; const float ri = rinv[row]; bf16_t* rowp = base + (size_t)row * ldc + col0;
#pragma unroll
                for (int bj = 0; bj < 2; ++bj) { f32x4 v0 = acc[ai][bj][m][0] * ri + bv[bj][0], v1 = acc[ai][bj][m][1] * ri + bv[bj][1];
                    if (sig) {
#pragma unroll
                        for (int j = 0; j < 4; ++j) { v0[j] = sigmoidf_(v0[j]); v1[j] = sigmoidf_(v1[j]); } }
                    u32x4 w; w.x = cvt_pk_bf16(v0[0], v0[1]); w.y = cvt_pk_bf16(v0[2], v0[3]); w.z = cvt_pk_bf16(v1[0], v1[1]); w.w = cvt_pk_bf16(v1[2], v1[3]);
                    *(u32x4*)(rowp + bj * 128) = w; } }
    }
};
struct EpiQKV {
    static constexpr bool PERM = true;
    bf16_t *qk, *v;
    __device__ __forceinline__ void operator()(AccRef acc, const Unit& u, int wr, int wc, int fr, int fq) const {
        const int head = u.pn & 3, kind = u.pn >> 2; bf16_t* base = (kind < 2) ? qk + (size_t)kind * T_ * 1024 : v;
        const int row0 = u.pm * 256 + wr * 64 + fr, col0 = head * 256 + wc * 32 + 8 * fq;
#pragma unroll
        for (int ai = 0; ai < 2; ++ai)
#pragma unroll
            for (int m = 0; m < 4; ++m) { bf16_t* rowp = base + (size_t)(row0 + ai * 128 + m * 16) * 1024 + col0;
#pragma unroll
                for (int bj = 0; bj < 2; ++bj) { const f32x4 v0 = acc[ai][bj][m][0], v1 = acc[ai][bj][m][1];
                    u32x4 w; w.x = cvt_pk_bf16(v0[0], v0[1]); w.y = cvt_pk_bf16(v0[2], v0[3]); w.z = cvt_pk_bf16(v1[0], v1[1]); w.w = cvt_pk_bf16(v1[2], v1[3]);
                    *(u32x4*)(rowp + bj * 128) = w; } }
    }
};
template <int MODE> struct EpiGate {
    static constexpr bool PERM = true;
    const bf16_t* X; const bf16_t* Y; const float* bias; bf16_t* O; int ldc;
    __device__ __forceinline__ void operator()(AccRef acc, const Unit& u, int wr, int wc, int fr, int fq) const {
        const int row0 = u.pm * 256 + wr * 64 + fr, col0 = u.pn * 256 + wc * 32 + 8 * fq;
        f32x4 bv[2][2];
#pragma unroll
        for (int bj = 0; bj < 2; ++bj)
#pragma unroll
            for (int n = 0; n < 2; ++n) bv[bj][n] = (MODE == 0) ? *(const f32x4*)(bias + col0 + bj * 128 + 4 * n) : (f32x4){0.f, 0.f, 0.f, 0.f};
#pragma unroll
        for (int ai = 0; ai < 2; ++ai)
#pragma unroll
            for (int m = 0; m < 4; ++m) { const size_t off = (size_t)(row0 + ai * 128 + m * 16) * ldc + col0;
#pragma unroll
                for (int bj = 0; bj < 2; ++bj) {
                    float xv[8], a[8], o[8]; unpack8(*(const u32x4*)(X + off + bj * 128), xv);
#pragma unroll
                    for (int j = 0; j < 4; ++j) { a[j] = acc[ai][bj][m][0][j] + bv[bj][0][j]; a[4 + j] = acc[ai][bj][m][1][j] + bv[bj][1][j]; }
                    if (MODE == 0) {
#pragma unroll
                        for (int j = 0; j < 8; ++j) o[j] = xv[j] * sigmoidf_(a[j]); }
                    else if (MODE == 1) {
#pragma unroll
                        for (int j = 0; j < 8; ++j) o[j] = xv[j] * a[j]; }
                    else { float yv[8]; unpack8(*(const u32x4*)(Y + off + bj * 128), yv);
#pragma unroll
                        for (int j = 0; j < 8; ++j) o[j] = xv[j] * a[j] + yv[j]; }
                    *(u32x4*)(O + off + bj * 128) = pack8(o); } }
    }
};
template <bool WB> struct EpiResid {
    static constexpr bool PERM = false;
    const float* Rs; float* Of; bf16_t* Ob; float* ss;
    __device__ __forceinline__ void operator()(AccRef acc, const Unit& u, int wr, int wc, int fr, int fq) const {
        const int row0 = u.pm * 256 + wr * 64 + fr, col0 = u.pn * 256 + wc * 32 + 4 * fq;
#pragma unroll
        for (int ai = 0; ai < 2; ++ai)
#pragma unroll
            for (int m = 0; m < 4; ++m) { const int row = row0 + ai * 128 + m * 16; const size_t off = (size_t)row * 1024 + col0; float s = 0.f;
#pragma unroll
                for (int bj = 0; bj < 2; ++bj)
#pragma unroll
                    for (int n = 0; n < 2; ++n) { const size_t o2 = off + bj * 128 + n * 16; const f32x4 r = *(const f32x4*)(Rs + o2); const f32x4 v = r + acc[ai][bj][m][n];
                        *(f32x4*)(Of + o2) = v; s += (v[0] * v[0] + v[1] * v[1]) + (v[2] * v[2] + v[3] * v[3]);
                        if (WB) { u32x2 w; w.x = cvt_pk_bf16(v[0], v[1]); w.y = cvt_pk_bf16(v[2], v[3]); *(u32x2*)(Ob + o2) = w; } }
                s += __shfl_xor(s, 16); s += __shfl_xor(s, 32);
                if (fq == 0) ss[(size_t)row * 16 + u.pn * 4 + wc] = s; }
    }
};
struct EpiUp {
    static constexpr bool PERM = true;
    const float* ss; bf16_t* U; int row_off;
    __device__ __forceinline__ void operator()(AccRef acc, const Unit& u, int wr, int wc, int fr, int fq) const {
        const int row0 = u.pm * 256 + wr * 64 + fr, col0 = u.pn * 256 + wc * 32 + 8 * fq;
#pragma unroll
        for (int ai = 0; ai < 2; ++ai)
#pragma unroll
            for (int m = 0; m < 4; ++m) { const int row = row0 + ai * 128 + m * 16; const f32x4* sp = (const f32x4*)(ss + (size_t)(row + row_off) * 16);
                const f32x4 s0 = sp[0], s1 = sp[1], s2 = sp[2], s3 = sp[3]; const f32x4 st = (s0 + s1) + (s2 + s3);
                const float ri = rsqrtf(((st[0] + st[1]) + (st[2] + st[3])) * (1.0f / 1024.0f) + EPS_);
                bf16_t* rowp = U + (size_t)row * F2_ + col0;
#pragma unroll
                for (int bj = 0; bj < 2; ++bj) { const f32x4 v0 = acc[ai][bj][m][0] * ri, v1 = acc[ai][bj][m][1] * ri;
                    u32x4 w; w.x = cvt_pk_bf16(v0[0], v0[1]); w.y = cvt_pk_bf16(v0[2], v0[3]); w.z = cvt_pk_bf16(v1[0], v1[1]); w.w = cvt_pk_bf16(v1[2], v1[3]);
                    *(u32x4*)(rowp + bj * 128) = w; } }
    }
};
struct SchedQKV : pg8::Order {
    const char *xc, *xm, *wqk, *wv;
    __device__ __forceinline__ const char* aptr(const Unit& u) const { const int head = u.pn & 3, kind = u.pn >> 2; return (kind < 2 ? xc : xm) + ((size_t)u.pm * 256 * 1024 + head * 256) * 2; }
    __device__ __forceinline__ const char* bptr(const Unit& u) const { const int head = u.pn & 3, kind = u.pn >> 2; return kind < 2 ? wqk + ((size_t)(head * 512 + kind * 256) * 256) * 2 : wv + ((size_t)head * 65536) * 2; }
};

__device__ __forceinline__ void transpose_item(const float* W, int ldw, int c0, const float* kscale, float scale, bf16_t* WT, int ldt, int row_off, LAS float* scr, int kb, int nb, int lane) {
    const int k0 = 64 * kb, n0 = 32 * nb;
#pragma unroll 8
    for (int i = 0; i < 32; ++i) { const int kk = 2 * i + (lane >> 5); float v = W[(size_t)(k0 + kk) * ldw + c0 + n0 + (lane & 31)] * scale; if (kscale) v *= kscale[k0 + kk]; scr[kk * 33 + (lane & 31)] = v; }
    asm volatile("s_waitcnt lgkmcnt(0)" ::: "memory");
    const int c = lane & 7;
#pragma unroll
    for (int j = 0; j < 4; ++j) { const int n = (lane >> 3) + 8 * j; const LAS float* s = scr + (8 * c) * 33 + n;
        u32x4 o; o.x = cvt_pk_bf16(s[0 * 33], s[1 * 33]); o.y = cvt_pk_bf16(s[2 * 33], s[3 * 33]); o.z = cvt_pk_bf16(s[4 * 33], s[5 * 33]); o.w = cvt_pk_bf16(s[6 * 33], s[7 * 33]);
        *(u32x4*)(WT + (size_t)(row_off + n0 + n) * ldt + k0 + 8 * c) = o; }
    asm volatile("s_waitcnt lgkmcnt(0)" ::: "memory");
}

__device__ __forceinline__ void phase0(const Params& p, LAS unsigned char* lds) {
    const int tid = fresh_tid(), lane = tid & 63, wave = tid >> 6;
    const int gw = blockIdx.x * 8 + wave, NGW = gridDim.x * 8;
    unsigned char* ws = p.ws;
    LAS float* scr = (LAS float*)(lds + wave * 8448);
    LAS float* gwt = (LAS float*)(lds + 8 * 8448);
    { const float* g1 = p.in[1]; const float* w_in = p.in[2];
      for (int i = tid; i < 8192; i += 512) { const int j = i & 7, k = i >> 3; gwt[j * 1024 + k] = g1[k] * w_in[(size_t)k * NIN_ + 2048 + j]; } }
    {
        const int nmat = 20;
        int base = 0;
        for (int mi = 0; mi < nmat; ++mi) {
            const float* W; int ldw, c0, ncols, K; const float* ks = nullptr; float sc = 1.f; bf16_t* WT; int ldt, roff = 0;
            if (mi == 0) { W = p.in[2]; ldw = NIN_; c0 = 0; ncols = 2048; K = 1024; ks = p.in[1]; WT = (bf16_t*)(ws + WS_WIN); ldt = 1024; roff = 0; }
            else if (mi == 1) { W = p.in[2]; ldw = NIN_; c0 = 2056; ncols = 2560; K = 1024; ks = p.in[1]; WT = (bf16_t*)(ws + WS_WIN); ldt = 1024; roff = 2048; }
            else if (mi < 6) { const int h = mi - 2; W = p.in[6] + h * 65536; ldw = 256; c0 = 0; ncols = 256; K = 256; WT = (bf16_t*)(ws + WS_WQK) + h * 512 * 256; ldt = 256; roff = 0; }
            else if (mi < 10) { const int h = mi - 6; W = p.in[7] + h * 65536; ldw = 256; c0 = 0; ncols = 256; K = 256; sc = 0.0625f; WT = (bf16_t*)(ws + WS_WQK) + h * 512 * 256; ldt = 256; roff = 256; }
            else if (mi < 14) { const int h = mi - 10; W = p.in[8] + h * 65536; ldw = 256; c0 = 0; ncols = 256; K = 256; WT = (bf16_t*)(ws + WS_WV) + h * 65536; ldt = 256; roff = 0; }
            else if (mi == 14) { W = p.in[19]; ldw = 512; c0 = 0; ncols = 512; K = 512; WT = (bf16_t*)(ws + WS_WGLU); ldt = 512; }
            else if (mi == 15) { W = p.in[21]; ldw = 1024; c0 = 0; ncols = 1024; K = 1024; WT = (bf16_t*)(ws + WS_WA); ldt = 1024; }
            else if (mi == 16) { W = p.in[22]; ldw = 1024; c0 = 0; ncols = 1024; K = 512; WT = (bf16_t*)(ws + WS_WB); ldt = 512; }
            else if (mi == 17) { W = p.in[23]; ldw = 1024; c0 = 0; ncols = 1024; K = 1024; WT = (bf16_t*)(ws + WS_WOUT); ldt = 1024; }
            else if (mi == 18) { W = p.in[25]; ldw = F2_; c0 = 0; ncols = F2_; K = 1024; ks = p.in[24]; WT = (bf16_t*)(ws + WS_WUP); ldt = 1024; }
            else { W = p.in[28]; ldw = 1024; c0 = 0; ncols = 1024; K = F_; WT = (bf16_t*)(ws + WS_WDN); ldt = F_; }
            const int nblk = ncols / 32, nit = (K / 64) * nblk;
            int it = gw - (base % NGW); if (it < 0) it += NGW;
            for (; it < nit; it += NGW) transpose_item(W, ldw, c0, ks, sc, WT, ldt, roff, scr, it / nblk, it % nblk, lane);
            base += nit;
        }
    }
    {
        const int gt = blockIdx.x * 512 + tid;
        if (gt < SG_ * SP_) {
            const int g = gt >> 6, pp = gt & 63;
            const float ar = p.in[11][gt], ai = p.in[12][gt], dt = expf(p.in[13][g]);
            const float mag = expf(dt * ar); float sn, cs; sincosf(dt * ai, &sn, &cs);
            const float abr = mag * cs, abi = mag * sn;
            const float den = ar * ar + ai * ai, xr = abr - 1.0f, xi = abi;
            const float rre = (xr * ar + xi * ai) / den, rim = (xi * ar - xr * ai) / den;
            float* A = (float*)(ws + WS_S5A); bf16_t* BbT = (bf16_t*)(ws + WS_S5BT);
            A[gt * 2] = abr; A[gt * 2 + 1] = abi;
            const float* bre = p.in[14] + (size_t)gt * 16; const float* bim = p.in[15] + (size_t)gt * 16;
            for (int c = 0; c < 16; ++c) { const float br = bre[c], bi = bim[c];
                BbT[((size_t)(g * 128 + pp)) * 16 + c] = f2bf(rre * br - rim * bi); BbT[((size_t)(g * 128 + 64 + pp)) * 16 + c] = f2bf(rre * bi + rim * br); }
        }
        bf16_t* CmT = (bf16_t*)(ws + WS_S5CT);
        for (int i = blockIdx.x * 512 + tid; i < SG_ * 16 * 128; i += gridDim.x * 512) { const int k = i & 127, gc = i >> 7;
            CmT[i] = f2bf(k < 64 ? p.in[16][(size_t)gc * 64 + k] : -p.in[17][(size_t)gc * 64 + k - 64]); }
    }
    {
        float* bp = (float*)(ws + WS_BIASP); const float* b_in = p.in[3];
        for (int i = blockIdx.x * 512 + tid; i < NP1_; i += gridDim.x * 512) bp[i] = b_in[i < 2048 ? i : i + 8];
    }
    __syncthreads();
    {
        const float* x = p.in[0]; const float* b_in = p.in[3];
        bf16_t* xb = (bf16_t*)(ws + R0); float* rinv1 = (float*)(ws + WS_RINV1); float* ig = (float*)(ws + WS_IG); float* fg = (float*)(ws + WS_FG);
        for (int row = gw; row < T_; row += NGW) {
            const f32x4* xr = (const f32x4*)(x + (size_t)row * 1024) + lane;
            f32x4 v[4]; float s = 0.f;
#pragma unroll
            for (int j = 0; j < 4; ++j) { v[j] = xr[64 * j]; s += (v[j][0] * v[j][0] + v[j][1] * v[j][1]) + (v[j][2] * v[j][2] + v[j][3] * v[j][3]); }
            float d[8];
#pragma unroll
            for (int g = 0; g < 8; ++g) { float a = 0.f;
#pragma unroll
                for (int j = 0; j < 4; ++j) { const f32x4 w = *(const LAS f32x4*)(gwt + g * 1024 + 256 * j + 4 * lane); a += (v[j][0] * w[0] + v[j][1] * w[1]) + (v[j][2] * w[2] + v[j][3] * w[3]); }
                d[g] = a; }
            s = wave_sum(s);
#pragma unroll
            for (int g = 0; g < 8; ++g) d[g] = wave_sum(d[g]);
            const float ri = rsqrtf(s * (1.0f / 1024.0f) + EPS_);
            u32x2* o8 = (u32x2*)(xb + (size_t)row * 1024) + lane;
#pragma unroll
            for (int j = 0; j < 4; ++j) { u32x2 w; w.x = cvt_pk_bf16(v[j][0], v[j][1]); w.y = cvt_pk_bf16(v[j][2], v[j][3]); o8[64 * j] = w; }
            if (lane == 0) rinv1[row] = ri;
            if (lane < 8) { float val = d[0];
#pragma unroll
                for (int g = 1; g < 8; ++g) val = (lane == g) ? d[g] : val;
                val = val * ri + b_in[2048 + lane];
                if (lane < 4) ig[(size_t)row * 4 + lane] = val; else fg[(size_t)row * 4 + lane - 4] = val; }
        }
    }
}

__device__ __forceinline__ void phase_conv_m(const Params& p) {
    const bf16_t* xm = (const bf16_t*)(p.ws + R1); bf16_t* xc = (bf16_t*)(p.ws + R0);
    const float* cw = p.in[4]; const float* cb = p.in[5];
    const int total = (T_ / 16) * 128;
    for (int idx = blockIdx.x * 512 + fresh_tid(); idx < total; idx += gridDim.x * 512) {
        const int cgi = idx & 127, tb = idx >> 7, c0 = cgi * 8, t0 = tb * 16;
        float w[4][8], b[8];
#pragma unroll
        for (int k = 0; k < 4; ++k) { const f32x4 a = *(const f32x4*)(cw + k * 1024 + c0), bb = *(const f32x4*)(cw + k * 1024 + c0 + 4);
#pragma unroll
            for (int j = 0; j < 4; ++j) { w[k][j] = a[j]; w[k][4 + j] = bb[j]; } }
        { const f32x4 a = *(const f32x4*)(cb + c0), bb = *(const f32x4*)(cb + c0 + 4);
#pragma unroll
          for (int j = 0; j < 4; ++j) { b[j] = a[j]; b[4 + j] = bb[j]; } }
        float r0[8], r1[8], r2[8], r3[8];
        const bool head = (t0 & (SEQ_ - 1)) == 0;
        if (head) {
#pragma unroll
            for (int j = 0; j < 8; ++j) { r0[j] = 0.f; r1[j] = 0.f; r2[j] = 0.f; } }
        else { unpack8(*(const u32x4*)(xm + (size_t)(t0 - 3) * 1024 + c0), r0); unpack8(*(const u32x4*)(xm + (size_t)(t0 - 2) * 1024 + c0), r1); unpack8(*(const u32x4*)(xm + (size_t)(t0 - 1) * 1024 + c0), r2); }
#pragma unroll 4
        for (int i = 0; i < 16; ++i) {
            unpack8(*(const u32x4*)(xm + (size_t)(t0 + i) * 1024 + c0), r3);
            float o[8];
#pragma unroll
            for (int j = 0; j < 8; ++j) { const float y = b[j] + w[0][j] * r0[j] + w[1][j] * r1[j] + w[2][j] * r2[j] + w[3][j] * r3[j]; o[j] = siluf_(y); }
            *(u32x4*)(xc + (size_t)(t0 + i) * 1024 + c0) = pack8(o);
#pragma unroll
            for (int j = 0; j < 8; ++j) { r0[j] = r1[j]; r1[j] = r2[j]; r2[j] = r3[j]; }
        }
    }
}

__device__ __forceinline__ void phase_gates(const Params& p, LAS unsigned char* lds) {
    const int tid = fresh_tid(), lane = tid & 63, wave = __builtin_amdgcn_readfirstlane(tid >> 6);
    const float* IG = (const float*)(p.ws + WS_IG); const float* FG = (const float*)(p.ws + WS_FG); float* GS = (float*)(p.ws + WS_GS);
    LAS float* LB = (LAS float*)lds; LAS float* LC = LB + 64; LAS float* Lm = LB + 128;
    for (int item = blockIdx.x; item < 32; item += gridDim.x) {
        const int b = item >> 2, h = item & 3;
        float av[8], bv[8], pv[8];
#pragma unroll
        for (int cc = 0; cc < 8; ++cc) {
            const int ch = wave * 8 + cc; const size_t t = (size_t)b * SEQ_ + ch * 64 + lane;
            const float fgv = FG[t * 4 + h], li = IG[t * 4 + h];
            const float lf = fminf(fgv, 0.f) - log1pf(expf(-fabsf(fgv)));
            float bc = lf;
#pragma unroll
            for (int o = 1; o < 64; o <<= 1) { const float x = __shfl_up(bc, o); if (lane >= o) bc += x; }
            const float a = li - bc; float pm = a;
#pragma unroll
            for (int o = 1; o < 64; o <<= 1) { const float x = __shfl_up(pm, o); if (lane >= o) pm = fmaxf(pm, x); }
            av[cc] = a; bv[cc] = bc; pv[cc] = pm;
            if (lane == 63) { LB[ch] = bc; LC[ch] = bc + pm; }
        }
        __syncthreads();
        if (tid == 0) { float m = 0.f; for (int j = 0; j < 64; ++j) { Lm[j] = m; m = fmaxf(m + LB[j], LC[j]); } }
        __syncthreads();
#pragma unroll
        for (int cc = 0; cc < 8; ++cc) {
            const int ch = wave * 8 + cc; const float m = Lm[ch];
            const float Mq = fmaxf(m, pv[cc]); const float M63 = __shfl(Mq, 63);
            float* gs = GS + ((size_t)item * 64 + ch) * 384;
            gs[lane] = av[cc]; gs[64 + lane] = Mq; gs[128 + lane] = expf(m - Mq); gs[192 + lane] = expf(-(bv[cc] + Mq)); gs[256 + lane] = expf(av[cc] - M63);
            if (lane == 0) gs[320] = expf(m - M63);
        }
        __syncthreads();
    }
}

constexpr int ML_KT = 0, ML_VT = 36864, ML_VTW = 43776, ML_SW = 50688, ML_CB = 59904, ML_SC = 85248;
__device__ __forceinline__ void phase_mlstm(const Params& p, LAS unsigned char* lds) {
    const int tid = fresh_tid(), lane = tid & 63, w = __builtin_amdgcn_readfirstlane(tid >> 6), qi = w & 3, half = w >> 2, lr = lane & 15, lg = lane >> 4;
    const bf16_t* Q = (const bf16_t*)p.out; const bf16_t* Kk = (const bf16_t*)p.out + (size_t)T_ * 1024; const bf16_t* V = (const bf16_t*)(p.ws + R6);
    bf16_t* HC = (bf16_t*)(p.ws + R1);
    const float* GS = (const float*)(p.ws + WS_GS);
    LAS bf16_t* kT = (LAS bf16_t*)(lds + ML_KT);
    LAS bf16_t* vT = (LAS bf16_t*)(lds + ML_VT);
    LAS bf16_t* vTw = (LAS bf16_t*)(lds + ML_VTW);
    LAS bf16_t* Sw = (LAS bf16_t*)(lds + ML_SW);
    LAS bf16_t* Cb = (LAS bf16_t*)(lds + ML_CB);
    LAS float* sc_den = (LAS float*)(lds + ML_SC);
    for (int item = blockIdx.x; item < 256; item += gridDim.x) {
        const int bh = item & 31, vs = item >> 5, b = bh >> 2, h = bh & 3;
        const size_t tok0 = (size_t)b * SEQ_;
        __syncthreads();
        for (int i = tid; i < 48 * 264 / 2; i += 512) ((LAS unsigned*)Cb)[i] = 0u;
        for (int i = tid; i < 2 * 48 * 72 / 2; i += 512) ((LAS unsigned*)vT)[i] = 0u;
        f32x4 Cacc[2][3];
#pragma unroll
        for (int a_ = 0; a_ < 2; ++a_)
#pragma unroll
            for (int c_ = 0; c_ < 3; ++c_) Cacc[a_][c_] = (f32x4){0.f, 0.f, 0.f, 0.f};
        bf16x8 qf[8], kf[2][8]; u32x4 vreg = (u32x4){0u, 0u, 0u, 0u};
        float sMq, swi, semr, swk = 0.f, sdecay; f32x4 sa[2];
        const int vsel = tid < 256 ? (tid >> 2) : (tid < 320 ? tid - 256 : 0);
#define ML_LOAD_K(tc0_) do { _Pragma("unroll") for (int jj = 0; jj < 2; ++jj) { const bf16_t* kp = Kk + ((tc0_) + 16 * (2 * half + jj) + lr) * 1024 + h * 256 + 8 * lg; \
            _Pragma("unroll") for (int ks = 0; ks < 8; ++ks) kf[jj][ks] = *(const bf16x8*)(kp + 32 * ks); } } while (0)
#define ML_LOAD_Q(tc0_) do { const bf16_t* qp = Q + ((tc0_) + 16 * qi + lr) * 1024 + h * 256 + 8 * lg; \
            _Pragma("unroll") for (int ks = 0; ks < 8; ++ks) qf[ks] = *(const bf16x8*)(qp + 32 * ks); } while (0)
        { const size_t tc0 = tok0; ML_LOAD_K(tc0); ML_LOAD_Q(tc0);
          if (tid < 256) vreg = *(const u32x4*)(V + (tc0 + (tid >> 2)) * 1024 + h * 256 + vs * 32 + (tid & 3) * 8);
          const float* gs = GS + ((size_t)bh * 64) * 384;
          sMq = gs[64 + 16 * qi + lr]; swi = gs[128 + 16 * qi + lr]; semr = gs[192 + 16 * qi + lr]; swk = gs[256 + vsel]; sdecay = gs[320];
          sa[0] = *(const f32x4*)(gs + 16 * (2 * half) + 4 * lg); sa[1] = *(const f32x4*)(gs + 16 * (2 * half + 1) + 4 * lg); }
        __syncthreads();
        for (int ch = 0; ch < NCH_; ++ch) {
            const size_t tc0 = tok0 + (size_t)ch * 64;
            const int chn = ch + 1 < NCH_ ? ch + 1 : ch; const size_t tcn = tok0 + (size_t)chn * 64;
            const float* gsn = GS + ((size_t)bh * 64 + chn) * 384;
            f32x4 St[2];
#pragma unroll
            for (int jj = 0; jj < 2; ++jj) { St[jj] = (f32x4){0.f, 0.f, 0.f, 0.f};
#pragma unroll
                for (int ks = 0; ks < 8; ++ks) St[jj] = __builtin_amdgcn_mfma_f32_16x16x32_bf16(kf[jj][ks], qf[ks], St[jj], 0, 0, 0); }
#pragma unroll
            for (int jj = 0; jj < 2; ++jj) { const int kt = 2 * half + jj; const int qtok = 16 * qi + lr, k0 = 16 * kt + 4 * lg;
                float o[4];
#pragma unroll
                for (int r = 0; r < 4; ++r) { const float wgt = (k0 + r <= qtok) ? __expf(sa[jj][r] - sMq) : 0.f; o[r] = St[jj][r] * wgt; }
                u32x2 pk; pk.x = cvt_pk_bf16(o[0], o[1]); pk.y = cvt_pk_bf16(o[2], o[3]);
                *(LAS u32x2*)(Sw + qtok * 72 + k0) = pk; }
#pragma unroll
            for (int jj = 0; jj < 2; ++jj)
#pragma unroll
                for (int k2 = 0; k2 < 2; ++k2) {
                    bf16x8 fragv = kf[jj][0];
#pragma unroll
                    for (int ks = 1; ks < 8; ++ks) if (ks == 2 * qi + k2) fragv = kf[jj][ks];
                    const int c = 16 * (2 * half + jj) + lr, d0 = 32 * (2 * qi + k2) + 8 * lg;
#pragma unroll
                    for (int j = 0; j < 8; ++j) kT[(d0 + j) * 72 + c] = (bf16_t)fragv[j];
                }
            if (tid < 256) { const int c = tid >> 2, v0 = (tid & 3) * 8; float vv[8]; unpack8(vreg, vv);
#pragma unroll
                for (int j = 0; j < 8; ++j) { vT[(v0 + j) * 72 + c] = f2bf(vv[j]); vTw[(v0 + j) * 72 + c] = f2bf(vv[j] * swk); } }
            else if (tid < 320) { const int c = tid - 256; vT[32 * 72 + c] = (bf16_t)0x3f80; vTw[32 * 72 + c] = f2bf(swk); }
            ML_LOAD_K(tcn);
            if (tid < 256) vreg = *(const u32x4*)(V + (tcn + (tid >> 2)) * 1024 + h * 256 + vs * 32 + (tid & 3) * 8);
            const float nMq = gsn[64 + 16 * qi + lr], nwk = gsn[256 + vsel];
            const f32x4 nsa0 = *(const f32x4*)(gsn + 16 * (2 * half) + 4 * lg), nsa1 = *(const f32x4*)(gsn + 16 * (2 * half + 1) + 4 * lg);
            __syncthreads();
            f32x4 num[2]; num[0] = (f32x4){0.f, 0.f, 0.f, 0.f}; num[1] = (f32x4){0.f, 0.f, 0.f, 0.f};
            const int nvt = half == 0 ? 2 : 1, vt0 = half == 0 ? 0 : 2;
#pragma unroll
            for (int i = 0; i < 2; ++i) if (i < nvt) {
                const int vn = vt0 + i;
#pragma unroll
                for (int ks = 0; ks < 8; ++ks) { const bf16x8 cf = *(const LAS bf16x8*)(Cb + (16 * vn + lr) * 264 + 32 * ks + 8 * lg);
                    num[i] = __builtin_amdgcn_mfma_f32_16x16x32_bf16(cf, qf[ks], num[i], 0, 0, 0); }
                num[i] *= swi;
#pragma unroll
                for (int k2 = 0; k2 < 2; ++k2) { const bf16x8 sf = *(const LAS bf16x8*)(Sw + (16 * qi + lr) * 72 + 32 * k2 + 8 * lg);
                    const bf16x8 vf = *(const LAS bf16x8*)(vT + (16 * vn + lr) * 72 + 32 * k2 + 8 * lg);
                    num[i] = __builtin_amdgcn_mfma_f32_16x16x32_bf16(vf, sf, num[i], 0, 0, 0); }
            }
            if (half == 1 && lg == 0) sc_den[16 * qi + lr] = num[0][0];
            ML_LOAD_Q(tcn);
            const float nwi = gsn[128 + 16 * qi + lr], nemr = gsn[192 + 16 * qi + lr], ndecay = gsn[320];
#pragma unroll
            for (int dm = 0; dm < 2; ++dm) {
                bf16x8 kf2[2];
#pragma unroll
                for (int k2 = 0; k2 < 2; ++k2) kf2[k2] = *(const LAS bf16x8*)(kT + (32 * w + 16 * dm + lr) * 72 + 32 * k2 + 8 * lg);
#pragma unroll
                for (int vn = 0; vn < 3; ++vn) { f32x4 c = Cacc[dm][vn] * sdecay;
#pragma unroll
                    for (int k2 = 0; k2 < 2; ++k2) { const bf16x8 vf = *(const LAS bf16x8*)(vTw + (16 * vn + lr) * 72 + 32 * k2 + 8 * lg);
                        c = __builtin_amdgcn_mfma_f32_16x16x32_bf16(kf2[k2], vf, c, 0, 0, 0); }
                    Cacc[dm][vn] = c; }
            }
            __syncthreads();
            if (half == 0) {
                const float dn = __builtin_amdgcn_rcpf(fmaxf(fabsf(sc_den[16 * qi + lr]), semr));
#pragma unroll
                for (int i = 0; i < 2; ++i) { u32x2 pk; pk.x = cvt_pk_bf16(num[i][0] * dn, num[i][1] * dn); pk.y = cvt_pk_bf16(num[i][2] * dn, num[i][3] * dn);
                    *(u32x2*)(HC + (tc0 + 16 * qi + lr) * 1024 + h * 256 + vs * 32 + 16 * i + 4 * lg) = pk; }
            }
#pragma unroll
            for (int dm = 0; dm < 2; ++dm)
#pragma unroll
                for (int vn = 0; vn < 3; ++vn) { const f32x4 c = Cacc[dm][vn]; u32x2 pk; pk.x = cvt_pk_bf16(c[0], c[1]); pk.y = cvt_pk_bf16(c[2], c[3]);
                    *(LAS u32x2*)(Cb + (16 * vn + lr) * 264 + 32 * w + 16 * dm + 4 * lg) = pk; }
            sMq = nMq; swk = nwk; sa[0] = nsa0; sa[1] = nsa1; swi = nwi; semr = nemr; sdecay = ndecay;
        }
#undef ML_LOAD_K
#undef ML_LOAD_Q
    }
}

__device__ __forceinline__ void phase_aout(const Params& p) {
    const int tid = fresh_tid(), lane = tid & 63, gw = blockIdx.x * 8 + (tid >> 6), NGW = gridDim.x * 8;
    const bf16_t* HC = (const bf16_t*)(p.ws + R1); const bf16_t* SOM = (const bf16_t*)(p.ws + R2); const bf16_t* XC = (const bf16_t*)(p.ws + R0);
    bf16_t* AO = (bf16_t*)(p.ws + R6);
    const float* hg = p.in[9]; const float* sk = p.in[10];
    for (int t = gw; t < T_; t += NGW) {
#pragma unroll
        for (int h = 0; h < 4; ++h) {
            const size_t off = (size_t)t * 1024 + h * 256 + 4 * lane;
            const u32x2 hw = *(const u32x2*)(HC + off), ow = *(const u32x2*)(SOM + off), xw = *(const u32x2*)(XC + off);
            const f32x4 g4 = *(const f32x4*)(hg + h * 256 + 4 * lane), s4 = *(const f32x4*)(sk + h * 256 + 4 * lane);
            float hv[4] = {bflo(hw.x), bfhi(hw.x), bflo(hw.y), bfhi(hw.y)};
            const float ov[4] = {bflo(ow.x), bfhi(ow.x), bflo(ow.y), bfhi(ow.y)}, xv[4] = {bflo(xw.x), bfhi(xw.x), bflo(xw.y), bfhi(xw.y)};
            const float mu = wave_sum((hv[0] + hv[1]) + (hv[2] + hv[3])) * (1.0f / 256.0f);
#pragma unroll
            for (int j = 0; j < 4; ++j) hv[j] -= mu;
            const float var = wave_sum((hv[0] * hv[0] + hv[1] * hv[1]) + (hv[2] * hv[2] + hv[3] * hv[3])) * (1.0f / 256.0f);
            const float rs = rsqrtf(var + EPS_);
            float o[4];
#pragma unroll
            for (int j = 0; j < 4; ++j) o[j] = ov[j] * (hv[j] * rs * g4[j]) + s4[j] * xv[j];
            u32x2 wv; wv.x = cvt_pk_bf16(o[0], o[1]); wv.y = cvt_pk_bf16(o[2], o[3]);
            *(u32x2*)(AO + off) = wv;
        }
    }
}

__device__ __forceinline__ bf16x8 s5_load_af(const bf16_t* US, size_t tokb, int g, int lane) {
    const int lr = lane & 15, lg = lane >> 4;
    bf16x8 af = *(const bf16x8*)(US + (tokb + lr) * 512 + g * 16 + 8 * (lg & 1));
    if (lg >= 2) af = (bf16x8){0, 0, 0, 0, 0, 0, 0, 0};
    return af;
}
template <bool PASS_C>
__device__ __forceinline__ void s5_block16(const bf16x8 af, int lane, const bf16x8 (&bbf)[8], LAS float* but, LAS bf16_t* stb, float ar, float ai, float& sr, float& si) {
    const int lr = lane & 15, lg = lane >> 4;
#pragma unroll
    for (int ct = 0; ct < 8; ++ct) { const f32x4 d = __builtin_amdgcn_mfma_f32_16x16x32_bf16(af, bbf[ct], (f32x4){0.f, 0.f, 0.f, 0.f}, 0, 0, 0);
#pragma unroll
        for (int r = 0; r < 4; ++r) but[(4 * lg + r) * 132 + 16 * ct + lr] = d[r]; }
#pragma unroll 4
    for (int tt = 0; tt < 16; ++tt) { const float br = but[tt * 132 + lane], bi = but[tt * 132 + 64 + lane];
        const float nr = ar * sr - ai * si + br, ni = ar * si + ai * sr + bi; sr = nr; si = ni;
        if (PASS_C) { stb[tt * 136 + lane] = f2bf(sr); stb[tt * 136 + 64 + lane] = f2bf(si); } }
}
__device__ __forceinline__ void phase_s5(const Params& p, LAS unsigned char* lds) {
    const int tid = fresh_tid(), lane = tid & 63, wave = __builtin_amdgcn_readfirstlane(tid >> 6), lr = lane & 15, lg = lane >> 4;
    const bf16_t* US = (const bf16_t*)(p.ws + R5);
    const float* A = (const float*)(p.ws + WS_S5A); const bf16_t* BbT = (const bf16_t*)(p.ws + WS_S5BT); const bf16_t* CmT = (const bf16_t*)(p.ws + WS_S5CT);
    bf16_t* YB = (bf16_t*)(p.ws + R7);
    LAS float* but = (LAS float*)(lds + wave * 16896);
    LAS bf16_t* stb = (LAS bf16_t*)(lds + wave * 16896 + 8448);
    LAS float* Eb = (LAS float*)(lds + 8 * 16896);
    for (int item = blockIdx.x; item < NB_ * SG_; item += gridDim.x) {
        const int b = item & 7, g = item >> 3, gp = g * 64 + lane;
        const float ar = A[gp * 2], ai = A[gp * 2 + 1];
        bf16x8 bbf[8];
#pragma unroll
        for (int ct = 0; ct < 8; ++ct) { bbf[ct] = *(const bf16x8*)(BbT + ((size_t)(g * 128 + 16 * ct + lr)) * 16 + 8 * (lg & 1)); if (lg >= 2) bbf[ct] = (bf16x8){0, 0, 0, 0, 0, 0, 0, 0}; }
        const size_t tokw = (size_t)b * SEQ_ + (size_t)wave * 512;
        float sr = 0.f, si = 0.f;
        { bf16x8 afc = s5_load_af(US, tokw, g, lane);
          for (int blk = 0; blk < 32; ++blk) { const int bn = blk + 1 < 32 ? blk + 1 : blk; const bf16x8 afn = s5_load_af(US, tokw + bn * 16, g, lane);
              s5_block16<false>(afc, lane, bbf, but, stb, ar, ai, sr, si); afc = afn; } }
        Eb[(wave * 64 + lane) * 2] = sr; Eb[(wave * 64 + lane) * 2 + 1] = si;
        __syncthreads();
        float pr = ar, pi = ai;
#pragma unroll
        for (int i = 0; i < 9; ++i) { const float nr = pr * pr - pi * pi, ni = 2.f * pr * pi; pr = nr; pi = ni; }
        sr = 0.f; si = 0.f;
        for (int j = 0; j < wave; ++j) { const float er = Eb[(j * 64 + lane) * 2], ei = Eb[(j * 64 + lane) * 2 + 1]; const float nr = pr * sr - pi * si + er, ni = pr * si + pi * sr + ei; sr = nr; si = ni; }
        bf16x8 cmf[4];
#pragma unroll
        for (int kk = 0; kk < 4; ++kk) cmf[kk] = *(const bf16x8*)(CmT + ((size_t)(g * 16 + lr)) * 128 + 32 * kk + 8 * lg);
        const float dsk = p.in[18][g * 16 + lr];
        bf16x8 afc = s5_load_af(US, tokw, g, lane);
        bf16_t uuc[4];
#pragma unroll
        for (int r = 0; r < 4; ++r) uuc[r] = US[(tokw + 4 * lg + r) * 512 + g * 16 + lr];
        for (int blk = 0; blk < 32; ++blk) {
            const size_t tokb = tokw + blk * 16;
            const int bn = blk + 1 < 32 ? blk + 1 : blk; const bf16x8 afn = s5_load_af(US, tokw + bn * 16, g, lane);
            bf16_t uun[4];
#pragma unroll
            for (int r = 0; r < 4; ++r) uun[r] = US[(tokw + bn * 16 + 4 * lg + r) * 512 + g * 16 + lr];
            s5_block16<true>(afc, lane, bbf, but, stb, ar, ai, sr, si);
            f32x4 y = (f32x4){0.f, 0.f, 0.f, 0.f};
#pragma unroll
            for (int kk = 0; kk < 4; ++kk) { const bf16x8 sf = *(const LAS bf16x8*)(stb + lr * 136 + 32 * kk + 8 * lg); y = __builtin_amdgcn_mfma_f32_16x16x32_bf16(sf, cmf[kk], y, 0, 0, 0); }
#pragma unroll
            for (int r = 0; r < 4; ++r) { const size_t tok = tokb + 4 * lg + r; const float uu = bf2f(uuc[r]);
                const float v = y[r] + dsk * uu;
                const float z = 0.7978845608f * (v + 0.044715f * v * v * v); const float th = 1.0f - 2.0f * __builtin_amdgcn_rcpf(1.0f + __expf(2.0f * z));
                YB[tok * 512 + g * 16 + lr] = f2bf(0.5f * v * (1.0f + th)); }
            afc = afn;
#pragma unroll
            for (int r = 0; r < 4; ++r) uuc[r] = uun[r];
        }
        __syncthreads();
    }
}

__device__ __forceinline__ void phase_ffn_act(const Params& p, int half) {
    const bf16_t* U = (const bf16_t*)(p.ws + WS_UH); bf16_t* ACT = (bf16_t*)(p.ws + WS_ACT) + (size_t)half * 16384 * F_;
    const float* cw = p.in[26]; const float* cb = p.in[27];
    const int total = (16384 / 16) * 352;
    for (int idx = blockIdx.x * 512 + fresh_tid(); idx < total; idx += gridDim.x * 512) {
        const int fg = idx % 352, tb = idx / 352, f0 = fg * 8, t0 = tb * 16;
        float wv[3][8], wg[3][8], bvv[8], bgg[8];
#pragma unroll
        for (int k = 0; k < 3; ++k) { const f32x4 a = *(const f32x4*)(cw + k * F2_ + f0), b = *(const f32x4*)(cw + k * F2_ + f0 + 4), c = *(const f32x4*)(cw + k * F2_ + F_ + f0), d = *(const f32x4*)(cw + k * F2_ + F_ + f0 + 4);
#pragma unroll
            for (int j = 0; j < 4; ++j) { wv[k][j] = a[j]; wv[k][4 + j] = b[j]; wg[k][j] = c[j]; wg[k][4 + j] = d[j]; } }
        { const f32x4 a = *(const f32x4*)(cb + f0), b = *(const f32x4*)(cb + f0 + 4), c = *(const f32x4*)(cb + F_ + f0), d = *(const f32x4*)(cb + F_ + f0 + 4);
#pragma unroll
          for (int j = 0; j < 4; ++j) { bvv[j] = a[j]; bvv[4 + j] = b[j]; bgg[j] = c[j]; bgg[4 + j] = d[j]; } }
        float v0[8], v1[8], v2[8], g0[8], g1[8], g2[8];
        const bool head = (t0 & (SEQ_ - 1)) == 0;
        if (head) {
#pragma unroll
            for (int j = 0; j < 8; ++j) { v0[j] = 0.f; v1[j] = 0.f; g0[j] = 0.f; g1[j] = 0.f; } }
        else { unpack8(*(const u32x4*)(U + (size_t)(t0 - 2) * F2_ + f0), v0); unpack8(*(const u32x4*)(U + (size_t)(t0 - 1) * F2_ + f0), v1);
               unpack8(*(const u32x4*)(U + (size_t)(t0 - 2) * F2_ + F_ + f0), g0); unpack8(*(const u32x4*)(U + (size_t)(t0 - 1) * F2_ + F_ + f0), g1); }
#pragma unroll 4
        for (int i = 0; i < 16; ++i) {
            unpack8(*(const u32x4*)(U + (size_t)(t0 + i) * F2_ + f0), v2); unpack8(*(const u32x4*)(U + (size_t)(t0 + i) * F2_ + F_ + f0), g2);
            float o[8];
#pragma unroll
            for (int j = 0; j < 8; ++j) { const float val = bvv[j] + wv[0][j] * v0[j] + wv[1][j] * v1[j] + wv[2][j] * v2[j]; const float gt = bgg[j] + wg[0][j] * g0[j] + wg[1][j] * g1[j] + wg[2][j] * g2[j]; o[j] = siluf_(gt) * val; }
            *(u32x4*)(ACT + (size_t)(t0 + i) * F_ + f0) = pack8(o);
#pragma unroll
            for (int j = 0; j < 8; ++j) { v0[j] = v1[j]; v1[j] = v2[j]; g0[j] = g1[j]; g1[j] = g2[j]; }
        }
    }
}

__device__ __forceinline__ void phase_final(const Params& p) {
    const int tid = fresh_tid(), lane = tid & 63, gw = blockIdx.x * 8 + (tid >> 6), NGW = gridDim.x * 8;
    const float* ss = (const float*)(p.ws + WS_SS2); const float* gf = p.in[29];
    for (int row = gw; row < T_; row += NGW) {
        const float sv = (lane < 16) ? ss[(size_t)row * 16 + lane] : 0.f;
        const float ri = rsqrtf(wave_sum(sv) * (1.0f / 1024.0f) + EPS_);
        f32x4* xr = (f32x4*)(p.out + (size_t)row * 1024) + lane;
#pragma unroll
        for (int j = 0; j < 4; ++j) { const f32x4 g4 = *((const f32x4*)gf + lane + 64 * j); f32x4 v = xr[64 * j]; v = v * ri * g4; xr[64 * j] = v; }
    }
}

#ifndef PHASE_MASK
#define PHASE_MASK 0xffffffffu
#endif
#define PH(k) ((PHASE_MASK >> (k)) & 1u)
#ifndef REP_MASK
#define REP_MASK 0u
#endif
#define REPS(k) for (int rep_ = 0; rep_ < 1 + (int)((REP_MASK >> (k)) & 1u); ++rep_)
__global__ void __launch_bounds__(512, 2) fwd_megakernel(Params p) {
    extern __shared__ __attribute__((aligned(16))) unsigned char lds_raw[];
    LAS unsigned char* lds = (LAS unsigned char*)lds_raw;
    cg::grid_group grid = cg::this_grid();
    unsigned char* ws = p.ws;
    bf16_t* dq = (bf16_t*)p.out;
    volatile LAS unsigned* bst = (volatile LAS unsigned*)(lds + LDS_BYTES - 64);
    if (threadIdx.x < 2) bst[threadIdx.x] = 0u;
    if (blockIdx.x == 0) { unsigned* bw = (unsigned*)(ws + WS_BAR); for (int i = threadIdx.x; i < XCD_BAR_WORDS; i += 512) bw[i] = 0u; }
    __syncthreads();
    REPS(0) if (PH(0)) phase0(p, lds);
    grid.sync();
    const XcdBarrier xbar = xcd_barrier_post((unsigned*)(ws + WS_BAR), bst);
    REPS(1) if (PH(1)) { pg8::PlainSched S; S.set(ws + R0, 1024, ws + WS_WIN, 1024, T_ / 256, NP1_ / 256);
      EpiProj E{(const float*)(ws + WS_RINV1), (const float*)(ws + WS_BIASP), (bf16_t*)(ws + R1), (bf16_t*)(ws + R2), (bf16_t*)(ws + R5), (bf16_t*)(ws + R3), (bf16_t*)(ws + R4)};
      pg8::gemm_phase(lds, S, E, 1024, 1024, 1024); }
    xcd_barrier(xbar);
    REPS(2) if (PH(2)) { phase_gates(p, lds); phase_conv_m(p); }
    xcd_barrier(xbar);
    REPS(3) if (PH(3)) { SchedQKV S; S.init(T_ / 256, 12, gridDim.x, blockIdx.x); S.xc = (const char*)(ws + R0); S.xm = (const char*)(ws + R1); S.wqk = (const char*)(ws + WS_WQK); S.wv = (const char*)(ws + WS_WV);
      EpiQKV E{dq, (bf16_t*)(ws + R6)};
      pg8::gemm_phase(lds, S, E, 256, 1024, 256); }
    xcd_barrier(xbar);
    REPS(4) if (PH(4)) phase_mlstm(p, lds);
    xcd_barrier(xbar);
    REPS(5) if (PH(5)) phase_aout(p);
    REPS(6) if (PH(6)) phase_s5(p, lds);
    xcd_barrier(xbar);
    REPS(8) if (PH(8)) { pg8::PlainSched S; S.set(ws + R7, 512, ws + WS_WGLU, 512, T_ / 256, 2);
      EpiGate<0> E{(const bf16_t*)(ws + R7), nullptr, p.in[20], dq, 512};
      pg8::gemm_phase(lds, S, E, 512, 512, 512); }
    xcd_barrier(xbar);
    REPS(9) if (PH(9)) { pg8::PlainSched S; S.set(dq, 512, ws + WS_WB, 512, T_ / 256, 4);
      EpiGate<1> E{(const bf16_t*)(ws + R4), nullptr, nullptr, (bf16_t*)(ws + R1), 1024};
      pg8::gemm_phase(lds, S, E, 512, 512, 512); }
    xcd_barrier(xbar);
    REPS(10) if (PH(10)) { pg8::PlainSched S; S.set(ws + R6, 1024, ws + WS_WA, 1024, T_ / 256, 4);
      EpiGate<2> E{(const bf16_t*)(ws + R3), (const bf16_t*)(ws + R1), nullptr, (bf16_t*)(ws + R0), 1024};
      pg8::gemm_phase(lds, S, E, 1024, 1024, 1024); }
    xcd_barrier(xbar);
    REPS(11) if (PH(11)) { pg8::PlainSched S; S.set(ws + R0, 1024, ws + WS_WOUT, 1024, T_ / 256, 4);
      EpiResid<true> E{p.in[0], p.out, (bf16_t*)(ws + WS_X1B), (float*)(ws + WS_SS1)};
      pg8::gemm_phase(lds, S, E, 1024, 1024, 1024); }
    xcd_barrier(xbar);
    for (int half = 0; half < 2; ++half) {
        REPS(12) if (PH(12)) { pg8::PlainSched S; S.set(ws + WS_X1B + (size_t)half * 16384 * 1024 * 2, 1024, ws + WS_WUP, 1024, 64, F2_ / 256);
          EpiUp E{(const float*)(ws + WS_SS1), (bf16_t*)(ws + WS_UH), half * 16384};
          pg8::gemm_phase(lds, S, E, 1024, 1024, 1024); }
        xcd_barrier(xbar);
        REPS(13) if (PH(13)) phase_ffn_act(p, half);
        xcd_barrier(xbar);
    }
    REPS(14) if (PH(14)) { pg8::PlainSched S; S.set(ws + WS_ACT, F_, ws + WS_WDN, F_, T_ / 256, 4);
      EpiResid<false> E{p.out, (rep_ + 1 < 1 + (int)((REP_MASK >> 14) & 1u)) ? (float*)(ws + WS_UH) : p.out, nullptr, (float*)(ws + WS_SS2)};
      pg8::gemm_phase(lds, S, E, F_, F_, F_); }
    xcd_barrier(xbar);
    REPS(15) if (PH(15)) phase_final(p);
}

extern "C" void kernel_launch(void* const* d_in, const int* in_sizes, int n_in, void* d_out, int out_size, void* d_ws, size_t ws_size, hipStream_t stream) {
    static int grid_blocks = 0;
    if (!grid_blocks) {
        int dev = 0, cus = 0, per_cu = 0;
        (void)hipGetDevice(&dev);
        (void)hipDeviceGetAttribute(&cus, hipDeviceAttributeMultiprocessorCount, dev);
        (void)hipFuncSetAttribute((const void*)fwd_megakernel, hipFuncAttributeMaxDynamicSharedMemorySize, LDS_BYTES);
        (void)hipOccupancyMaxActiveBlocksPerMultiprocessor(&per_cu, (const void*)fwd_megakernel, 512, LDS_BYTES);
        if (per_cu < 1) { fprintf(stderr, "kernel_launch: occupancy query returned %d\n", per_cu); }
        grid_blocks = cus;
        if (n_in != 30 || out_size != T_ * D_ || ws_size < 512 * MiB) fprintf(stderr, "kernel_launch: unexpected sizes n_in=%d out=%d ws=%zu\n", n_in, out_size, ws_size);
    }
    Params p{};
    for (int i = 0; i < 30; ++i) p.in[i] = (const float*)d_in[i];
    p.out = (float*)d_out; p.ws = (unsigned char*)d_ws;
    void* args[] = {&p};
    hipError_t e = hipLaunchCooperativeKernel((void*)fwd_megakernel, dim3(grid_blocks), dim3(512), args, LDS_BYTES, stream);
    if (e != hipSuccess) fprintf(stderr, "cooperative launch failed: %s (grid %d)\n", hipGetErrorString(e), grid_blocks);
}
```

```cpp
#include <hip/hip_runtime.h>
#include <hip/hip_cooperative_groups.h>
#include <cstdio>
#include <cstdint>
namespace cg = cooperative_groups;

#define LAS __attribute__((address_space(3)))
typedef unsigned short bf16_t;
typedef short bf16x8 __attribute__((ext_vector_type(8)));
typedef float f32x4 __attribute__((ext_vector_type(4)));
typedef float f32x2 __attribute__((ext_vector_type(2)));
typedef unsigned u32x4 __attribute__((ext_vector_type(4)));
typedef unsigned u32x2 __attribute__((ext_vector_type(2)));

constexpr int T_ = 32768, D_ = 1024, SEQ_ = 4096, NB_ = 8;
constexpr int NH_ = 4, DH_ = 256, NCH_ = 64;
constexpr int SW_ = 512, SG_ = 32, SP_ = 64;
constexpr int F_ = 2816, F2_ = 5632, NIN_ = 4616, NP1_ = 4608;
constexpr float EPS_ = 1e-6f;

constexpr size_t MiB = 1ull << 20, KiB = 1024;
constexpr size_t WS_WIN = 0, WS_WQK = 9 * MiB, WS_WV = 10 * MiB, WS_WGLU = 10 * MiB + 512 * KiB, WS_WA = 11 * MiB, WS_WB = 13 * MiB, WS_WOUT = 14 * MiB,
                 WS_WUP = 16 * MiB, WS_WDN = 27 * MiB;
constexpr size_t WS_S5A = 33 * MiB, WS_S5BT = WS_S5A + 32 * KiB, WS_S5CT = WS_S5A + 192 * KiB;
constexpr size_t WS_RINV1 = 34 * MiB, WS_IG = 34 * MiB + 512 * KiB, WS_FG = 35 * MiB, WS_BIASP = 35 * MiB + 512 * KiB;
constexpr size_t WS_GS = 50 * MiB;
constexpr size_t WS_BAR = 49 * MiB;
constexpr size_t WS_SS1 = 36 * MiB, WS_SS2 = 38 * MiB, WS_E = 40 * MiB;
constexpr size_t R0 = 56 * MiB, R1 = 120 * MiB, R2 = 184 * MiB, R3 = 248 * MiB, R4 = 312 * MiB, R5 = 376 * MiB, R6 = 408 * MiB, R7 = 472 * MiB;
constexpr size_t WS_X1B = 448 * MiB, WS_UH = 56 * MiB, WS_ACT = 232 * MiB;
constexpr int LDS_BYTES = 147456;

struct Params {
    const float* in[30];
    float* out;
    unsigned char* ws;
};

__device__ __forceinline__ unsigned cvt_pk_bf16(float lo, float hi) { unsigned r; asm volatile("v_cvt_pk_bf16_f32 %0, %1, %2" : "=v"(r) : "v"(lo), "v"(hi)); return r; }
__device__ __forceinline__ bf16_t f2bf(float x) { return (bf16_t)(cvt_pk_bf16(x, x) & 0xffffu); }
__device__ __forceinline__ float bf2f(unsigned short u) { return __uint_as_float(((unsigned)u) << 16); }
__device__ __forceinline__ float bflo(unsigned w) { return __uint_as_float(w << 16); }
__device__ __forceinline__ float bfhi(unsigned w) { return __uint_as_float(w & 0xffff0000u); }
__device__ __forceinline__ float sigmoidf_(float x) { return __builtin_amdgcn_rcpf(1.0f + __expf(-x)); }
__device__ __forceinline__ float siluf_(float x) { return x * sigmoidf_(x); }
__device__ __forceinline__ int fresh_tid() { int t = threadIdx.x; asm volatile("" : "+v"(t)); return t; }
__device__ __forceinline__ float wave_sum(float v) {
#pragma unroll
    for (int o = 1; o < 64; o <<= 1) v += __shfl_xor(v, o);
    return v;
}
__device__ __forceinline__ void unpack8(const u32x4 w, float (&f)[8]) {
    f[0] = bflo(w.x); f[1] = bfhi(w.x); f[2] = bflo(w.y); f[3] = bfhi(w.y); f[4] = bflo(w.z); f[5] = bfhi(w.z); f[6] = bflo(w.w); f[7] = bfhi(w.w);
}
__device__ __forceinline__ u32x4 pack8(const float (&f)[8]) {
    u32x4 w; w.x = cvt_pk_bf16(f[0], f[1]); w.y = cvt_pk_bf16(f[2], f[3]); w.z = cvt_pk_bf16(f[4], f[5]); w.w = cvt_pk_bf16(f[6], f[7]); return w;
}


#define XB_TMO      128
#define XB_XCNT(j)  (256  + 64 * (j))
#define XB_XSUB(j)  (1280 + 64 * (j))
#define XB_XGEN(j)  (2304 + 64 * (j))
#define XB_TOP      3328
#define XB_TOPGEN   3392
#define XCD_BAR_WORDS 3456
#define XB_SPIN_CAP (1u << 18)
__device__ __forceinline__ unsigned xb_ld(unsigned* p)              { return __hip_atomic_load(p, __ATOMIC_RELAXED, __HIP_MEMORY_SCOPE_AGENT); }
__device__ __forceinline__ unsigned xb_add(unsigned* p, unsigned v) { return __hip_atomic_fetch_add(p, v, __ATOMIC_RELAXED, __HIP_MEMORY_SCOPE_AGENT); }
__device__ __forceinline__ unsigned xb_xcc_id() { return (unsigned)__builtin_amdgcn_s_getreg((3 << 11) | 20) & 0xFu; }
#define XB_SPIN(cond, bar) do { unsigned _sp = 0; while (cond) { __builtin_amdgcn_s_sleep(1); \
    if ((++_sp & 255u) == 0u) { if (xb_ld(&(bar)[XB_TMO])) break; if (_sp > XB_SPIN_CAP) { atomicAdd(&(bar)[XB_TMO], 1u); break; } } } } while (0)
struct XcdBarrier { unsigned* bar; unsigned x; volatile LAS unsigned* st; };
__device__ __forceinline__ XcdBarrier xcd_barrier_post(unsigned* bar, volatile LAS unsigned* st) {
    XcdBarrier b; b.bar = bar; b.x = xb_xcc_id(); b.st = st;
    if (threadIdx.x == 0) (void)xb_add(&bar[XB_XCNT(b.x)], 1u);
    return b;
}
__device__ __forceinline__ void xcd_barrier_complete(unsigned* bar, unsigned x, unsigned& nloc, unsigned& nx) {
    const unsigned G = gridDim.x * gridDim.y * gridDim.z;
    unsigned sum, cnt, mine, sp = 0u;
    for (;;) {
        sum = 0u; cnt = 0u; mine = 0u;
#pragma unroll
        for (unsigned j = 0; j < 16; ++j) { const unsigned c = xb_ld(&bar[XB_XCNT(j)]); sum += c; cnt += (c > 0u) ? 1u : 0u; mine = (j == x) ? c : mine; }
        if (sum == G) break;
        __builtin_amdgcn_s_sleep(1);
        if ((++sp & 255u) == 0u) { if (xb_ld(&bar[XB_TMO])) break; if (sp > XB_SPIN_CAP) { atomicAdd(&bar[XB_TMO], 1u); break; } }
    }
    nloc = mine > 0u ? mine : 1u; nx = cnt > 0u ? cnt : 1u;
}
__device__ __forceinline__ void xcd_barrier(const XcdBarrier& b) {
    asm volatile("s_waitcnt vmcnt(0)" ::: "memory");
    __syncthreads();
    if (threadIdx.x == 0) {
        unsigned* bar = b.bar;
        __builtin_amdgcn_s_waitcnt(0);
        unsigned nloc = b.st[0], nx = b.st[1];
        if (nloc == 0u) { xcd_barrier_complete(bar, b.x, nloc, nx); b.st[0] = nloc; b.st[1] = nx; }
        const unsigned old = xb_add(&bar[XB_XSUB(b.x)], 1u);
        const unsigned gen = old / nloc;
        if (old + 1u == (gen + 1u) * nloc) {
            __builtin_amdgcn_fence(__ATOMIC_RELEASE, "agent");
            asm volatile("s_waitcnt vmcnt(0)" ::: "memory");
            const unsigned og = xb_add(&bar[XB_TOP], 1u);
            const unsigned tg = og / nx;
            if (og + 1u == (tg + 1u) * nx) xb_add(&bar[XB_TOPGEN], 1u);
            else XB_SPIN(xb_ld(&bar[XB_TOPGEN]) == tg, bar);
            __builtin_amdgcn_fence(__ATOMIC_ACQUIRE, "agent");
            xb_add(&bar[XB_XGEN(b.x)], 1u);
            asm volatile("s_waitcnt vmcnt(0)" ::: "memory");
        } else {
            XB_SPIN(xb_ld(&bar[XB_XGEN(b.x)]) == gen, bar);
            __builtin_amdgcn_fence(__ATOMIC_ACQUIRE, "agent");
            asm volatile("s_waitcnt vmcnt(0)" ::: "memory");
        }
    }
    __syncthreads();
}

namespace pg8 {
constexpr int BM = 256, BK = 64, HALF = 128, HTB = HALF * BK * 2, STAGE_BYTES = 8 * HTB, NXCD = 8, WGM = 8;
__device__ __forceinline__ int lds_byte(int r, int c) { const int st = (r >> 4) * 2 + (c >> 5), rr = r & 15, cc = c & 31, ob = rr * 64 + cc * 2; return st * 1024 + (ob ^ (((ob >> 9) & 1) << 5)); }
__device__ __forceinline__ void stage_rc(int b, int& R, int& C) { const int st = b / 1024, sb = b % 1024, swz = sb ^ (((sb >> 9) & 1) << 5); R = (st >> 1) * 16 + swz / 64; C = (st & 1) * 32 + (swz % 64) / 2; }
__device__ __forceinline__ int perm32(int rho) { const int n = rho >> 4, i = rho & 15; return 8 * (i >> 2) + 4 * n + (i & 3); }
struct Unit { int pm, pn; };
struct Order {
    int nM, nN, nwg, G, c;
    __device__ __forceinline__ void init(int nM_, int nN_, int G_, int c_) { nM = nM_; nN = nN_; nwg = nM * nN; G = G_; c = c_; }
    __device__ __forceinline__ bool next(int i, Unit& u) const {
        const long L = (long)i * G + c; if (L >= nwg) return false;
        int wgid = (int)L; { const int q = nwg / NXCD, r = nwg % NXCD, xcd = wgid % NXCD, off = wgid / NXCD; wgid = (xcd < r ? xcd * (q + 1) : r * (q + 1) + (xcd - r) * q) + off; }
        const int nig = WGM * nN, gid = wgid / nig, fm = gid * WGM, gsz = (nM - fm) < WGM ? (nM - fm) : WGM;
        u.pm = fm + ((wgid % nig) % gsz); u.pn = (wgid % nig) / gsz; return true;
    }
};
template <class Epi, class Sched>
__device__ __forceinline__ void gemm_phase(LAS unsigned char* lds, const Sched& S, const Epi& E, const int K, const int lda, const int ldb) {
    const int tid = fresh_tid(), wid = __builtin_amdgcn_readfirstlane(tid >> 6), lane = tid & 63, wr = wid >> 2, wc = wid & 3, fr = lane & 15, fq = lane >> 4;
    const int nt = K / BK;
    unsigned voffA[2], voffB[2];
#pragma unroll
    for (int i = 0; i < 2; ++i) { int R, C; stage_rc(tid * 16 + i * 8192, R, C); const int Rb = Epi::PERM ? ((R & ~31) + perm32(R & 31)) : R;
        voffA[i] = (unsigned)(R * lda + C) * 2u; voffB[i] = (unsigned)(Rb * ldb + C) * 2u; }
    const size_t kstep = (size_t)(BK * 2);
    const size_t hstepA = (size_t)HALF * lda * 2, hstepB = (size_t)HALF * ldb * 2;
    const unsigned ldsw = (unsigned)wid * 1024u;
    const int aoff = lds_byte(wr * 64 + fr, fq * 8), boff = lds_byte(wc * 32 + fr, fq * 8);
#define PG8_SA(b, h) (((b) * 2 + (h)) * HTB)
#define PG8_SB(b, h) ((4 + (b) * 2 + (h)) * HTB)
#define PG8_STAGE(bufoff, gbase, voff) do { _Pragma("unroll") for (int _i = 0; _i < 2; ++_i) \
        __builtin_amdgcn_global_load_lds((const unsigned*)((const char*)(gbase) + (voff)[_i]), (LAS unsigned*)(lds + (bufoff) + ldsw + _i * 8192), 16, 0, 0); } while (0)
#define PG8_LDA(dst, b, h) do { _Pragma("unroll") for (int m = 0; m < 4; ++m) _Pragma("unroll") for (int k = 0; k < 2; ++k) dst[m][k] = *(const LAS bf16x8*)(lds + PG8_SA(b, h) + aoff + m * 2048 + k * 1024); } while (0)
#define PG8_LDB(dst, b, h) do { _Pragma("unroll") for (int n = 0; n < 2; ++n) _Pragma("unroll") for (int k = 0; k < 2; ++k) dst[n][k] = *(const LAS bf16x8*)(lds + PG8_SB(b, h) + boff + n * 2048 + k * 1024); } while (0)
#define PG8_MMA(ai, bj, At, Bt) do { __builtin_amdgcn_s_setprio(1); _Pragma("unroll") for (int m = 0; m < 4; ++m) _Pragma("unroll") for (int n = 0; n < 2; ++n) _Pragma("unroll") for (int k = 0; k < 2; ++k) \
        acc[ai][bj][m][n] = __builtin_amdgcn_mfma_f32_16x16x32_bf16(Bt[n][k], At[m][k], acc[ai][bj][m][n], 0, 0, 0); __builtin_amdgcn_s_setprio(0); } while (0)
#define PG8_WAIT_V(n) asm volatile("s_waitcnt vmcnt(" #n ")" ::: "memory")
#define PG8_WAIT_L(n) asm volatile("s_waitcnt lgkmcnt(" #n ")" ::: "memory")
#define PG8_BAR __builtin_amdgcn_s_barrier()
#define PG8_SCHED __builtin_amdgcn_sched_barrier(0)
    Unit cur, nxt; int ui = 0;
    if (!S.next(0, cur)) return;
    f32x4 acc[2][2][4][2];
#pragma unroll
    for (int a = 0; a < 2; ++a)
#pragma unroll
        for (int b = 0; b < 2; ++b)
#pragma unroll
            for (int m = 0; m < 4; ++m)
#pragma unroll
                for (int n = 0; n < 2; ++n) acc[a][b][m][n] = (f32x4){0.f, 0.f, 0.f, 0.f};
    bf16x8 At[4][2], B0[2][2], B1[2][2];
    const char* cA = S.aptr(cur); const char* cB = S.bptr(cur);
    PG8_STAGE(PG8_SB(0, 0), cB, voffB); PG8_STAGE(PG8_SB(0, 1), cB + hstepB, voffB); PG8_STAGE(PG8_SA(0, 0), cA, voffA); PG8_STAGE(PG8_SA(0, 1), cA + hstepA, voffA);
    if (wr == 1) PG8_BAR;
    PG8_WAIT_V(2); PG8_BAR;
    PG8_STAGE(PG8_SB(1, 0), cB + kstep, voffB); PG8_STAGE(PG8_SA(1, 0), cA + kstep, voffA); PG8_STAGE(PG8_SB(1, 1), cB + hstepB + kstep, voffB);
    PG8_WAIT_V(6); PG8_BAR;
    for (;;) {
        const bool has_next = S.next(ui + 1, nxt);
        const char* nA = has_next ? S.aptr(nxt) : cA; const char* nB = has_next ? S.bptr(nxt) : cB;
#pragma unroll 1
        for (int t = 0; t < nt; t += 2) {
            const bool last = (t == nt - 2);
            const char* a1 = cA + (size_t)(t + 1) * kstep;
            const char* a2 = last ? nA : cA + (size_t)(t + 2) * kstep; const char* b2 = last ? nB : cB + (size_t)(t + 2) * kstep;
            const char* a3 = a2 + kstep; const char* b3 = b2 + kstep;
            PG8_LDB(B0, 0, 0); PG8_LDB(B1, 0, 1); PG8_SCHED; PG8_LDA(At, 0, 0); PG8_STAGE(PG8_SA(1, 1), a1 + hstepA, voffA);
            PG8_WAIT_V(8); PG8_WAIT_L(0); PG8_BAR; PG8_MMA(0, 0, At, B0); PG8_MMA(0, 1, At, B1); PG8_BAR; PG8_SCHED;
            PG8_LDA(At, 0, 1); PG8_STAGE(PG8_SB(0, 0), b2, voffB); PG8_STAGE(PG8_SB(0, 1), b2 + hstepB, voffB); PG8_STAGE(PG8_SA(0, 0), a2, voffA);
            PG8_WAIT_V(8); PG8_WAIT_L(0); PG8_BAR; PG8_MMA(1, 0, At, B0); PG8_MMA(1, 1, At, B1); PG8_BAR; PG8_SCHED;
            PG8_LDB(B0, 1, 0); PG8_LDB(B1, 1, 1); PG8_SCHED; PG8_LDA(At, 1, 0); PG8_STAGE(PG8_SA(0, 1), a2 + hstepA, voffA);
            PG8_WAIT_V(8); PG8_WAIT_L(0); PG8_BAR; PG8_MMA(0, 0, At, B0); PG8_MMA(0, 1, At, B1); PG8_BAR; PG8_SCHED;
            PG8_LDA(At, 1, 1); PG8_STAGE(PG8_SB(1, 0), b3, voffB); PG8_STAGE(PG8_SB(1, 1), b3 + hstepB, voffB); PG8_STAGE(PG8_SA(1, 0), a3, voffA);
            PG8_WAIT_V(8); PG8_WAIT_L(0); PG8_BAR; PG8_MMA(1, 0, At, B0); PG8_MMA(1, 1, At, B1); PG8_BAR; PG8_SCHED;
        }
        if (wr == 0) PG8_BAR;
        E(acc, cur, wr, wc, fr, fq);
        if (!has_next) break;
#pragma unroll
        for (int a = 0; a < 2; ++a)
#pragma unroll
            for (int b = 0; b < 2; ++b)
#pragma unroll
                for (int m = 0; m < 4; ++m)
#pragma unroll
                    for (int n = 0; n < 2; ++n) acc[a][b][m][n] = (f32x4){0.f, 0.f, 0.f, 0.f};
        cur = nxt; cA = nA; cB = nB; ++ui;
        if (wr == 1) PG8_BAR;
    }
    PG8_WAIT_V(0);
    PG8_BAR;
#undef PG8_SA
#undef PG8_SB
#undef PG8_STAGE
#undef PG8_LDA
#undef PG8_LDB
#undef PG8_MMA
#undef PG8_WAIT_V
#undef PG8_WAIT_L
#undef PG8_BAR
#undef PG8_SCHED
}
struct PlainSched : Order {
    const char* A; const char* B; size_t astep, bstep;
    __device__ __forceinline__ void set(const void* A_, int lda, const void* B_, int ldb, int nM_, int nN_) { A = (const char*)A_; B = (const char*)B_; astep = (size_t)BM * lda * 2; bstep = (size_t)BM * ldb * 2; init(nM_, nN_, gridDim.x, blockIdx.x); }
    __device__ __forceinline__ const char* aptr(const Unit& u) const { return A + (size_t)u.pm * astep; }
    __device__ __forceinline__ const char* bptr(const Unit& u) const { return B + (size_t)u.pn * bstep; }
};
}
using pg8::Unit;
typedef const f32x4 (&AccRef)[2][2][4][2];

struct EpiProj {
    static constexpr bool PERM = true;
    const float* rinv; const float* bias; bf16_t *xm, *som, *us, *sga, *sgb;
    __device__ __forceinline__ void operator()(AccRef acc, const Unit& u, int wr, int wc, int fr, int fq) const {
        const int pn = u.pn; bf16_t* base; int ldc, colt; bool sig;
        if (pn < 4) { base = xm; ldc = 1024; colt = pn * 256; sig = false; }
        else if (pn < 8) { base = som; ldc = 1024; colt = (pn - 4) * 256; sig = true; }
        else if (pn < 10) { base = us; ldc = 512; colt = (pn - 8) * 256; sig = false; }
        else if (pn < 14) { base = sga; ldc = 1024; colt = (pn - 10) * 256; sig = true; }
        else { base = sgb; ldc = 1024; colt = (pn - 14) * 256; sig = true; }
        const int row0 = u.pm * 256 + wr * 64 + fr, col0 = colt + wc * 32 + 8 * fq, bcol0 = pn * 256 + wc * 32 + 8 * fq;
        f32x4 bv[2][2];
#pragma unroll
        for (int bj = 0; bj < 2; ++bj)
#pragma unroll
            for (int n = 0; n < 2; ++n) bv[bj][n] = *(const f32x4*)(bias + bcol0 + bj * 128 + 4 * n);
#pragma unroll
        for (int ai = 0; ai < 2; ++ai)
#pragma unroll
            for (int m = 0; m < 4; ++m) { const int row = row0 + ai * 128 + m * 16; const float ri = rinv[row]; bf16_t* rowp = base + (size_t)row * ldc + col0;
#pragma unroll
                for (int bj = 0; bj < 2; ++bj) { f32x4 v0 = acc[ai][bj][m][0] * ri + bv[bj][0], v1 = acc[ai][bj][m][1] * ri + bv[bj][1];
                    if (sig) {
#pragma unroll
                        for (int j = 0; j < 4; ++j) { v0[j] = sigmoidf_(v0[j]); v1[j] = sigmoidf_(v1[j]); } }
                    u32x4 w; w.x = cvt_pk_bf16(v0[0], v0[1]); w.y = cvt_pk_bf16(v0[2], v0[3]); w.z = cvt_pk_bf16(v1[0], v1[1]); w.w = cvt_pk_bf16(v1[2], v1[3]);
                    *(u32x4*)(rowp + bj * 128) = w; } }
    }
};
struct EpiQKV {
    static constexpr bool PERM = true;
    bf16_t *qk, *v;
    __device__ __forceinline__ void operator()(AccRef acc, const Unit& u, int wr, int wc, int fr, int fq) const {
        const int head = u.pn & 3, kind = u.pn >> 2; bf16_t* base = (kind < 2) ? qk + (size_t)kind * T_ * 1024 : v;
        const int row0 = u.pm * 256 + wr * 64 + fr, col0 = head * 256 + wc * 32 + 8 * fq;
#pragma unroll
        for (int ai = 0; ai < 2; ++ai)
#pragma unroll
            for (int m = 0; m < 4; ++m) { bf16_t* rowp = base + (size_t)(row0 + ai * 128 + m * 16) * 1024 + col0;
#pragma unroll
                for (int bj = 0; bj < 2; ++bj) { const f32x4 v0 = acc[ai][bj][m][0], v1 = acc[ai][bj][m][1];
                    u32x4 w; w.x = cvt_pk_bf16(v0[0], v0[1]); w.y = cvt_pk_bf16(v0[2], v0[3]); w.z = cvt_pk_bf16(v1[0], v1[1]); w.w = cvt_pk_bf16(v1[2], v1[3]);
                    *(u32x4*)(rowp + bj * 128) = w; } }
    }
};
template <int MODE> struct EpiGate {
    static constexpr bool PERM = true;
    const bf16_t* X; const bf16_t* Y; const float* bias; bf16_t* O; int ldc;
    __device__ __forceinline__ void operator()(AccRef acc, const Unit& u, int wr, int wc, int fr, int fq) const {
        const int row0 = u.pm * 256 + wr * 64 + fr, col0 = u.pn * 256 + wc * 32 + 8 * fq;
        f32x4 bv[2][2];
#pragma unroll
        for (int bj = 0; bj < 2; ++bj)
#pragma unroll
            for (int n = 0; n < 2; ++n) bv[bj][n] = (MODE == 0) ? *(const f32x4*)(bias + col0 + bj * 128 + 4 * n) : (f32x4){0.f, 0.f, 0.f, 0.f};
#pragma unroll
        for (int ai = 0; ai < 2; ++ai)
#pragma unroll
            for (int m = 0; m < 4; ++m) { const size_t off = (size_t)(row0 + ai * 128 + m * 16) * ldc + col0;
#pragma unroll
                for (int bj = 0; bj < 2; ++bj) {
                    float xv[8], a[8], o[8]; unpack8(*(const u32x4*)(X + off + bj * 128), xv);
#pragma unroll
                    for (int j = 0; j < 4; ++j) { a[j] = acc[ai][bj][m][0][j] + bv[bj][0][j]; a[4 + j] = acc[ai][bj][m][1][j] + bv[bj][1][j]; }
                    if (MODE == 0) {
#pragma unroll
                        for (int j = 0; j < 8; ++j) o[j] = xv[j] * sigmoidf_(a[j]); }
                    else if (MODE == 1) {
#pragma unroll
                        for (int j = 0; j < 8; ++j) o[j] = xv[j] * a[j]; }
                    else { float yv[8]; unpack8(*(const u32x4*)(Y + off + bj * 128), yv);
#pragma unroll
                        for (int j = 0; j < 8; ++j) o[j] = xv[j] * a[j] + yv[j]; }
                    *(u32x4*)(O + off + bj * 128) = pack8(o); } }
    }
};
template <bool WB> struct EpiResid {
    static constexpr bool PERM = false;
    const float* Rs; float* Of; bf16_t* Ob; float* ss;
    __device__ __forceinline__ void operator()(AccRef acc, const Unit& u, int wr, int wc, int fr, int fq) const {
        const int row0 = u.pm * 256 + wr * 64 + fr, col0 = u.pn * 256 + wc * 32 + 4 * fq;
#pragma unroll
        for (int ai = 0; ai < 2; ++ai)
#pragma unroll
            for (int m = 0; m < 4; ++m) { const int row = row0 + ai * 128 + m * 16; const size_t off = (size_t)row * 1024 + col0; float s = 0.f;
#pragma unroll
                for (int bj = 0; bj < 2; ++bj)
#pragma unroll
                    for (int n = 0; n < 2; ++n) { const size_t o2 = off + bj * 128 + n * 16; const f32x4 r = *(const f32x4*)(Rs + o2); const f32x4 v = r + acc[ai][bj][m][n];
                        *(f32x4*)(Of + o2) = v; s += (v[0] * v[0] + v[1] * v[1]) + (v[2] * v[2] + v[3] * v[3]);
                        if (WB) { u32x2 w; w.x = cvt_pk_bf16(v[0], v[1]); w.y = cvt_pk_bf16(v[2], v[3]); *(u32x2*)(Ob + o2) = w; } }
                s += __shfl_xor(s, 16); s += __shfl_xor(s, 32);
                if (fq == 0) ss[(size_t)row * 16 + u.pn * 4 + wc] = s; }
    }
};
struct EpiUp {
    static constexpr bool PERM = true;
    const float* ss; bf16_t* U; int row_off;
    __device__ __forceinline__ void operator()(AccRef acc, const Unit& u, int wr, int wc, int fr, int fq) const {
        const int row0 = u.pm * 256 + wr * 64 + fr, col0 = u.pn * 256 + wc * 32 + 8 * fq;
#pragma unroll
        for (int ai = 0; ai < 2; ++ai)
#pragma unroll
            for (int m = 0; m < 4; ++m) { const int row = row0 + ai * 128 + m * 16; const f32x4* sp = (const f32x4*)(ss + (size_t)(row + row_off) * 16);
                const f32x4 s0 = sp[0], s1 = sp[1], s2 = sp[2], s3 = sp[3]; const f32x4 st = (s0 + s1) + (s2 + s3);
                const float ri = rsqrtf(((st[0] + st[1]) + (st[2] + st[3])) * (1.0f / 1024.0f) + EPS_);
                bf16_t* rowp = U + (size_t)row * F2_ + col0;
#pragma unroll
                for (int bj = 0; bj < 2; ++bj) { const f32x4 v0 = acc[ai][bj][m][0] * ri, v1 = acc[ai][bj][m][1] * ri;
                    u32x4 w; w.x = cvt_pk_bf16(v0[0], v0[1]); w.y = cvt_pk_bf16(v0[2], v0[3]); w.z = cvt_pk_bf16(v1[0], v1[1]); w.w = cvt_pk_bf16(v1[2], v1[3]);
                    *(u32x4*)(rowp + bj * 128) = w; } }
    }
};
struct SchedQKV : pg8::Order {
    const char *xc, *xm, *wqk, *wv;
    __device__ __forceinline__ const char* aptr(const Unit& u) const { const int head = u.pn & 3, kind = u.pn >> 2; return (kind < 2 ? xc : xm) + ((size_t)u.pm * 256 * 1024 + head * 256) * 2; }
    __device__ __forceinline__ const char* bptr(const Unit& u) const { const int head = u.pn & 3, kind = u.pn >> 2; return kind < 2 ? wqk + ((size_t)(head * 512 + kind * 256) * 256) * 2 : wv + ((size_t)head * 65536) * 2; }
};

__device__ __forceinline__ void transpose_item(const float* W, int ldw, int c0, const float* kscale, float scale, bf16_t* WT, int ldt, int row_off, LAS float* scr, int kb, int nb, int lane) {
    const int k0 = 64 * kb, n0 = 32 * nb;
#pragma unroll 8
    for (int i = 0; i < 32; ++i) { const int kk = 2 * i + (lane >> 5); float v = W[(size_t)(k0 + kk) * ldw + c0 + n0 + (lane & 31)] * scale; if (kscale) v *= kscale[k0 + kk]; scr[kk * 33 + (lane & 31)] = v; }
    asm volatile("s_waitcnt lgkmcnt(0)" ::: "memory");
    const int c = lane & 7;
#pragma unroll
    for (int j = 0; j < 4; ++j) { const int n = (lane >> 3) + 8 * j; const LAS float* s = scr + (8 * c) * 33 + n;
        u32x4 o; o.x = cvt_pk_bf16(s[0 * 33], s[1 * 33]); o.y = cvt_pk_bf16(s[2 * 33], s[3 * 33]); o.z = cvt_pk_bf16(s[4 * 33], s[5 * 33]); o.w = cvt_pk_bf16(s[6 * 33], s[7 * 33]);
        *(u32x4*)(WT + (size_t)(row_off + n0 + n) * ldt + k0 + 8 * c) = o; }
    asm volatile("s_waitcnt lgkmcnt(0)" ::: "memory");
}

__device__ __forceinline__ void phase0(const Params& p, LAS unsigned char* lds) {
    const int tid = fresh_tid(), lane = tid & 63, wave = tid >> 6;
    const int gw = blockIdx.x * 8 + wave, NGW = gridDim.x * 8;
    unsigned char* ws = p.ws;
    LAS float* scr = (LAS float*)(lds + wave * 8448);
    LAS float* gwt = (LAS float*)(lds + 8 * 8448);
    { const float* g1 = p.in[1]; const float* w_in = p.in[2];
      for (int i = tid; i < 8192; i += 512) { const int j = i & 7, k = i >> 3; gwt[j * 1024 + k] = g1[k] * w_in[(size_t)k * NIN_ + 2048 + j]; } }
    {
        const int nmat = 20;
        int base = 0;
        for (int mi = 0; mi < nmat; ++mi) {
            const float* W; int ldw, c0, ncols, K; const float* ks = nullptr; float sc = 1.f; bf16_t* WT; int ldt, roff = 0;
            if (mi == 0) { W = p.in[2]; ldw = NIN_; c0 = 0; ncols = 2048; K = 1024; ks = p.in[1]; WT = (bf16_t*)(ws + WS_WIN); ldt = 1024; roff = 0; }
            else if (mi == 1) { W = p.in[2]; ldw = NIN_; c0 = 2056; ncols = 2560; K = 1024; ks = p.in[1]; WT = (bf16_t*)(ws + WS_WIN); ldt = 1024; roff = 2048; }
            else if (mi < 6) { const int h = mi - 2; W = p.in[6] + h * 65536; ldw = 256; c0 = 0; ncols = 256; K = 256; WT = (bf16_t*)(ws + WS_WQK) + h * 512 * 256; ldt = 256; roff = 0; }
            else if (mi < 10) { const int h = mi - 6; W = p.in[7] + h * 65536; ldw = 256; c0 = 0; ncols = 256; K = 256; sc = 0.0625f; WT = (bf16_t*)(ws + WS_WQK) + h * 512 * 256; ldt = 256; roff = 256; }
            else if (mi < 14) { const int h = mi - 10; W = p.in[8] + h * 65536; ldw = 256; c0 = 0; ncols = 256; K = 256; WT = (bf16_t*)(ws + WS_WV) + h * 65536; ldt = 256; roff = 0; }
            else if (mi == 14) { W = p.in[19]; ldw = 512; c0 = 0; ncols = 512; K = 512; WT = (bf16_t*)(ws + WS_WGLU); ldt = 512; }
            else if (mi == 15) { W = p.in[21]; ldw = 1024; c0 = 0; ncols = 1024; K = 1024; WT = (bf16_t*)(ws + WS_WA); ldt = 1024; }
            else if (mi == 16) { W = p.in[22]; ldw = 1024; c0 = 0; ncols = 1024; K = 512; WT = (bf16_t*)(ws + WS_WB); ldt = 512; }
            else if (mi == 17) { W = p.in[23]; ldw = 1024; c0 = 0; ncols = 1024; K = 1024; WT = (bf16_t*)(ws + WS_WOUT); ldt = 1024; }
            else if (mi == 18) { W = p.in[25]; ldw = F2_; c0 = 0; ncols = F2_; K = 1024; ks = p.in[24]; WT = (bf16_t*)(ws + WS_WUP); ldt = 1024; }
            else { W = p.in[28]; ldw = 1024; c0 = 0; ncols = 1024; K = F_; WT = (bf16_t*)(ws + WS_WDN); ldt = F_; }
            const int nblk = ncols / 32, nit = (K / 64) * nblk;
            int it = gw - (base % NGW); if (it < 0) it += NGW;
            for (; it < nit; it += NGW) transpose_item(W, ldw, c0, ks, sc, WT, ldt, roff, scr, it / nblk, it % nblk, lane);
            base += nit;
        }
    }
    {
        const int gt = blockIdx.x * 512 + tid;
        if (gt < SG_ * SP_) {
            const int g = gt >> 6, pp = gt & 63;
            const float ar = p.in[11][gt], ai = p.in[12][gt], dt = expf(p.in[13][g]);
            const float mag = expf(dt * ar); float sn, cs; sincosf(dt * ai, &sn, &cs);
            const float abr = mag * cs, abi = mag * sn;
            const float den = ar * ar + ai * ai, xr = abr - 1.0f, xi = abi;
            const float rre = (xr * ar + xi * ai) / den, rim = (xi * ar - xr * ai) / den;
            float* A = (float*)(ws + WS_S5A); bf16_t* BbT = (bf16_t*)(ws + WS_S5BT);
            A[gt * 2] = abr; A[gt * 2 + 1] = abi;
            const float* bre = p.in[14] + (size_t)gt * 16; const float* bim = p.in[15] + (size_t)gt * 16;
            for (int c = 0; c < 16; ++c) { const float br = bre[c], bi = bim[c];
                BbT[((size_t)(g * 128 + pp)) * 16 + c] = f2bf(rre * br - rim * bi); BbT[((size_t)(g * 128 + 64 + pp)) * 16 + c] = f2bf(rre * bi + rim * br); }
        }
        bf16_t* CmT = (bf16_t*)(ws + WS_S5CT);
        for (int i = blockIdx.x * 512 + tid; i < SG_ * 16 * 128; i += gridDim.x * 512) { const int k = i & 127, gc = i >> 7;
            CmT[i] = f2bf(k < 64 ? p.in[16][(size_t)gc * 64 + k] : -p.in[17][(size_t)gc * 64 + k - 64]); }
    }
    {
        float* bp = (float*)(ws + WS_BIASP); const float* b_in = p.in[3];
        for (int i = blockIdx.x * 512 + tid; i < NP1_; i += gridDim.x * 512) bp[i] = b_in[i < 2048 ? i : i + 8];
    }
    __syncthreads();
    {
        const float* x = p.in[0]; const float* b_in = p.in[3];
        bf16_t* xb = (bf16_t*)(ws + R0); float* rinv1 = (float*)(ws + WS_RINV1); float* ig = (float*)(ws + WS_IG); float* fg = (float*)(ws + WS_FG);
        for (int row = gw; row < T_; row += NGW) {
            const f32x4* xr = (const f32x4*)(x + (size_t)row * 1024) + lane;
            f32x4 v[4]; float s = 0.f;
#pragma unroll
            for (int j = 0; j < 4; ++j) { v[j] = xr[64 * j]; s += (v[j][0] * v[j][0] + v[j][1] * v[j][1]) + (v[j][2] * v[j][2] + v[j][3] * v[j][3]); }
            float d[8];
#pragma unroll
            for (int g = 0; g < 8; ++g) { float a = 0.f;
#pragma unroll
                for (int j = 0; j < 4; ++j) { const f32x4 w = *(const LAS f32x4*)(gwt + g * 1024 + 256 * j + 4 * lane); a += (v[j][0] * w[0] + v[j][1] * w[1]) + (v[j][2] * w[2] + v[j][3] * w[3]); }
                d[g] = a; }
            s = wave_sum(s);
#pragma unroll
            for (int g = 0; g < 8; ++g) d[g] = wave_sum(d[g]);
            const float ri = rsqrtf(s * (1.0f / 1024.0f) + EPS_);
            u32x2* o8 = (u32x2*)(xb + (size_t)row * 1024) + lane;
#pragma unroll
            for (int j = 0; j < 4; ++j) { u32x2 w; w.x = cvt_pk_bf16(v[j][0], v[j][1]); w.y = cvt_pk_bf16(v[j][2], v[j][3]); o8[64 * j] = w; }
            if (lane == 0) rinv1[row] = ri;
            if (lane < 8) { float val = d[0];
#pragma unroll
                for (int g = 1; g < 8; ++g) val = (lane == g) ? d[g] : val;
                val = val * ri + b_in[2048 + lane];
                if (lane < 4) ig[(size_t)row * 4 + lane] = val; else fg[(size_t)row * 4 + lane - 4] = val; }
        }
    }
}

__device__ __forceinline__ void phase_conv_m(const Params& p) {
    const bf16_t* xm = (const bf16_t*)(p.ws + R1); bf16_t* xc = (bf16_t*)(p.ws + R0);
    const float* cw = p.in[4]; const float* cb = p.in[5];
    const int total = (T_ / 16) * 128;
    for (int idx = blockIdx.x * 512 + fresh_tid(); idx < total; idx += gridDim.x * 512) {
        const int cgi = idx & 127, tb = idx >> 7, c0 = cgi * 8, t0 = tb * 16;
        float w[4][8], b[8];
#pragma unroll
        for (int k = 0; k < 4; ++k) { const f32x4 a = *(const f32x4*)(cw + k * 1024 + c0), bb = *(const f32x4*)(cw + k * 1024 + c0 + 4);
#pragma unroll
            for (int j = 0; j < 4; ++j) { w[k][j] = a[j]; w[k][4 + j] = bb[j]; } }
        { const f32x4 a = *(const f32x4*)(cb + c0), bb = *(const f32x4*)(cb + c0 + 4);
#pragma unroll
          for (int j = 0; j < 4; ++j) { b[j] = a[j]; b[4 + j] = bb[j]; } }
        float r0[8], r1[8], r2[8], r3[8];
        const bool head = (t0 & (SEQ_ - 1)) == 0;
        if (head) {
#pragma unroll
            for (int j = 0; j < 8; ++j) { r0[j] = 0.f; r1[j] = 0.f; r2[j] = 0.f; } }
        else { unpack8(*(const u32x4*)(xm + (size_t)(t0 - 3) * 1024 + c0), r0); unpack8(*(const u32x4*)(xm + (size_t)(t0 - 2) * 1024 + c0), r1); unpack8(*(const u32x4*)(xm + (size_t)(t0 - 1) * 1024 + c0), r2); }
#pragma unroll 4
        for (int i = 0; i < 16; ++i) {
            unpack8(*(const u32x4*)(xm + (size_t)(t0 + i) * 1024 + c0), r3);
            float o[8];
#pragma unroll
            for (int j = 0; j < 8; ++j) { const float y = b[j] + w[0][j] * r0[j] + w[1][j] * r1[j] + w[2][j] * r2[j] + w[3][j] * r3[j]; o[j] = siluf_(y); }
            *(u32x4*)(xc + (size_t)(t0 + i) * 1024 + c0) = pack8(o);
#pragma unroll
            for (int j = 0; j < 8; ++j) { r0[j] = r1[j]; r1[j] = r2[j]; r2[j] = r3[j]; }
        }
    }
}

__device__ __forceinline__ void phase_gates(const Params& p, LAS unsigned char* lds) {
    const int tid = fresh_tid(), lane = tid & 63, wave = __builtin_amdgcn_readfirstlane(tid >> 6);
    const float* IG = (const float*)(p.ws + WS_IG); const float* FG = (const float*)(p.ws + WS_FG); float* GS = (float*)(p.ws + WS_GS);
    LAS float* LB = (LAS float*)lds; LAS float* LC = LB + 64; LAS float* Lm = LB + 128;
    for (int item = blockIdx.x; item < 32; item += gridDim.x) {
        const int b = item >> 2, h = item & 3;
        float av[8], bv[8], pv[8];
#pragma unroll
        for (int cc = 0; cc < 8; ++cc) {
            const int ch = wave * 8 + cc; const size_t t = (size_t)b * SEQ_ + ch * 64 + lane;
            const float fgv = FG[t * 4 + h], li = IG[t * 4 + h];
            const float lf = fminf(fgv, 0.f) - log1pf(expf(-fabsf(fgv)));
            float bc = lf;
#pragma unroll
            for (int o = 1; o < 64; o <<= 1) { const float x = __shfl_up(bc, o); if (lane >= o) bc += x; }
            const float a = li - bc; float pm = a;
#pragma unroll
            for (int o = 1; o < 64; o <<= 1) { const float x = __shfl_up(pm, o); if (lane >= o) pm = fmaxf(pm, x); }
            av[cc] = a; bv[cc] = bc; pv[cc] = pm;
            if (lane == 63) { LB[ch] = bc; LC[ch] = bc + pm; }
        }
        __syncthreads();
        if (tid == 0) { float m = 0.f; for (int j = 0; j < 64; ++j) { Lm[j] = m; m = fmaxf(m + LB[j], LC[j]); } }
        __syncthreads();
#pragma unroll
        for (int cc = 0; cc < 8; ++cc) {
            const int ch = wave * 8 + cc; const float m = Lm[ch];
            const float Mq = fmaxf(m, pv[cc]); const float M63 = __shfl(Mq, 63);
            float* gs = GS + ((size_t)item * 64 + ch) * 384;
            gs[lane] = av[cc]; gs[64 + lane] = Mq; gs[128 + lane] = expf(m - Mq); gs[192 + lane] = expf(-(bv[cc] + Mq)); gs[256 + lane] = expf(av[cc] - M63);
            if (lane == 0) gs[320] = expf(m - M63);
        }
        __syncthreads();
    }
}

typedef short s16x4 __attribute__((ext_vector_type(4)));
__device__ __forceinline__ bf16x8 lds_tr_frag(const LAS bf16_t* p, int row_stride) {
    const s16x4 lo = __builtin_amdgcn_ds_read_tr16_b64_v4i16((LAS s16x4*)p);
    const s16x4 hi = __builtin_amdgcn_ds_read_tr16_b64_v4i16((LAS s16x4*)(p + 4 * row_stride));
    return (bf16x8){lo[0], lo[1], lo[2], lo[3], hi[0], hi[1], hi[2], hi[3]};
}
constexpr int ML_QN = 0, ML_KN = 33792, ML_VN = 67584, ML_VW = 74752, ML_SW = 81920, ML_CB = 91136, ML_DEN = 116480;
__device__ __forceinline__ void phase_mlstm(const Params& p, LAS unsigned char* lds) {
    const int tid = fresh_tid(), lane = tid & 63, w = __builtin_amdgcn_readfirstlane(tid >> 6), qi = w & 3, half = w >> 2, lr = lane & 15, lg = lane >> 4;
    const bf16_t* Q = (const bf16_t*)p.out; const bf16_t* Kk = (const bf16_t*)p.out + (size_t)T_ * 1024; const bf16_t* V = (const bf16_t*)(p.ws + R6);
    bf16_t* HC = (bf16_t*)(p.ws + R1);
    const float* GS = (const float*)(p.ws + WS_GS);
    LAS bf16_t* QN = (LAS bf16_t*)(lds + ML_QN);
    LAS bf16_t* KN = (LAS bf16_t*)(lds + ML_KN);
    LAS bf16_t* VN = (LAS bf16_t*)(lds + ML_VN);
    LAS bf16_t* VW = (LAS bf16_t*)(lds + ML_VW);
    LAS bf16_t* Sw = (LAS bf16_t*)(lds + ML_SW);
    LAS bf16_t* Cb = (LAS bf16_t*)(lds + ML_CB);
    LAS float* sc_den = (LAS float*)(lds + ML_DEN);
    const int trq = lr >> 2, trp = 4 * (lr & 3);
    for (int item = blockIdx.x; item < 256; item += gridDim.x) {
        const int bh = item & 31, vs = item >> 5, b = bh >> 2, h = bh & 3;
        const size_t tok0 = (size_t)b * SEQ_;
        __syncthreads();
        for (int i = tid; i < 48 * 264 / 2; i += 512) ((LAS unsigned*)Cb)[i] = 0u;
        for (int i = tid; i < 2 * 64 * 56 / 2; i += 512) ((LAS unsigned*)VN)[i] = 0u;
        f32x4 Cacc[2][3];
#pragma unroll
        for (int a_ = 0; a_ < 2; ++a_)
#pragma unroll
            for (int c_ = 0; c_ < 3; ++c_) Cacc[a_][c_] = (f32x4){0.f, 0.f, 0.f, 0.f};
        u32x4 qreg[4], kreg[4], vreg = (u32x4){0u, 0u, 0u, 0u};
        float sMq, swi, semr, swk, sdecay; f32x4 sa[2];
        const int vsel = tid < 256 ? (tid >> 2) : (tid < 320 ? tid - 256 : 0);
#define ML_GLOAD(tc0_) do { _Pragma("unroll") for (int i_ = 0; i_ < 4; ++i_) { const int pi = tid + 512 * i_; const size_t go = ((tc0_) + (pi >> 5)) * 1024 + h * 256 + (pi & 31) * 8; \
            qreg[i_] = *(const u32x4*)(Q + go); kreg[i_] = *(const u32x4*)(Kk + go); } \
            if (tid < 256) vreg = *(const u32x4*)(V + ((tc0_) + (tid >> 2)) * 1024 + h * 256 + vs * 32 + (tid & 3) * 8); } while (0)
#define ML_GSCAL(gs_) do { sMq = (gs_)[64 + 16 * qi + lr]; swi = (gs_)[128 + 16 * qi + lr]; semr = (gs_)[192 + 16 * qi + lr]; swk = (gs_)[256 + vsel]; sdecay = (gs_)[320]; \
            sa[0] = *(const f32x4*)((gs_) + 16 * (2 * half) + 4 * lg); sa[1] = *(const f32x4*)((gs_) + 16 * (2 * half + 1) + 4 * lg); } while (0)
#define ML_LWRITE() do { _Pragma("unroll") for (int i_ = 0; i_ < 4; ++i_) { const int pi = tid + 512 * i_; const int lo_ = (pi >> 5) * 264 + (pi & 31) * 8; \
            *(LAS u32x4*)(QN + lo_) = qreg[i_]; *(LAS u32x4*)(KN + lo_) = kreg[i_]; } \
            if (tid < 256) { float vv[8], vw[8]; unpack8(vreg, vv); _Pragma("unroll") for (int j = 0; j < 8; ++j) vw[j] = vv[j] * swk; \
                *(LAS u32x4*)(VN + (tid >> 2) * 56 + (tid & 3) * 8) = vreg; *(LAS u32x4*)(VW + (tid >> 2) * 56 + (tid & 3) * 8) = pack8(vw); } \
            else if (tid < 320) { VN[(tid - 256) * 56 + 32] = (bf16_t)0x3f80; VW[(tid - 256) * 56 + 32] = f2bf(swk); } } while (0)
        { ML_GLOAD(tok0); const float* gs = GS + ((size_t)bh * 64) * 384; ML_GSCAL(gs); }
        __syncthreads();
        ML_LWRITE();
        __syncthreads();
        for (int ch = 0; ch < NCH_; ++ch) {
            const size_t tc0 = tok0 + (size_t)ch * 64;
            const int chn = ch + 1 < NCH_ ? ch + 1 : ch; const size_t tcn = tok0 + (size_t)chn * 64;
            const float* gsn = GS + ((size_t)bh * 64 + chn) * 384;
            const float cMq = sMq, cwi = swi, cemr = semr, cdecay = sdecay; const f32x4 ca0 = sa[0], ca1 = sa[1];
            ML_GLOAD(tcn); ML_GSCAL(gsn);
            bf16x8 qf[8];
#pragma unroll
            for (int ks = 0; ks < 8; ++ks) qf[ks] = *(const LAS bf16x8*)(QN + (16 * qi + lr) * 264 + 32 * ks + 8 * lg);
            f32x4 St[2];
#pragma unroll
            for (int jj = 0; jj < 2; ++jj) { St[jj] = (f32x4){0.f, 0.f, 0.f, 0.f};
#pragma unroll
                for (int ks = 0; ks < 8; ++ks) { const bf16x8 kfr = *(const LAS bf16x8*)(KN + (16 * (2 * half + jj) + lr) * 264 + 32 * ks + 8 * lg);
                    St[jj] = __builtin_amdgcn_mfma_f32_16x16x32_bf16(kfr, qf[ks], St[jj], 0, 0, 0); } }
#pragma unroll
            for (int jj = 0; jj < 2; ++jj) { const int kt = 2 * half + jj; const int qtok = 16 * qi + lr, k0 = 16 * kt + 4 * lg; const f32x4 av = jj == 0 ? ca0 : ca1;
                float o[4];
#pragma unroll
                for (int r = 0; r < 4; ++r) { const float wgt = (k0 + r <= qtok) ? __expf(av[r] - cMq) : 0.f; o[r] = St[jj][r] * wgt; }
                u32x2 pk; pk.x = cvt_pk_bf16(o[0], o[1]); pk.y = cvt_pk_bf16(o[2], o[3]);
                *(LAS u32x2*)(Sw + qtok * 72 + k0) = pk; }
            __syncthreads();
            f32x4 num[2]; num[0] = (f32x4){0.f, 0.f, 0.f, 0.f}; num[1] = (f32x4){0.f, 0.f, 0.f, 0.f};
            const int nvt = half == 0 ? 2 : 1, vt0 = half == 0 ? 0 : 2;
#pragma unroll
            for (int i = 0; i < 2; ++i) if (i < nvt) {
                const int vn = vt0 + i;
#pragma unroll
                for (int ks = 0; ks < 8; ++ks) { const bf16x8 cf = *(const LAS bf16x8*)(Cb + (16 * vn + lr) * 264 + 32 * ks + 8 * lg);
                    num[i] = __builtin_amdgcn_mfma_f32_16x16x32_bf16(cf, qf[ks], num[i], 0, 0, 0); }
                num[i] *= cwi;
#pragma unroll
                for (int k2 = 0; k2 < 2; ++k2) { const bf16x8 sf = *(const LAS bf16x8*)(Sw + (16 * qi + lr) * 72 + 32 * k2 + 8 * lg);
                    const bf16x8 vf = lds_tr_frag(VN + (32 * k2 + 8 * lg + trq) * 56 + 16 * vn + trp, 56);
                    num[i] = __builtin_amdgcn_mfma_f32_16x16x32_bf16(vf, sf, num[i], 0, 0, 0); }
            }
            if (half == 1 && lg == 0) sc_den[16 * qi + lr] = num[0][0];
            {
                bf16x8 vwf[3][2];
#pragma unroll
                for (int vn = 0; vn < 3; ++vn)
#pragma unroll
                    for (int k2 = 0; k2 < 2; ++k2) vwf[vn][k2] = lds_tr_frag(VW + (32 * k2 + 8 * lg + trq) * 56 + 16 * vn + trp, 56);
#pragma unroll
                for (int dm = 0; dm < 2; ++dm) {
                    bf16x8 kf2[2];
#pragma unroll
                    for (int k2 = 0; k2 < 2; ++k2) kf2[k2] = lds_tr_frag(KN + (32 * k2 + 8 * lg + trq) * 264 + 32 * w + 16 * dm + trp, 264);
#pragma unroll
                    for (int vn = 0; vn < 3; ++vn) { f32x4 c = Cacc[dm][vn] * cdecay;
#pragma unroll
                        for (int k2 = 0; k2 < 2; ++k2) c = __builtin_amdgcn_mfma_f32_16x16x32_bf16(kf2[k2], vwf[vn][k2], c, 0, 0, 0);
                        Cacc[dm][vn] = c; }
                }
            }
            __syncthreads();
            if (half == 0) {
                const float dn = __builtin_amdgcn_rcpf(fmaxf(fabsf(sc_den[16 * qi + lr]), cemr));
#pragma unroll
                for (int i = 0; i < 2; ++i) { u32x2 pk; pk.x = cvt_pk_bf16(num[i][0] * dn, num[i][1] * dn); pk.y = cvt_pk_bf16(num[i][2] * dn, num[i][3] * dn);
                    *(u32x2*)(HC + (tc0 + 16 * qi + lr) * 1024 + h * 256 + vs * 32 + 16 * i + 4 * lg) = pk; }
            }
#pragma unroll
            for (int dm = 0; dm < 2; ++dm)
#pragma unroll
                for (int vn = 0; vn < 3; ++vn) { const f32x4 c = Cacc[dm][vn]; u32x2 pk; pk.x = cvt_pk_bf16(c[0], c[1]); pk.y = cvt_pk_bf16(c[2], c[3]);
                    *(LAS u32x2*)(Cb + (16 * vn + lr) * 264 + 32 * w + 16 * dm + 4 * lg) = pk; }
            ML_LWRITE();
            __syncthreads();
        }
#undef ML_GLOAD
#undef ML_GSCAL
#undef ML_LWRITE
    }
}

__device__ __forceinline__ void phase_aout(const Params& p) {
    const int tid = fresh_tid(), lane = tid & 63, gw = blockIdx.x * 8 + (tid >> 6), NGW = gridDim.x * 8;
    const bf16_t* HC = (const bf16_t*)(p.ws + R1); const bf16_t* SOM = (const bf16_t*)(p.ws + R2); const bf16_t* XC = (const bf16_t*)(p.ws + R0);
    bf16_t* AO = (bf16_t*)(p.ws + R6);
    const float* hg = p.in[9]; const float* sk = p.in[10];
    for (int t = gw; t < T_; t += NGW) {
#pragma unroll
        for (int h = 0; h < 4; ++h) {
            const size_t off = (size_t)t * 1024 + h * 256 + 4 * lane;
            const u32x2 hw = *(const u32x2*)(HC + off), ow = *(const u32x2*)(SOM + off), xw = *(const u32x2*)(XC + off);
            const f32x4 g4 = *(const f32x4*)(hg + h * 256 + 4 * lane), s4 = *(const f32x4*)(sk + h * 256 + 4 * lane);
            float hv[4] = {bflo(hw.x), bfhi(hw.x), bflo(hw.y), bfhi(hw.y)};
            const float ov[4] = {bflo(ow.x), bfhi(ow.x), bflo(ow.y), bfhi(ow.y)}, xv[4] = {bflo(xw.x), bfhi(xw.x), bflo(xw.y), bfhi(xw.y)};
            const float mu = wave_sum((hv[0] + hv[1]) + (hv[2] + hv[3])) * (1.0f / 256.0f);
#pragma unroll
            for (int j = 0; j < 4; ++j) hv[j] -= mu;
            const float var = wave_sum((hv[0] * hv[0] + hv[1] * hv[1]) + (hv[2] * hv[2] + hv[3] * hv[3])) * (1.0f / 256.0f);
            const float rs = rsqrtf(var + EPS_);
            float o[4];
#pragma unroll
            for (int j = 0; j < 4; ++j) o[j] = ov[j] * (hv[j] * rs * g4[j]) + s4[j] * xv[j];
            u32x2 wv; wv.x = cvt_pk_bf16(o[0], o[1]); wv.y = cvt_pk_bf16(o[2], o[3]);
            *(u32x2*)(AO + off) = wv;
        }
    }
}

__device__ __forceinline__ bf16x8 s5_load_af(const bf16_t* US, size_t tokb, int g, int lane) {
    const int lr = lane & 15, lg = lane >> 4;
    bf16x8 af = *(const bf16x8*)(US + (tokb + lr) * 512 + g * 16 + 8 * (lg & 1));
    if (lg >= 2) af = (bf16x8){0, 0, 0, 0, 0, 0, 0, 0};
    return af;
}
template <bool PASS_C>
__device__ __forceinline__ void s5_block16(const bf16x8 af, int lane, const bf16x8 (&bbf)[8], LAS float* but, LAS bf16_t* stb, float ar, float ai, float& sr, float& si) {
    const int lr = lane & 15, lg = lane >> 4;
#pragma unroll
    for (int ct = 0; ct < 8; ++ct) { const f32x4 d = __builtin_amdgcn_mfma_f32_16x16x32_bf16(af, bbf[ct], (f32x4){0.f, 0.f, 0.f, 0.f}, 0, 0, 0);
#pragma unroll
        for (int r = 0; r < 4; ++r) but[(4 * lg + r) * 132 + 16 * ct + lr] = d[r]; }
#pragma unroll 4
    for (int tt = 0; tt < 16; ++tt) { const float br = but[tt * 132 + lane], bi = but[tt * 132 + 64 + lane];
        const float nr = ar * sr - ai * si + br, ni = ar * si + ai * sr + bi; sr = nr; si = ni;
        if (PASS_C) { stb[tt * 136 + lane] = f2bf(sr); stb[tt * 136 + 64 + lane] = f2bf(si); } }
}
__device__ __forceinline__ void phase_s5(const Params& p, LAS unsigned char* lds) {
    const int tid = fresh_tid(), lane = tid & 63, wave = __builtin_amdgcn_readfirstlane(tid >> 6), lr = lane & 15, lg = lane >> 4;
    const bf16_t* US = (const bf16_t*)(p.ws + R5);
    const float* A = (const float*)(p.ws + WS_S5A); const bf16_t* BbT = (const bf16_t*)(p.ws + WS_S5BT); const bf16_t* CmT = (const bf16_t*)(p.ws + WS_S5CT);
    bf16_t* YB = (bf16_t*)(p.ws + R7);
    LAS float* but = (LAS float*)(lds + wave * 16896);
    LAS bf16_t* stb = (LAS bf16_t*)(lds + wave * 16896 + 8448);
    LAS float* Eb = (LAS float*)(lds + 8 * 16896);
    for (int item = blockIdx.x; item < NB_ * SG_; item += gridDim.x) {
        const int b = item & 7, g = item >> 3, gp = g * 64 + lane;
        const float ar = A[gp * 2], ai = A[gp * 2 + 1];
        bf16x8 bbf[8];
#pragma unroll
        for (int ct = 0; ct < 8; ++ct) { bbf[ct] = *(const bf16x8*)(BbT + ((size_t)(g * 128 + 16 * ct + lr)) * 16 + 8 * (lg & 1)); if (lg >= 2) bbf[ct] = (bf16x8){0, 0, 0, 0, 0, 0, 0, 0}; }
        const size_t tokw = (size_t)b * SEQ_ + (size_t)wave * 512;
        float sr = 0.f, si = 0.f;
        { bf16x8 afc = s5_load_af(US, tokw, g, lane);
          for (int blk = 0; blk < 32; ++blk) { const int bn = blk + 1 < 32 ? blk + 1 : blk; const bf16x8 afn = s5_load_af(US, tokw + bn * 16, g, lane);
              s5_block16<false>(afc, lane, bbf, but, stb, ar, ai, sr, si); afc = afn; } }
        Eb[(wave * 64 + lane) * 2] = sr; Eb[(wave * 64 + lane) * 2 + 1] = si;
        __syncthreads();
        float pr = ar, pi = ai;
#pragma unroll
        for (int i = 0; i < 9; ++i) { const float nr = pr * pr - pi * pi, ni = 2.f * pr * pi; pr = nr; pi = ni; }
        sr = 0.f; si = 0.f;
        for (int j = 0; j < wave; ++j) { const float er = Eb[(j * 64 + lane) * 2], ei = Eb[(j * 64 + lane) * 2 + 1]; const float nr = pr * sr - pi * si + er, ni = pr * si + pi * sr + ei; sr = nr; si = ni; }
        bf16x8 cmf[4];
#pragma unroll
        for (int kk = 0; kk < 4; ++kk) cmf[kk] = *(const bf16x8*)(CmT + ((size_t)(g * 16 + lr)) * 128 + 32 * kk + 8 * lg);
        const float dsk = p.in[18][g * 16 + lr];
        bf16x8 afc = s5_load_af(US, tokw, g, lane);
        bf16_t uuc[4];
#pragma unroll
        for (int r = 0; r < 4; ++r) uuc[r] = US[(tokw + 4 * lg + r) * 512 + g * 16 + lr];
        for (int blk = 0; blk < 32; ++blk) {
            const size_t tokb = tokw + blk * 16;
            const int bn = blk + 1 < 32 ? blk + 1 : blk; const bf16x8 afn = s5_load_af(US, tokw + bn * 16, g, lane);
            bf16_t uun[4];
#pragma unroll
            for (int r = 0; r < 4; ++r) uun[r] = US[(tokw + bn * 16 + 4 * lg + r) * 512 + g * 16 + lr];
            s5_block16<true>(afc, lane, bbf, but, stb, ar, ai, sr, si);
            f32x4 y = (f32x4){0.f, 0.f, 0.f, 0.f};
#pragma unroll
            for (int kk = 0; kk < 4; ++kk) { const bf16x8 sf = *(const LAS bf16x8*)(stb + lr * 136 + 32 * kk + 8 * lg); y = __builtin_amdgcn_mfma_f32_16x16x32_bf16(sf, cmf[kk], y, 0, 0, 0); }
#pragma unroll
            for (int r = 0; r < 4; ++r) { const size_t tok = tokb + 4 * lg + r; const float uu = bf2f(uuc[r]);
                const float v = y[r] + dsk * uu;
                const float z = 0.7978845608f * (v + 0.044715f * v * v * v); const float th = 1.0f - 2.0f * __builtin_amdgcn_rcpf(1.0f + __expf(2.0f * z));
                YB[tok * 512 + g * 16 + lr] = f2bf(0.5f * v * (1.0f + th)); }
            afc = afn;
#pragma unroll
            for (int r = 0; r < 4; ++r) uuc[r] = uun[r];
        }
        __syncthreads();
    }
}

__device__ __forceinline__ void phase_ffn_act(const Params& p, int half) {
    const bf16_t* U = (const bf16_t*)(p.ws + WS_UH); bf16_t* ACT = (bf16_t*)(p.ws + WS_ACT) + (size_t)half * 16384 * F_;
    const float* cw = p.in[26]; const float* cb = p.in[27];
    const int total = (16384 / 16) * 352;
    for (int idx = blockIdx.x * 512 + fresh_tid(); idx < total; idx += gridDim.x * 512) {
        const int fg = idx % 352, tb = idx / 352, f0 = fg * 8, t0 = tb * 16;
        float wv[3][8], wg[3][8], bvv[8], bgg[8];
#pragma unroll
        for (int k = 0; k < 3; ++k) { const f32x4 a = *(const f32x4*)(cw + k * F2_ + f0), b = *(const f32x4*)(cw + k * F2_ + f0 + 4), c = *(const f32x4*)(cw + k * F2_ + F_ + f0), d = *(const f32x4*)(cw + k * F2_ + F_ + f0 + 4);
#pragma unroll
            for (int j = 0; j < 4; ++j) { wv[k][j] = a[j]; wv[k][4 + j] = b[j]; wg[k][j] = c[j]; wg[k][4 + j] = d[j]; } }
        { const f32x4 a = *(const f32x4*)(cb + f0), b = *(const f32x4*)(cb + f0 + 4), c = *(const f32x4*)(cb + F_ + f0), d = *(const f32x4*)(cb + F_ + f0 + 4);
#pragma unroll
          for (int j = 0; j < 4; ++j) { bvv[j] = a[j]; bvv[4 + j] = b[j]; bgg[j] = c[j]; bgg[4 + j] = d[j]; } }
        float v0[8], v1[8], v2[8], g0[8], g1[8], g2[8];
        const bool head = (t0 & (SEQ_ - 1)) == 0;
        if (head) {
#pragma unroll
            for (int j = 0; j < 8; ++j) { v0[j] = 0.f; v1[j] = 0.f; g0[j] = 0.f; g1[j] = 0.f; } }
        else { unpack8(*(const u32x4*)(U + (size_t)(t0 - 2) * F2_ + f0), v0); unpack8(*(const u32x4*)(U + (size_t)(t0 - 1) * F2_ + f0), v1);
               unpack8(*(const u32x4*)(U + (size_t)(t0 - 2) * F2_ + F_ + f0), g0); unpack8(*(const u32x4*)(U + (size_t)(t0 - 1) * F2_ + F_ + f0), g1); }
#pragma unroll 4
        for (int i = 0; i < 16; ++i) {
            unpack8(*(const u32x4*)(U + (size_t)(t0 + i) * F2_ + f0), v2); unpack8(*(const u32x4*)(U + (size_t)(t0 + i) * F2_ + F_ + f0), g2);
            float o[8];
#pragma unroll
            for (int j = 0; j < 8; ++j) { const float val = bvv[j] + wv[0][j] * v0[j] + wv[1][j] * v1[j] + wv[2][j] * v2[j]; const float gt = bgg[j] + wg[0][j] * g0[j] + wg[1][j] * g1[j] + wg[2][j] * g2[j]; o[j] = siluf_(gt) * val; }
            *(u32x4*)(ACT + (size_t)(t0 + i) * F_ + f0) = pack8(o);
#pragma unroll
            for (int j = 0; j < 8; ++j) { v0[j] = v1[j]; v1[j] = v2[j]; g0[j] = g1[j]; g1[j] = g2[j]; }
        }
    }
}

__device__ __forceinline__ void phase_final(const Params& p) {
    const int tid = fresh_tid(), lane = tid & 63, gw = blockIdx.x * 8 + (tid >> 6), NGW = gridDim.x * 8;
    const float* ss = (const float*)(p.ws + WS_SS2); const float* gf = p.in[29];
    for (int row = gw; row < T_; row += NGW) {
        const float sv = (lane < 16) ? ss[(size_t)row * 16 + lane] : 0.f;
        const float ri = rsqrtf(wave_sum(sv) * (1.0f / 1024.0f) + EPS_);
        f32x4* xr = (f32x4*)(p.out + (size_t)row * 1024) + lane;
#pragma unroll
        for (int j = 0; j < 4; ++j) { const f32x4 g4 = *((const f32x4*)gf + lane + 64 * j); f32x4 v = xr[64 * j]; v = v * ri * g4; xr[64 * j] = v; }
    }
}

#ifndef PHASE_MASK
#define PHASE_MASK 0xffffffffu
#endif
#define PH(k) ((PHASE_MASK >> (k)) & 1u)
#ifndef REP_MASK
#define REP_MASK 0u
#endif
#define REPS(k) for (int rep_ = 0; rep_ < 1 + (int)((REP_MASK >> (k)) & 1u); ++rep_)
__global__ void __launch_bounds__(512, 2) fwd_megakernel(Params p) {
    extern __shared__ __attribute__((aligned(16))) unsigned char lds_raw[];
    LAS unsigned char* lds = (LAS unsigned char*)lds_raw;
    cg::grid_group grid = cg::this_grid();
    unsigned char* ws = p.ws;
    bf16_t* dq = (bf16_t*)p.out;
    volatile LAS unsigned* bst = (volatile LAS unsigned*)(lds + LDS_BYTES - 64);
    if (threadIdx.x < 2) bst[threadIdx.x] = 0u;
    if (blockIdx.x == 0) { unsigned* bw = (unsigned*)(ws + WS_BAR); for (int i = threadIdx.x; i < XCD_BAR_WORDS; i += 512) bw[i] = 0u; }
    __syncthreads();
    REPS(0) if (PH(0)) phase0(p, lds);
    grid.sync();
    const XcdBarrier xbar = xcd_barrier_post((unsigned*)(ws + WS_BAR), bst);
    REPS(1) if (PH(1)) { pg8::PlainSched S; S.set(ws + R0, 1024, ws + WS_WIN, 1024, T_ / 256, NP1_ / 256);
      EpiProj E{(const float*)(ws + WS_RINV1), (const float*)(ws + WS_BIASP), (bf16_t*)(ws + R1), (bf16_t*)(ws + R2), (bf16_t*)(ws + R5), (bf16_t*)(ws + R3), (bf16_t*)(ws + R4)};
      pg8::gemm_phase(lds, S, E, 1024, 1024, 1024); }
    xcd_barrier(xbar);
    REPS(2) if (PH(2)) { phase_gates(p, lds); phase_conv_m(p); }
    xcd_barrier(xbar);
    REPS(3) if (PH(3)) { SchedQKV S; S.init(T_ / 256, 12, gridDim.x, blockIdx.x); S.xc = (const char*)(ws + R0); S.xm = (const char*)(ws + R1); S.wqk = (const char*)(ws + WS_WQK); S.wv = (const char*)(ws + WS_WV);
      EpiQKV E{dq, (bf16_t*)(ws + R6)};
      pg8::gemm_phase(lds, S, E, 256, 1024, 256); }
    xcd_barrier(xbar);
    REPS(4) if (PH(4)) phase_mlstm(p, lds);
    xcd_barrier(xbar);
    REPS(5) if (PH(5)) phase_aout(p);
    REPS(6) if (PH(6)) phase_s5(p, lds);
    xcd_barrier(xbar);
    REPS(8) if (PH(8)) { pg8::PlainSched S; S.set(ws + R7, 512, ws + WS_WGLU, 512, T_ / 256, 2);
      EpiGate<0> E{(const bf16_t*)(ws + R7), nullptr, p.in[20], dq, 512};
      pg8::gemm_phase(lds, S, E, 512, 512, 512); }
    xcd_barrier(xbar);
    REPS(9) if (PH(9)) { pg8::PlainSched S; S.set(dq, 512, ws + WS_WB, 512, T_ / 256, 4);
      EpiGate<1> E{(const bf16_t*)(ws + R4), nullptr, nullptr, (bf16_t*)(ws + R1), 1024};
      pg8::gemm_phase(lds, S, E, 512, 512, 512); }
    xcd_barrier(xbar);
    REPS(10) if (PH(10)) { pg8::PlainSched S; S.set(ws + R6, 1024, ws + WS_WA, 1024, T_ / 256, 4);
      EpiGate<2> E{(const bf16_t*)(ws + R3), (const bf16_t*)(ws + R1), nullptr, (bf16_t*)(ws + R0), 1024};
      pg8::gemm_phase(lds, S, E, 1024, 1024, 1024); }
    xcd_barrier(xbar);
    REPS(11) if (PH(11)) { pg8::PlainSched S; S.set(ws + R0, 1024, ws + WS_WOUT, 1024, T_ / 256, 4);
      EpiResid<true> E{p.in[0], p.out, (bf16_t*)(ws + WS_X1B), (float*)(ws + WS_SS1)};
      pg8::gemm_phase(lds, S, E, 1024, 1024, 1024); }
    xcd_barrier(xbar);
    for (int half = 0; half < 2; ++half) {
        REPS(12) if (PH(12)) { pg8::PlainSched S; S.set(ws + WS_X1B + (size_t)half * 16384 * 1024 * 2, 1024, ws + WS_WUP, 1024, 64, F2_ / 256);
          EpiUp E{(const float*)(ws + WS_SS1), (bf16_t*)(ws + WS_UH), half * 16384};
          pg8::gemm_phase(lds, S, E, 1024, 1024, 1024); }
        xcd_barrier(xbar);
        REPS(13) if (PH(13)) phase_ffn_act(p, half);
        xcd_barrier(xbar);
    }
    REPS(14) if (PH(14)) { pg8::PlainSched S; S.set(ws + WS_ACT, F_, ws + WS_WDN, F_, T_ / 256, 4);
      EpiResid<false> E{p.out, (rep_ + 1 < 1 + (int)((REP_MASK >> 14) & 1u)) ? (float*)(ws + WS_UH) : p.out, nullptr, (float*)(ws + WS_SS2)};
      pg8::gemm_phase(lds, S, E, F_, F_, F_); }
    xcd_barrier(xbar);
    REPS(15) if (PH(15)) phase_final(p);
}

extern "C" void kernel_launch(void* const* d_in, const int* in_sizes, int n_in, void* d_out, int out_size, void* d_ws, size_t ws_size, hipStream_t stream) {
    static int grid_blocks = 0;
    if (!grid_blocks) {
        int dev = 0, cus = 0, per_cu = 0;
        (void)hipGetDevice(&dev);
        (void)hipDeviceGetAttribute(&cus, hipDeviceAttributeMultiprocessorCount, dev);
        (void)hipFuncSetAttribute((const void*)fwd_megakernel, hipFuncAttributeMaxDynamicSharedMemorySize, LDS_BYTES);
        (void)hipOccupancyMaxActiveBlocksPerMultiprocessor(&per_cu, (const void*)fwd_megakernel, 512, LDS_BYTES);
        if (per_cu < 1) { fprintf(stderr, "kernel_launch: occupancy query returned %d\n", per_cu); }
        grid_blocks = cus;
        if (n_in != 30 || out_size != T_ * D_ || ws_size < 512 * MiB) fprintf(stderr, "kernel_launch: unexpected sizes n_in=%d out=%d ws=%zu\n", n_in, out_size, ws_size);
    }
    Params p{};
    for (int i = 0; i < 30; ++i) p.in[i] = (const float*)d_in[i];
    p.out = (float*)d_out; p.ws = (unsigned char*)d_ws;
    void* args[] = {&p};
    hipError_t e = hipLaunchCooperativeKernel((void*)fwd_megakernel, dim3(grid_blocks), dim3(512), args, LDS_BYTES, stream);
    if (e != hipSuccess) fprintf(stderr, "cooperative launch failed: %s (grid %d)\n", hipGetErrorString(e), grid_blocks);
}
```

```cpp
#include <hip/hip_runtime.h>
#include <hip/hip_cooperative_groups.h>
#include <cstdio>
#include <cstdint>
namespace cg = cooperative_groups;

#define LAS __attribute__((address_space(3)))
typedef unsigned short bf16_t;
typedef short bf16x8 __attribute__((ext_vector_type(8)));
typedef float f32x4 __attribute__((ext_vector_type(4)));
typedef float f32x2 __attribute__((ext_vector_type(2)));
typedef unsigned u32x4 __attribute__((ext_vector_type(4)));
typedef unsigned u32x2 __attribute__((ext_vector_type(2)));

constexpr int T_ = 32768, D_ = 1024, SEQ_ = 4096, NB_ = 8;
constexpr int NH_ = 4, DH_ = 256, NCH_ = 64;
constexpr int SW_ = 512, SG_ = 32, SP_ = 64;
constexpr int F_ = 2816, F2_ = 5632, NIN_ = 4616, NP1_ = 4608;
constexpr float EPS_ = 1e-6f;

constexpr size_t MiB = 1ull << 20, KiB = 1024;
constexpr size_t WS_WIN = 0, WS_WQK = 9 * MiB, WS_WV = 10 * MiB, WS_WGLU = 10 * MiB + 512 * KiB, WS_WA = 11 * MiB, WS_WB = 13 * MiB, WS_WOUT = 14 * MiB,
                 WS_WUP = 16 * MiB, WS_WDN = 27 * MiB;
constexpr size_t WS_S5A = 33 * MiB, WS_S5BT = WS_S5A + 32 * KiB, WS_S5CT = WS_S5A + 192 * KiB;
constexpr size_t WS_RINV1 = 34 * MiB, WS_IG = 34 * MiB + 512 * KiB, WS_FG = 35 * MiB, WS_BIASP = 35 * MiB + 512 * KiB;
constexpr size_t WS_GS = 50 * MiB;
constexpr size_t WS_BAR = 49 * MiB;
constexpr size_t WS_SS1 = 36 * MiB, WS_SS2 = 38 * MiB, WS_E = 40 * MiB;
constexpr size_t R0 = 56 * MiB, R1 = 120 * MiB, R2 = 184 * MiB, R3 = 248 * MiB, R4 = 312 * MiB, R5 = 376 * MiB, R6 = 408 * MiB, R7 = 472 * MiB;
constexpr size_t WS_X1B = 448 * MiB, WS_UH = 56 * MiB, WS_SIDE = 56 * MiB, WS_ACT = 232 * MiB;
constexpr int LDS_BYTES = 147456;

struct Params {
    const float* in[30];
    float* out;
    unsigned char* ws;
};

__device__ __forceinline__ unsigned cvt_pk_bf16(float lo, float hi) { unsigned r; asm volatile("v_cvt_pk_bf16_f32 %0, %1, %2" : "=v"(r) : "v"(lo), "v"(hi)); return r; }
__device__ __forceinline__ bf16_t f2bf(float x) { return (bf16_t)(cvt_pk_bf16(x, x) & 0xffffu); }
__device__ __forceinline__ float bf2f(unsigned short u) { return __uint_as_float(((unsigned)u) << 16); }
__device__ __forceinline__ float bflo(unsigned w) { return __uint_as_float(w << 16); }
__device__ __forceinline__ float bfhi(unsigned w) { return __uint_as_float(w & 0xffff0000u); }
__device__ __forceinline__ float sigmoidf_(float x) { return __builtin_amdgcn_rcpf(1.0f + __expf(-x)); }
__device__ __forceinline__ float siluf_(float x) { return x * sigmoidf_(x); }
__device__ __forceinline__ int fresh_tid() { int t = threadIdx.x; asm volatile("" : "+v"(t)); return t; }
__device__ __forceinline__ float wave_sum(float v) {
#pragma unroll
    for (int o = 1; o < 64; o <<= 1) v += __shfl_xor(v, o);
    return v;
}
__device__ __forceinline__ void unpack8(const u32x4 w, float (&f)[8]) {
    f[0] = bflo(w.x); f[1] = bfhi(w.x); f[2] = bflo(w.y); f[3] = bfhi(w.y); f[4] = bflo(w.z); f[5] = bfhi(w.z); f[6] = bflo(w.w); f[7] = bfhi(w.w);
}
__device__ __forceinline__ u32x4 pack8(const float (&f)[8]) {
    u32x4 w; w.x = cvt_pk_bf16(f[0], f[1]); w.y = cvt_pk_bf16(f[2], f[3]); w.z = cvt_pk_bf16(f[4], f[5]); w.w = cvt_pk_bf16(f[6], f[7]); return w;
}


#define XB_TMO      128
#define XB_XCNT(j)  (256  + 64 * (j))
#define XB_XSUB(j)  (1280 + 64 * (j))
#define XB_XGEN(j)  (2304 + 64 * (j))
#define XB_TOP      3328
#define XB_TOPGEN   3392
#define XCD_BAR_WORDS 3456
#define XB_SPIN_CAP (1u << 18)
__device__ __forceinline__ unsigned xb_ld(unsigned* p)              { return __hip_atomic_load(p, __ATOMIC_RELAXED, __HIP_MEMORY_SCOPE_AGENT); }
__device__ __forceinline__ unsigned xb_add(unsigned* p, unsigned v) { return __hip_atomic_fetch_add(p, v, __ATOMIC_RELAXED, __HIP_MEMORY_SCOPE_AGENT); }
__device__ __forceinline__ unsigned xb_xcc_id() { return (unsigned)__builtin_amdgcn_s_getreg((3 << 11) | 20) & 0xFu; }
#define XB_SPIN(cond, bar) do { unsigned _sp = 0; while (cond) { __builtin_amdgcn_s_sleep(1); \
    if ((++_sp & 255u) == 0u) { if (xb_ld(&(bar)[XB_TMO])) break; if (_sp > XB_SPIN_CAP) { atomicAdd(&(bar)[XB_TMO], 1u); break; } } } } while (0)
struct XcdBarrier { unsigned* bar; unsigned x; volatile LAS unsigned* st; };
__device__ __forceinline__ XcdBarrier xcd_barrier_post(unsigned* bar, volatile LAS unsigned* st) {
    XcdBarrier b; b.bar = bar; b.x = xb_xcc_id(); b.st = st;
    if (threadIdx.x == 0) (void)xb_add(&bar[XB_XCNT(b.x)], 1u);
    return b;
}
__device__ __forceinline__ void xcd_barrier_complete(unsigned* bar, unsigned x, unsigned& nloc, unsigned& nx) {
    const unsigned G = gridDim.x * gridDim.y * gridDim.z;
    unsigned sum, cnt, mine, sp = 0u;
    for (;;) {
        sum = 0u; cnt = 0u; mine = 0u;
#pragma unroll
        for (unsigned j = 0; j < 16; ++j) { const unsigned c = xb_ld(&bar[XB_XCNT(j)]); sum += c; cnt += (c > 0u) ? 1u : 0u; mine = (j == x) ? c : mine; }
        if (sum == G) break;
        __builtin_amdgcn_s_sleep(1);
        if ((++sp & 255u) == 0u) { if (xb_ld(&bar[XB_TMO])) break; if (sp > XB_SPIN_CAP) { atomicAdd(&bar[XB_TMO], 1u); break; } }
    }
    nloc = mine > 0u ? mine : 1u; nx = cnt > 0u ? cnt : 1u;
}
__device__ __forceinline__ void xcd_barrier(const XcdBarrier& b) {
    asm volatile("s_waitcnt vmcnt(0)" ::: "memory");
    __syncthreads();
    if (threadIdx.x == 0) {
        unsigned* bar = b.bar;
        __builtin_amdgcn_s_waitcnt(0);
        unsigned nloc = b.st[0], nx = b.st[1];
        if (nloc == 0u) { xcd_barrier_complete(bar, b.x, nloc, nx); b.st[0] = nloc; b.st[1] = nx; }
        const unsigned old = xb_add(&bar[XB_XSUB(b.x)], 1u);
        const unsigned gen = old / nloc;
        if (old + 1u == (gen + 1u) * nloc) {
            __builtin_amdgcn_fence(__ATOMIC_RELEASE, "agent");
            asm volatile("s_waitcnt vmcnt(0)" ::: "memory");
            const unsigned og = xb_add(&bar[XB_TOP], 1u);
            const unsigned tg = og / nx;
            if (og + 1u == (tg + 1u) * nx) xb_add(&bar[XB_TOPGEN], 1u);
            else XB_SPIN(xb_ld(&bar[XB_TOPGEN]) == tg, bar);
            __builtin_amdgcn_fence(__ATOMIC_ACQUIRE, "agent");
            xb_add(&bar[XB_XGEN(b.x)], 1u);
            asm volatile("s_waitcnt vmcnt(0)" ::: "memory");
        } else {
            XB_SPIN(xb_ld(&bar[XB_XGEN(b.x)]) == gen, bar);
            __builtin_amdgcn_fence(__ATOMIC_ACQUIRE, "agent");
            asm volatile("s_waitcnt vmcnt(0)" ::: "memory");
        }
    }
    __syncthreads();
}

namespace pg8 {
constexpr int BM = 256, BK = 64, HALF = 128, HTB = HALF * BK * 2, STAGE_BYTES = 8 * HTB, NXCD = 8, WGM = 8;
__device__ __forceinline__ int lds_byte(int r, int c) { const int st = (r >> 4) * 2 + (c >> 5), rr = r & 15, cc = c & 31, ob = rr * 64 + cc * 2; return st * 1024 + (ob ^ (((ob >> 9) & 1) << 5)); }
__device__ __forceinline__ void stage_rc(int b, int& R, int& C) { const int st = b / 1024, sb = b % 1024, swz = sb ^ (((sb >> 9) & 1) << 5); R = (st >> 1) * 16 + swz / 64; C = (st & 1) * 32 + (swz % 64) / 2; }
__device__ __forceinline__ int perm32(int rho) { const int n = rho >> 4, i = rho & 15; return 8 * (i >> 2) + 4 * n + (i & 3); }
struct Unit { int pm, pn; };
struct Order {
    int nM, nN, nwg, G, c;
    __device__ __forceinline__ void init(int nM_, int nN_, int G_, int c_) { nM = nM_; nN = nN_; nwg = nM * nN; G = G_; c = c_; }
    __device__ __forceinline__ bool next(int i, Unit& u) const {
        const long L = (long)i * G + c; if (L >= nwg) return false;
        int wgid = (int)L; { const int q = nwg / NXCD, r = nwg % NXCD, xcd = wgid % NXCD, off = wgid / NXCD; wgid = (xcd < r ? xcd * (q + 1) : r * (q + 1) + (xcd - r) * q) + off; }
        const int nig = WGM * nN, gid = wgid / nig, fm = gid * WGM, gsz = (nM - fm) < WGM ? (nM - fm) : WGM;
        u.pm = fm + ((wgid % nig) % gsz); u.pn = (wgid % nig) / gsz; return true;
    }
};
template <class Epi, class Sched>
__device__ __forceinline__ void gemm_phase(LAS unsigned char* lds, const Sched& S, const Epi& E, const int K, const int lda, const int ldb) {
    const int tid = fresh_tid(), wid = __builtin_amdgcn_readfirstlane(tid >> 6), lane = tid & 63, wr = wid >> 2, wc = wid & 3, fr = lane & 15, fq = lane >> 4;
    const int nt = K / BK;
    unsigned voffA[2], voffB[2];
#pragma unroll
    for (int i = 0; i < 2; ++i) { int R, C; stage_rc(tid * 16 + i * 8192, R, C); const int Rb = Epi::PERM ? ((R & ~31) + perm32(R & 31)) : R;
        const int Ra = Epi::ROWPERM ? (((R >> 6) * 16 + (R & 15)) * 8 + ((R >> 4) & 3)) : R;
        voffA[i] = (unsigned)(Ra * lda + C) * 2u; voffB[i] = (unsigned)(Rb * ldb + C) * 2u; }
    const size_t kstep = (size_t)(BK * 2);
    const size_t hstepA = (size_t)(Epi::ROWPERM ? 4 : HALF) * lda * 2, hstepB = (size_t)HALF * ldb * 2;
    const unsigned ldsw = (unsigned)wid * 1024u;
    const int aoff = lds_byte(wr * 64 + fr, fq * 8), boff = lds_byte(wc * 32 + fr, fq * 8);
#define PG8_SA(b, h) (((b) * 2 + (h)) * HTB)
#define PG8_SB(b, h) ((4 + (b) * 2 + (h)) * HTB)
#define PG8_STAGE(bufoff, gbase, voff) do { _Pragma("unroll") for (int _i = 0; _i < 2; ++_i) \
        __builtin_amdgcn_global_load_lds((const unsigned*)((const char*)(gbase) + (voff)[_i]), (LAS unsigned*)(lds + (bufoff) + ldsw + _i * 8192), 16, 0, 0); } while (0)
#define PG8_LDA(dst, b, h) do { _Pragma("unroll") for (int m = 0; m < 4; ++m) _Pragma("unroll") for (int k = 0; k < 2; ++k) dst[m][k] = *(const LAS bf16x8*)(lds + PG8_SA(b, h) + aoff + m * 2048 + k * 1024); } while (0)
#define PG8_LDB(dst, b, h) do { _Pragma("unroll") for (int n = 0; n < 2; ++n) _Pragma("unroll") for (int k = 0; k < 2; ++k) dst[n][k] = *(const LAS bf16x8*)(lds + PG8_SB(b, h) + boff + n * 2048 + k * 1024); } while (0)
#define PG8_MMA(ai, bj, At, Bt) do { __builtin_amdgcn_s_setprio(1); _Pragma("unroll") for (int m = 0; m < 4; ++m) _Pragma("unroll") for (int n = 0; n < 2; ++n) _Pragma("unroll") for (int k = 0; k < 2; ++k) \
        acc[ai][bj][m][n] = __builtin_amdgcn_mfma_f32_16x16x32_bf16(Bt[n][k], At[m][k], acc[ai][bj][m][n], 0, 0, 0); __builtin_amdgcn_s_setprio(0); } while (0)
#define PG8_WAIT_V(n) asm volatile("s_waitcnt vmcnt(" #n ")" ::: "memory")
#define PG8_WAIT_L(n) asm volatile("s_waitcnt lgkmcnt(" #n ")" ::: "memory")
#define PG8_BAR __builtin_amdgcn_s_barrier()
#define PG8_SCHED __builtin_amdgcn_sched_barrier(0)
    Unit cur, nxt; int ui = 0;
    if (!S.next(0, cur)) return;
    f32x4 acc[2][2][4][2];
#pragma unroll
    for (int a = 0; a < 2; ++a)
#pragma unroll
        for (int b = 0; b < 2; ++b)
#pragma unroll
            for (int m = 0; m < 4; ++m)
#pragma unroll
                for (int n = 0; n < 2; ++n) acc[a][b][m][n] = (f32x4){0.f, 0.f, 0.f, 0.f};
    bf16x8 At[4][2], B0[2][2], B1[2][2];
    const char* cA = S.aptr(cur); const char* cB = S.bptr(cur);
    PG8_STAGE(PG8_SB(0, 0), cB, voffB); PG8_STAGE(PG8_SB(0, 1), cB + hstepB, voffB); PG8_STAGE(PG8_SA(0, 0), cA, voffA); PG8_STAGE(PG8_SA(0, 1), cA + hstepA, voffA);
    if (wr == 1) PG8_BAR;
    PG8_WAIT_V(2); PG8_BAR;
    PG8_STAGE(PG8_SB(1, 0), cB + kstep, voffB); PG8_STAGE(PG8_SA(1, 0), cA + kstep, voffA); PG8_STAGE(PG8_SB(1, 1), cB + hstepB + kstep, voffB);
    PG8_WAIT_V(6); PG8_BAR;
    for (;;) {
        const bool has_next = S.next(ui + 1, nxt);
        const char* nA = has_next ? S.aptr(nxt) : cA; const char* nB = has_next ? S.bptr(nxt) : cB;
#pragma unroll 1
        for (int t = 0; t < nt; t += 2) {
            const bool last = (t == nt - 2);
            const char* a1 = cA + (size_t)(t + 1) * kstep;
            const char* a2 = last ? nA : cA + (size_t)(t + 2) * kstep; const char* b2 = last ? nB : cB + (size_t)(t + 2) * kstep;
            const char* a3 = a2 + kstep; const char* b3 = b2 + kstep;
            PG8_LDB(B0, 0, 0); PG8_LDB(B1, 0, 1); PG8_SCHED; PG8_LDA(At, 0, 0); PG8_STAGE(PG8_SA(1, 1), a1 + hstepA, voffA);
            PG8_WAIT_V(8); PG8_WAIT_L(0); PG8_BAR; PG8_MMA(0, 0, At, B0); PG8_MMA(0, 1, At, B1); PG8_BAR; PG8_SCHED;
            PG8_LDA(At, 0, 1); PG8_STAGE(PG8_SB(0, 0), b2, voffB); PG8_STAGE(PG8_SB(0, 1), b2 + hstepB, voffB); PG8_STAGE(PG8_SA(0, 0), a2, voffA);
            PG8_WAIT_V(8); PG8_WAIT_L(0); PG8_BAR; PG8_MMA(1, 0, At, B0); PG8_MMA(1, 1, At, B1); PG8_BAR; PG8_SCHED;
            PG8_LDB(B0, 1, 0); PG8_LDB(B1, 1, 1); PG8_SCHED; PG8_LDA(At, 1, 0); PG8_STAGE(PG8_SA(0, 1), a2 + hstepA, voffA);
            PG8_WAIT_V(8); PG8_WAIT_L(0); PG8_BAR; PG8_MMA(0, 0, At, B0); PG8_MMA(0, 1, At, B1); PG8_BAR; PG8_SCHED;
            PG8_LDA(At, 1, 1); PG8_STAGE(PG8_SB(1, 0), b3, voffB); PG8_STAGE(PG8_SB(1, 1), b3 + hstepB, voffB); PG8_STAGE(PG8_SA(1, 0), a3, voffA);
            PG8_WAIT_V(8); PG8_WAIT_L(0); PG8_BAR; PG8_MMA(1, 0, At, B0); PG8_MMA(1, 1, At, B1); PG8_BAR; PG8_SCHED;
        }
        if (wr == 0) PG8_BAR;
        E(acc, cur, wr, wc, fr, fq);
        if (!has_next) break;
#pragma unroll
        for (int a = 0; a < 2; ++a)
#pragma unroll
            for (int b = 0; b < 2; ++b)
#pragma unroll
                for (int m = 0; m < 4; ++m)
#pragma unroll
                    for (int n = 0; n < 2; ++n) acc[a][b][m][n] = (f32x4){0.f, 0.f, 0.f, 0.f};
        cur = nxt; cA = nA; cB = nB; ++ui;
        if (wr == 1) PG8_BAR;
    }
    PG8_WAIT_V(0);
    PG8_BAR;
#undef PG8_SA
#undef PG8_SB
#undef PG8_STAGE
#undef PG8_LDA
#undef PG8_LDB
#undef PG8_MMA
#undef PG8_WAIT_V
#undef PG8_WAIT_L
#undef PG8_BAR
#undef PG8_SCHED
}
struct PlainSched : Order {
    const char* A; const char* B; size_t astep, bstep;
    __device__ __forceinline__ void set(const void* A_, int lda, const void* B_, int ldb, int nM_, int nN_) { A = (const char*)A_; B = (const char*)B_; astep = (size_t)BM * lda * 2; bstep = (size_t)BM * ldb * 2; init(nM_, nN_, gridDim.x, blockIdx.x); }
    __device__ __forceinline__ const char* aptr(const Unit& u) const { return A + (size_t)u.pm * astep; }
    __device__ __forceinline__ const char* bptr(const Unit& u) const { return B + (size_t)u.pn * bstep; }
};
}
using pg8::Unit;
typedef const f32x4 (&AccRef)[2][2][4][2];

struct EpiProj {
    static constexpr bool PERM = true, ROWPERM = false;
    const float* rinv; const float* bias; bf16_t *xm, *som, *us, *sga, *sgb;
    __device__ __forceinline__ void operator()(AccRef acc, const Unit& u, int wr, int wc, int fr, int fq) const {
        const int pn = u.pn; bf16_t* base; int ldc, colt; bool sig;
        if (pn < 4) { base = xm; ldc = 1024; colt = pn * 256; sig = false; }
        else if (pn < 8) { base = som; ldc = 1024; colt = (pn - 4) * 256; sig = true; }
        else if (pn < 10) { base = us; ldc = 512; colt = (pn - 8) * 256; sig = false; }
        else if (pn < 14) { base = sga; ldc = 1024; colt = (pn - 10) * 256; sig = true; }
        else { base = sgb; ldc = 1024; colt = (pn - 14) * 256; sig = true; }
        const int row0 = u.pm * 256 + wr * 64 + fr, col0 = colt + wc * 32 + 8 * fq, bcol0 = pn * 256 + wc * 32 + 8 * fq;
        f32x4 bv[2][2];
#pragma unroll
        for (int bj = 0; bj < 2; ++bj)
#pragma unroll
            for (int n = 0; n < 2; ++n) bv[bj][n] = *(const f32x4*)(bias + bcol0 + bj * 128 + 4 * n);
#pragma unroll
        for (int ai = 0; ai < 2; ++ai)
#pragma unroll
            for (int m = 0; m < 4; ++m) { const int row = row0 + ai * 128 + m * 16; const float ri = rinv[row]; bf16_t* rowp = base + (size_t)row * ldc + col0;
#pragma unroll
                for (int bj = 0; bj < 2; ++bj) { f32x4 v0 = acc[ai][bj][m][0] * ri + bv[bj][0], v1 = acc[ai][bj][m][1] * ri + bv[bj][1];
                    if (sig) {
#pragma unroll
                        for (int j = 0; j < 4; ++j) { v0[j] = sigmoidf_(v0[j]); v1[j] = sigmoidf_(v1[j]); } }
                    u32x4 w; w.x = cvt_pk_bf16(v0[0], v0[1]); w.y = cvt_pk_bf16(v0[2], v0[3]); w.z = cvt_pk_bf16(v1[0], v1[1]); w.w = cvt_pk_bf16(v1[2], v1[3]);
                    *(u32x4*)(rowp + bj * 128) = w; } }
    }
};
struct EpiQKV {
    static constexpr bool PERM = true, ROWPERM = false;
    bf16_t *qk, *v;
    __device__ __forceinline__ void operator()(AccRef acc, const Unit& u, int wr, int wc, int fr, int fq) const {
        const int head = u.pn & 3, kind = u.pn >> 2; bf16_t* base = (kind < 2) ? qk + (size_t)kind * T_ * 1024 : v;
        const int row0 = u.pm * 256 + wr * 64 + fr, col0 = head * 256 + wc * 32 + 8 * fq;
#pragma unroll
        for (int ai = 0; ai < 2; ++ai)
#pragma unroll
            for (int m = 0; m < 4; ++m) { bf16_t* rowp = base + (size_t)(row0 + ai * 128 + m * 16) * 1024 + col0;
#pragma unroll
                for (int bj = 0; bj < 2; ++bj) { const f32x4 v0 = acc[ai][bj][m][0], v1 = acc[ai][bj][m][1];
                    u32x4 w; w.x = cvt_pk_bf16(v0[0], v0[1]); w.y = cvt_pk_bf16(v0[2], v0[3]); w.z = cvt_pk_bf16(v1[0], v1[1]); w.w = cvt_pk_bf16(v1[2], v1[3]);
                    *(u32x4*)(rowp + bj * 128) = w; } }
    }
};
template <int MODE> struct EpiGate {
    static constexpr bool PERM = true, ROWPERM = false;
    const bf16_t* X; const bf16_t* Y; const float* bias; bf16_t* O; int ldc;
    __device__ __forceinline__ void operator()(AccRef acc, const Unit& u, int wr, int wc, int fr, int fq) const {
        const int row0 = u.pm * 256 + wr * 64 + fr, col0 = u.pn * 256 + wc * 32 + 8 * fq;
        f32x4 bv[2][2];
#pragma unroll
        for (int bj = 0; bj < 2; ++bj)
#pragma unroll
            for (int n = 0; n < 2; ++n) bv[bj][n] = (MODE == 0) ? *(const f32x4*)(bias + col0 + bj * 128 + 4 * n) : (f32x4){0.f, 0.f, 0.f, 0.f};
#pragma unroll
        for (int ai = 0; ai < 2; ++ai)
#pragma unroll
            for (int m = 0; m < 4; ++m) { const size_t off = (size_t)(row0 + ai * 128 + m * 16) * ldc + col0;
#pragma unroll
                for (int bj = 0; bj < 2; ++bj) {
                    float xv[8], a[8], o[8]; unpack8(*(const u32x4*)(X + off + bj * 128), xv);
#pragma unroll
                    for (int j = 0; j < 4; ++j) { a[j] = acc[ai][bj][m][0][j] + bv[bj][0][j]; a[4 + j] = acc[ai][bj][m][1][j] + bv[bj][1][j]; }
                    if (MODE == 0) {
#pragma unroll
                        for (int j = 0; j < 8; ++j) o[j] = xv[j] * sigmoidf_(a[j]); }
                    else if (MODE == 1) {
#pragma unroll
                        for (int j = 0; j < 8; ++j) o[j] = xv[j] * a[j]; }
                    else { float yv[8]; unpack8(*(const u32x4*)(Y + off + bj * 128), yv);
#pragma unroll
                        for (int j = 0; j < 8; ++j) o[j] = xv[j] * a[j] + yv[j]; }
                    *(u32x4*)(O + off + bj * 128) = pack8(o); } }
    }
};
template <bool WB> struct EpiResid {
    static constexpr bool PERM = false, ROWPERM = false;
    const float* Rs; float* Of; bf16_t* Ob; float* ss;
    __device__ __forceinline__ void operator()(AccRef acc, const Unit& u, int wr, int wc, int fr, int fq) const {
        const int row0 = u.pm * 256 + wr * 64 + fr, col0 = u.pn * 256 + wc * 32 + 4 * fq;
#pragma unroll
        for (int ai = 0; ai < 2; ++ai)
#pragma unroll
            for (int m = 0; m < 4; ++m) { const int row = row0 + ai * 128 + m * 16; const size_t off = (size_t)row * 1024 + col0; float s = 0.f;
#pragma unroll
                for (int bj = 0; bj < 2; ++bj)
#pragma unroll
                    for (int n = 0; n < 2; ++n) { const size_t o2 = off + bj * 128 + n * 16; const f32x4 r = *(const f32x4*)(Rs + o2); const f32x4 v = r + acc[ai][bj][m][n];
                        *(f32x4*)(Of + o2) = v; s += (v[0] * v[0] + v[1] * v[1]) + (v[2] * v[2] + v[3] * v[3]);
                        if (WB) { u32x2 w; w.x = cvt_pk_bf16(v[0], v[1]); w.y = cvt_pk_bf16(v[2], v[3]); *(u32x2*)(Ob + o2) = w; } }
                s += __shfl_xor(s, 16); s += __shfl_xor(s, 32);
                if (fq == 0) { if (WB) atomicAdd(ss + row, s); else ss[(size_t)row * 16 + u.pn * 4 + wc] = s; } }
    }
};
__device__ __forceinline__ float dpp_shr1(float x) { return __int_as_float(__builtin_amdgcn_update_dpp(0, __float_as_int(x), 0x111, 0xf, 0xf, true)); }
__device__ __forceinline__ float ffn_gate(float bg, float wg0, float wg1, float wg2, float ga, float gb, float gc, float bv, float wv0, float wv1, float wv2, float va, float vb, float vc) {
    const float g = bg + wg0 * ga + wg1 * gb + wg2 * gc, v = bv + wv0 * va + wv1 * vb + wv2 * vc; return siluf_(g) * v; }
struct EpiUpFused {
    static constexpr bool PERM = true, ROWPERM = true;
    const float* ss; const float* cw; const float* cb; bf16_t* ACT; bf16_t* SIDE;
    __device__ __forceinline__ void operator()(AccRef acc, const Unit& u, int wr, int wc, int fr, int fq) const {
        const int tok0 = u.pm * 256 + (wr * 16 + fr) * 8;
        float ri[8];
        { const f32x4 q0 = *(const f32x4*)(ss + tok0), q1 = *(const f32x4*)(ss + tok0 + 4);
#pragma unroll
          for (int i = 0; i < 4; ++i) { ri[i] = rsqrtf(q0[i] * (1.0f / 1024.0f) + EPS_); ri[4 + i] = rsqrtf(q1[i] * (1.0f / 1024.0f) + EPS_); } }
        const int fb = u.pn * 128 + wc * 32 + 8 * fq;
#pragma unroll
        for (int n = 0; n < 2; ++n) {
            unsigned pk[8][2];
#pragma unroll
            for (int jp = 0; jp < 2; ++jp) {
                const int c = fb + 4 * n + 2 * jp;
                const f32x2 wv0 = *(const f32x2*)(cw + c), wv1 = *(const f32x2*)(cw + F2_ + c), wv2 = *(const f32x2*)(cw + 2 * F2_ + c);
                const f32x2 wg0 = *(const f32x2*)(cw + F_ + c), wg1 = *(const f32x2*)(cw + F2_ + F_ + c), wg2 = *(const f32x2*)(cw + 2 * F2_ + F_ + c);
                const f32x2 bv = *(const f32x2*)(cb + c), bg = *(const f32x2*)(cb + F_ + c);
                float v0[10], v1[10], g0[10], g1[10];
#pragma unroll
                for (int ai = 0; ai < 2; ++ai)
#pragma unroll
                    for (int m = 0; m < 4; ++m) { const int i = ai * 4 + m; v0[2 + i] = acc[ai][0][m][n][2 * jp] * ri[i]; v1[2 + i] = acc[ai][0][m][n][2 * jp + 1] * ri[i];
                        g0[2 + i] = acc[ai][1][m][n][2 * jp] * ri[i]; g1[2 + i] = acc[ai][1][m][n][2 * jp + 1] * ri[i]; }
                v0[0] = dpp_shr1(v0[8]); v0[1] = dpp_shr1(v0[9]); v1[0] = dpp_shr1(v1[8]); v1[1] = dpp_shr1(v1[9]);
                g0[0] = dpp_shr1(g0[8]); g0[1] = dpp_shr1(g0[9]); g1[0] = dpp_shr1(g1[8]); g1[1] = dpp_shr1(g1[9]);
                if (fr == 0 || fr == 15) {
                    const bool lo = fr == 0; const int slot = wr * 4 + (lo ? 0 : 2);
                    bf16_t* sp = SIDE + ((size_t)u.pm * 8 + slot) * F2_ + c;
                    *(unsigned*)(sp) = cvt_pk_bf16(lo ? v0[2] : v0[8], lo ? v1[2] : v1[8]); *(unsigned*)(sp + F2_) = cvt_pk_bf16(lo ? v0[3] : v0[9], lo ? v1[3] : v1[9]);
                    *(unsigned*)(sp + F_) = cvt_pk_bf16(lo ? g0[2] : g0[8], lo ? g1[2] : g1[8]); *(unsigned*)(sp + F2_ + F_) = cvt_pk_bf16(lo ? g0[3] : g0[9], lo ? g1[3] : g1[9]);
                }
#pragma unroll
                for (int i = 0; i < 8; ++i) {
                    const float o0 = ffn_gate(bg.x, wg0.x, wg1.x, wg2.x, g0[i], g0[i + 1], g0[i + 2], bv.x, wv0.x, wv1.x, wv2.x, v0[i], v0[i + 1], v0[i + 2]);
                    const float o1 = ffn_gate(bg.y, wg0.y, wg1.y, wg2.y, g1[i], g1[i + 1], g1[i + 2], bv.y, wv0.y, wv1.y, wv2.y, v1[i], v1[i + 1], v1[i + 2]);
                    pk[i][jp] = cvt_pk_bf16(o0, o1); }
            }
#pragma unroll
            for (int i = 0; i < 8; ++i) if (!(fr == 0 && i < 2)) { u32x2 w; w.x = pk[i][0]; w.y = pk[i][1]; *(u32x2*)(ACT + (size_t)(tok0 + i) * F_ + fb + 4 * n) = w; }
            asm volatile("" ::: "memory");
        }
    }
};
struct SchedQKV : pg8::Order {
    const char *xc, *xm, *wqk, *wv;
    __device__ __forceinline__ const char* aptr(const Unit& u) const { const int head = u.pn & 3, kind = u.pn >> 2; return (kind < 2 ? xc : xm) + ((size_t)u.pm * 256 * 1024 + head * 256) * 2; }
    __device__ __forceinline__ const char* bptr(const Unit& u) const { const int head = u.pn & 3, kind = u.pn >> 2; return kind < 2 ? wqk + ((size_t)(head * 512 + kind * 256) * 256) * 2 : wv + ((size_t)head * 65536) * 2; }
};

__device__ __forceinline__ void transpose_item(const float* W, int ldw, int c0, const float* kscale, float scale, bf16_t* WT, int ldt, int row_off, LAS float* scr, int kb, int nb, int lane) {
    const int k0 = 64 * kb, n0 = 32 * nb;
#pragma unroll 8
    for (int i = 0; i < 32; ++i) { const int kk = 2 * i + (lane >> 5); float v = W[(size_t)(k0 + kk) * ldw + c0 + n0 + (lane & 31)] * scale; if (kscale) v *= kscale[k0 + kk]; scr[kk * 33 + (lane & 31)] = v; }
    asm volatile("s_waitcnt lgkmcnt(0)" ::: "memory");
    const int c = lane & 7;
#pragma unroll
    for (int j = 0; j < 4; ++j) { const int n = (lane >> 3) + 8 * j; const LAS float* s = scr + (8 * c) * 33 + n;
        u32x4 o; o.x = cvt_pk_bf16(s[0 * 33], s[1 * 33]); o.y = cvt_pk_bf16(s[2 * 33], s[3 * 33]); o.z = cvt_pk_bf16(s[4 * 33], s[5 * 33]); o.w = cvt_pk_bf16(s[6 * 33], s[7 * 33]);
        *(u32x4*)(WT + (size_t)(row_off + n0 + n) * ldt + k0 + 8 * c) = o; }
    asm volatile("s_waitcnt lgkmcnt(0)" ::: "memory");
}

__device__ __forceinline__ void phase0(const Params& p, LAS unsigned char* lds) {
    const int tid = fresh_tid(), lane = tid & 63, wave = tid >> 6;
    const int gw = blockIdx.x * 8 + wave, NGW = gridDim.x * 8;
    unsigned char* ws = p.ws;
    LAS float* scr = (LAS float*)(lds + wave * 8448);
    LAS float* gwt = (LAS float*)(lds + 8 * 8448);
    { const float* g1 = p.in[1]; const float* w_in = p.in[2];
      for (int i = tid; i < 8192; i += 512) { const int j = i & 7, k = i >> 3; gwt[j * 1024 + k] = g1[k] * w_in[(size_t)k * NIN_ + 2048 + j]; } }
    {
        const int nmat = 63;
        int base = 0;
        for (int mi = 0; mi < nmat; ++mi) {
            const float* W; int ldw, c0, ncols, K; const float* ks = nullptr; float sc = 1.f; bf16_t* WT; int ldt, roff = 0;
            if (mi == 0) { W = p.in[2]; ldw = NIN_; c0 = 0; ncols = 2048; K = 1024; ks = p.in[1]; WT = (bf16_t*)(ws + WS_WIN); ldt = 1024; roff = 0; }
            else if (mi == 1) { W = p.in[2]; ldw = NIN_; c0 = 2056; ncols = 2560; K = 1024; ks = p.in[1]; WT = (bf16_t*)(ws + WS_WIN); ldt = 1024; roff = 2048; }
            else if (mi < 6) { const int h = mi - 2; W = p.in[6] + h * 65536; ldw = 256; c0 = 0; ncols = 256; K = 256; WT = (bf16_t*)(ws + WS_WQK) + h * 512 * 256; ldt = 256; roff = 0; }
            else if (mi < 10) { const int h = mi - 6; W = p.in[7] + h * 65536; ldw = 256; c0 = 0; ncols = 256; K = 256; sc = 0.0625f; WT = (bf16_t*)(ws + WS_WQK) + h * 512 * 256; ldt = 256; roff = 256; }
            else if (mi < 14) { const int h = mi - 10; W = p.in[8] + h * 65536; ldw = 256; c0 = 0; ncols = 256; K = 256; WT = (bf16_t*)(ws + WS_WV) + h * 65536; ldt = 256; roff = 0; }
            else if (mi == 14) { W = p.in[19]; ldw = 512; c0 = 0; ncols = 512; K = 512; WT = (bf16_t*)(ws + WS_WGLU); ldt = 512; }
            else if (mi == 15) { W = p.in[21]; ldw = 1024; c0 = 0; ncols = 1024; K = 1024; WT = (bf16_t*)(ws + WS_WA); ldt = 1024; }
            else if (mi == 16) { W = p.in[22]; ldw = 1024; c0 = 0; ncols = 1024; K = 512; WT = (bf16_t*)(ws + WS_WB); ldt = 512; }
            else if (mi == 17) { W = p.in[23]; ldw = 1024; c0 = 0; ncols = 1024; K = 1024; WT = (bf16_t*)(ws + WS_WOUT); ldt = 1024; }
            else if (mi < 62) { const int qq = mi - 18, pn = qq >> 1, bj = qq & 1;
                W = p.in[25]; ldw = F2_; c0 = bj * F_ + pn * 128; ncols = 128; K = 1024; ks = p.in[24]; WT = (bf16_t*)(ws + WS_WUP); ldt = 1024; roff = pn * 256 + bj * 128; }
            else { W = p.in[28]; ldw = 1024; c0 = 0; ncols = 1024; K = F_; WT = (bf16_t*)(ws + WS_WDN); ldt = F_; }
            const int nblk = ncols / 32, nit = (K / 64) * nblk;
            int it = gw - (base % NGW); if (it < 0) it += NGW;
            for (; it < nit; it += NGW) transpose_item(W, ldw, c0, ks, sc, WT, ldt, roff, scr, it / nblk, it % nblk, lane);
            base += nit;
        }
    }
    {
        const int gt = blockIdx.x * 512 + tid;
        if (gt < SG_ * SP_) {
            const int g = gt >> 6, pp = gt & 63;
            const float ar = p.in[11][gt], ai = p.in[12][gt], dt = expf(p.in[13][g]);
            const float mag = expf(dt * ar); float sn, cs; sincosf(dt * ai, &sn, &cs);
            const float abr = mag * cs, abi = mag * sn;
            const float den = ar * ar + ai * ai, xr = abr - 1.0f, xi = abi;
            const float rre = (xr * ar + xi * ai) / den, rim = (xi * ar - xr * ai) / den;
            float* A = (float*)(ws + WS_S5A); bf16_t* BbT = (bf16_t*)(ws + WS_S5BT);
            A[gt * 2] = abr; A[gt * 2 + 1] = abi;
            const float* bre = p.in[14] + (size_t)gt * 16; const float* bim = p.in[15] + (size_t)gt * 16;
            for (int c = 0; c < 16; ++c) { const float br = bre[c], bi = bim[c];
                BbT[((size_t)(g * 128 + pp)) * 16 + c] = f2bf(rre * br - rim * bi); BbT[((size_t)(g * 128 + 64 + pp)) * 16 + c] = f2bf(rre * bi + rim * br); }
        }
        bf16_t* CmT = (bf16_t*)(ws + WS_S5CT);
        for (int i = blockIdx.x * 512 + tid; i < SG_ * 16 * 128; i += gridDim.x * 512) { const int k = i & 127, gc = i >> 7;
            CmT[i] = f2bf(k < 64 ? p.in[16][(size_t)gc * 64 + k] : -p.in[17][(size_t)gc * 64 + k - 64]); }
    }
    { float* z = (float*)(ws + WS_SS1); for (int i = blockIdx.x * 512 + tid; i < T_; i += gridDim.x * 512) z[i] = 0.f; }
    {
        float* bp = (float*)(ws + WS_BIASP); const float* b_in = p.in[3];
        for (int i = blockIdx.x * 512 + tid; i < NP1_; i += gridDim.x * 512) bp[i] = b_in[i < 2048 ? i : i + 8];
    }
    __syncthreads();
    {
        const float* x = p.in[0]; const float* b_in = p.in[3];
        bf16_t* xb = (bf16_t*)(ws + R0); float* rinv1 = (float*)(ws + WS_RINV1); float* ig = (float*)(ws + WS_IG); float* fg = (float*)(ws + WS_FG);
        for (int row = gw; row < T_; row += NGW) {
            const f32x4* xr = (const f32x4*)(x + (size_t)row * 1024) + lane;
            f32x4 v[4]; float s = 0.f;
#pragma unroll
            for (int j = 0; j < 4; ++j) { v[j] = xr[64 * j]; s += (v[j][0] * v[j][0] + v[j][1] * v[j][1]) + (v[j][2] * v[j][2] + v[j][3] * v[j][3]); }
            float d[8];
#pragma unroll
            for (int g = 0; g < 8; ++g) { float a = 0.f;
#pragma unroll
                for (int j = 0; j < 4; ++j) { const f32x4 w = *(const LAS f32x4*)(gwt + g * 1024 + 256 * j + 4 * lane); a += (v[j][0] * w[0] + v[j][1] * w[1]) + (v[j][2] * w[2] + v[j][3] * w[3]); }
                d[g] = a; }
            s = wave_sum(s);
#pragma unroll
            for (int g = 0; g < 8; ++g) d[g] = wave_sum(d[g]);
            const float ri = rsqrtf(s * (1.0f / 1024.0f) + EPS_);
            u32x2* o8 = (u32x2*)(xb + (size_t)row * 1024) + lane;
#pragma unroll
            for (int j = 0; j < 4; ++j) { u32x2 w; w.x = cvt_pk_bf16(v[j][0], v[j][1]); w.y = cvt_pk_bf16(v[j][2], v[j][3]); o8[64 * j] = w; }
            if (lane == 0) rinv1[row] = ri;
            if (lane < 8) { float val = d[0];
#pragma unroll
                for (int g = 1; g < 8; ++g) val = (lane == g) ? d[g] : val;
                val = val * ri + b_in[2048 + lane];
                if (lane < 4) ig[(size_t)row * 4 + lane] = val; else fg[(size_t)row * 4 + lane - 4] = val; }
        }
    }
}

__device__ __forceinline__ void phase_conv_m(const Params& p) {
    const bf16_t* xm = (const bf16_t*)(p.ws + R1); bf16_t* xc = (bf16_t*)(p.ws + R0);
    const float* cw = p.in[4]; const float* cb = p.in[5];
    const int total = (T_ / 16) * 128;
    for (int idx = blockIdx.x * 512 + fresh_tid(); idx < total; idx += gridDim.x * 512) {
        const int cgi = idx & 127, tb = idx >> 7, c0 = cgi * 8, t0 = tb * 16;
        float w[4][8], b[8];
#pragma unroll
        for (int k = 0; k < 4; ++k) { const f32x4 a = *(const f32x4*)(cw + k * 1024 + c0), bb = *(const f32x4*)(cw + k * 1024 + c0 + 4);
#pragma unroll
            for (int j = 0; j < 4; ++j) { w[k][j] = a[j]; w[k][4 + j] = bb[j]; } }
        { const f32x4 a = *(const f32x4*)(cb + c0), bb = *(const f32x4*)(cb + c0 + 4);
#pragma unroll
          for (int j = 0; j < 4; ++j) { b[j] = a[j]; b[4 + j] = bb[j]; } }
        float r0[8], r1[8], r2[8], r3[8];
        const bool head = (t0 & (SEQ_ - 1)) == 0;
        if (head) {
#pragma unroll
            for (int j = 0; j < 8; ++j) { r0[j] = 0.f; r1[j] = 0.f; r2[j] = 0.f; } }
        else { unpack8(*(const u32x4*)(xm + (size_t)(t0 - 3) * 1024 + c0), r0); unpack8(*(const u32x4*)(xm + (size_t)(t0 - 2) * 1024 + c0), r1); unpack8(*(const u32x4*)(xm + (size_t)(t0 - 1) * 1024 + c0), r2); }
#pragma unroll 4
        for (int i = 0; i < 16; ++i) {
            unpack8(*(const u32x4*)(xm + (size_t)(t0 + i) * 1024 + c0), r3);
            float o[8];
#pragma unroll
            for (int j = 0; j < 8; ++j) { const float y = b[j] + w[0][j] * r0[j] + w[1][j] * r1[j] + w[2][j] * r2[j] + w[3][j] * r3[j]; o[j] = siluf_(y); }
            *(u32x4*)(xc + (size_t)(t0 + i) * 1024 + c0) = pack8(o);
#pragma unroll
            for (int j = 0; j < 8; ++j) { r0[j] = r1[j]; r1[j] = r2[j]; r2[j] = r3[j]; }
        }
    }
}

__device__ __forceinline__ void phase_gates(const Params& p, LAS unsigned char* lds) {
    const int tid = fresh_tid(), lane = tid & 63, wave = __builtin_amdgcn_readfirstlane(tid >> 6);
    const float* IG = (const float*)(p.ws + WS_IG); const float* FG = (const float*)(p.ws + WS_FG); float* GS = (float*)(p.ws + WS_GS);
    LAS float* LB = (LAS float*)lds; LAS float* LC = LB + 64; LAS float* Lm = LB + 128;
    for (int item = blockIdx.x; item < 32; item += gridDim.x) {
        const int b = item >> 2, h = item & 3;
        float av[8], bv[8], pv[8];
#pragma unroll
        for (int cc = 0; cc < 8; ++cc) {
            const int ch = wave * 8 + cc; const size_t t = (size_t)b * SEQ_ + ch * 64 + lane;
            const float fgv = FG[t * 4 + h], li = IG[t * 4 + h];
            const float lf = fminf(fgv, 0.f) - log1pf(expf(-fabsf(fgv)));
            float bc = lf;
#pragma unroll
            for (int o = 1; o < 64; o <<= 1) { const float x = __shfl_up(bc, o); if (lane >= o) bc += x; }
            const float a = li - bc; float pm = a;
#pragma unroll
            for (int o = 1; o < 64; o <<= 1) { const float x = __shfl_up(pm, o); if (lane >= o) pm = fmaxf(pm, x); }
            av[cc] = a; bv[cc] = bc; pv[cc] = pm;
            if (lane == 63) { LB[ch] = bc; LC[ch] = bc + pm; }
        }
        __syncthreads();
        if (tid == 0) { float m = 0.f; for (int j = 0; j < 64; ++j) { Lm[j] = m; m = fmaxf(m + LB[j], LC[j]); } }
        __syncthreads();
#pragma unroll
        for (int cc = 0; cc < 8; ++cc) {
            const int ch = wave * 8 + cc; const float m = Lm[ch];
            const float Mq = fmaxf(m, pv[cc]); const float M63 = __shfl(Mq, 63);
            float* gs = GS + ((size_t)item * 64 + ch) * 384;
            gs[lane] = av[cc]; gs[64 + lane] = Mq; gs[128 + lane] = expf(m - Mq); gs[192 + lane] = expf(-(bv[cc] + Mq)); gs[256 + lane] = expf(av[cc] - M63);
            if (lane == 0) gs[320] = expf(m - M63);
        }
        __syncthreads();
    }
}

typedef short s16x4 __attribute__((ext_vector_type(4)));
__device__ __forceinline__ bf16x8 lds_tr_frag(const LAS bf16_t* p, int row_stride) {
    const s16x4 lo = __builtin_amdgcn_ds_read_tr16_b64_v4i16((LAS s16x4*)p);
    const s16x4 hi = __builtin_amdgcn_ds_read_tr16_b64_v4i16((LAS s16x4*)(p + 4 * row_stride));
    return (bf16x8){lo[0], lo[1], lo[2], lo[3], hi[0], hi[1], hi[2], hi[3]};
}
constexpr int ML_QN = 0, ML_KN = 33792, ML_VN = 67584, ML_VW = 74752, ML_SW = 81920, ML_CB = 91136, ML_DEN = 116480;
__device__ __forceinline__ void phase_mlstm(const Params& p, LAS unsigned char* lds) {
    const int tid = fresh_tid(), lane = tid & 63, w = __builtin_amdgcn_readfirstlane(tid >> 6), qi = w & 3, half = w >> 2, lr = lane & 15, lg = lane >> 4;
    const bf16_t* Q = (const bf16_t*)p.out; const bf16_t* Kk = (const bf16_t*)p.out + (size_t)T_ * 1024; const bf16_t* V = (const bf16_t*)(p.ws + R6);
    bf16_t* HC = (bf16_t*)(p.ws + R1);
    const float* GS = (const float*)(p.ws + WS_GS);
    LAS bf16_t* QN = (LAS bf16_t*)(lds + ML_QN);
    LAS bf16_t* KN = (LAS bf16_t*)(lds + ML_KN);
    LAS bf16_t* VN = (LAS bf16_t*)(lds + ML_VN);
    LAS bf16_t* VW = (LAS bf16_t*)(lds + ML_VW);
    LAS bf16_t* Sw = (LAS bf16_t*)(lds + ML_SW);
    LAS bf16_t* Cb = (LAS bf16_t*)(lds + ML_CB);
    LAS float* sc_den = (LAS float*)(lds + ML_DEN);
    const int trq = lr >> 2, trp = 4 * (lr & 3);
    for (int item = blockIdx.x; item < 256; item += gridDim.x) {
        const int bh = item & 31, vs = item >> 5, b = bh >> 2, h = bh & 3;
        const size_t tok0 = (size_t)b * SEQ_;
        __syncthreads();
        for (int i = tid; i < 48 * 264 / 2; i += 512) ((LAS unsigned*)Cb)[i] = 0u;
        for (int i = tid; i < 2 * 64 * 56 / 2; i += 512) ((LAS unsigned*)VN)[i] = 0u;
        f32x4 Cacc[2][3];
#pragma unroll
        for (int a_ = 0; a_ < 2; ++a_)
#pragma unroll
            for (int c_ = 0; c_ < 3; ++c_) Cacc[a_][c_] = (f32x4){0.f, 0.f, 0.f, 0.f};
        u32x4 qreg[4], kreg[4], vreg = (u32x4){0u, 0u, 0u, 0u};
        float sMq, swi, semr, swk, sdecay; f32x4 sa[2];
        const int vsel = tid < 256 ? (tid >> 2) : (tid < 320 ? tid - 256 : 0);
#define ML_GLOAD(tc0_) do { _Pragma("unroll") for (int i_ = 0; i_ < 4; ++i_) { const int pi = tid + 512 * i_; const size_t go = ((tc0_) + (pi >> 5)) * 1024 + h * 256 + (pi & 31) * 8; \
            qreg[i_] = *(const u32x4*)(Q + go); kreg[i_] = *(const u32x4*)(Kk + go); } \
            if (tid < 256) vreg = *(const u32x4*)(V + ((tc0_) + (tid >> 2)) * 1024 + h * 256 + vs * 32 + (tid & 3) * 8); } while (0)
#define ML_GSCAL(gs_) do { sMq = (gs_)[64 + 16 * qi + lr]; swi = (gs_)[128 + 16 * qi + lr]; semr = (gs_)[192 + 16 * qi + lr]; swk = (gs_)[256 + vsel]; sdecay = (gs_)[320]; \
            sa[0] = *(const f32x4*)((gs_) + 16 * (2 * half) + 4 * lg); sa[1] = *(const f32x4*)((gs_) + 16 * (2 * half + 1) + 4 * lg); } while (0)
#define ML_LWRITE() do { _Pragma("unroll") for (int i_ = 0; i_ < 4; ++i_) { const int pi = tid + 512 * i_; const int lo_ = (pi >> 5) * 264 + (pi & 31) * 8; \
            *(LAS u32x4*)(QN + lo_) = qreg[i_]; *(LAS u32x4*)(KN + lo_) = kreg[i_]; } \
            if (tid < 256) { float vv[8], vw[8]; unpack8(vreg, vv); _Pragma("unroll") for (int j = 0; j < 8; ++j) vw[j] = vv[j] * swk; \
                *(LAS u32x4*)(VN + (tid >> 2) * 56 + (tid & 3) * 8) = vreg; *(LAS u32x4*)(VW + (tid >> 2) * 56 + (tid & 3) * 8) = pack8(vw); } \
            else if (tid < 320) { VN[(tid - 256) * 56 + 32] = (bf16_t)0x3f80; VW[(tid - 256) * 56 + 32] = f2bf(swk); } } while (0)
        { ML_GLOAD(tok0); const float* gs = GS + ((size_t)bh * 64) * 384; ML_GSCAL(gs); }
        __syncthreads();
        ML_LWRITE();
        __syncthreads();
        for (int ch = 0; ch < NCH_; ++ch) {
            const size_t tc0 = tok0 + (size_t)ch * 64;
            const int chn = ch + 1 < NCH_ ? ch + 1 : ch; const size_t tcn = tok0 + (size_t)chn * 64;
            const float* gsn = GS + ((size_t)bh * 64 + chn) * 384;
            const float cMq = sMq, cwi = swi, cemr = semr, cdecay = sdecay; const f32x4 ca0 = sa[0], ca1 = sa[1];
            ML_GLOAD(tcn); ML_GSCAL(gsn);
            bf16x8 qf[8];
#pragma unroll
            for (int ks = 0; ks < 8; ++ks) qf[ks] = *(const LAS bf16x8*)(QN + (16 * qi + lr) * 264 + 32 * ks + 8 * lg);
            f32x4 St[2];
#pragma unroll
            for (int jj = 0; jj < 2; ++jj) { St[jj] = (f32x4){0.f, 0.f, 0.f, 0.f};
#pragma unroll
                for (int ks = 0; ks < 8; ++ks) { const bf16x8 kfr = *(const LAS bf16x8*)(KN + (16 * (2 * half + jj) + lr) * 264 + 32 * ks + 8 * lg);
                    St[jj] = __builtin_amdgcn_mfma_f32_16x16x32_bf16(kfr, qf[ks], St[jj], 0, 0, 0); } }
#pragma unroll
            for (int jj = 0; jj < 2; ++jj) { const int kt = 2 * half + jj; const int qtok = 16 * qi + lr, k0 = 16 * kt + 4 * lg; const f32x4 av = jj == 0 ? ca0 : ca1;
                float o[4];
#pragma unroll
                for (int r = 0; r < 4; ++r) { const float wgt = (k0 + r <= qtok) ? __expf(av[r] - cMq) : 0.f; o[r] = St[jj][r] * wgt; }
                u32x2 pk; pk.x = cvt_pk_bf16(o[0], o[1]); pk.y = cvt_pk_bf16(o[2], o[3]);
                *(LAS u32x2*)(Sw + qtok * 72 + k0) = pk; }
            __syncthreads();
            f32x4 num[2]; num[0] = (f32x4){0.f, 0.f, 0.f, 0.f}; num[1] = (f32x4){0.f, 0.f, 0.f, 0.f};
            const int nvt = half == 0 ? 2 : 1, vt0 = half == 0 ? 0 : 2;
#pragma unroll
            for (int i = 0; i < 2; ++i) if (i < nvt) {
                const int vn = vt0 + i;
#pragma unroll
                for (int ks = 0; ks < 8; ++ks) { const bf16x8 cf = *(const LAS bf16x8*)(Cb + (16 * vn + lr) * 264 + 32 * ks + 8 * lg);
                    num[i] = __builtin_amdgcn_mfma_f32_16x16x32_bf16(cf, qf[ks], num[i], 0, 0, 0); }
                num[i] *= cwi;
#pragma unroll
                for (int k2 = 0; k2 < 2; ++k2) { const bf16x8 sf = *(const LAS bf16x8*)(Sw + (16 * qi + lr) * 72 + 32 * k2 + 8 * lg);
                    const bf16x8 vf = lds_tr_frag(VN + (32 * k2 + 8 * lg + trq) * 56 + 16 * vn + trp, 56);
                    num[i] = __builtin_amdgcn_mfma_f32_16x16x32_bf16(vf, sf, num[i], 0, 0, 0); }
            }
            if (half == 1 && lg == 0) sc_den[16 * qi + lr] = num[0][0];
            {
                bf16x8 vwf[3][2];
#pragma unroll
                for (int vn = 0; vn < 3; ++vn)
#pragma unroll
                    for (int k2 = 0; k2 < 2; ++k2) vwf[vn][k2] = lds_tr_frag(VW + (32 * k2 + 8 * lg + trq) * 56 + 16 * vn + trp, 56);
#pragma unroll
                for (int dm = 0; dm < 2; ++dm) {
                    bf16x8 kf2[2];
#pragma unroll
                    for (int k2 = 0; k2 < 2; ++k2) kf2[k2] = lds_tr_frag(KN + (32 * k2 + 8 * lg + trq) * 264 + 32 * w + 16 * dm + trp, 264);
#pragma unroll
                    for (int vn = 0; vn < 3; ++vn) { f32x4 c = Cacc[dm][vn] * cdecay;
#pragma unroll
                        for (int k2 = 0; k2 < 2; ++k2) c = __builtin_amdgcn_mfma_f32_16x16x32_bf16(kf2[k2], vwf[vn][k2], c, 0, 0, 0);
                        Cacc[dm][vn] = c; }
                }
            }
            __syncthreads();
            if (half == 0) {
                const float dn = __builtin_amdgcn_rcpf(fmaxf(fabsf(sc_den[16 * qi + lr]), cemr));
#pragma unroll
                for (int i = 0; i < 2; ++i) { u32x2 pk; pk.x = cvt_pk_bf16(num[i][0] * dn, num[i][1] * dn); pk.y = cvt_pk_bf16(num[i][2] * dn, num[i][3] * dn);
                    *(u32x2*)(HC + (tc0 + 16 * qi + lr) * 1024 + h * 256 + vs * 32 + 16 * i + 4 * lg) = pk; }
            }
#pragma unroll
            for (int dm = 0; dm < 2; ++dm)
#pragma unroll
                for (int vn = 0; vn < 3; ++vn) { const f32x4 c = Cacc[dm][vn]; u32x2 pk; pk.x = cvt_pk_bf16(c[0], c[1]); pk.y = cvt_pk_bf16(c[2], c[3]);
                    *(LAS u32x2*)(Cb + (16 * vn + lr) * 264 + 32 * w + 16 * dm + 4 * lg) = pk; }
            ML_LWRITE();
            __syncthreads();
        }
#undef ML_GLOAD
#undef ML_GSCAL
#undef ML_LWRITE
    }
}

__device__ __forceinline__ void phase_aout(const Params& p) {
    const int tid = fresh_tid(), lane = tid & 63, gw = blockIdx.x * 8 + (tid >> 6), NGW = gridDim.x * 8;
    const bf16_t* HC = (const bf16_t*)(p.ws + R1); const bf16_t* SOM = (const bf16_t*)(p.ws + R2); const bf16_t* XC = (const bf16_t*)(p.ws + R0);
    bf16_t* AO = (bf16_t*)(p.ws + R6);
    const float* hg = p.in[9]; const float* sk = p.in[10];
    for (int t = gw; t < T_; t += NGW) {
#pragma unroll
        for (int h = 0; h < 4; ++h) {
            const size_t off = (size_t)t * 1024 + h * 256 + 4 * lane;
            const u32x2 hw = *(const u32x2*)(HC + off), ow = *(const u32x2*)(SOM + off), xw = *(const u32x2*)(XC + off);
            const f32x4 g4 = *(const f32x4*)(hg + h * 256 + 4 * lane), s4 = *(const f32x4*)(sk + h * 256 + 4 * lane);
            float hv[4] = {bflo(hw.x), bfhi(hw.x), bflo(hw.y), bfhi(hw.y)};
            const float ov[4] = {bflo(ow.x), bfhi(ow.x), bflo(ow.y), bfhi(ow.y)}, xv[4] = {bflo(xw.x), bfhi(xw.x), bflo(xw.y), bfhi(xw.y)};
            const float mu = wave_sum((hv[0] + hv[1]) + (hv[2] + hv[3])) * (1.0f / 256.0f);
#pragma unroll
            for (int j = 0; j < 4; ++j) hv[j] -= mu;
            const float var = wave_sum((hv[0] * hv[0] + hv[1] * hv[1]) + (hv[2] * hv[2] + hv[3] * hv[3])) * (1.0f / 256.0f);
            const float rs = rsqrtf(var + EPS_);
            float o[4];
#pragma unroll
            for (int j = 0; j < 4; ++j) o[j] = ov[j] * (hv[j] * rs * g4[j]) + s4[j] * xv[j];
            u32x2 wv; wv.x = cvt_pk_bf16(o[0], o[1]); wv.y = cvt_pk_bf16(o[2], o[3]);
            *(u32x2*)(AO + off) = wv;
        }
    }
}

__device__ __forceinline__ bf16x8 s5_load_af(const bf16_t* US, size_t tokb, int g, int lane) {
    const int lr = lane & 15, lg = lane >> 4;
    bf16x8 af = *(const bf16x8*)(US + (tokb + lr) * 512 + g * 16 + 8 * (lg & 1));
    if (lg >= 2) af = (bf16x8){0, 0, 0, 0, 0, 0, 0, 0};
    return af;
}
template <bool PASS_C>
__device__ __forceinline__ void s5_block16(const bf16x8 af, int lane, const bf16x8 (&bbf)[8], LAS float* but, LAS bf16_t* stb, float ar, float ai, float& sr, float& si) {
    const int lr = lane & 15, lg = lane >> 4;
#pragma unroll
    for (int ct = 0; ct < 8; ++ct) { const f32x4 d = __builtin_amdgcn_mfma_f32_16x16x32_bf16(af, bbf[ct], (f32x4){0.f, 0.f, 0.f, 0.f}, 0, 0, 0);
#pragma unroll
        for (int r = 0; r < 4; ++r) but[(4 * lg + r) * 132 + 16 * ct + lr] = d[r]; }
#pragma unroll 4
    for (int tt = 0; tt < 16; ++tt) { const float br = but[tt * 132 + lane], bi = but[tt * 132 + 64 + lane];
        const float nr = ar * sr - ai * si + br, ni = ar * si + ai * sr + bi; sr = nr; si = ni;
        if (PASS_C) { stb[tt * 136 + lane] = f2bf(sr); stb[tt * 136 + 64 + lane] = f2bf(si); } }
}
__device__ __forceinline__ void phase_s5(const Params& p, LAS unsigned char* lds) {
    const int tid = fresh_tid(), lane = tid & 63, wave = __builtin_amdgcn_readfirstlane(tid >> 6), lr = lane & 15, lg = lane >> 4;
    const bf16_t* US = (const bf16_t*)(p.ws + R5);
    const float* A = (const float*)(p.ws + WS_S5A); const bf16_t* BbT = (const bf16_t*)(p.ws + WS_S5BT); const bf16_t* CmT = (const bf16_t*)(p.ws + WS_S5CT);
    bf16_t* YB = (bf16_t*)(p.ws + R7);
    LAS float* but = (LAS float*)(lds + wave * 16896);
    LAS bf16_t* stb = (LAS bf16_t*)(lds + wave * 16896 + 8448);
    LAS float* Eb = (LAS float*)(lds + 8 * 16896);
    for (int item = blockIdx.x; item < NB_ * SG_; item += gridDim.x) {
        const int b = item & 7, g = item >> 3, gp = g * 64 + lane;
        const float ar = A[gp * 2], ai = A[gp * 2 + 1];
        bf16x8 bbf[8];
#pragma unroll
        for (int ct = 0; ct < 8; ++ct) { bbf[ct] = *(const bf16x8*)(BbT + ((size_t)(g * 128 + 16 * ct + lr)) * 16 + 8 * (lg & 1)); if (lg >= 2) bbf[ct] = (bf16x8){0, 0, 0, 0, 0, 0, 0, 0}; }
        const size_t tokw = (size_t)b * SEQ_ + (size_t)wave * 512;
        float sr = 0.f, si = 0.f;
        { bf16x8 afc = s5_load_af(US, tokw, g, lane);
          for (int blk = 0; blk < 32; ++blk) { const int bn = blk + 1 < 32 ? blk + 1 : blk; const bf16x8 afn = s5_load_af(US, tokw + bn * 16, g, lane);
              s5_block16<false>(afc, lane, bbf, but, stb, ar, ai, sr, si); afc = afn; } }
        Eb[(wave * 64 + lane) * 2] = sr; Eb[(wave * 64 + lane) * 2 + 1] = si;
        __syncthreads();
        float pr = ar, pi = ai;
#pragma unroll
        for (int i = 0; i < 9; ++i) { const float nr = pr * pr - pi * pi, ni = 2.f * pr * pi; pr = nr; pi = ni; }
        sr = 0.f; si = 0.f;
        for (int j = 0; j < wave; ++j) { const float er = Eb[(j * 64 + lane) * 2], ei = Eb[(j * 64 + lane) * 2 + 1]; const float nr = pr * sr - pi * si + er, ni = pr * si + pi * sr + ei; sr = nr; si = ni; }
        bf16x8 cmf[4];
#pragma unroll
        for (int kk = 0; kk < 4; ++kk) cmf[kk] = *(const bf16x8*)(CmT + ((size_t)(g * 16 + lr)) * 128 + 32 * kk + 8 * lg);
        const float dsk = p.in[18][g * 16 + lr];
        bf16x8 afc = s5_load_af(US, tokw, g, lane);
        bf16_t uuc[4];
#pragma unroll
        for (int r = 0; r < 4; ++r) uuc[r] = US[(tokw + 4 * lg + r) * 512 + g * 16 + lr];
        for (int blk = 0; blk < 32; ++blk) {
            const size_t tokb = tokw + blk * 16;
            const int bn = blk + 1 < 32 ? blk + 1 : blk; const bf16x8 afn = s5_load_af(US, tokw + bn * 16, g, lane);
            bf16_t uun[4];
#pragma unroll
            for (int r = 0; r < 4; ++r) uun[r] = US[(tokw + bn * 16 + 4 * lg + r) * 512 + g * 16 + lr];
            s5_block16<true>(afc, lane, bbf, but, stb, ar, ai, sr, si);
            f32x4 y = (f32x4){0.f, 0.f, 0.f, 0.f};
#pragma unroll
            for (int kk = 0; kk < 4; ++kk) { const bf16x8 sf = *(const LAS bf16x8*)(stb + lr * 136 + 32 * kk + 8 * lg); y = __builtin_amdgcn_mfma_f32_16x16x32_bf16(sf, cmf[kk], y, 0, 0, 0); }
#pragma unroll
            for (int r = 0; r < 4; ++r) { const size_t tok = tokb + 4 * lg + r; const float uu = bf2f(uuc[r]);
                const float v = y[r] + dsk * uu;
                const float z = 0.7978845608f * (v + 0.044715f * v * v * v); const float th = 1.0f - 2.0f * __builtin_amdgcn_rcpf(1.0f + __expf(2.0f * z));
                YB[tok * 512 + g * 16 + lr] = f2bf(0.5f * v * (1.0f + th)); }
            afc = afn;
#pragma unroll
            for (int r = 0; r < 4; ++r) uuc[r] = uun[r];
        }
        __syncthreads();
    }
}

__device__ __forceinline__ void phase_ffn_fix(const Params& p) {
    const bf16_t* SIDE = (const bf16_t*)(p.ws + WS_SIDE); bf16_t* ACT = (bf16_t*)(p.ws + WS_ACT);
    const float* cw = p.in[26]; const float* cb = p.in[27];
    const int total = 128 * 2 * 352;
    for (int idx = blockIdx.x * 512 + fresh_tid(); idx < total; idx += gridDim.x * 512) {
        const int fg = idx % 352, s2 = (idx / 352) & 1, pm = idx / 704, f0 = fg * 8;
        float va[8], vb[8], vc[8], vd[8], ga[8], gb[8], gc[8], gd[8];
        const bf16_t* cur = SIDE + (size_t)pm * 8 * F2_ + f0;
        if (s2 == 0) {
            if ((pm & 15) == 0) {
#pragma unroll
                for (int j = 0; j < 8; ++j) { va[j] = 0.f; vb[j] = 0.f; ga[j] = 0.f; gb[j] = 0.f; } }
            else { const bf16_t* prv = SIDE + (size_t)(pm - 1) * 8 * F2_ + f0;
                unpack8(*(const u32x4*)(prv + 6 * F2_), va); unpack8(*(const u32x4*)(prv + 7 * F2_), vb); unpack8(*(const u32x4*)(prv + 6 * F2_ + F_), ga); unpack8(*(const u32x4*)(prv + 7 * F2_ + F_), gb); }
            unpack8(*(const u32x4*)(cur), vc); unpack8(*(const u32x4*)(cur + F2_), vd); unpack8(*(const u32x4*)(cur + F_), gc); unpack8(*(const u32x4*)(cur + F2_ + F_), gd);
        } else {
            unpack8(*(const u32x4*)(cur + 2 * F2_), va); unpack8(*(const u32x4*)(cur + 3 * F2_), vb); unpack8(*(const u32x4*)(cur + 2 * F2_ + F_), ga); unpack8(*(const u32x4*)(cur + 3 * F2_ + F_), gb);
            unpack8(*(const u32x4*)(cur + 4 * F2_), vc); unpack8(*(const u32x4*)(cur + 5 * F2_), vd); unpack8(*(const u32x4*)(cur + 4 * F2_ + F_), gc); unpack8(*(const u32x4*)(cur + 5 * F2_ + F_), gd);
        }
        float o0[8], o1[8];
#pragma unroll
        for (int j = 0; j < 8; ++j) { const int f = f0 + j;
            const float wv0 = cw[f], wv1 = cw[F2_ + f], wv2 = cw[2 * F2_ + f], wg0 = cw[F_ + f], wg1 = cw[F2_ + F_ + f], wg2 = cw[2 * F2_ + F_ + f], bv = cb[f], bg = cb[F_ + f];
            o0[j] = ffn_gate(bg, wg0, wg1, wg2, ga[j], gb[j], gc[j], bv, wv0, wv1, wv2, va[j], vb[j], vc[j]);
            o1[j] = ffn_gate(bg, wg0, wg1, wg2, gb[j], gc[j], gd[j], bv, wv0, wv1, wv2, vb[j], vc[j], vd[j]); }
        bf16_t* op = ACT + ((size_t)pm * 256 + 128 * s2) * F_ + f0;
        *(u32x4*)(op) = pack8(o0); *(u32x4*)(op + F_) = pack8(o1);
    }
}

__device__ __forceinline__ void phase_final(const Params& p) {
    const int tid = fresh_tid(), lane = tid & 63, gw = blockIdx.x * 8 + (tid >> 6), NGW = gridDim.x * 8;
    const float* ss = (const float*)(p.ws + WS_SS2); const float* gf = p.in[29];
    for (int row = gw; row < T_; row += NGW) {
        const float sv = (lane < 16) ? ss[(size_t)row * 16 + lane] : 0.f;
        const float ri = rsqrtf(wave_sum(sv) * (1.0f / 1024.0f) + EPS_);
        f32x4* xr = (f32x4*)(p.out + (size_t)row * 1024) + lane;
#pragma unroll
        for (int j = 0; j < 4; ++j) { const f32x4 g4 = *((const f32x4*)gf + lane + 64 * j); f32x4 v = xr[64 * j]; v = v * ri * g4; xr[64 * j] = v; }
    }
}

#ifndef PHASE_MASK
#define PHASE_MASK 0xffffffffu
#endif
#define PH(k) ((PHASE_MASK >> (k)) & 1u)
#ifndef REP_MASK
#define REP_MASK 0u
#endif
#define REPS(k) for (int rep_ = 0; rep_ < 1 + (int)((REP_MASK >> (k)) & 1u); ++rep_)
__global__ void __launch_bounds__(512, 2) fwd_megakernel(Params p) {
    extern __shared__ __attribute__((aligned(16))) unsigned char lds_raw[];
    LAS unsigned char* lds = (LAS unsigned char*)lds_raw;
    cg::grid_group grid = cg::this_grid();
    unsigned char* ws = p.ws;
    bf16_t* dq = (bf16_t*)p.out;
    volatile LAS unsigned* bst = (volatile LAS unsigned*)(lds + LDS_BYTES - 64);
    if (threadIdx.x < 2) bst[threadIdx.x] = 0u;
    if (blockIdx.x == 0) { unsigned* bw = (unsigned*)(ws + WS_BAR); for (int i = threadIdx.x; i < XCD_BAR_WORDS; i += 512) bw[i] = 0u; }
    __syncthreads();
    REPS(0) if (PH(0)) phase0(p, lds);
    grid.sync();
    const XcdBarrier xbar = xcd_barrier_post((unsigned*)(ws + WS_BAR), bst);
    REPS(1) if (PH(1)) { pg8::PlainSched S; S.set(ws + R0, 1024, ws + WS_WIN, 1024, T_ / 256, NP1_ / 256);
      EpiProj E{(const float*)(ws + WS_RINV1), (const float*)(ws + WS_BIASP), (bf16_t*)(ws + R1), (bf16_t*)(ws + R2), (bf16_t*)(ws + R5), (bf16_t*)(ws + R3), (bf16_t*)(ws + R4)};
      pg8::gemm_phase(lds, S, E, 1024, 1024, 1024); }
    xcd_barrier(xbar);
    REPS(2) if (PH(2)) { phase_gates(p, lds); phase_conv_m(p); }
    xcd_barrier(xbar);
    REPS(3) if (PH(3)) { SchedQKV S; S.init(T_ / 256, 12, gridDim.x, blockIdx.x); S.xc = (const char*)(ws + R0); S.xm = (const char*)(ws + R1); S.wqk = (const char*)(ws + WS_WQK); S.wv = (const char*)(ws + WS_WV);
      EpiQKV E{dq, (bf16_t*)(ws + R6)};
      pg8::gemm_phase(lds, S, E, 256, 1024, 256); }
    xcd_barrier(xbar);
    REPS(4) if (PH(4)) phase_mlstm(p, lds);
    xcd_barrier(xbar);
    REPS(5) if (PH(5)) phase_aout(p);
    REPS(6) if (PH(6)) phase_s5(p, lds);
    xcd_barrier(xbar);
    REPS(8) if (PH(8)) { pg8::PlainSched S; S.set(ws + R7, 512, ws + WS_WGLU, 512, T_ / 256, 2);
      EpiGate<0> E{(const bf16_t*)(ws + R7), nullptr, p.in[20], dq, 512};
      pg8::gemm_phase(lds, S, E, 512, 512, 512); }
    xcd_barrier(xbar);
    REPS(9) if (PH(9)) { pg8::PlainSched S; S.set(dq, 512, ws + WS_WB, 512, T_ / 256, 4);
      EpiGate<1> E{(const bf16_t*)(ws + R4), nullptr, nullptr, (bf16_t*)(ws + R1), 1024};
      pg8::gemm_phase(lds, S, E, 512, 512, 512); }
    xcd_barrier(xbar);
    REPS(10) if (PH(10)) { pg8::PlainSched S; S.set(ws + R6, 1024, ws + WS_WA, 1024, T_ / 256, 4);
      EpiGate<2> E{(const bf16_t*)(ws + R3), (const bf16_t*)(ws + R1), nullptr, (bf16_t*)(ws + R0), 1024};
      pg8::gemm_phase(lds, S, E, 1024, 1024, 1024); }
    xcd_barrier(xbar);
    REPS(11) if (PH(11)) { pg8::PlainSched S; S.set(ws + R0, 1024, ws + WS_WOUT, 1024, T_ / 256, 4);
      EpiResid<true> E{p.in[0], p.out, (bf16_t*)(ws + WS_X1B), (float*)(ws + WS_SS1)};
      pg8::gemm_phase(lds, S, E, 1024, 1024, 1024); }
    xcd_barrier(xbar);
    REPS(12) if (PH(12)) { pg8::PlainSched S; S.set(ws + WS_X1B, 1024, ws + WS_WUP, 1024, T_ / 256, F_ / 128);
      EpiUpFused E{(const float*)(ws + WS_SS1), p.in[26], p.in[27], (bf16_t*)(ws + WS_ACT), (bf16_t*)(ws + WS_SIDE)};
      pg8::gemm_phase(lds, S, E, 1024, 1024, 1024); }
    xcd_barrier(xbar);
    REPS(13) if (PH(13)) phase_ffn_fix(p);
    xcd_barrier(xbar);
    REPS(14) if (PH(14)) { pg8::PlainSched S; S.set(ws + WS_ACT, F_, ws + WS_WDN, F_, T_ / 256, 4);
      EpiResid<false> E{p.out, (rep_ + 1 < 1 + (int)((REP_MASK >> 14) & 1u)) ? (float*)(ws + WS_UH) : p.out, nullptr, (float*)(ws + WS_SS2)};
      pg8::gemm_phase(lds, S, E, F_, F_, F_); }
    xcd_barrier(xbar);
    REPS(15) if (PH(15)) phase_final(p);
}

extern "C" void kernel_launch(void* const* d_in, const int* in_sizes, int n_in, void* d_out, int out_size, void* d_ws, size_t ws_size, hipStream_t stream) {
    static int grid_blocks = 0;
    if (!grid_blocks) {
        int dev = 0, cus = 0, per_cu = 0;
        (void)hipGetDevice(&dev);
        (void)hipDeviceGetAttribute(&cus, hipDeviceAttributeMultiprocessorCount, dev);
        (void)hipFuncSetAttribute((const void*)fwd_megakernel, hipFuncAttributeMaxDynamicSharedMemorySize, LDS_BYTES);
        (void)hipOccupancyMaxActiveBlocksPerMultiprocessor(&per_cu, (const void*)fwd_megakernel, 512, LDS_BYTES);
        if (per_cu < 1) { fprintf(stderr, "kernel_launch: occupancy query returned %d\n", per_cu); }
        grid_blocks = cus;
        if (n_in != 30 || out_size != T_ * D_ || ws_size < 512 * MiB) fprintf(stderr, "kernel_launch: unexpected sizes n_in=%d out=%d ws=%zu\n", n_in, out_size, ws_size);
    }
    Params p{};
    for (int i = 0; i < 30; ++i) p.in[i] = (const float*)d_in[i];
    p.out = (float*)d_out; p.ws = (unsigned char*)d_ws;
    void* args[] = {&p};
    hipError_t e = hipLaunchCooperativeKernel((void*)fwd_megakernel, dim3(grid_blocks), dim3(512), args, LDS_BYTES, stream);
    if (e != hipSuccess) fprintf(stderr, "cooperative launch failed: %s (grid %d)\n", hipGetErrorString(e), grid_blocks);
}
```

```cpp
#include <hip/hip_runtime.h>
#include <hip/hip_cooperative_groups.h>
#include <cstdio>
#include <cstdint>
namespace cg = cooperative_groups;

#define LAS __attribute__((address_space(3)))
typedef unsigned short bf16_t;
typedef short bf16x8 __attribute__((ext_vector_type(8)));
typedef float f32x4 __attribute__((ext_vector_type(4)));
typedef float f32x2 __attribute__((ext_vector_type(2)));
typedef unsigned u32x4 __attribute__((ext_vector_type(4)));
typedef unsigned u32x2 __attribute__((ext_vector_type(2)));

constexpr int T_ = 32768, D_ = 1024, SEQ_ = 4096, NB_ = 8;
constexpr int NH_ = 4, DH_ = 256, NCH_ = 64;
constexpr int SW_ = 512, SG_ = 32, SP_ = 64;
constexpr int F_ = 2816, F2_ = 5632, NIN_ = 4616, NP1_ = 4608;
constexpr float EPS_ = 1e-6f;

constexpr size_t MiB = 1ull << 20, KiB = 1024;
constexpr size_t WS_WIN = 0, WS_WQK = 9 * MiB, WS_WV = 10 * MiB, WS_WGLU = 10 * MiB + 512 * KiB, WS_WA = 11 * MiB, WS_WB = 13 * MiB, WS_WOUT = 14 * MiB,
                 WS_WUP = 16 * MiB, WS_WDN = 27 * MiB;
constexpr size_t WS_S5A = 33 * MiB, WS_S5BT = WS_S5A + 32 * KiB, WS_S5CT = WS_S5A + 192 * KiB;
constexpr size_t WS_RINV1 = 34 * MiB, WS_IG = 34 * MiB + 512 * KiB, WS_FG = 35 * MiB, WS_BIASP = 35 * MiB + 512 * KiB;
constexpr size_t WS_GS = 50 * MiB;
constexpr size_t WS_BAR = 49 * MiB;
constexpr size_t WS_SS1 = 36 * MiB, WS_SS2 = 38 * MiB, WS_E = 40 * MiB;
constexpr size_t R0 = 56 * MiB, R1 = 120 * MiB, R2 = 184 * MiB, R3 = 248 * MiB, R4 = 312 * MiB, R5 = 376 * MiB, R6 = 408 * MiB, R7 = 472 * MiB;
constexpr size_t WS_X1B = 448 * MiB, WS_UH = 56 * MiB, WS_SIDE = 56 * MiB, WS_ACT = 232 * MiB;
constexpr int LDS_BYTES = 147456;

struct Params {
    const float* in[30];
    float* out;
    unsigned char* ws;
};

__device__ __forceinline__ unsigned cvt_pk_bf16(float lo, float hi) { unsigned r; asm volatile("v_cvt_pk_bf16_f32 %0, %1, %2" : "=v"(r) : "v"(lo), "v"(hi)); return r; }
__device__ __forceinline__ bf16_t f2bf(float x) { return (bf16_t)(cvt_pk_bf16(x, x) & 0xffffu); }
__device__ __forceinline__ float bf2f(unsigned short u) { return __uint_as_float(((unsigned)u) << 16); }
__device__ __forceinline__ float bflo(unsigned w) { return __uint_as_float(w << 16); }
__device__ __forceinline__ float bfhi(unsigned w) { return __uint_as_float(w & 0xffff0000u); }
__device__ __forceinline__ float sigmoidf_(float x) { return __builtin_amdgcn_rcpf(1.0f + __expf(-x)); }
__device__ __forceinline__ float siluf_(float x) { return x * sigmoidf_(x); }
__device__ __forceinline__ int fresh_tid() { int t = threadIdx.x; asm volatile("" : "+v"(t)); return t; }
__device__ __forceinline__ float wave_sum(float v) {
#pragma unroll
    for (int o = 1; o < 64; o <<= 1) v += __shfl_xor(v, o);
    return v;
}
__device__ __forceinline__ void unpack8(const u32x4 w, float (&f)[8]) {
    f[0] = bflo(w.x); f[1] = bfhi(w.x); f[2] = bflo(w.y); f[3] = bfhi(w.y); f[4] = bflo(w.z); f[5] = bfhi(w.z); f[6] = bflo(w.w); f[7] = bfhi(w.w);
}
__device__ __forceinline__ u32x4 pack8(const float (&f)[8]) {
    u32x4 w; w.x = cvt_pk_bf16(f[0], f[1]); w.y = cvt_pk_bf16(f[2], f[3]); w.z = cvt_pk_bf16(f[4], f[5]); w.w = cvt_pk_bf16(f[6], f[7]); return w;
}


#define XB_TMO      128
#define XB_XCNT(j)  (256  + 64 * (j))
#define XB_XSUB(j)  (1280 + 64 * (j))
#define XB_XGEN(j)  (2304 + 64 * (j))
#define XB_TOP      3328
#define XB_TOPGEN   3392
#define XCD_BAR_WORDS 3456
#define XB_SPIN_CAP (1u << 18)
__device__ __forceinline__ unsigned xb_ld(unsigned* p)              { return __hip_atomic_load(p, __ATOMIC_RELAXED, __HIP_MEMORY_SCOPE_AGENT); }
__device__ __forceinline__ unsigned xb_add(unsigned* p, unsigned v) { return __hip_atomic_fetch_add(p, v, __ATOMIC_RELAXED, __HIP_MEMORY_SCOPE_AGENT); }
__device__ __forceinline__ unsigned xb_xcc_id() { return (unsigned)__builtin_amdgcn_s_getreg((3 << 11) | 20) & 0xFu; }
#define XB_SPIN(cond, bar) do { unsigned _sp = 0; while (cond) { __builtin_amdgcn_s_sleep(1); \
    if ((++_sp & 255u) == 0u) { if (xb_ld(&(bar)[XB_TMO])) break; if (_sp > XB_SPIN_CAP) { atomicAdd(&(bar)[XB_TMO], 1u); break; } } } } while (0)
struct XcdBarrier { unsigned* bar; unsigned x; volatile LAS unsigned* st; };
__device__ __forceinline__ XcdBarrier xcd_barrier_post(unsigned* bar, volatile LAS unsigned* st) {
    XcdBarrier b; b.bar = bar; b.x = xb_xcc_id(); b.st = st;
    if (threadIdx.x == 0) (void)xb_add(&bar[XB_XCNT(b.x)], 1u);
    return b;
}
__device__ __forceinline__ void xcd_barrier_complete(unsigned* bar, unsigned x, unsigned& nloc, unsigned& nx) {
    const unsigned G = gridDim.x * gridDim.y * gridDim.z;
    unsigned sum, cnt, mine, sp = 0u;
    for (;;) {
        sum = 0u; cnt = 0u; mine = 0u;
#pragma unroll
        for (unsigned j = 0; j < 16; ++j) { const unsigned c = xb_ld(&bar[XB_XCNT(j)]); sum += c; cnt += (c > 0u) ? 1u : 0u; mine = (j == x) ? c : mine; }
        if (sum == G) break;
        __builtin_amdgcn_s_sleep(1);
        if ((++sp & 255u) == 0u) { if (xb_ld(&bar[XB_TMO])) break; if (sp > XB_SPIN_CAP) { atomicAdd(&bar[XB_TMO], 1u); break; } }
    }
    nloc = mine > 0u ? mine : 1u; nx = cnt > 0u ? cnt : 1u;
}
__device__ __forceinline__ void xcd_barrier(const XcdBarrier& b) {
    asm volatile("s_waitcnt vmcnt(0)" ::: "memory");
    __syncthreads();
    if (threadIdx.x == 0) {
        unsigned* bar = b.bar;
        __builtin_amdgcn_s_waitcnt(0);
        unsigned nloc = b.st[0], nx = b.st[1];
        if (nloc == 0u) { xcd_barrier_complete(bar, b.x, nloc, nx); b.st[0] = nloc; b.st[1] = nx; }
        const unsigned old = xb_add(&bar[XB_XSUB(b.x)], 1u);
        const unsigned gen = old / nloc;
        if (old + 1u == (gen + 1u) * nloc) {
            __builtin_amdgcn_fence(__ATOMIC_RELEASE, "agent");
            asm volatile("s_waitcnt vmcnt(0)" ::: "memory");
            const unsigned og = xb_add(&bar[XB_TOP], 1u);
            const unsigned tg = og / nx;
            if (og + 1u == (tg + 1u) * nx) xb_add(&bar[XB_TOPGEN], 1u);
            else XB_SPIN(xb_ld(&bar[XB_TOPGEN]) == tg, bar);
            __builtin_amdgcn_fence(__ATOMIC_ACQUIRE, "agent");
            xb_add(&bar[XB_XGEN(b.x)], 1u);
            asm volatile("s_waitcnt vmcnt(0)" ::: "memory");
        } else {
            XB_SPIN(xb_ld(&bar[XB_XGEN(b.x)]) == gen, bar);
            __builtin_amdgcn_fence(__ATOMIC_ACQUIRE, "agent");
            asm volatile("s_waitcnt vmcnt(0)" ::: "memory");
        }
    }
    __syncthreads();
}

namespace pg8 {
constexpr int BM = 256, BK = 64, HALF = 128, HTB = HALF * BK * 2, STAGE_BYTES = 8 * HTB, NXCD = 8, WGM = 8;
__device__ __forceinline__ int lds_byte(int r, int c) { const int st = (r >> 4) * 2 + (c >> 5), rr = r & 15, cc = c & 31, ob = rr * 64 + cc * 2; return st * 1024 + (ob ^ (((ob >> 9) & 1) << 5)); }
__device__ __forceinline__ void stage_rc(int b, int& R, int& C) { const int st = b / 1024, sb = b % 1024, swz = sb ^ (((sb >> 9) & 1) << 5); R = (st >> 1) * 16 + swz / 64; C = (st & 1) * 32 + (swz % 64) / 2; }
__device__ __forceinline__ int perm32(int rho) { const int n = rho >> 4, i = rho & 15; return 8 * (i >> 2) + 4 * n + (i & 3); }
struct Unit { int pm, pn; };
struct Order {
    int nM, nN, nwg, G, c;
    __device__ __forceinline__ void init(int nM_, int nN_, int G_, int c_) { nM = nM_; nN = nN_; nwg = nM * nN; G = G_; c = c_; }
    __device__ __forceinline__ bool next(int i, Unit& u) const {
        const long L = (long)i * G + c; if (L >= nwg) return false;
        int wgid = (int)L; { const int q = nwg / NXCD, r = nwg % NXCD, xcd = wgid % NXCD, off = wgid / NXCD; wgid = (xcd < r ? xcd * (q + 1) : r * (q + 1) + (xcd - r) * q) + off; }
        const int nig = WGM * nN, gid = wgid / nig, fm = gid * WGM, gsz = (nM - fm) < WGM ? (nM - fm) : WGM;
        u.pm = fm + ((wgid % nig) % gsz); u.pn = (wgid % nig) / gsz; return true;
    }
};
template <class Epi, class Sched>
__device__ __forceinline__ void gemm_phase(LAS unsigned char* lds, const Sched& S, const Epi& E, const int K, const int lda, const int ldb) {
    const int tid = fresh_tid(), wid = __builtin_amdgcn_readfirstlane(tid >> 6), lane = tid & 63, wr = wid >> 2, wc = wid & 3, fr = lane & 15, fq = lane >> 4;
    const int nt = K / BK;
    unsigned voffA[2], voffB[2];
#pragma unroll
    for (int i = 0; i < 2; ++i) { int R, C; stage_rc(tid * 16 + i * 8192, R, C); const int Rb = Epi::PERM ? ((R & ~31) + perm32(R & 31)) : R;
        const int Ra = Epi::ROWPERM ? (((R >> 6) * 16 + (R & 15)) * 8 + ((R >> 4) & 3)) : R;
        voffA[i] = (unsigned)(Ra * lda + C) * 2u; voffB[i] = (unsigned)(Rb * ldb + C) * 2u; }
    const size_t kstep = (size_t)(BK * 2);
    const size_t hstepA = (size_t)(Epi::ROWPERM ? 4 : HALF) * lda * 2, hstepB = (size_t)HALF * ldb * 2;
    const unsigned ldsw = (unsigned)wid * 1024u;
    const int aoff = lds_byte(wr * 64 + fr, fq * 8), boff = lds_byte(wc * 32 + fr, fq * 8);
#define PG8_SA(b, h) (((b) * 2 + (h)) * HTB)
#define PG8_SB(b, h) ((4 + (b) * 2 + (h)) * HTB)
#define PG8_STAGE(bufoff, gbase, voff) do { _Pragma("unroll") for (int _i = 0; _i < 2; ++_i) \
        __builtin_amdgcn_global_load_lds((const unsigned*)((const char*)(gbase) + (voff)[_i]), (LAS unsigned*)(lds + (bufoff) + ldsw + _i * 8192), 16, 0, 0); } while (0)
#define PG8_LDA(dst, b, h) do { _Pragma("unroll") for (int m = 0; m < 4; ++m) _Pragma("unroll") for (int k = 0; k < 2; ++k) dst[m][k] = *(const LAS bf16x8*)(lds + PG8_SA(b, h) + aoff + m * 2048 + k * 1024); } while (0)
#define PG8_LDB(dst, b, h) do { _Pragma("unroll") for (int n = 0; n < 2; ++n) _Pragma("unroll") for (int k = 0; k < 2; ++k) dst[n][k] = *(const LAS bf16x8*)(lds + PG8_SB(b, h) + boff + n * 2048 + k * 1024); } while (0)
#define PG8_MMA(ai, bj, At, Bt) do { __builtin_amdgcn_s_setprio(1); _Pragma("unroll") for (int m = 0; m < 4; ++m) _Pragma("unroll") for (int n = 0; n < 2; ++n) _Pragma("unroll") for (int k = 0; k < 2; ++k) \
        acc[ai][bj][m][n] = __builtin_amdgcn_mfma_f32_16x16x32_bf16(Bt[n][k], At[m][k], acc[ai][bj][m][n], 0, 0, 0); __builtin_amdgcn_s_setprio(0); } while (0)
#define PG8_WAIT_V(n) asm volatile("s_waitcnt vmcnt(" #n ")" ::: "memory")
#define PG8_WAIT_L(n) asm volatile("s_waitcnt lgkmcnt(" #n ")" ::: "memory")
#define PG8_BAR __builtin_amdgcn_s_barrier()
#define PG8_SCHED __builtin_amdgcn_sched_barrier(0)
    Unit cur, nxt; int ui = 0;
    if (!S.next(0, cur)) return;
    f32x4 acc[2][2][4][2];
#pragma unroll
    for (int a = 0; a < 2; ++a)
#pragma unroll
        for (int b = 0; b < 2; ++b)
#pragma unroll
            for (int m = 0; m < 4; ++m)
#pragma unroll
                for (int n = 0; n < 2; ++n) acc[a][b][m][n] = (f32x4){0.f, 0.f, 0.f, 0.f};
    bf16x8 At[4][2], B0[2][2], B1[2][2];
    const char* cA = S.aptr(cur); const char* cB = S.bptr(cur);
    PG8_STAGE(PG8_SB(0, 0), cB, voffB); PG8_STAGE(PG8_SB(0, 1), cB + hstepB, voffB); PG8_STAGE(PG8_SA(0, 0), cA, voffA); PG8_STAGE(PG8_SA(0, 1), cA + hstepA, voffA);
    if (wr == 1) PG8_BAR;
    PG8_WAIT_V(2); PG8_BAR;
    PG8_STAGE(PG8_SB(1, 0), cB + kstep, voffB); PG8_STAGE(PG8_SA(1, 0), cA + kstep, voffA); PG8_STAGE(PG8_SB(1, 1), cB + hstepB + kstep, voffB);
    PG8_WAIT_V(6); PG8_BAR;
    for (;;) {
        const bool has_next = S.next(ui + 1, nxt);
        const char* nA = has_next ? S.aptr(nxt) : cA; const char* nB = has_next ? S.bptr(nxt) : cB;
#pragma unroll 1
        for (int t = 0; t < nt; t += 2) {
            const bool last = (t == nt - 2);
            const char* a1 = cA + (size_t)(t + 1) * kstep;
            const char* a2 = last ? nA : cA + (size_t)(t + 2) * kstep; const char* b2 = last ? nB : cB + (size_t)(t + 2) * kstep;
            const char* a3 = a2 + kstep; const char* b3 = b2 + kstep;
            PG8_LDB(B0, 0, 0); PG8_LDB(B1, 0, 1); PG8_SCHED; PG8_LDA(At, 0, 0); PG8_STAGE(PG8_SA(1, 1), a1 + hstepA, voffA);
            PG8_WAIT_V(8); PG8_WAIT_L(0); PG8_BAR; PG8_MMA(0, 0, At, B0); PG8_MMA(0, 1, At, B1); PG8_BAR; PG8_SCHED;
            PG8_LDA(At, 0, 1); PG8_STAGE(PG8_SB(0, 0), b2, voffB); PG8_STAGE(PG8_SB(0, 1), b2 + hstepB, voffB); PG8_STAGE(PG8_SA(0, 0), a2, voffA);
            PG8_WAIT_V(8); PG8_WAIT_L(0); PG8_BAR; PG8_MMA(1, 0, At, B0); PG8_MMA(1, 1, At, B1); PG8_BAR; PG8_SCHED;
            PG8_LDB(B0, 1, 0); PG8_LDB(B1, 1, 1); PG8_SCHED; PG8_LDA(At, 1, 0); PG8_STAGE(PG8_SA(0, 1), a2 + hstepA, voffA);
            PG8_WAIT_V(8); PG8_WAIT_L(0); PG8_BAR; PG8_MMA(0, 0, At, B0); PG8_MMA(0, 1, At, B1); PG8_BAR; PG8_SCHED;
            PG8_LDA(At, 1, 1); PG8_STAGE(PG8_SB(1, 0), b3, voffB); PG8_STAGE(PG8_SB(1, 1), b3 + hstepB, voffB); PG8_STAGE(PG8_SA(1, 0), a3, voffA);
            PG8_WAIT_V(8); PG8_WAIT_L(0); PG8_BAR; PG8_MMA(1, 0, At, B0); PG8_MMA(1, 1, At, B1); PG8_BAR; PG8_SCHED;
        }
        if (wr == 0) PG8_BAR;
        E(acc, cur, wr, wc, fr, fq);
        if (!has_next) break;
#pragma unroll
        for (int a = 0; a < 2; ++a)
#pragma unroll
            for (int b = 0; b < 2; ++b)
#pragma unroll
                for (int m = 0; m < 4; ++m)
#pragma unroll
                    for (int n = 0; n < 2; ++n) acc[a][b][m][n] = (f32x4){0.f, 0.f, 0.f, 0.f};
        cur = nxt; cA = nA; cB = nB; ++ui;
        if (wr == 1) PG8_BAR;
    }
    PG8_WAIT_V(0);
    PG8_BAR;
#undef PG8_SA
#undef PG8_SB
#undef PG8_STAGE
#undef PG8_LDA
#undef PG8_LDB
#undef PG8_MMA
#undef PG8_WAIT_V
#undef PG8_WAIT_L
#undef PG8_BAR
#undef PG8_SCHED
}
struct PlainSched : Order {
    const char* A; const char* B; size_t astep, bstep;
    __device__ __forceinline__ void set(const void* A_, int lda, const void* B_, int ldb, int nM_, int nN_) { A = (const char*)A_; B = (const char*)B_; astep = (size_t)BM * lda * 2; bstep = (size_t)BM * ldb * 2; init(nM_, nN_, gridDim.x, blockIdx.x); }
    __device__ __forceinline__ const char* aptr(const Unit& u) const { return A + (size_t)u.pm * astep; }
    __device__ __forceinline__ const char* bptr(const Unit& u) const { return B + (size_t)u.pn * bstep; }
};
}
using pg8::Unit;
typedef const f32x4 (&AccRef)[2][2][4][2];

struct EpiProj {
    static constexpr bool PERM = true, ROWPERM = false;
    const float* rinv; const float* bias; bf16_t *xm, *som, *us, *sga, *sgb;
    __device__ __forceinline__ void operator()(AccRef acc, const Unit& u, int wr, int wc, int fr, int fq) const {
        const int pn = u.pn; bf16_t* base; int ldc, colt; bool sig;
        if (pn < 4) { base = xm; ldc = 1024; colt = pn * 256; sig = false; }
        else if (pn < 8) { base = som; ldc = 1024; colt = (pn - 4) * 256; sig = true; }
        else if (pn < 10) { base = us; ldc = 512; colt = (pn - 8) * 256; sig = false; }
        else if (pn < 14) { base = sga; ldc = 1024; colt = (pn - 10) * 256; sig = true; }
        else { base = sgb; ldc = 1024; colt = (pn - 14) * 256; sig = true; }
        const int row0 = u.pm * 256 + wr * 64 + fr, col0 = colt + wc * 32 + 8 * fq, bcol0 = pn * 256 + wc * 32 + 8 * fq;
        f32x4 bv[2][2];
#pragma unroll
        for (int bj = 0; bj < 2; ++bj)
#pragma unroll
            for (int n = 0; n < 2; ++n) bv[bj][n] = *(const f32x4*)(bias + bcol0 + bj * 128 + 4 * n);
#pragma unroll
        for (int ai = 0; ai < 2; ++ai)
#pragma unroll
            for (int m = 0; m < 4; ++m) { const int row = row0 + ai * 128 + m * 16; const float ri = rinv[row]; bf16_t* rowp = base + (size_t)row * ldc + col0;
#pragma unroll
                for (int bj = 0; bj < 2; ++bj) { f32x4 v0 = acc[ai][bj][m][0] * ri + bv[bj][0], v1 = acc[ai][bj][m][1] * ri + bv[bj][1];
                    if (sig) {
#pragma unroll
                        for (int j = 0; j < 4; ++j) { v0[j] = sigmoidf_(v0[j]); v1[j] = sigmoidf_(v1[j]); } }
                    u32x4 w; w.x = cvt_pk_bf16(v0[0], v0[1]); w.y = cvt_pk_bf16(v0[2], v0[3]); w.z = cvt_pk_bf16(v1[0], v1[1]); w.w = cvt_pk_bf16(v1[2], v1[3]);
                    *(u32x4*)(rowp + bj * 128) = w; } }
    }
};
struct EpiQKV {
    static constexpr bool PERM = true, ROWPERM = false;
    bf16_t *qk, *v;
    __device__ __forceinline__ void operator()(AccRef acc, const Unit& u, int wr, int wc, int fr, int fq) const {
        const int head = u.pn & 3, kind = u.pn >> 2; bf16_t* base = (kind < 2) ? qk + (size_t)kind * T_ * 1024 : v;
        const int row0 = u.pm * 256 + wr * 64 + fr, col0 = head * 256 + wc * 32 + 8 * fq;
#pragma unroll
        for (int ai = 0; ai < 2; ++ai)
#pragma unroll
            for (int m = 0; m < 4; ++m) { bf16_t* rowp = base + (size_t)(row0 + ai * 128 + m * 16) * 1024 + col0;
#pragma unroll
                for (int bj = 0; bj < 2; ++bj) { const f32x4 v0 = acc[ai][bj][m][0], v1 = acc[ai][bj][m][1];
                    u32x4 w; w.x = cvt_pk_bf16(v0[0], v0[1]); w.y = cvt_pk_bf16(v0[2], v0[3]); w.z = cvt_pk_bf16(v1[0], v1[1]); w.w = cvt_pk_bf16(v1[2], v1[3]);
                    *(u32x4*)(rowp + bj * 128) = w; } }
    }
};
template <int MODE> struct EpiGate {
    static constexpr bool PERM = true, ROWPERM = false;
    const bf16_t* X; const bf16_t* Y; const float* bias; bf16_t* O; int ldc;
    __device__ __forceinline__ void operator()(AccRef acc, const Unit& u, int wr, int wc, int fr, int fq) const {
        const int row0 = u.pm * 256 + wr * 64 + fr, col0 = u.pn * 256 + wc * 32 + 8 * fq;
        f32x4 bv[2][2];
#pragma unroll
        for (int bj = 0; bj < 2; ++bj)
#pragma unroll
            for (int n = 0; n < 2; ++n) bv[bj][n] = (MODE == 0) ? *(const f32x4*)(bias + col0 + bj * 128 + 4 * n) : (f32x4){0.f, 0.f, 0.f, 0.f};
#pragma unroll
        for (int ai = 0; ai < 2; ++ai)
#pragma unroll
            for (int m = 0; m < 4; ++m) { const size_t off = (size_t)(row0 + ai * 128 + m * 16) * ldc + col0;
#pragma unroll
                for (int bj = 0; bj < 2; ++bj) {
                    float xv[8], a[8], o[8]; unpack8(*(const u32x4*)(X + off + bj * 128), xv);
#pragma unroll
                    for (int j = 0; j < 4; ++j) { a[j] = acc[ai][bj][m][0][j] + bv[bj][0][j]; a[4 + j] = acc[ai][bj][m][1][j] + bv[bj][1][j]; }
                    if (MODE == 0) {
#pragma unroll
                        for (int j = 0; j < 8; ++j) o[j] = xv[j] * sigmoidf_(a[j]); }
                    else if (MODE == 1) {
#pragma unroll
                        for (int j = 0; j < 8; ++j) o[j] = xv[j] * a[j]; }
                    else { float yv[8]; unpack8(*(const u32x4*)(Y + off + bj * 128), yv);
#pragma unroll
                        for (int j = 0; j < 8; ++j) o[j] = xv[j] * a[j] + yv[j]; }
                    *(u32x4*)(O + off + bj * 128) = pack8(o); } }
    }
};
template <bool WB> struct EpiResid {
    static constexpr bool PERM = false, ROWPERM = false;
    const float* Rs; const bf16_t* Rb; float* Of; bf16_t* Ob; float* ss;
    __device__ __forceinline__ void operator()(AccRef acc, const Unit& u, int wr, int wc, int fr, int fq) const {
        const int row0 = u.pm * 256 + wr * 64 + fr, col0 = u.pn * 256 + wc * 32 + 4 * fq;
#pragma unroll
        for (int ai = 0; ai < 2; ++ai)
#pragma unroll
            for (int m = 0; m < 4; ++m) { const int row = row0 + ai * 128 + m * 16; const size_t off = (size_t)row * 1024 + col0; float s = 0.f;
#pragma unroll
                for (int bj = 0; bj < 2; ++bj)
#pragma unroll
                    for (int n = 0; n < 2; ++n) { const size_t o2 = off + bj * 128 + n * 16; f32x4 r;
                        if (WB) r = *(const f32x4*)(Rs + o2); else { const u32x2 rw = *(const u32x2*)(Rb + o2); r = (f32x4){bflo(rw.x), bfhi(rw.x), bflo(rw.y), bfhi(rw.y)}; }
                        const f32x4 v = r + acc[ai][bj][m][n];
                        s += (v[0] * v[0] + v[1] * v[1]) + (v[2] * v[2] + v[3] * v[3]);
                        if (WB) { u32x2 w; w.x = cvt_pk_bf16(v[0], v[1]); w.y = cvt_pk_bf16(v[2], v[3]); *(u32x2*)(Ob + o2) = w; } else *(f32x4*)(Of + o2) = v; }
                s += __shfl_xor(s, 16); s += __shfl_xor(s, 32);
                if (fq == 0) { if (WB) atomicAdd(ss + row, s); else ss[(size_t)row * 16 + u.pn * 4 + wc] = s; } }
    }
};
__device__ __forceinline__ float dpp_shr1(float x) { return __int_as_float(__builtin_amdgcn_update_dpp(0, __float_as_int(x), 0x111, 0xf, 0xf, true)); }
__device__ __forceinline__ float ffn_gate(float bg, float wg0, float wg1, float wg2, float ga, float gb, float gc, float bv, float wv0, float wv1, float wv2, float va, float vb, float vc) {
    const float g = bg + wg0 * ga + wg1 * gb + wg2 * gc, v = bv + wv0 * va + wv1 * vb + wv2 * vc; return siluf_(g) * v; }
struct EpiUpFused {
    static constexpr bool PERM = true, ROWPERM = true;
    const float* ss; const float* cw; const float* cb; bf16_t* ACT; bf16_t* SIDE;
    __device__ __forceinline__ void operator()(AccRef acc, const Unit& u, int wr, int wc, int fr, int fq) const {
        const int tok0 = u.pm * 256 + (wr * 16 + fr) * 8;
        float ri[8];
        { const f32x4 q0 = *(const f32x4*)(ss + tok0), q1 = *(const f32x4*)(ss + tok0 + 4);
#pragma unroll
          for (int i = 0; i < 4; ++i) { ri[i] = rsqrtf(q0[i] * (1.0f / 1024.0f) + EPS_); ri[4 + i] = rsqrtf(q1[i] * (1.0f / 1024.0f) + EPS_); } }
        const int fb = u.pn * 128 + wc * 32 + 8 * fq;
#pragma unroll
        for (int n = 0; n < 2; ++n) {
            unsigned pk[8][2];
#pragma unroll
            for (int jp = 0; jp < 2; ++jp) {
                const int c = fb + 4 * n + 2 * jp;
                const f32x2 wv0 = *(const f32x2*)(cw + c), wv1 = *(const f32x2*)(cw + F2_ + c), wv2 = *(const f32x2*)(cw + 2 * F2_ + c);
                const f32x2 wg0 = *(const f32x2*)(cw + F_ + c), wg1 = *(const f32x2*)(cw + F2_ + F_ + c), wg2 = *(const f32x2*)(cw + 2 * F2_ + F_ + c);
                const f32x2 bv = *(const f32x2*)(cb + c), bg = *(const f32x2*)(cb + F_ + c);
                float v0[10], v1[10], g0[10], g1[10];
#pragma unroll
                for (int ai = 0; ai < 2; ++ai)
#pragma unroll
                    for (int m = 0; m < 4; ++m) { const int i = ai * 4 + m; v0[2 + i] = acc[ai][0][m][n][2 * jp] * ri[i]; v1[2 + i] = acc[ai][0][m][n][2 * jp + 1] * ri[i];
                        g0[2 + i] = acc[ai][1][m][n][2 * jp] * ri[i]; g1[2 + i] = acc[ai][1][m][n][2 * jp + 1] * ri[i]; }
                v0[0] = dpp_shr1(v0[8]); v0[1] = dpp_shr1(v0[9]); v1[0] = dpp_shr1(v1[8]); v1[1] = dpp_shr1(v1[9]);
                g0[0] = dpp_shr1(g0[8]); g0[1] = dpp_shr1(g0[9]); g1[0] = dpp_shr1(g1[8]); g1[1] = dpp_shr1(g1[9]);
                if (fr == 0 || fr == 15) {
                    const bool lo = fr == 0; const int slot = wr * 4 + (lo ? 0 : 2);
                    bf16_t* sp = SIDE + ((size_t)u.pm * 8 + slot) * F2_ + c;
                    *(unsigned*)(sp) = cvt_pk_bf16(lo ? v0[2] : v0[8], lo ? v1[2] : v1[8]); *(unsigned*)(sp + F2_) = cvt_pk_bf16(lo ? v0[3] : v0[9], lo ? v1[3] : v1[9]);
                    *(unsigned*)(sp + F_) = cvt_pk_bf16(lo ? g0[2] : g0[8], lo ? g1[2] : g1[8]); *(unsigned*)(sp + F2_ + F_) = cvt_pk_bf16(lo ? g0[3] : g0[9], lo ? g1[3] : g1[9]);
                }
#pragma unroll
                for (int i = 0; i < 8; ++i) {
                    const float o0 = ffn_gate(bg.x, wg0.x, wg1.x, wg2.x, g0[i], g0[i + 1], g0[i + 2], bv.x, wv0.x, wv1.x, wv2.x, v0[i], v0[i + 1], v0[i + 2]);
                    const float o1 = ffn_gate(bg.y, wg0.y, wg1.y, wg2.y, g1[i], g1[i + 1], g1[i + 2], bv.y, wv0.y, wv1.y, wv2.y, v1[i], v1[i + 1], v1[i + 2]);
                    pk[i][jp] = cvt_pk_bf16(o0, o1); }
            }
#pragma unroll
            for (int i = 0; i < 8; ++i) if (!(fr == 0 && i < 2)) { u32x2 w; w.x = pk[i][0]; w.y = pk[i][1]; *(u32x2*)(ACT + (size_t)(tok0 + i) * F_ + fb + 4 * n) = w; }
            asm volatile("" ::: "memory");
        }
    }
};
struct SchedQKV : pg8::Order {
    const char *xc, *xm, *wqk, *wv;
    __device__ __forceinline__ const char* aptr(const Unit& u) const { const int head = u.pn & 3, kind = u.pn >> 2; return (kind < 2 ? xc : xm) + ((size_t)u.pm * 256 * 1024 + head * 256) * 2; }
    __device__ __forceinline__ const char* bptr(const Unit& u) const { const int head = u.pn & 3, kind = u.pn >> 2; return kind < 2 ? wqk + ((size_t)(head * 512 + kind * 256) * 256) * 2 : wv + ((size_t)head * 65536) * 2; }
};

__device__ __forceinline__ void transpose_item(const float* W, int ldw, int c0, const float* kscale, float scale, bf16_t* WT, int ldt, int row_off, LAS float* scr, int kb, int nb, int lane) {
    const int k0 = 64 * kb, n0 = 32 * nb;
#pragma unroll 8
    for (int i = 0; i < 32; ++i) { const int kk = 2 * i + (lane >> 5); float v = W[(size_t)(k0 + kk) * ldw + c0 + n0 + (lane & 31)] * scale; if (kscale) v *= kscale[k0 + kk]; scr[kk * 33 + (lane & 31)] = v; }
    asm volatile("s_waitcnt lgkmcnt(0)" ::: "memory");
    const int c = lane & 7;
#pragma unroll
    for (int j = 0; j < 4; ++j) { const int n = (lane >> 3) + 8 * j; const LAS float* s = scr + (8 * c) * 33 + n;
        u32x4 o; o.x = cvt_pk_bf16(s[0 * 33], s[1 * 33]); o.y = cvt_pk_bf16(s[2 * 33], s[3 * 33]); o.z = cvt_pk_bf16(s[4 * 33], s[5 * 33]); o.w = cvt_pk_bf16(s[6 * 33], s[7 * 33]);
        *(u32x4*)(WT + (size_t)(row_off + n0 + n) * ldt + k0 + 8 * c) = o; }
    asm volatile("s_waitcnt lgkmcnt(0)" ::: "memory");
}

__device__ __forceinline__ void phase0(const Params& p, LAS unsigned char* lds) {
    const int tid = fresh_tid(), lane = tid & 63, wave = tid >> 6;
    const int gw = blockIdx.x * 8 + wave, NGW = gridDim.x * 8;
    unsigned char* ws = p.ws;
    LAS float* scr = (LAS float*)(lds + wave * 8448);
    LAS float* gwt = (LAS float*)(lds + 8 * 8448);
    { const float* g1 = p.in[1]; const float* w_in = p.in[2];
      for (int i = tid; i < 8192; i += 512) { const int j = i & 7, k = i >> 3; gwt[j * 1024 + k] = g1[k] * w_in[(size_t)k * NIN_ + 2048 + j]; } }
    {
        const int nmat = 63;
        int base = 0;
        for (int mi = 0; mi < nmat; ++mi) {
            const float* W; int ldw, c0, ncols, K; const float* ks = nullptr; float sc = 1.f; bf16_t* WT; int ldt, roff = 0;
            if (mi == 0) { W = p.in[2]; ldw = NIN_; c0 = 0; ncols = 2048; K = 1024; ks = p.in[1]; WT = (bf16_t*)(ws + WS_WIN); ldt = 1024; roff = 0; }
            else if (mi == 1) { W = p.in[2]; ldw = NIN_; c0 = 2056; ncols = 2560; K = 1024; ks = p.in[1]; WT = (bf16_t*)(ws + WS_WIN); ldt = 1024; roff = 2048; }
            else if (mi < 6) { const int h = mi - 2; W = p.in[6] + h * 65536; ldw = 256; c0 = 0; ncols = 256; K = 256; WT = (bf16_t*)(ws + WS_WQK) + h * 512 * 256; ldt = 256; roff = 0; }
            else if (mi < 10) { const int h = mi - 6; W = p.in[7] + h * 65536; ldw = 256; c0 = 0; ncols = 256; K = 256; sc = 0.0625f; WT = (bf16_t*)(ws + WS_WQK) + h * 512 * 256; ldt = 256; roff = 256; }
            else if (mi < 14) { const int h = mi - 10; W = p.in[8] + h * 65536; ldw = 256; c0 = 0; ncols = 256; K = 256; WT = (bf16_t*)(ws + WS_WV) + h * 65536; ldt = 256; roff = 0; }
            else if (mi == 14) { W = p.in[19]; ldw = 512; c0 = 0; ncols = 512; K = 512; WT = (bf16_t*)(ws + WS_WGLU); ldt = 512; }
            else if (mi == 15) { W = p.in[21]; ldw = 1024; c0 = 0; ncols = 1024; K = 1024; WT = (bf16_t*)(ws + WS_WA); ldt = 1024; }
            else if (mi == 16) { W = p.in[22]; ldw = 1024; c0 = 0; ncols = 1024; K = 512; WT = (bf16_t*)(ws + WS_WB); ldt = 512; }
            else if (mi == 17) { W = p.in[23]; ldw = 1024; c0 = 0; ncols = 1024; K = 1024; WT = (bf16_t*)(ws + WS_WOUT); ldt = 1024; }
            else if (mi < 62) { const int qq = mi - 18, pn = qq >> 1, bj = qq & 1;
                W = p.in[25]; ldw = F2_; c0 = bj * F_ + pn * 128; ncols = 128; K = 1024; ks = p.in[24]; WT = (bf16_t*)(ws + WS_WUP); ldt = 1024; roff = pn * 256 + bj * 128; }
            else { W = p.in[28]; ldw = 1024; c0 = 0; ncols = 1024; K = F_; WT = (bf16_t*)(ws + WS_WDN); ldt = F_; }
            const int nblk = ncols / 32, nit = (K / 64) * nblk;
            int it = gw - (base % NGW); if (it < 0) it += NGW;
            for (; it < nit; it += NGW) transpose_item(W, ldw, c0, ks, sc, WT, ldt, roff, scr, it / nblk, it % nblk, lane);
            base += nit;
        }
    }
    {
        const int gt = blockIdx.x * 512 + tid;
        if (gt < SG_ * SP_) {
            const int g = gt >> 6, pp = gt & 63;
            const float ar = p.in[11][gt], ai = p.in[12][gt], dt = expf(p.in[13][g]);
            const float mag = expf(dt * ar); float sn, cs; sincosf(dt * ai, &sn, &cs);
            const float abr = mag * cs, abi = mag * sn;
            const float den = ar * ar + ai * ai, xr = abr - 1.0f, xi = abi;
            const float rre = (xr * ar + xi * ai) / den, rim = (xi * ar - xr * ai) / den;
            float* A = (float*)(ws + WS_S5A); bf16_t* BbT = (bf16_t*)(ws + WS_S5BT);
            A[gt * 2] = abr; A[gt * 2 + 1] = abi;
            const float* bre = p.in[14] + (size_t)gt * 16; const float* bim = p.in[15] + (size_t)gt * 16;
            for (int c = 0; c < 16; ++c) { const float br = bre[c], bi = bim[c];
                BbT[((size_t)(g * 128 + pp)) * 16 + c] = f2bf(rre * br - rim * bi); BbT[((size_t)(g * 128 + 64 + pp)) * 16 + c] = f2bf(rre * bi + rim * br); }
        }
        bf16_t* CmT = (bf16_t*)(ws + WS_S5CT);
        for (int i = blockIdx.x * 512 + tid; i < SG_ * 16 * 128; i += gridDim.x * 512) { const int k = i & 127, gc = i >> 7;
            CmT[i] = f2bf(k < 64 ? p.in[16][(size_t)gc * 64 + k] : -p.in[17][(size_t)gc * 64 + k - 64]); }
    }
    { float* z = (float*)(ws + WS_SS1); for (int i = blockIdx.x * 512 + tid; i < T_; i += gridDim.x * 512) z[i] = 0.f; }
    {
        float* bp = (float*)(ws + WS_BIASP); const float* b_in = p.in[3];
        for (int i = blockIdx.x * 512 + tid; i < NP1_; i += gridDim.x * 512) bp[i] = b_in[i < 2048 ? i : i + 8];
    }
    __syncthreads();
    {
        const float* x = p.in[0]; const float* b_in = p.in[3];
        bf16_t* xb = (bf16_t*)(ws + R0); float* rinv1 = (float*)(ws + WS_RINV1); float* ig = (float*)(ws + WS_IG); float* fg = (float*)(ws + WS_FG);
        for (int row = gw; row < T_; row += NGW) {
            const f32x4* xr = (const f32x4*)(x + (size_t)row * 1024) + lane;
            f32x4 v[4]; float s = 0.f;
#pragma unroll
            for (int j = 0; j < 4; ++j) { v[j] = xr[64 * j]; s += (v[j][0] * v[j][0] + v[j][1] * v[j][1]) + (v[j][2] * v[j][2] + v[j][3] * v[j][3]); }
            float d[8];
#pragma unroll
            for (int g = 0; g < 8; ++g) { float a = 0.f;
#pragma unroll
                for (int j = 0; j < 4; ++j) { const f32x4 w = *(const LAS f32x4*)(gwt + g * 1024 + 256 * j + 4 * lane); a += (v[j][0] * w[0] + v[j][1] * w[1]) + (v[j][2] * w[2] + v[j][3] * w[3]); }
                d[g] = a; }
            s = wave_sum(s);
#pragma unroll
            for (int g = 0; g < 8; ++g) d[g] = wave_sum(d[g]);
            const float ri = rsqrtf(s * (1.0f / 1024.0f) + EPS_);
            u32x2* o8 = (u32x2*)(xb + (size_t)row * 1024) + lane;
#pragma unroll
            for (int j = 0; j < 4; ++j) { u32x2 w; w.x = cvt_pk_bf16(v[j][0], v[j][1]); w.y = cvt_pk_bf16(v[j][2], v[j][3]); o8[64 * j] = w; }
            if (lane == 0) rinv1[row] = ri;
            if (lane < 8) { float val = d[0];
#pragma unroll
                for (int g = 1; g < 8; ++g) val = (lane == g) ? d[g] : val;
                val = val * ri + b_in[2048 + lane];
                if (lane < 4) ig[(size_t)row * 4 + lane] = val; else fg[(size_t)row * 4 + lane - 4] = val; }
        }
    }
}

__device__ __forceinline__ void phase_conv_m(const Params& p) {
    const bf16_t* xm = (const bf16_t*)(p.ws + R1); bf16_t* xc = (bf16_t*)(p.ws + R0);
    const float* cw = p.in[4]; const float* cb = p.in[5];
    const int total = (T_ / 16) * 128;
    for (int idx = blockIdx.x * 512 + fresh_tid(); idx < total; idx += gridDim.x * 512) {
        const int cgi = idx & 127, tb = idx >> 7, c0 = cgi * 8, t0 = tb * 16;
        float w[4][8], b[8];
#pragma unroll
        for (int k = 0; k < 4; ++k) { const f32x4 a = *(const f32x4*)(cw + k * 1024 + c0), bb = *(const f32x4*)(cw + k * 1024 + c0 + 4);
#pragma unroll
            for (int j = 0; j < 4; ++j) { w[k][j] = a[j]; w[k][4 + j] = bb[j]; } }
        { const f32x4 a = *(const f32x4*)(cb + c0), bb = *(const f32x4*)(cb + c0 + 4);
#pragma unroll
          for (int j = 0; j < 4; ++j) { b[j] = a[j]; b[4 + j] = bb[j]; } }
        float r0[8], r1[8], r2[8], r3[8];
        const bool head = (t0 & (SEQ_ - 1)) == 0;
        if (head) {
#pragma unroll
            for (int j = 0; j < 8; ++j) { r0[j] = 0.f; r1[j] = 0.f; r2[j] = 0.f; } }
        else { unpack8(*(const u32x4*)(xm + (size_t)(t0 - 3) * 1024 + c0), r0); unpack8(*(const u32x4*)(xm + (size_t)(t0 - 2) * 1024 + c0), r1); unpack8(*(const u32x4*)(xm + (size_t)(t0 - 1) * 1024 + c0), r2); }
#pragma unroll 4
        for (int i = 0; i < 16; ++i) {
            unpack8(*(const u32x4*)(xm + (size_t)(t0 + i) * 1024 + c0), r3);
            float o[8];
#pragma unroll
            for (int j = 0; j < 8; ++j) { const float y = b[j] + w[0][j] * r0[j] + w[1][j] * r1[j] + w[2][j] * r2[j] + w[3][j] * r3[j]; o[j] = siluf_(y); }
            *(u32x4*)(xc + (size_t)(t0 + i) * 1024 + c0) = pack8(o);
#pragma unroll
            for (int j = 0; j < 8; ++j) { r0[j] = r1[j]; r1[j] = r2[j]; r2[j] = r3[j]; }
        }
    }
}

__device__ __forceinline__ void phase_gates(const Params& p, LAS unsigned char* lds) {
    const int tid = fresh_tid(), lane = tid & 63, wave = __builtin_amdgcn_readfirstlane(tid >> 6);
    const float* IG = (const float*)(p.ws + WS_IG); const float* FG = (const float*)(p.ws + WS_FG); float* GS = (float*)(p.ws + WS_GS);
    LAS float* LB = (LAS float*)lds; LAS float* LC = LB + 64; LAS float* Lm = LB + 128;
    for (int item = blockIdx.x; item < 32; item += gridDim.x) {
        const int b = item >> 2, h = item & 3;
        float av[8], bv[8], pv[8];
#pragma unroll
        for (int cc = 0; cc < 8; ++cc) {
            const int ch = wave * 8 + cc; const size_t t = (size_t)b * SEQ_ + ch * 64 + lane;
            const float fgv = FG[t * 4 + h], li = IG[t * 4 + h];
            const float lf = fminf(fgv, 0.f) - log1pf(expf(-fabsf(fgv)));
            float bc = lf;
#pragma unroll
            for (int o = 1; o < 64; o <<= 1) { const float x = __shfl_up(bc, o); if (lane >= o) bc += x; }
            const float a = li - bc; float pm = a;
#pragma unroll
            for (int o = 1; o < 64; o <<= 1) { const float x = __shfl_up(pm, o); if (lane >= o) pm = fmaxf(pm, x); }
            av[cc] = a; bv[cc] = bc; pv[cc] = pm;
            if (lane == 63) { LB[ch] = bc; LC[ch] = bc + pm; }
        }
        __syncthreads();
        if (tid == 0) { float m = 0.f; for (int j = 0; j < 64; ++j) { Lm[j] = m; m = fmaxf(m + LB[j], LC[j]); } }
        __syncthreads();
#pragma unroll
        for (int cc = 0; cc < 8; ++cc) {
            const int ch = wave * 8 + cc; const float m = Lm[ch];
            const float Mq = fmaxf(m, pv[cc]); const float M63 = __shfl(Mq, 63);
            float* gs = GS + ((size_t)item * 64 + ch) * 384;
            gs[lane] = av[cc]; gs[64 + lane] = Mq; gs[128 + lane] = expf(m - Mq); gs[192 + lane] = expf(-(bv[cc] + Mq)); gs[256 + lane] = expf(av[cc] - M63);
            if (lane == 0) gs[320] = expf(m - M63);
        }
        __syncthreads();
    }
}

typedef short s16x4 __attribute__((ext_vector_type(4)));
__device__ __forceinline__ bf16x8 lds_tr_frag(const LAS bf16_t* p, int row_stride) {
    const s16x4 lo = __builtin_amdgcn_ds_read_tr16_b64_v4i16((LAS s16x4*)p);
    const s16x4 hi = __builtin_amdgcn_ds_read_tr16_b64_v4i16((LAS s16x4*)(p + 4 * row_stride));
    return (bf16x8){lo[0], lo[1], lo[2], lo[3], hi[0], hi[1], hi[2], hi[3]};
}
constexpr int ML_QN = 0, ML_KN = 33792, ML_VN = 67584, ML_VW = 74752, ML_SW = 81920, ML_CB = 91136, ML_DEN = 116480;
__device__ __forceinline__ void phase_mlstm(const Params& p, LAS unsigned char* lds) {
    const int tid = fresh_tid(), lane = tid & 63, w = __builtin_amdgcn_readfirstlane(tid >> 6), qi = w & 3, half = w >> 2, lr = lane & 15, lg = lane >> 4;
    const bf16_t* Q = (const bf16_t*)p.out; const bf16_t* Kk = (const bf16_t*)p.out + (size_t)T_ * 1024; const bf16_t* V = (const bf16_t*)(p.ws + R6);
    bf16_t* HC = (bf16_t*)(p.ws + R1);
    const float* GS = (const float*)(p.ws + WS_GS);
    LAS bf16_t* QN = (LAS bf16_t*)(lds + ML_QN);
    LAS bf16_t* KN = (LAS bf16_t*)(lds + ML_KN);
    LAS bf16_t* VN = (LAS bf16_t*)(lds + ML_VN);
    LAS bf16_t* VW = (LAS bf16_t*)(lds + ML_VW);
    LAS bf16_t* Sw = (LAS bf16_t*)(lds + ML_SW);
    LAS bf16_t* Cb = (LAS bf16_t*)(lds + ML_CB);
    LAS float* sc_den = (LAS float*)(lds + ML_DEN);
    const int trq = lr >> 2, trp = 4 * (lr & 3);
    for (int item = blockIdx.x; item < 256; item += gridDim.x) {
        const int bh = item & 31, vs = item >> 5, b = bh >> 2, h = bh & 3;
        const size_t tok0 = (size_t)b * SEQ_;
        __syncthreads();
        for (int i = tid; i < 48 * 264 / 2; i += 512) ((LAS unsigned*)Cb)[i] = 0u;
        for (int i = tid; i < 2 * 64 * 56 / 2; i += 512) ((LAS unsigned*)VN)[i] = 0u;
        f32x4 Cacc[2][3];
#pragma unroll
        for (int a_ = 0; a_ < 2; ++a_)
#pragma unroll
            for (int c_ = 0; c_ < 3; ++c_) Cacc[a_][c_] = (f32x4){0.f, 0.f, 0.f, 0.f};
        u32x4 qreg[4], kreg[4], vreg = (u32x4){0u, 0u, 0u, 0u};
        float sMq, swi, semr, swk, sdecay; f32x4 sa[2];
        const int vsel = tid < 256 ? (tid >> 2) : (tid < 320 ? tid - 256 : 0);
#define ML_GLOAD(tc0_) do { _Pragma("unroll") for (int i_ = 0; i_ < 4; ++i_) { const int pi = tid + 512 * i_; const size_t go = ((tc0_) + (pi >> 5)) * 1024 + h * 256 + (pi & 31) * 8; \
            qreg[i_] = *(const u32x4*)(Q + go); kreg[i_] = *(const u32x4*)(Kk + go); } \
            if (tid < 256) vreg = *(const u32x4*)(V + ((tc0_) + (tid >> 2)) * 1024 + h * 256 + vs * 32 + (tid & 3) * 8); } while (0)
#define ML_GSCAL(gs_) do { sMq = (gs_)[64 + 16 * qi + lr]; swi = (gs_)[128 + 16 * qi + lr]; semr = (gs_)[192 + 16 * qi + lr]; swk = (gs_)[256 + vsel]; sdecay = (gs_)[320]; \
            sa[0] = *(const f32x4*)((gs_) + 16 * (2 * half) + 4 * lg); sa[1] = *(const f32x4*)((gs_) + 16 * (2 * half + 1) + 4 * lg); } while (0)
#define ML_LWRITE() do { _Pragma("unroll") for (int i_ = 0; i_ < 4; ++i_) { const int pi = tid + 512 * i_; const int lo_ = (pi >> 5) * 264 + (pi & 31) * 8; \
            *(LAS u32x4*)(QN + lo_) = qreg[i_]; *(LAS u32x4*)(KN + lo_) = kreg[i_]; } \
            if (tid < 256) { float vv[8], vw[8]; unpack8(vreg, vv); _Pragma("unroll") for (int j = 0; j < 8; ++j) vw[j] = vv[j] * swk; \
                *(LAS u32x4*)(VN + (tid >> 2) * 56 + (tid & 3) * 8) = vreg; *(LAS u32x4*)(VW + (tid >> 2) * 56 + (tid & 3) * 8) = pack8(vw); } \
            else if (tid < 320) { VN[(tid - 256) * 56 + 32] = (bf16_t)0x3f80; VW[(tid - 256) * 56 + 32] = f2bf(swk); } } while (0)
        { ML_GLOAD(tok0); const float* gs = GS + ((size_t)bh * 64) * 384; ML_GSCAL(gs); }
        __syncthreads();
        ML_LWRITE();
        __syncthreads();
        for (int ch = 0; ch < NCH_; ++ch) {
            const size_t tc0 = tok0 + (size_t)ch * 64;
            const int chn = ch + 1 < NCH_ ? ch + 1 : ch; const size_t tcn = tok0 + (size_t)chn * 64;
            const float* gsn = GS + ((size_t)bh * 64 + chn) * 384;
            const float cMq = sMq, cwi = swi, cemr = semr, cdecay = sdecay; const f32x4 ca0 = sa[0], ca1 = sa[1];
            ML_GLOAD(tcn); ML_GSCAL(gsn);
            bf16x8 qf[8];
#pragma unroll
            for (int ks = 0; ks < 8; ++ks) qf[ks] = *(const LAS bf16x8*)(QN + (16 * qi + lr) * 264 + 32 * ks + 8 * lg);
            f32x4 St[2];
#pragma unroll
            for (int jj = 0; jj < 2; ++jj) { St[jj] = (f32x4){0.f, 0.f, 0.f, 0.f};
#pragma unroll
                for (int ks = 0; ks < 8; ++ks) { const bf16x8 kfr = *(const LAS bf16x8*)(KN + (16 * (2 * half + jj) + lr) * 264 + 32 * ks + 8 * lg);
                    St[jj] = __builtin_amdgcn_mfma_f32_16x16x32_bf16(kfr, qf[ks], St[jj], 0, 0, 0); } }
#pragma unroll
            for (int jj = 0; jj < 2; ++jj) { const int kt = 2 * half + jj; const int qtok = 16 * qi + lr, k0 = 16 * kt + 4 * lg; const f32x4 av = jj == 0 ? ca0 : ca1;
                float o[4];
#pragma unroll
                for (int r = 0; r < 4; ++r) { const float wgt = (k0 + r <= qtok) ? __expf(av[r] - cMq) : 0.f; o[r] = St[jj][r] * wgt; }
                u32x2 pk; pk.x = cvt_pk_bf16(o[0], o[1]); pk.y = cvt_pk_bf16(o[2], o[3]);
                *(LAS u32x2*)(Sw + qtok * 72 + k0) = pk; }
            __syncthreads();
            f32x4 num[2]; num[0] = (f32x4){0.f, 0.f, 0.f, 0.f}; num[1] = (f32x4){0.f, 0.f, 0.f, 0.f};
            const int nvt = half == 0 ? 2 : 1, vt0 = half == 0 ? 0 : 2;
#pragma unroll
            for (int i = 0; i < 2; ++i) if (i < nvt) {
                const int vn = vt0 + i;
#pragma unroll
                for (int ks = 0; ks < 8; ++ks) { const bf16x8 cf = *(const LAS bf16x8*)(Cb + (16 * vn + lr) * 264 + 32 * ks + 8 * lg);
                    num[i] = __builtin_amdgcn_mfma_f32_16x16x32_bf16(cf, qf[ks], num[i], 0, 0, 0); }
                num[i] *= cwi;
#pragma unroll
                for (int k2 = 0; k2 < 2; ++k2) { const bf16x8 sf = *(const LAS bf16x8*)(Sw + (16 * qi + lr) * 72 + 32 * k2 + 8 * lg);
                    const bf16x8 vf = lds_tr_frag(VN + (32 * k2 + 8 * lg + trq) * 56 + 16 * vn + trp, 56);
                    num[i] = __builtin_amdgcn_mfma_f32_16x16x32_bf16(vf, sf, num[i], 0, 0, 0); }
            }
            if (half == 1 && lg == 0) sc_den[16 * qi + lr] = num[0][0];
            {
                bf16x8 vwf[3][2];
#pragma unroll
                for (int vn = 0; vn < 3; ++vn)
#pragma unroll
                    for (int k2 = 0; k2 < 2; ++k2) vwf[vn][k2] = lds_tr_frag(VW + (32 * k2 + 8 * lg + trq) * 56 + 16 * vn + trp, 56);
#pragma unroll
                for (int dm = 0; dm < 2; ++dm) {
                    bf16x8 kf2[2];
#pragma unroll
                    for (int k2 = 0; k2 < 2; ++k2) kf2[k2] = lds_tr_frag(KN + (32 * k2 + 8 * lg + trq) * 264 + 32 * w + 16 * dm + trp, 264);
#pragma unroll
                    for (int vn = 0; vn < 3; ++vn) { f32x4 c = Cacc[dm][vn] * cdecay;
#pragma unroll
                        for (int k2 = 0; k2 < 2; ++k2) c = __builtin_amdgcn_mfma_f32_16x16x32_bf16(kf2[k2], vwf[vn][k2], c, 0, 0, 0);
                        Cacc[dm][vn] = c; }
                }
            }
            __syncthreads();
            if (half == 0) {
                const float dn = __builtin_amdgcn_rcpf(fmaxf(fabsf(sc_den[16 * qi + lr]), cemr));
#pragma unroll
                for (int i = 0; i < 2; ++i) { u32x2 pk; pk.x = cvt_pk_bf16(num[i][0] * dn, num[i][1] * dn); pk.y = cvt_pk_bf16(num[i][2] * dn, num[i][3] * dn);
                    *(u32x2*)(HC + (tc0 + 16 * qi + lr) * 1024 + h * 256 + vs * 32 + 16 * i + 4 * lg) = pk; }
            }
#pragma unroll
            for (int dm = 0; dm < 2; ++dm)
#pragma unroll
                for (int vn = 0; vn < 3; ++vn) { const f32x4 c = Cacc[dm][vn]; u32x2 pk; pk.x = cvt_pk_bf16(c[0], c[1]); pk.y = cvt_pk_bf16(c[2], c[3]);
                    *(LAS u32x2*)(Cb + (16 * vn + lr) * 264 + 32 * w + 16 * dm + 4 * lg) = pk; }
            ML_LWRITE();
            __syncthreads();
        }
#undef ML_GLOAD
#undef ML_GSCAL
#undef ML_LWRITE
    }
}

__device__ __forceinline__ void phase_aout(const Params& p) {
    const int tid = fresh_tid(), lane = tid & 63, gw = blockIdx.x * 8 + (tid >> 6), NGW = gridDim.x * 8;
    const bf16_t* HC = (const bf16_t*)(p.ws + R1); const bf16_t* SOM = (const bf16_t*)(p.ws + R2); const bf16_t* XC = (const bf16_t*)(p.ws + R0);
    bf16_t* AO = (bf16_t*)(p.ws + R6);
    const float* hg = p.in[9]; const float* sk = p.in[10];
    for (int t = gw; t < T_; t += NGW) {
#pragma unroll
        for (int h = 0; h < 4; ++h) {
            const size_t off = (size_t)t * 1024 + h * 256 + 4 * lane;
            const u32x2 hw = *(const u32x2*)(HC + off), ow = *(const u32x2*)(SOM + off), xw = *(const u32x2*)(XC + off);
            const f32x4 g4 = *(const f32x4*)(hg + h * 256 + 4 * lane), s4 = *(const f32x4*)(sk + h * 256 + 4 * lane);
            float hv[4] = {bflo(hw.x), bfhi(hw.x), bflo(hw.y), bfhi(hw.y)};
            const float ov[4] = {bflo(ow.x), bfhi(ow.x), bflo(ow.y), bfhi(ow.y)}, xv[4] = {bflo(xw.x), bfhi(xw.x), bflo(xw.y), bfhi(xw.y)};
            const float mu = wave_sum((hv[0] + hv[1]) + (hv[2] + hv[3])) * (1.0f / 256.0f);
#pragma unroll
            for (int j = 0; j < 4; ++j) hv[j] -= mu;
            const float var = wave_sum((hv[0] * hv[0] + hv[1] * hv[1]) + (hv[2] * hv[2] + hv[3] * hv[3])) * (1.0f / 256.0f);
            const float rs = rsqrtf(var + EPS_);
            float o[4];
#pragma unroll
            for (int j = 0; j < 4; ++j) o[j] = ov[j] * (hv[j] * rs * g4[j]) + s4[j] * xv[j];
            u32x2 wv; wv.x = cvt_pk_bf16(o[0], o[1]); wv.y = cvt_pk_bf16(o[2], o[3]);
            *(u32x2*)(AO + off) = wv;
        }
    }
}

__device__ __forceinline__ bf16x8 s5_load_af(const bf16_t* US, size_t tokb, int g, int lane) {
    const int lr = lane & 15, lg = lane >> 4;
    bf16x8 af = *(const bf16x8*)(US + (tokb + lr) * 512 + g * 16 + 8 * (lg & 1));
    if (lg >= 2) af = (bf16x8){0, 0, 0, 0, 0, 0, 0, 0};
    return af;
}
template <bool PASS_C>
__device__ __forceinline__ void s5_block16(const bf16x8 af, int lane, const bf16x8 (&bbf)[8], LAS float* but, LAS bf16_t* stb, float ar, float ai, float& sr, float& si) {
    const int lr = lane & 15, lg = lane >> 4;
#pragma unroll
    for (int ct = 0; ct < 8; ++ct) { const f32x4 d = __builtin_amdgcn_mfma_f32_16x16x32_bf16(af, bbf[ct], (f32x4){0.f, 0.f, 0.f, 0.f}, 0, 0, 0);
#pragma unroll
        for (int r = 0; r < 4; ++r) but[(4 * lg + r) * 132 + 16 * ct + lr] = d[r]; }
#pragma unroll 4
    for (int tt = 0; tt < 16; ++tt) { const float br = but[tt * 132 + lane], bi = but[tt * 132 + 64 + lane];
        const float nr = ar * sr - ai * si + br, ni = ar * si + ai * sr + bi; sr = nr; si = ni;
        if (PASS_C) { stb[tt * 136 + lane] = f2bf(sr); stb[tt * 136 + 64 + lane] = f2bf(si); } }
}
__device__ __forceinline__ void phase_s5(const Params& p, LAS unsigned char* lds) {
    const int tid = fresh_tid(), lane = tid & 63, wave = __builtin_amdgcn_readfirstlane(tid >> 6), lr = lane & 15, lg = lane >> 4;
    const bf16_t* US = (const bf16_t*)(p.ws + R5);
    const float* A = (const float*)(p.ws + WS_S5A); const bf16_t* BbT = (const bf16_t*)(p.ws + WS_S5BT); const bf16_t* CmT = (const bf16_t*)(p.ws + WS_S5CT);
    bf16_t* YB = (bf16_t*)(p.ws + R7);
    LAS float* but = (LAS float*)(lds + wave * 16896);
    LAS bf16_t* stb = (LAS bf16_t*)(lds + wave * 16896 + 8448);
    LAS float* Eb = (LAS float*)(lds + 8 * 16896);
    for (int item = blockIdx.x; item < NB_ * SG_; item += gridDim.x) {
        const int b = item & 7, g = item >> 3, gp = g * 64 + lane;
        const float ar = A[gp * 2], ai = A[gp * 2 + 1];
        bf16x8 bbf[8];
#pragma unroll
        for (int ct = 0; ct < 8; ++ct) { bbf[ct] = *(const bf16x8*)(BbT + ((size_t)(g * 128 + 16 * ct + lr)) * 16 + 8 * (lg & 1)); if (lg >= 2) bbf[ct] = (bf16x8){0, 0, 0, 0, 0, 0, 0, 0}; }
        const size_t tokw = (size_t)b * SEQ_ + (size_t)wave * 512;
        float sr = 0.f, si = 0.f;
        { bf16x8 afc = s5_load_af(US, tokw, g, lane);
          for (int blk = 0; blk < 32; ++blk) { const int bn = blk + 1 < 32 ? blk + 1 : blk; const bf16x8 afn = s5_load_af(US, tokw + bn * 16, g, lane);
              s5_block16<false>(afc, lane, bbf, but, stb, ar, ai, sr, si); afc = afn; } }
        Eb[(wave * 64 + lane) * 2] = sr; Eb[(wave * 64 + lane) * 2 + 1] = si;
        __syncthreads();
        float pr = ar, pi = ai;
#pragma unroll
        for (int i = 0; i < 9; ++i) { const float nr = pr * pr - pi * pi, ni = 2.f * pr * pi; pr = nr; pi = ni; }
        sr = 0.f; si = 0.f;
        for (int j = 0; j < wave; ++j) { const float er = Eb[(j * 64 + lane) * 2], ei = Eb[(j * 64 + lane) * 2 + 1]; const float nr = pr * sr - pi * si + er, ni = pr * si + pi * sr + ei; sr = nr; si = ni; }
        bf16x8 cmf[4];
#pragma unroll
        for (int kk = 0; kk < 4; ++kk) cmf[kk] = *(const bf16x8*)(CmT + ((size_t)(g * 16 + lr)) * 128 + 32 * kk + 8 * lg);
        const float dsk = p.in[18][g * 16 + lr];
        bf16x8 afc = s5_load_af(US, tokw, g, lane);
        bf16_t uuc[4];
#pragma unroll
        for (int r = 0; r < 4; ++r) uuc[r] = US[(tokw + 4 * lg + r) * 512 + g * 16 + lr];
        for (int blk = 0; blk < 32; ++blk) {
            const size_t tokb = tokw + blk * 16;
            const int bn = blk + 1 < 32 ? blk + 1 : blk; const bf16x8 afn = s5_load_af(US, tokw + bn * 16, g, lane);
            bf16_t uun[4];
#pragma unroll
            for (int r = 0; r < 4; ++r) uun[r] = US[(tokw + bn * 16 + 4 * lg + r) * 512 + g * 16 + lr];
            s5_block16<true>(afc, lane, bbf, but, stb, ar, ai, sr, si);
            f32x4 y = (f32x4){0.f, 0.f, 0.f, 0.f};
#pragma unroll
            for (int kk = 0; kk < 4; ++kk) { const bf16x8 sf = *(const LAS bf16x8*)(stb + lr * 136 + 32 * kk + 8 * lg); y = __builtin_amdgcn_mfma_f32_16x16x32_bf16(sf, cmf[kk], y, 0, 0, 0); }
#pragma unroll
            for (int r = 0; r < 4; ++r) { const size_t tok = tokb + 4 * lg + r; const float uu = bf2f(uuc[r]);
                const float v = y[r] + dsk * uu;
                const float z = 0.7978845608f * (v + 0.044715f * v * v * v); const float th = 1.0f - 2.0f * __builtin_amdgcn_rcpf(1.0f + __expf(2.0f * z));
                YB[tok * 512 + g * 16 + lr] = f2bf(0.5f * v * (1.0f + th)); }
            afc = afn;
#pragma unroll
            for (int r = 0; r < 4; ++r) uuc[r] = uun[r];
        }
        __syncthreads();
    }
}

__device__ __forceinline__ void phase_ffn_fix(const Params& p) {
    const bf16_t* SIDE = (const bf16_t*)(p.ws + WS_SIDE); bf16_t* ACT = (bf16_t*)(p.ws + WS_ACT);
    const float* cw = p.in[26]; const float* cb = p.in[27];
    const int total = 128 * 2 * 352;
    for (int idx = blockIdx.x * 512 + fresh_tid(); idx < total; idx += gridDim.x * 512) {
        const int fg = idx % 352, s2 = (idx / 352) & 1, pm = idx / 704, f0 = fg * 8;
        float va[8], vb[8], vc[8], vd[8], ga[8], gb[8], gc[8], gd[8];
        const bf16_t* cur = SIDE + (size_t)pm * 8 * F2_ + f0;
        if (s2 == 0) {
            if ((pm & 15) == 0) {
#pragma unroll
                for (int j = 0; j < 8; ++j) { va[j] = 0.f; vb[j] = 0.f; ga[j] = 0.f; gb[j] = 0.f; } }
            else { const bf16_t* prv = SIDE + (size_t)(pm - 1) * 8 * F2_ + f0;
                unpack8(*(const u32x4*)(prv + 6 * F2_), va); unpack8(*(const u32x4*)(prv + 7 * F2_), vb); unpack8(*(const u32x4*)(prv + 6 * F2_ + F_), ga); unpack8(*(const u32x4*)(prv + 7 * F2_ + F_), gb); }
            unpack8(*(const u32x4*)(cur), vc); unpack8(*(const u32x4*)(cur + F2_), vd); unpack8(*(const u32x4*)(cur + F_), gc); unpack8(*(const u32x4*)(cur + F2_ + F_), gd);
        } else {
            unpack8(*(const u32x4*)(cur + 2 * F2_), va); unpack8(*(const u32x4*)(cur + 3 * F2_), vb); unpack8(*(const u32x4*)(cur + 2 * F2_ + F_), ga); unpack8(*(const u32x4*)(cur + 3 * F2_ + F_), gb);
            unpack8(*(const u32x4*)(cur + 4 * F2_), vc); unpack8(*(const u32x4*)(cur + 5 * F2_), vd); unpack8(*(const u32x4*)(cur + 4 * F2_ + F_), gc); unpack8(*(const u32x4*)(cur + 5 * F2_ + F_), gd);
        }
        float o0[8], o1[8];
#pragma unroll
        for (int j = 0; j < 8; ++j) { const int f = f0 + j;
            const float wv0 = cw[f], wv1 = cw[F2_ + f], wv2 = cw[2 * F2_ + f], wg0 = cw[F_ + f], wg1 = cw[F2_ + F_ + f], wg2 = cw[2 * F2_ + F_ + f], bv = cb[f], bg = cb[F_ + f];
            o0[j] = ffn_gate(bg, wg0, wg1, wg2, ga[j], gb[j], gc[j], bv, wv0, wv1, wv2, va[j], vb[j], vc[j]);
            o1[j] = ffn_gate(bg, wg0, wg1, wg2, gb[j], gc[j], gd[j], bv, wv0, wv1, wv2, vb[j], vc[j], vd[j]); }
        bf16_t* op = ACT + ((size_t)pm * 256 + 128 * s2) * F_ + f0;
        *(u32x4*)(op) = pack8(o0); *(u32x4*)(op + F_) = pack8(o1);
    }
}

__device__ __forceinline__ void phase_final(const Params& p) {
    const int tid = fresh_tid(), lane = tid & 63, gw = blockIdx.x * 8 + (tid >> 6), NGW = gridDim.x * 8;
    const float* ss = (const float*)(p.ws + WS_SS2); const float* gf = p.in[29];
    for (int row = gw; row < T_; row += NGW) {
        const float sv = (lane < 16) ? ss[(size_t)row * 16 + lane] : 0.f;
        const float ri = rsqrtf(wave_sum(sv) * (1.0f / 1024.0f) + EPS_);
        f32x4* xr = (f32x4*)(p.out + (size_t)row * 1024) + lane;
#pragma unroll
        for (int j = 0; j < 4; ++j) { const f32x4 g4 = *((const f32x4*)gf + lane + 64 * j); f32x4 v = xr[64 * j]; v = v * ri * g4; xr[64 * j] = v; }
    }
}

#ifndef PHASE_MASK
#define PHASE_MASK 0xffffffffu
#endif
#define PH(k) ((PHASE_MASK >> (k)) & 1u)
#ifndef REP_MASK
#define REP_MASK 0u
#endif
#define REPS(k) for (int rep_ = 0; rep_ < 1 + (int)((REP_MASK >> (k)) & 1u); ++rep_)
__global__ void __launch_bounds__(512, 2) fwd_megakernel(Params p) {
    extern __shared__ __attribute__((aligned(16))) unsigned char lds_raw[];
    LAS unsigned char* lds = (LAS unsigned char*)lds_raw;
    unsigned char* ws = p.ws;
    bf16_t* dq = (bf16_t*)p.out;
    volatile LAS unsigned* bst = (volatile LAS unsigned*)(lds + LDS_BYTES - 64);
    if (threadIdx.x < 2) bst[threadIdx.x] = 0u;
    __syncthreads();
    const XcdBarrier xbar = xcd_barrier_post((unsigned*)(ws + WS_BAR), bst);
    REPS(0) if (PH(0)) phase0(p, lds);
    xcd_barrier(xbar);
    REPS(1) if (PH(1)) { pg8::PlainSched S; S.set(ws + R0, 1024, ws + WS_WIN, 1024, T_ / 256, NP1_ / 256);
      EpiProj E{(const float*)(ws + WS_RINV1), (const float*)(ws + WS_BIASP), (bf16_t*)(ws + R1), (bf16_t*)(ws + R2), (bf16_t*)(ws + R5), (bf16_t*)(ws + R3), (bf16_t*)(ws + R4)};
      pg8::gemm_phase(lds, S, E, 1024, 1024, 1024); }
    xcd_barrier(xbar);
    REPS(2) if (PH(2)) { phase_gates(p, lds); phase_conv_m(p); }
    REPS(6) if (PH(6)) phase_s5(p, lds);
    xcd_barrier(xbar);
    REPS(3) if (PH(3)) { SchedQKV S; S.init(T_ / 256, 12, gridDim.x, blockIdx.x); S.xc = (const char*)(ws + R0); S.xm = (const char*)(ws + R1); S.wqk = (const char*)(ws + WS_WQK); S.wv = (const char*)(ws + WS_WV);
      EpiQKV E{dq, (bf16_t*)(ws + R6)};
      pg8::gemm_phase(lds, S, E, 256, 1024, 256); }
    REPS(8) if (PH(8)) { pg8::PlainSched S; S.set(ws + R7, 512, ws + WS_WGLU, 512, T_ / 256, 2);
      EpiGate<0> E{(const bf16_t*)(ws + R7), nullptr, p.in[20], (bf16_t*)(ws + R5), 512};
      pg8::gemm_phase(lds, S, E, 512, 512, 512); }
    xcd_barrier(xbar);
    REPS(4) if (PH(4)) phase_mlstm(p, lds);
    xcd_barrier(xbar);
    REPS(5) if (PH(5)) phase_aout(p);
    REPS(9) if (PH(9)) { pg8::PlainSched S; S.set(ws + R5, 512, ws + WS_WB, 512, T_ / 256, 4);
      EpiGate<1> E{(const bf16_t*)(ws + R4), nullptr, nullptr, dq, 1024};
      pg8::gemm_phase(lds, S, E, 512, 512, 512); }
    xcd_barrier(xbar);
    REPS(10) if (PH(10)) { pg8::PlainSched S; S.set(ws + R6, 1024, ws + WS_WA, 1024, T_ / 256, 4);
      EpiGate<2> E{(const bf16_t*)(ws + R3), dq, nullptr, (bf16_t*)(ws + R0), 1024};
      pg8::gemm_phase(lds, S, E, 1024, 1024, 1024); }
    xcd_barrier(xbar);
    REPS(11) if (PH(11)) { pg8::PlainSched S; S.set(ws + R0, 1024, ws + WS_WOUT, 1024, T_ / 256, 4);
      EpiResid<true> E{p.in[0], nullptr, nullptr, (bf16_t*)(ws + WS_X1B), (float*)(ws + WS_SS1)};
      pg8::gemm_phase(lds, S, E, 1024, 1024, 1024); }
    xcd_barrier(xbar);
    REPS(12) if (PH(12)) { pg8::PlainSched S; S.set(ws + WS_X1B, 1024, ws + WS_WUP, 1024, T_ / 256, F_ / 128);
      EpiUpFused E{(const float*)(ws + WS_SS1), p.in[26], p.in[27], (bf16_t*)(ws + WS_ACT), (bf16_t*)(ws + WS_SIDE)};
      pg8::gemm_phase(lds, S, E, 1024, 1024, 1024); }
    xcd_barrier(xbar);
    REPS(13) if (PH(13)) phase_ffn_fix(p);
    xcd_barrier(xbar);
    REPS(14) if (PH(14)) { pg8::PlainSched S; S.set(ws + WS_ACT, F_, ws + WS_WDN, F_, T_ / 256, 4);
      EpiResid<false> E{nullptr, (const bf16_t*)(ws + WS_X1B), p.out, nullptr, (float*)(ws + WS_SS2)};
      pg8::gemm_phase(lds, S, E, F_, F_, F_); }
    xcd_barrier(xbar);
    REPS(15) if (PH(15)) phase_final(p);
}

extern "C" void kernel_launch(void* const* d_in, const int* in_sizes, int n_in, void* d_out, int out_size, void* d_ws, size_t ws_size, hipStream_t stream) {
    static int grid_blocks = 0;
    if (!grid_blocks) {
        int dev = 0, cus = 0, per_cu = 0;
        (void)hipGetDevice(&dev);
        (void)hipDeviceGetAttribute(&cus, hipDeviceAttributeMultiprocessorCount, dev);
        (void)hipFuncSetAttribute((const void*)fwd_megakernel, hipFuncAttributeMaxDynamicSharedMemorySize, LDS_BYTES);
        (void)hipOccupancyMaxActiveBlocksPerMultiprocessor(&per_cu, (const void*)fwd_megakernel, 512, LDS_BYTES);
        if (per_cu < 1) { fprintf(stderr, "kernel_launch: occupancy query returned %d\n", per_cu); }
        grid_blocks = cus;
        if (n_in != 30 || out_size != T_ * D_ || ws_size < 512 * MiB) fprintf(stderr, "kernel_launch: unexpected sizes n_in=%d out=%d ws=%zu\n", n_in, out_size, ws_size);
    }
    Params p{};
    for (int i = 0; i < 30; ++i) p.in[i] = (const float*)d_in[i];
    p.out = (float*)d_out; p.ws = (unsigned char*)d_ws;
    (void)hipMemsetAsync((unsigned char*)d_ws + WS_BAR, 0, XCD_BAR_WORDS * 4, stream);
    void* args[] = {&p};
    hipError_t e = hipLaunchCooperativeKernel((void*)fwd_megakernel, dim3(grid_blocks), dim3(512), args, LDS_BYTES, stream);
    if (e != hipSuccess) fprintf(stderr, "cooperative launch failed: %s (grid %d)\n", hipGetErrorString(e), grid_blocks);
}
```

```cpp
#include <hip/hip_runtime.h>
#include <hip/hip_cooperative_groups.h>
#include <cstdio>
#include <cstdint>
namespace cg = cooperative_groups;

#define LAS __attribute__((address_space(3)))
typedef unsigned short bf16_t;
typedef short bf16x8 __attribute__((ext_vector_type(8)));
typedef float f32x4 __attribute__((ext_vector_type(4)));
typedef float f32x2 __attribute__((ext_vector_type(2)));
typedef unsigned u32x4 __attribute__((ext_vector_type(4)));
typedef unsigned u32x2 __attribute__((ext_vector_type(2)));

constexpr int T_ = 32768, D_ = 1024, SEQ_ = 4096, NB_ = 8;
constexpr int NH_ = 4, DH_ = 256, NCH_ = 64;
constexpr int SW_ = 512, SG_ = 32, SP_ = 64;
constexpr int F_ = 2816, F2_ = 5632, NIN_ = 4616, NP1_ = 4608;
constexpr float EPS_ = 1e-6f;

constexpr size_t MiB = 1ull << 20, KiB = 1024;
constexpr size_t WS_WIN = 0, WS_WQK = 9 * MiB, WS_WV = 10 * MiB, WS_WGLU = 10 * MiB + 512 * KiB, WS_WA = 11 * MiB, WS_WB = 13 * MiB, WS_WOUT = 14 * MiB,
                 WS_WUP = 16 * MiB, WS_WDN = 27 * MiB;
constexpr size_t WS_S5A = 33 * MiB, WS_S5BT = WS_S5A + 32 * KiB, WS_S5CT = WS_S5A + 192 * KiB;
constexpr size_t WS_RINV1 = 34 * MiB, WS_IG = 34 * MiB + 512 * KiB, WS_FG = 35 * MiB, WS_BIASP = 35 * MiB + 512 * KiB;
constexpr size_t WS_GS = 50 * MiB;
constexpr size_t WS_BAR = 49 * MiB;
constexpr size_t WS_SS1 = 36 * MiB, WS_SS2 = 38 * MiB, WS_E = 40 * MiB;
constexpr size_t R0 = 56 * MiB, R1 = 120 * MiB, R2 = 184 * MiB, R3 = 248 * MiB, R4 = 312 * MiB, R5 = 376 * MiB, R6 = 408 * MiB, R7 = 472 * MiB;
constexpr size_t WS_XC = 408 * MiB;
constexpr size_t WS_X1B = 448 * MiB, WS_UH = 56 * MiB, WS_SIDE = 56 * MiB, WS_ACT = 232 * MiB;
constexpr int LDS_BYTES = 147456;

struct Params {
    const float* in[30];
    float* out;
    unsigned char* ws;
};

__device__ __forceinline__ unsigned cvt_pk_bf16(float lo, float hi) { unsigned r; asm volatile("v_cvt_pk_bf16_f32 %0, %1, %2" : "=v"(r) : "v"(lo), "v"(hi)); return r; }
__device__ __forceinline__ bf16_t f2bf(float x) { return (bf16_t)(cvt_pk_bf16(x, x) & 0xffffu); }
__device__ __forceinline__ float bf2f(unsigned short u) { return __uint_as_float(((unsigned)u) << 16); }
__device__ __forceinline__ float bflo(unsigned w) { return __uint_as_float(w << 16); }
__device__ __forceinline__ float bfhi(unsigned w) { return __uint_as_float(w & 0xffff0000u); }
__device__ __forceinline__ float sigmoidf_(float x) { return __builtin_amdgcn_rcpf(1.0f + __expf(-x)); }
__device__ __forceinline__ float siluf_(float x) { return x * sigmoidf_(x); }
__device__ __forceinline__ int fresh_tid() { int t = threadIdx.x; asm volatile("" : "+v"(t)); return t; }
__device__ __forceinline__ float wave_sum(float v) {
#pragma unroll
    for (int o = 1; o < 64; o <<= 1) v += __shfl_xor(v, o);
    return v;
}
__device__ __forceinline__ void unpack8(const u32x4 w, float (&f)[8]) {
    f[0] = bflo(w.x); f[1] = bfhi(w.x); f[2] = bflo(w.y); f[3] = bfhi(w.y); f[4] = bflo(w.z); f[5] = bfhi(w.z); f[6] = bflo(w.w); f[7] = bfhi(w.w);
}
__device__ __forceinline__ u32x4 pack8(const float (&f)[8]) {
    u32x4 w; w.x = cvt_pk_bf16(f[0], f[1]); w.y = cvt_pk_bf16(f[2], f[3]); w.z = cvt_pk_bf16(f[4], f[5]); w.w = cvt_pk_bf16(f[6], f[7]); return w;
}


#define XB_TMO      128
#define XB_XCNT(j)  (256  + 64 * (j))
#define XB_XSUB(j)  (1280 + 64 * (j))
#define XB_XGEN(j)  (2304 + 64 * (j))
#define XB_TOP      3328
#define XB_TOPGEN   3392
#define XCD_BAR_WORDS 3456
#define XB_SPIN_CAP (1u << 18)
__device__ __forceinline__ unsigned xb_ld(unsigned* p)              { return __hip_atomic_load(p, __ATOMIC_RELAXED, __HIP_MEMORY_SCOPE_AGENT); }
__device__ __forceinline__ unsigned xb_add(unsigned* p, unsigned v) { return __hip_atomic_fetch_add(p, v, __ATOMIC_RELAXED, __HIP_MEMORY_SCOPE_AGENT); }
__device__ __forceinline__ unsigned xb_xcc_id() { return (unsigned)__builtin_amdgcn_s_getreg((3 << 11) | 20) & 0xFu; }
#define XB_SPIN(cond, bar) do { unsigned _sp = 0; while (cond) { __builtin_amdgcn_s_sleep(1); \
    if ((++_sp & 255u) == 0u) { if (xb_ld(&(bar)[XB_TMO])) break; if (_sp > XB_SPIN_CAP) { atomicAdd(&(bar)[XB_TMO], 1u); break; } } } } while (0)
struct XcdBarrier { unsigned* bar; unsigned x; volatile LAS unsigned* st; };
__device__ __forceinline__ XcdBarrier xcd_barrier_post(unsigned* bar, volatile LAS unsigned* st) {
    XcdBarrier b; b.bar = bar; b.x = xb_xcc_id(); b.st = st;
    if (threadIdx.x == 0) (void)xb_add(&bar[XB_XCNT(b.x)], 1u);
    return b;
}
__device__ __forceinline__ void xcd_barrier_complete(unsigned* bar, unsigned x, unsigned& nloc, unsigned& nx) {
    const unsigned G = gridDim.x * gridDim.y * gridDim.z;
    unsigned sum, cnt, mine, sp = 0u;
    for (;;) {
        sum = 0u; cnt = 0u; mine = 0u;
#pragma unroll
        for (unsigned j = 0; j < 16; ++j) { const unsigned c = xb_ld(&bar[XB_XCNT(j)]); sum += c; cnt += (c > 0u) ? 1u : 0u; mine = (j == x) ? c : mine; }
        if (sum == G) break;
        __builtin_amdgcn_s_sleep(1);
        if ((++sp & 255u) == 0u) { if (xb_ld(&bar[XB_TMO])) break; if (sp > XB_SPIN_CAP) { atomicAdd(&bar[XB_TMO], 1u); break; } }
    }
    nloc = mine > 0u ? mine : 1u; nx = cnt > 0u ? cnt : 1u;
}
__device__ __forceinline__ void xcd_barrier(const XcdBarrier& b) {
    asm volatile("s_waitcnt vmcnt(0)" ::: "memory");
    __syncthreads();
    if (threadIdx.x == 0) {
        unsigned* bar = b.bar;
        __builtin_amdgcn_s_waitcnt(0);
        unsigned nloc = b.st[0], nx = b.st[1];
        if (nloc == 0u) { xcd_barrier_complete(bar, b.x, nloc, nx); b.st[0] = nloc; b.st[1] = nx; }
        const unsigned old = xb_add(&bar[XB_XSUB(b.x)], 1u);
        const unsigned gen = old / nloc;
        if (old + 1u == (gen + 1u) * nloc) {
            __builtin_amdgcn_fence(__ATOMIC_RELEASE, "agent");
            asm volatile("s_waitcnt vmcnt(0)" ::: "memory");
            const unsigned og = xb_add(&bar[XB_TOP], 1u);
            const unsigned tg = og / nx;
            if (og + 1u == (tg + 1u) * nx) xb_add(&bar[XB_TOPGEN], 1u);
            else XB_SPIN(xb_ld(&bar[XB_TOPGEN]) == tg, bar);
            __builtin_amdgcn_fence(__ATOMIC_ACQUIRE, "agent");
            xb_add(&bar[XB_XGEN(b.x)], 1u);
            asm volatile("s_waitcnt vmcnt(0)" ::: "memory");
        } else {
            XB_SPIN(xb_ld(&bar[XB_XGEN(b.x)]) == gen, bar);
            __builtin_amdgcn_fence(__ATOMIC_ACQUIRE, "agent");
            asm volatile("s_waitcnt vmcnt(0)" ::: "memory");
        }
    }
    __syncthreads();
}

namespace pg8 {
constexpr int BM = 256, BK = 64, HALF = 128, HTB = HALF * BK * 2, STAGE_BYTES = 8 * HTB, NXCD = 8, WGM = 8;
__device__ __forceinline__ int lds_byte(int r, int c) { const int st = (r >> 4) * 2 + (c >> 5), rr = r & 15, cc = c & 31, ob = rr * 64 + cc * 2; return st * 1024 + (ob ^ (((ob >> 9) & 1) << 5)); }
__device__ __forceinline__ void stage_rc(int b, int& R, int& C) { const int st = b / 1024, sb = b % 1024, swz = sb ^ (((sb >> 9) & 1) << 5); R = (st >> 1) * 16 + swz / 64; C = (st & 1) * 32 + (swz % 64) / 2; }
__device__ __forceinline__ int perm32(int rho) { const int n = rho >> 4, i = rho & 15; return 8 * (i >> 2) + 4 * n + (i & 3); }
struct Unit { int pm, pn; };
struct Order {
    int nM, nN, nwg, G, c;
    __device__ __forceinline__ void init(int nM_, int nN_, int G_, int c_) { nM = nM_; nN = nN_; nwg = nM * nN; G = G_; c = c_; }
    __device__ __forceinline__ bool next(int i, Unit& u) const {
        const long L = (long)i * G + c; if (L >= nwg) return false;
        int wgid = (int)L; { const int q = nwg / NXCD, r = nwg % NXCD, xcd = wgid % NXCD, off = wgid / NXCD; wgid = (xcd < r ? xcd * (q + 1) : r * (q + 1) + (xcd - r) * q) + off; }
        const int nig = WGM * nN, gid = wgid / nig, fm = gid * WGM, gsz = (nM - fm) < WGM ? (nM - fm) : WGM;
        u.pm = fm + ((wgid % nig) % gsz); u.pn = (wgid % nig) / gsz; return true;
    }
};
template <class Epi, class Sched>
__device__ __forceinline__ void gemm_phase(LAS unsigned char* lds, const Sched& S, const Epi& E, const int K, const int lda, const int ldb) {
    const int tid = fresh_tid(), wid = __builtin_amdgcn_readfirstlane(tid >> 6), lane = tid & 63, wr = wid >> 2, wc = wid & 3, fr = lane & 15, fq = lane >> 4;
    const int nt = K / BK;
    unsigned voffA[2], voffB[2];
#pragma unroll
    for (int i = 0; i < 2; ++i) { int R, C; stage_rc(tid * 16 + i * 8192, R, C); const int Rb = Epi::PERM ? ((R & ~31) + perm32(R & 31)) : R;
        const int Ra = Epi::ROWPERM ? (((R >> 6) * 16 + (R & 15)) * 8 + ((R >> 4) & 3)) : R;
        voffA[i] = (unsigned)(Ra * lda + C) * 2u; voffB[i] = (unsigned)(Rb * ldb + C) * 2u; }
    const size_t kstep = (size_t)(BK * 2);
    const size_t hstepA = (size_t)(Epi::ROWPERM ? 4 : HALF) * lda * 2, hstepB = (size_t)HALF * ldb * 2;
    const unsigned ldsw = (unsigned)wid * 1024u;
    const int aoff = lds_byte(wr * 64 + fr, fq * 8), boff = lds_byte(wc * 32 + fr, fq * 8);
#define PG8_SA(b, h) (((b) * 2 + (h)) * HTB)
#define PG8_SB(b, h) ((4 + (b) * 2 + (h)) * HTB)
#define PG8_STAGE(bufoff, gbase, voff) do { _Pragma("unroll") for (int _i = 0; _i < 2; ++_i) \
        __builtin_amdgcn_global_load_lds((const unsigned*)((const char*)(gbase) + (voff)[_i]), (LAS unsigned*)(lds + (bufoff) + ldsw + _i * 8192), 16, 0, 0); } while (0)
#define PG8_LDA(dst, b, h) do { _Pragma("unroll") for (int m = 0; m < 4; ++m) _Pragma("unroll") for (int k = 0; k < 2; ++k) dst[m][k] = *(const LAS bf16x8*)(lds + PG8_SA(b, h) + aoff + m * 2048 + k * 1024); } while (0)
#define PG8_LDB(dst, b, h) do { _Pragma("unroll") for (int n = 0; n < 2; ++n) _Pragma("unroll") for (int k = 0; k < 2; ++k) dst[n][k] = *(const LAS bf16x8*)(lds + PG8_SB(b, h) + boff + n * 2048 + k * 1024); } while (0)
#define PG8_MMA(ai, bj, At, Bt) do { __builtin_amdgcn_s_setprio(1); _Pragma("unroll") for (int m = 0; m < 4; ++m) _Pragma("unroll") for (int n = 0; n < 2; ++n) _Pragma("unroll") for (int k = 0; k < 2; ++k) \
        acc[ai][bj][m][n] = __builtin_amdgcn_mfma_f32_16x16x32_bf16(Bt[n][k], At[m][k], acc[ai][bj][m][n], 0, 0, 0); __builtin_amdgcn_s_setprio(0); } while (0)
#define PG8_WAIT_V(n) asm volatile("s_waitcnt vmcnt(" #n ")" ::: "memory")
#define PG8_WAIT_L(n) asm volatile("s_waitcnt lgkmcnt(" #n ")" ::: "memory")
#define PG8_BAR __builtin_amdgcn_s_barrier()
#define PG8_SCHED __builtin_amdgcn_sched_barrier(0)
    Unit cur, nxt; int ui = 0;
    if (!S.next(0, cur)) return;
    f32x4 acc[2][2][4][2];
#pragma unroll
    for (int a = 0; a < 2; ++a)
#pragma unroll
        for (int b = 0; b < 2; ++b)
#pragma unroll
            for (int m = 0; m < 4; ++m)
#pragma unroll
                for (int n = 0; n < 2; ++n) acc[a][b][m][n] = (f32x4){0.f, 0.f, 0.f, 0.f};
    bf16x8 At[4][2], B0[2][2], B1[2][2];
    const char* cA = S.aptr(cur); const char* cB = S.bptr(cur);
    PG8_STAGE(PG8_SB(0, 0), cB, voffB); PG8_STAGE(PG8_SB(0, 1), cB + hstepB, voffB); PG8_STAGE(PG8_SA(0, 0), cA, voffA); PG8_STAGE(PG8_SA(0, 1), cA + hstepA, voffA);
    if (wr == 1) PG8_BAR;
    PG8_WAIT_V(2); PG8_BAR;
    PG8_STAGE(PG8_SB(1, 0), cB + kstep, voffB); PG8_STAGE(PG8_SA(1, 0), cA + kstep, voffA); PG8_STAGE(PG8_SB(1, 1), cB + hstepB + kstep, voffB);
    PG8_WAIT_V(6); PG8_BAR;
    for (;;) {
        const bool has_next = S.next(ui + 1, nxt);
        const char* nA = has_next ? S.aptr(nxt) : cA; const char* nB = has_next ? S.bptr(nxt) : cB;
#pragma unroll 1
        for (int t = 0; t < nt; t += 2) {
            const bool last = (t == nt - 2);
            const char* a1 = cA + (size_t)(t + 1) * kstep;
            const char* a2 = last ? nA : cA + (size_t)(t + 2) * kstep; const char* b2 = last ? nB : cB + (size_t)(t + 2) * kstep;
            const char* a3 = a2 + kstep; const char* b3 = b2 + kstep;
            PG8_LDB(B0, 0, 0); PG8_LDB(B1, 0, 1); PG8_SCHED; PG8_LDA(At, 0, 0); PG8_STAGE(PG8_SA(1, 1), a1 + hstepA, voffA);
            PG8_WAIT_V(8); PG8_WAIT_L(0); PG8_BAR; PG8_MMA(0, 0, At, B0); PG8_MMA(0, 1, At, B1); PG8_BAR; PG8_SCHED;
            PG8_LDA(At, 0, 1); PG8_STAGE(PG8_SB(0, 0), b2, voffB); PG8_STAGE(PG8_SB(0, 1), b2 + hstepB, voffB); PG8_STAGE(PG8_SA(0, 0), a2, voffA);
            PG8_WAIT_V(8); PG8_WAIT_L(0); PG8_BAR; PG8_MMA(1, 0, At, B0); PG8_MMA(1, 1, At, B1); PG8_BAR; PG8_SCHED;
            PG8_LDB(B0, 1, 0); PG8_LDB(B1, 1, 1); PG8_SCHED; PG8_LDA(At, 1, 0); PG8_STAGE(PG8_SA(0, 1), a2 + hstepA, voffA);
            PG8_WAIT_V(8); PG8_WAIT_L(0); PG8_BAR; PG8_MMA(0, 0, At, B0); PG8_MMA(0, 1, At, B1); PG8_BAR; PG8_SCHED;
            PG8_LDA(At, 1, 1); PG8_STAGE(PG8_SB(1, 0), b3, voffB); PG8_STAGE(PG8_SB(1, 1), b3 + hstepB, voffB); PG8_STAGE(PG8_SA(1, 0), a3, voffA);
            PG8_WAIT_V(8); PG8_WAIT_L(0); PG8_BAR; PG8_MMA(1, 0, At, B0); PG8_MMA(1, 1, At, B1); PG8_BAR; PG8_SCHED;
        }
        if (wr == 0) PG8_BAR;
        E(acc, cur, wr, wc, fr, fq);
        if (!has_next) break;
#pragma unroll
        for (int a = 0; a < 2; ++a)
#pragma unroll
            for (int b = 0; b < 2; ++b)
#pragma unroll
                for (int m = 0; m < 4; ++m)
#pragma unroll
                    for (int n = 0; n < 2; ++n) acc[a][b][m][n] = (f32x4){0.f, 0.f, 0.f, 0.f};
        cur = nxt; cA = nA; cB = nB; ++ui;
        if (wr == 1) PG8_BAR;
    }
    PG8_WAIT_V(0);
    PG8_BAR;
#undef PG8_SA
#undef PG8_SB
#undef PG8_STAGE
#undef PG8_LDA
#undef PG8_LDB
#undef PG8_MMA
#undef PG8_WAIT_V
#undef PG8_WAIT_L
#undef PG8_BAR
#undef PG8_SCHED
}
struct PlainSched : Order {
    const char* A; const char* B; size_t astep, bstep;
    __device__ __forceinline__ void set(const void* A_, int lda, const void* B_, int ldb, int nM_, int nN_) { A = (const char*)A_; B = (const char*)B_; astep = (size_t)BM * lda * 2; bstep = (size_t)BM * ldb * 2; init(nM_, nN_, gridDim.x, blockIdx.x); }
    __device__ __forceinline__ const char* aptr(const Unit& u) const { return A + (size_t)u.pm * astep; }
    __device__ __forceinline__ const char* bptr(const Unit& u) const { return B + (size_t)u.pn * bstep; }
};
}
using pg8::Unit;
typedef const f32x4 (&AccRef)[2][2][4][2];

__device__ __forceinline__ float dpp_shr1(float x) { return __int_as_float(__builtin_amdgcn_update_dpp(0, __float_as_int(x), 0x111, 0xf, 0xf, true)); }
struct EpiProj {
    static constexpr bool PERM = true, ROWPERM = true;
    const float* rinv; const float* bias; unsigned char* wsb; bf16_t *xm, *xc; const float* cw; const float* cb;
    __device__ __forceinline__ void operator()(AccRef acc, const Unit& u, int wr, int wc, int fr, int fq) const {
        const int pn = u.pn, tok0 = u.pm * 256 + (wr * 16 + fr) * 8;
        float ri[8];
        { const f32x4 q0 = *(const f32x4*)(rinv + tok0), q1 = *(const f32x4*)(rinv + tok0 + 4);
#pragma unroll
          for (int i = 0; i < 4; ++i) { ri[i] = q0[i]; ri[4 + i] = q1[i]; } }
        if (pn >= 4) {
            const size_t boff = pn < 8 ? R2 : (pn < 10 ? R5 : (pn < 14 ? R3 : R4));
            const int ldc = (pn >= 8 && pn < 10) ? 512 : 1024, colt = (pn < 8 ? pn - 4 : (pn < 10 ? pn - 8 : (pn < 14 ? pn - 10 : pn - 14))) * 256; const bool sig = !(pn >= 8 && pn < 10);
            bf16_t* base = (bf16_t*)(wsb + boff);
            const int col0 = colt + wc * 32 + 8 * fq, bcol0 = pn * 256 + wc * 32 + 8 * fq;
            f32x4 bv[2][2];
#pragma unroll
            for (int bj = 0; bj < 2; ++bj)
#pragma unroll
                for (int n = 0; n < 2; ++n) bv[bj][n] = *(const f32x4*)(bias + bcol0 + bj * 128 + 4 * n);
#pragma unroll
            for (int ai = 0; ai < 2; ++ai)
#pragma unroll
                for (int m = 0; m < 4; ++m) { const int i = ai * 4 + m; bf16_t* rowp = base + (size_t)(tok0 + i) * ldc + col0;
#pragma unroll
                    for (int bj = 0; bj < 2; ++bj) { f32x4 v0 = acc[ai][bj][m][0] * ri[i] + bv[bj][0], v1 = acc[ai][bj][m][1] * ri[i] + bv[bj][1];
                        if (sig) {
#pragma unroll
                            for (int j = 0; j < 4; ++j) { v0[j] = sigmoidf_(v0[j]); v1[j] = sigmoidf_(v1[j]); } }
                        u32x4 w; w.x = cvt_pk_bf16(v0[0], v0[1]); w.y = cvt_pk_bf16(v0[2], v0[3]); w.z = cvt_pk_bf16(v1[0], v1[1]); w.w = cvt_pk_bf16(v1[2], v1[3]);
                        *(u32x4*)(rowp + bj * 128) = w; } }
        } else {
#pragma unroll
            for (int bj = 0; bj < 2; ++bj)
#pragma unroll
                for (int n = 0; n < 2; ++n) {
                    const int c4 = pn * 256 + bj * 128 + wc * 32 + 8 * fq + 4 * n;
                    unsigned pkm[8][2], pkc[8][2];
#pragma unroll
                    for (int jp = 0; jp < 2; ++jp) {
                        const int c = c4 + 2 * jp;
                        const f32x2 bs = *(const f32x2*)(bias + c), w0 = *(const f32x2*)(cw + c), w1 = *(const f32x2*)(cw + 1024 + c), w2 = *(const f32x2*)(cw + 2048 + c), w3 = *(const f32x2*)(cw + 3072 + c), bc = *(const f32x2*)(cb + c);
                        float x0[11], x1[11];
#pragma unroll
                        for (int ai = 0; ai < 2; ++ai)
#pragma unroll
                            for (int m = 0; m < 4; ++m) { const int i = ai * 4 + m; x0[3 + i] = acc[ai][bj][m][n][2 * jp] * ri[i] + bs.x; x1[3 + i] = acc[ai][bj][m][n][2 * jp + 1] * ri[i] + bs.y; }
                        x0[0] = dpp_shr1(x0[8]); x0[1] = dpp_shr1(x0[9]); x0[2] = dpp_shr1(x0[10]);
                        x1[0] = dpp_shr1(x1[8]); x1[1] = dpp_shr1(x1[9]); x1[2] = dpp_shr1(x1[10]);
#pragma unroll
                        for (int i = 0; i < 8; ++i) {
                            const float y0 = bc.x + w0.x * x0[i] + w1.x * x0[i + 1] + w2.x * x0[i + 2] + w3.x * x0[i + 3];
                            const float y1 = bc.y + w0.y * x1[i] + w1.y * x1[i + 1] + w2.y * x1[i + 2] + w3.y * x1[i + 3];
                            pkc[i][jp] = cvt_pk_bf16(siluf_(y0), siluf_(y1)); pkm[i][jp] = cvt_pk_bf16(x0[3 + i], x1[3 + i]); }
                    }
#pragma unroll
                    for (int i = 0; i < 8; ++i) { const size_t o = (size_t)(tok0 + i) * 1024 + c4;
                        u32x2 wm; wm.x = pkm[i][0]; wm.y = pkm[i][1]; *(u32x2*)(xm + o) = wm;
                        if (!(fr == 0 && i < 3)) { u32x2 wx; wx.x = pkc[i][0]; wx.y = pkc[i][1]; *(u32x2*)(xc + o) = wx; } }
                    asm volatile("" ::: "memory");
                }
        }
    }
};
struct EpiQKV {
    static constexpr bool PERM = true, ROWPERM = false;
    bf16_t *qk, *v;
    __device__ __forceinline__ void operator()(AccRef acc, const Unit& u, int wr, int wc, int fr, int fq) const {
        const int head = u.pn & 3, kind = u.pn >> 2; bf16_t* base = (kind < 2) ? qk + (size_t)kind * T_ * 1024 : v;
        const int row0 = u.pm * 256 + wr * 64 + fr, col0 = head * 256 + wc * 32 + 8 * fq;
#pragma unroll
        for (int ai = 0; ai < 2; ++ai)
#pragma unroll
            for (int m = 0; m < 4; ++m) { bf16_t* rowp = base + (size_t)(row0 + ai * 128 + m * 16) * 1024 + col0;
#pragma unroll
                for (int bj = 0; bj < 2; ++bj) { const f32x4 v0 = acc[ai][bj][m][0], v1 = acc[ai][bj][m][1];
                    u32x4 w; w.x = cvt_pk_bf16(v0[0], v0[1]); w.y = cvt_pk_bf16(v0[2], v0[3]); w.z = cvt_pk_bf16(v1[0], v1[1]); w.w = cvt_pk_bf16(v1[2], v1[3]);
                    *(u32x4*)(rowp + bj * 128) = w; } }
    }
};
template <int MODE> struct EpiGate {
    static constexpr bool PERM = true, ROWPERM = false;
    const bf16_t* X; const bf16_t* Y; const float* bias; bf16_t* O; int ldc;
    __device__ __forceinline__ void operator()(AccRef acc, const Unit& u, int wr, int wc, int fr, int fq) const {
        const int row0 = u.pm * 256 + wr * 64 + fr, col0 = u.pn * 256 + wc * 32 + 8 * fq;
        f32x4 bv[2][2];
#pragma unroll
        for (int bj = 0; bj < 2; ++bj)
#pragma unroll
            for (int n = 0; n < 2; ++n) bv[bj][n] = (MODE == 0) ? *(const f32x4*)(bias + col0 + bj * 128 + 4 * n) : (f32x4){0.f, 0.f, 0.f, 0.f};
#pragma unroll
        for (int ai = 0; ai < 2; ++ai)
#pragma unroll
            for (int m = 0; m < 4; ++m) { const size_t off = (size_t)(row0 + ai * 128 + m * 16) * ldc + col0;
#pragma unroll
                for (int bj = 0; bj < 2; ++bj) {
                    float xv[8], a[8], o[8]; unpack8(*(const u32x4*)(X + off + bj * 128), xv);
#pragma unroll
                    for (int j = 0; j < 4; ++j) { a[j] = acc[ai][bj][m][0][j] + bv[bj][0][j]; a[4 + j] = acc[ai][bj][m][1][j] + bv[bj][1][j]; }
                    if (MODE == 0) {
#pragma unroll
                        for (int j = 0; j < 8; ++j) o[j] = xv[j] * sigmoidf_(a[j]); }
                    else if (MODE == 1) {
#pragma unroll
                        for (int j = 0; j < 8; ++j) o[j] = xv[j] * a[j]; }
                    else { float yv[8]; unpack8(*(const u32x4*)(Y + off + bj * 128), yv);
#pragma unroll
                        for (int j = 0; j < 8; ++j) o[j] = xv[j] * a[j] + yv[j]; }
                    *(u32x4*)(O + off + bj * 128) = pack8(o); } }
    }
};
template <bool WB> struct EpiResid {
    static constexpr bool PERM = false, ROWPERM = false;
    const float* Rs; const bf16_t* Rb; float* Of; bf16_t* Ob; float* ss;
    __device__ __forceinline__ void operator()(AccRef acc, const Unit& u, int wr, int wc, int fr, int fq) const {
        const int row0 = u.pm * 256 + wr * 64 + fr, col0 = u.pn * 256 + wc * 32 + 4 * fq;
#pragma unroll
        for (int ai = 0; ai < 2; ++ai)
#pragma unroll
            for (int m = 0; m < 4; ++m) { const int row = row0 + ai * 128 + m * 16; const size_t off = (size_t)row * 1024 + col0; float s = 0.f;
#pragma unroll
                for (int bj = 0; bj < 2; ++bj)
#pragma unroll
                    for (int n = 0; n < 2; ++n) { const size_t o2 = off + bj * 128 + n * 16; f32x4 r;
                        if (WB) r = *(const f32x4*)(Rs + o2); else { const u32x2 rw = *(const u32x2*)(Rb + o2); r = (f32x4){bflo(rw.x), bfhi(rw.x), bflo(rw.y), bfhi(rw.y)}; }
                        const f32x4 v = r + acc[ai][bj][m][n];
                        s += (v[0] * v[0] + v[1] * v[1]) + (v[2] * v[2] + v[3] * v[3]);
                        if (WB) { u32x2 w; w.x = cvt_pk_bf16(v[0], v[1]); w.y = cvt_pk_bf16(v[2], v[3]); *(u32x2*)(Ob + o2) = w; } else *(f32x4*)(Of + o2) = v; }
                s += __shfl_xor(s, 16); s += __shfl_xor(s, 32);
                if (fq == 0) { if (WB) atomicAdd(ss + row, s); else ss[(size_t)row * 16 + u.pn * 4 + wc] = s; } }
    }
};
__device__ __forceinline__ float ffn_gate(float bg, float wg0, float wg1, float wg2, float ga, float gb, float gc, float bv, float wv0, float wv1, float wv2, float va, float vb, float vc) {
    const float g = bg + wg0 * ga + wg1 * gb + wg2 * gc, v = bv + wv0 * va + wv1 * vb + wv2 * vc; return siluf_(g) * v; }
struct EpiUpFused {
    static constexpr bool PERM = true, ROWPERM = true;
    const float* ss; const float* cw; const float* cb; bf16_t* ACT; bf16_t* SIDE;
    __device__ __forceinline__ void operator()(AccRef acc, const Unit& u, int wr, int wc, int fr, int fq) const {
        const int tok0 = u.pm * 256 + (wr * 16 + fr) * 8;
        float ri[8];
        { const f32x4 q0 = *(const f32x4*)(ss + tok0), q1 = *(const f32x4*)(ss + tok0 + 4);
#pragma unroll
          for (int i = 0; i < 4; ++i) { ri[i] = rsqrtf(q0[i] * (1.0f / 1024.0f) + EPS_); ri[4 + i] = rsqrtf(q1[i] * (1.0f / 1024.0f) + EPS_); } }
        const int fb = u.pn * 128 + wc * 32 + 8 * fq;
#pragma unroll
        for (int n = 0; n < 2; ++n) {
            unsigned pk[8][2];
#pragma unroll
            for (int jp = 0; jp < 2; ++jp) {
                const int c = fb + 4 * n + 2 * jp;
                const f32x2 wv0 = *(const f32x2*)(cw + c), wv1 = *(const f32x2*)(cw + F2_ + c), wv2 = *(const f32x2*)(cw + 2 * F2_ + c);
                const f32x2 wg0 = *(const f32x2*)(cw + F_ + c), wg1 = *(const f32x2*)(cw + F2_ + F_ + c), wg2 = *(const f32x2*)(cw + 2 * F2_ + F_ + c);
                const f32x2 bv = *(const f32x2*)(cb + c), bg = *(const f32x2*)(cb + F_ + c);
                float v0[10], v1[10], g0[10], g1[10];
#pragma unroll
                for (int ai = 0; ai < 2; ++ai)
#pragma unroll
                    for (int m = 0; m < 4; ++m) { const int i = ai * 4 + m; v0[2 + i] = acc[ai][0][m][n][2 * jp] * ri[i]; v1[2 + i] = acc[ai][0][m][n][2 * jp + 1] * ri[i];
                        g0[2 + i] = acc[ai][1][m][n][2 * jp] * ri[i]; g1[2 + i] = acc[ai][1][m][n][2 * jp + 1] * ri[i]; }
                v0[0] = dpp_shr1(v0[8]); v0[1] = dpp_shr1(v0[9]); v1[0] = dpp_shr1(v1[8]); v1[1] = dpp_shr1(v1[9]);
                g0[0] = dpp_shr1(g0[8]); g0[1] = dpp_shr1(g0[9]); g1[0] = dpp_shr1(g1[8]); g1[1] = dpp_shr1(g1[9]);
                if (fr == 0 || fr == 15) {
                    const bool lo = fr == 0; const int slot = wr * 4 + (lo ? 0 : 2);
                    bf16_t* sp = SIDE + ((size_t)u.pm * 8 + slot) * F2_ + c;
                    *(unsigned*)(sp) = cvt_pk_bf16(lo ? v0[2] : v0[8], lo ? v1[2] : v1[8]); *(unsigned*)(sp + F2_) = cvt_pk_bf16(lo ? v0[3] : v0[9], lo ? v1[3] : v1[9]);
                    *(unsigned*)(sp + F_) = cvt_pk_bf16(lo ? g0[2] : g0[8], lo ? g1[2] : g1[8]); *(unsigned*)(sp + F2_ + F_) = cvt_pk_bf16(lo ? g0[3] : g0[9], lo ? g1[3] : g1[9]);
                }
#pragma unroll
                for (int i = 0; i < 8; ++i) {
                    const float o0 = ffn_gate(bg.x, wg0.x, wg1.x, wg2.x, g0[i], g0[i + 1], g0[i + 2], bv.x, wv0.x, wv1.x, wv2.x, v0[i], v0[i + 1], v0[i + 2]);
                    const float o1 = ffn_gate(bg.y, wg0.y, wg1.y, wg2.y, g1[i], g1[i + 1], g1[i + 2], bv.y, wv0.y, wv1.y, wv2.y, v1[i], v1[i + 1], v1[i + 2]);
                    pk[i][jp] = cvt_pk_bf16(o0, o1); }
            }
#pragma unroll
            for (int i = 0; i < 8; ++i) if (!(fr == 0 && i < 2)) { u32x2 w; w.x = pk[i][0]; w.y = pk[i][1]; *(u32x2*)(ACT + (size_t)(tok0 + i) * F_ + fb + 4 * n) = w; }
            asm volatile("" ::: "memory");
        }
    }
};
struct SchedQKV : pg8::Order {
    const char *xc, *xm, *wqk, *wv;
    __device__ __forceinline__ const char* aptr(const Unit& u) const { const int head = u.pn & 3, kind = u.pn >> 2; return (kind < 2 ? xc : xm) + ((size_t)u.pm * 256 * 1024 + head * 256) * 2; }
    __device__ __forceinline__ const char* bptr(const Unit& u) const { const int head = u.pn & 3, kind = u.pn >> 2; return kind < 2 ? wqk + ((size_t)(head * 512 + kind * 256) * 256) * 2 : wv + ((size_t)head * 65536) * 2; }
};

__device__ __forceinline__ void transpose_item(const float* W, int ldw, int c0, const float* kscale, float scale, bf16_t* WT, int ldt, int row_off, LAS float* scr, int kb, int nb, int lane) {
    const int k0 = 64 * kb, n0 = 32 * nb;
#pragma unroll 8
    for (int i = 0; i < 32; ++i) { const int kk = 2 * i + (lane >> 5); float v = W[(size_t)(k0 + kk) * ldw + c0 + n0 + (lane & 31)] * scale; if (kscale) v *= kscale[k0 + kk]; scr[kk * 33 + (lane & 31)] = v; }
    asm volatile("s_waitcnt lgkmcnt(0)" ::: "memory");
    const int c = lane & 7;
#pragma unroll
    for (int j = 0; j < 4; ++j) { const int n = (lane >> 3) + 8 * j; const LAS float* s = scr + (8 * c) * 33 + n;
        u32x4 o; o.x = cvt_pk_bf16(s[0 * 33], s[1 * 33]); o.y = cvt_pk_bf16(s[2 * 33], s[3 * 33]); o.z = cvt_pk_bf16(s[4 * 33], s[5 * 33]); o.w = cvt_pk_bf16(s[6 * 33], s[7 * 33]);
        *(u32x4*)(WT + (size_t)(row_off + n0 + n) * ldt + k0 + 8 * c) = o; }
    asm volatile("s_waitcnt lgkmcnt(0)" ::: "memory");
}

__device__ __forceinline__ void phase0(const Params& p, LAS unsigned char* lds) {
    const int tid = fresh_tid(), lane = tid & 63, wave = tid >> 6;
    const int gw = blockIdx.x * 8 + wave, NGW = gridDim.x * 8;
    unsigned char* ws = p.ws;
    LAS float* scr = (LAS float*)(lds + wave * 8448);
    LAS float* gwt = (LAS float*)(lds + 8 * 8448);
    { const float* g1 = p.in[1]; const float* w_in = p.in[2];
      for (int i = tid; i < 8192; i += 512) { const int j = i & 7, k = i >> 3; gwt[j * 1024 + k] = g1[k] * w_in[(size_t)k * NIN_ + 2048 + j]; } }
    {
        const int nmat = 63;
        int base = 0;
        for (int mi = 0; mi < nmat; ++mi) {
            const float* W; int ldw, c0, ncols, K; const float* ks = nullptr; float sc = 1.f; bf16_t* WT; int ldt, roff = 0;
            if (mi == 0) { W = p.in[2]; ldw = NIN_; c0 = 0; ncols = 2048; K = 1024; ks = p.in[1]; WT = (bf16_t*)(ws + WS_WIN); ldt = 1024; roff = 0; }
            else if (mi == 1) { W = p.in[2]; ldw = NIN_; c0 = 2056; ncols = 2560; K = 1024; ks = p.in[1]; WT = (bf16_t*)(ws + WS_WIN); ldt = 1024; roff = 2048; }
            else if (mi < 6) { const int h = mi - 2; W = p.in[6] + h * 65536; ldw = 256; c0 = 0; ncols = 256; K = 256; WT = (bf16_t*)(ws + WS_WQK) + h * 512 * 256; ldt = 256; roff = 0; }
            else if (mi < 10) { const int h = mi - 6; W = p.in[7] + h * 65536; ldw = 256; c0 = 0; ncols = 256; K = 256; sc = 0.0625f; WT = (bf16_t*)(ws + WS_WQK) + h * 512 * 256; ldt = 256; roff = 256; }
            else if (mi < 14) { const int h = mi - 10; W = p.in[8] + h * 65536; ldw = 256; c0 = 0; ncols = 256; K = 256; WT = (bf16_t*)(ws + WS_WV) + h * 65536; ldt = 256; roff = 0; }
            else if (mi == 14) { W = p.in[19]; ldw = 512; c0 = 0; ncols = 512; K = 512; WT = (bf16_t*)(ws + WS_WGLU); ldt = 512; }
            else if (mi == 15) { W = p.in[21]; ldw = 1024; c0 = 0; ncols = 1024; K = 1024; WT = (bf16_t*)(ws + WS_WA); ldt = 1024; }
            else if (mi == 16) { W = p.in[22]; ldw = 1024; c0 = 0; ncols = 1024; K = 512; WT = (bf16_t*)(ws + WS_WB); ldt = 512; }
            else if (mi == 17) { W = p.in[23]; ldw = 1024; c0 = 0; ncols = 1024; K = 1024; WT = (bf16_t*)(ws + WS_WOUT); ldt = 1024; }
            else if (mi < 62) { const int qq = mi - 18, pn = qq >> 1, bj = qq & 1;
                W = p.in[25]; ldw = F2_; c0 = bj * F_ + pn * 128; ncols = 128; K = 1024; ks = p.in[24]; WT = (bf16_t*)(ws + WS_WUP); ldt = 1024; roff = pn * 256 + bj * 128; }
            else { W = p.in[28]; ldw = 1024; c0 = 0; ncols = 1024; K = F_; WT = (bf16_t*)(ws + WS_WDN); ldt = F_; }
            const int nblk = ncols / 32, nit = (K / 64) * nblk;
            int it = gw - (base % NGW); if (it < 0) it += NGW;
            for (; it < nit; it += NGW) transpose_item(W, ldw, c0, ks, sc, WT, ldt, roff, scr, it / nblk, it % nblk, lane);
            base += nit;
        }
    }
    {
        const int gt = blockIdx.x * 512 + tid;
        if (gt < SG_ * SP_) {
            const int g = gt >> 6, pp = gt & 63;
            const float ar = p.in[11][gt], ai = p.in[12][gt], dt = expf(p.in[13][g]);
            const float mag = expf(dt * ar); float sn, cs; sincosf(dt * ai, &sn, &cs);
            const float abr = mag * cs, abi = mag * sn;
            const float den = ar * ar + ai * ai, xr = abr - 1.0f, xi = abi;
            const float rre = (xr * ar + xi * ai) / den, rim = (xi * ar - xr * ai) / den;
            float* A = (float*)(ws + WS_S5A); bf16_t* BbT = (bf16_t*)(ws + WS_S5BT);
            A[gt * 2] = abr; A[gt * 2 + 1] = abi;
            const float* bre = p.in[14] + (size_t)gt * 16; const float* bim = p.in[15] + (size_t)gt * 16;
            for (int c = 0; c < 16; ++c) { const float br = bre[c], bi = bim[c];
                BbT[((size_t)(g * 128 + pp)) * 16 + c] = f2bf(rre * br - rim * bi); BbT[((size_t)(g * 128 + 64 + pp)) * 16 + c] = f2bf(rre * bi + rim * br); }
        }
        bf16_t* CmT = (bf16_t*)(ws + WS_S5CT);
        for (int i = blockIdx.x * 512 + tid; i < SG_ * 16 * 128; i += gridDim.x * 512) { const int k = i & 127, gc = i >> 7;
            CmT[i] = f2bf(k < 64 ? p.in[16][(size_t)gc * 64 + k] : -p.in[17][(size_t)gc * 64 + k - 64]); }
    }
    { float* z = (float*)(ws + WS_SS1); for (int i = blockIdx.x * 512 + tid; i < T_; i += gridDim.x * 512) z[i] = 0.f; }
    {
        float* bp = (float*)(ws + WS_BIASP); const float* b_in = p.in[3];
        for (int i = blockIdx.x * 512 + tid; i < NP1_; i += gridDim.x * 512) bp[i] = b_in[i < 2048 ? i : i + 8];
    }
    __syncthreads();
    {
        const float* x = p.in[0]; const float* b_in = p.in[3];
        bf16_t* xb = (bf16_t*)(ws + R0); float* rinv1 = (float*)(ws + WS_RINV1); float* ig = (float*)(ws + WS_IG); float* fg = (float*)(ws + WS_FG);
        for (int row = gw; row < T_; row += NGW) {
            const f32x4* xr = (const f32x4*)(x + (size_t)row * 1024) + lane;
            f32x4 v[4]; float s = 0.f;
#pragma unroll
            for (int j = 0; j < 4; ++j) { v[j] = xr[64 * j]; s += (v[j][0] * v[j][0] + v[j][1] * v[j][1]) + (v[j][2] * v[j][2] + v[j][3] * v[j][3]); }
            float d[8];
#pragma unroll
            for (int g = 0; g < 8; ++g) { float a = 0.f;
#pragma unroll
                for (int j = 0; j < 4; ++j) { const f32x4 w = *(const LAS f32x4*)(gwt + g * 1024 + 256 * j + 4 * lane); a += (v[j][0] * w[0] + v[j][1] * w[1]) + (v[j][2] * w[2] + v[j][3] * w[3]); }
                d[g] = a; }
            s = wave_sum(s);
#pragma unroll
            for (int g = 0; g < 8; ++g) d[g] = wave_sum(d[g]);
            const float ri = rsqrtf(s * (1.0f / 1024.0f) + EPS_);
            u32x2* o8 = (u32x2*)(xb + (size_t)row * 1024) + lane;
#pragma unroll
            for (int j = 0; j < 4; ++j) { u32x2 w; w.x = cvt_pk_bf16(v[j][0], v[j][1]); w.y = cvt_pk_bf16(v[j][2], v[j][3]); o8[64 * j] = w; }
            if (lane == 0) rinv1[row] = ri;
            if (lane < 8) { float val = d[0];
#pragma unroll
                for (int g = 1; g < 8; ++g) val = (lane == g) ? d[g] : val;
                val = val * ri + b_in[2048 + lane];
                if (lane < 4) ig[(size_t)row * 4 + lane] = val; else fg[(size_t)row * 4 + lane - 4] = val; }
        }
    }
}

__device__ __forceinline__ void phase_xc_fix(const Params& p) {
    const bf16_t* xm = (const bf16_t*)(p.ws + R1); bf16_t* xc = (bf16_t*)(p.ws + WS_XC);
    const float* cw = p.in[4]; const float* cb = p.in[5];
    const int total = 128 * 2 * 128;
    for (int idx = blockIdx.x * 512 + fresh_tid(); idx < total; idx += gridDim.x * 512) {
        const int cgi = idx & 127, s2 = (idx >> 7) & 1, pm = idx >> 8, c0 = cgi * 8, t0 = pm * 256 + 128 * s2;
        float w[4][8], b[8];
#pragma unroll
        for (int k = 0; k < 4; ++k) { const f32x4 a = *(const f32x4*)(cw + k * 1024 + c0), bb = *(const f32x4*)(cw + k * 1024 + c0 + 4);
#pragma unroll
            for (int j = 0; j < 4; ++j) { w[k][j] = a[j]; w[k][4 + j] = bb[j]; } }
        { const f32x4 a = *(const f32x4*)(cb + c0), bb = *(const f32x4*)(cb + c0 + 4);
#pragma unroll
          for (int j = 0; j < 4; ++j) { b[j] = a[j]; b[4 + j] = bb[j]; } }
        float r0[8], r1[8], r2[8], r3[8];
        const bool head = (t0 & (SEQ_ - 1)) == 0;
        if (head) {
#pragma unroll
            for (int j = 0; j < 8; ++j) { r0[j] = 0.f; r1[j] = 0.f; r2[j] = 0.f; } }
        else { unpack8(*(const u32x4*)(xm + (size_t)(t0 - 3) * 1024 + c0), r0); unpack8(*(const u32x4*)(xm + (size_t)(t0 - 2) * 1024 + c0), r1); unpack8(*(const u32x4*)(xm + (size_t)(t0 - 1) * 1024 + c0), r2); }
#pragma unroll
        for (int i = 0; i < 3; ++i) {
            unpack8(*(const u32x4*)(xm + (size_t)(t0 + i) * 1024 + c0), r3);
            float o[8];
#pragma unroll
            for (int j = 0; j < 8; ++j) { const float y = b[j] + w[0][j] * r0[j] + w[1][j] * r1[j] + w[2][j] * r2[j] + w[3][j] * r3[j]; o[j] = siluf_(y); }
            *(u32x4*)(xc + (size_t)(t0 + i) * 1024 + c0) = pack8(o);
#pragma unroll
            for (int j = 0; j < 8; ++j) { r0[j] = r1[j]; r1[j] = r2[j]; r2[j] = r3[j]; }
        }
    }
}

__device__ __forceinline__ void phase_gates(const Params& p, LAS unsigned char* lds) {
    const int tid = fresh_tid(), lane = tid & 63, wave = __builtin_amdgcn_readfirstlane(tid >> 6);
    const float* IG = (const float*)(p.ws + WS_IG); const float* FG = (const float*)(p.ws + WS_FG); float* GS = (float*)(p.ws + WS_GS);
    LAS float* LB = (LAS float*)lds; LAS float* LC = LB + 64; LAS float* Lm = LB + 128;
    for (int item = blockIdx.x; item < 32; item += gridDim.x) {
        const int b = item >> 2, h = item & 3;
        float av[8], bv[8], pv[8];
#pragma unroll
        for (int cc = 0; cc < 8; ++cc) {
            const int ch = wave * 8 + cc; const size_t t = (size_t)b * SEQ_ + ch * 64 + lane;
            const float fgv = FG[t * 4 + h], li = IG[t * 4 + h];
            const float lf = fminf(fgv, 0.f) - log1pf(expf(-fabsf(fgv)));
            float bc = lf;
#pragma unroll
            for (int o = 1; o < 64; o <<= 1) { const float x = __shfl_up(bc, o); if (lane >= o) bc += x; }
            const float a = li - bc; float pm = a;
#pragma unroll
            for (int o = 1; o < 64; o <<= 1) { const float x = __shfl_up(pm, o); if (lane >= o) pm = fmaxf(pm, x); }
            av[cc] = a; bv[cc] = bc; pv[cc] = pm;
            if (lane == 63) { LB[ch] = bc; LC[ch] = bc + pm; }
        }
        __syncthreads();
        if (tid == 0) { float m = 0.f; for (int j = 0; j < 64; ++j) { Lm[j] = m; m = fmaxf(m + LB[j], LC[j]); } }
        __syncthreads();
#pragma unroll
        for (int cc = 0; cc < 8; ++cc) {
            const int ch = wave * 8 + cc; const float m = Lm[ch];
            const float Mq = fmaxf(m, pv[cc]); const float M63 = __shfl(Mq, 63);
            float* gs = GS + ((size_t)item * 64 + ch) * 384;
            gs[lane] = av[cc]; gs[64 + lane] = Mq; gs[128 + lane] = expf(m - Mq); gs[192 + lane] = expf(-(bv[cc] + Mq)); gs[256 + lane] = expf(av[cc] - M63);
            if (lane == 0) gs[320] = expf(m - M63);
        }
        __syncthreads();
    }
}

typedef short s16x4 __attribute__((ext_vector_type(4)));
__device__ __forceinline__ bf16x8 lds_tr_frag(const LAS bf16_t* p, int row_stride) {
    const s16x4 lo = __builtin_amdgcn_ds_read_tr16_b64_v4i16((LAS s16x4*)p);
    const s16x4 hi = __builtin_amdgcn_ds_read_tr16_b64_v4i16((LAS s16x4*)(p + 4 * row_stride));
    return (bf16x8){lo[0], lo[1], lo[2], lo[3], hi[0], hi[1], hi[2], hi[3]};
}
constexpr int ML_QN = 0, ML_KN = 33792, ML_VN = 67584, ML_VW = 74752, ML_SW = 81920, ML_CB = 91136, ML_DEN = 116480;
__device__ __forceinline__ void phase_mlstm(const Params& p, LAS unsigned char* lds) {
    const int tid = fresh_tid(), lane = tid & 63, w = __builtin_amdgcn_readfirstlane(tid >> 6), qi = w & 3, half = w >> 2, lr = lane & 15, lg = lane >> 4;
    const bf16_t* Q = (const bf16_t*)p.out; const bf16_t* Kk = (const bf16_t*)p.out + (size_t)T_ * 1024; const bf16_t* V = (const bf16_t*)(p.ws + R0);
    bf16_t* HC = (bf16_t*)(p.ws + R1);
    const float* GS = (const float*)(p.ws + WS_GS);
    LAS bf16_t* QN = (LAS bf16_t*)(lds + ML_QN);
    LAS bf16_t* KN = (LAS bf16_t*)(lds + ML_KN);
    LAS bf16_t* VN = (LAS bf16_t*)(lds + ML_VN);
    LAS bf16_t* VW = (LAS bf16_t*)(lds + ML_VW);
    LAS bf16_t* Sw = (LAS bf16_t*)(lds + ML_SW);
    LAS bf16_t* Cb = (LAS bf16_t*)(lds + ML_CB);
    LAS float* sc_den = (LAS float*)(lds + ML_DEN);
    const int trq = lr >> 2, trp = 4 * (lr & 3);
    for (int item = blockIdx.x; item < 256; item += gridDim.x) {
        const int bh = item & 31, vs = item >> 5, b = bh >> 2, h = bh & 3;
        const size_t tok0 = (size_t)b * SEQ_;
        __syncthreads();
        for (int i = tid; i < 48 * 264 / 2; i += 512) ((LAS unsigned*)Cb)[i] = 0u;
        for (int i = tid; i < 2 * 64 * 56 / 2; i += 512) ((LAS unsigned*)VN)[i] = 0u;
        f32x4 Cacc[2][3];
#pragma unroll
        for (int a_ = 0; a_ < 2; ++a_)
#pragma unroll
            for (int c_ = 0; c_ < 3; ++c_) Cacc[a_][c_] = (f32x4){0.f, 0.f, 0.f, 0.f};
        u32x4 qreg[4], kreg[4], vreg = (u32x4){0u, 0u, 0u, 0u};
        float sMq, swi, semr, swk, sdecay; f32x4 sa[2];
        const int vsel = tid < 256 ? (tid >> 2) : (tid < 320 ? tid - 256 : 0);
#define ML_GLOAD(tc0_) do { _Pragma("unroll") for (int i_ = 0; i_ < 4; ++i_) { const int pi = tid + 512 * i_; const size_t go = ((tc0_) + (pi >> 5)) * 1024 + h * 256 + (pi & 31) * 8; \
            qreg[i_] = *(const u32x4*)(Q + go); kreg[i_] = *(const u32x4*)(Kk + go); } \
            if (tid < 256) vreg = *(const u32x4*)(V + ((tc0_) + (tid >> 2)) * 1024 + h * 256 + vs * 32 + (tid & 3) * 8); } while (0)
#define ML_GSCAL(gs_) do { sMq = (gs_)[64 + 16 * qi + lr]; swi = (gs_)[128 + 16 * qi + lr]; semr = (gs_)[192 + 16 * qi + lr]; swk = (gs_)[256 + vsel]; sdecay = (gs_)[320]; \
            sa[0] = *(const f32x4*)((gs_) + 16 * (2 * half) + 4 * lg); sa[1] = *(const f32x4*)((gs_) + 16 * (2 * half + 1) + 4 * lg); } while (0)
#define ML_LWRITE() do { _Pragma("unroll") for (int i_ = 0; i_ < 4; ++i_) { const int pi = tid + 512 * i_; const int lo_ = (pi >> 5) * 264 + (pi & 31) * 8; \
            *(LAS u32x4*)(QN + lo_) = qreg[i_]; *(LAS u32x4*)(KN + lo_) = kreg[i_]; } \
            if (tid < 256) { float vv[8], vw[8]; unpack8(vreg, vv); _Pragma("unroll") for (int j = 0; j < 8; ++j) vw[j] = vv[j] * swk; \
                *(LAS u32x4*)(VN + (tid >> 2) * 56 + (tid & 3) * 8) = vreg; *(LAS u32x4*)(VW + (tid >> 2) * 56 + (tid & 3) * 8) = pack8(vw); } \
            else if (tid < 320) { VN[(tid - 256) * 56 + 32] = (bf16_t)0x3f80; VW[(tid - 256) * 56 + 32] = f2bf(swk); } } while (0)
        { ML_GLOAD(tok0); const float* gs = GS + ((size_t)bh * 64) * 384; ML_GSCAL(gs); }
        __syncthreads();
        ML_LWRITE();
        __syncthreads();
        for (int ch = 0; ch < NCH_; ++ch) {
            const size_t tc0 = tok0 + (size_t)ch * 64;
            const int chn = ch + 1 < NCH_ ? ch + 1 : ch; const size_t tcn = tok0 + (size_t)chn * 64;
            const float* gsn = GS + ((size_t)bh * 64 + chn) * 384;
            const float cMq = sMq, cwi = swi, cemr = semr, cdecay = sdecay; const f32x4 ca0 = sa[0], ca1 = sa[1];
            ML_GLOAD(tcn); ML_GSCAL(gsn);
            bf16x8 qf[8];
#pragma unroll
            for (int ks = 0; ks < 8; ++ks) qf[ks] = *(const LAS bf16x8*)(QN + (16 * qi + lr) * 264 + 32 * ks + 8 * lg);
            f32x4 St[2];
#pragma unroll
            for (int jj = 0; jj < 2; ++jj) { St[jj] = (f32x4){0.f, 0.f, 0.f, 0.f};
#pragma unroll
                for (int ks = 0; ks < 8; ++ks) { const bf16x8 kfr = *(const LAS bf16x8*)(KN + (16 * (2 * half + jj) + lr) * 264 + 32 * ks + 8 * lg);
                    St[jj] = __builtin_amdgcn_mfma_f32_16x16x32_bf16(kfr, qf[ks], St[jj], 0, 0, 0); } }
#pragma unroll
            for (int jj = 0; jj < 2; ++jj) { const int kt = 2 * half + jj; const int qtok = 16 * qi + lr, k0 = 16 * kt + 4 * lg; const f32x4 av = jj == 0 ? ca0 : ca1;
                float o[4];
#pragma unroll
                for (int r = 0; r < 4; ++r) { const float wgt = (k0 + r <= qtok) ? __expf(av[r] - cMq) : 0.f; o[r] = St[jj][r] * wgt; }
                u32x2 pk; pk.x = cvt_pk_bf16(o[0], o[1]); pk.y = cvt_pk_bf16(o[2], o[3]);
                *(LAS u32x2*)(Sw + qtok * 72 + k0) = pk; }
            __syncthreads();
            f32x4 num[2]; num[0] = (f32x4){0.f, 0.f, 0.f, 0.f}; num[1] = (f32x4){0.f, 0.f, 0.f, 0.f};
            const int nvt = half == 0 ? 2 : 1, vt0 = half == 0 ? 0 : 2;
#pragma unroll
            for (int i = 0; i < 2; ++i) if (i < nvt) {
                const int vn = vt0 + i;
#pragma unroll
                for (int ks = 0; ks < 8; ++ks) { const bf16x8 cf = *(const LAS bf16x8*)(Cb + (16 * vn + lr) * 264 + 32 * ks + 8 * lg);
                    num[i] = __builtin_amdgcn_mfma_f32_16x16x32_bf16(cf, qf[ks], num[i], 0, 0, 0); }
                num[i] *= cwi;
#pragma unroll
                for (int k2 = 0; k2 < 2; ++k2) { const bf16x8 sf = *(const LAS bf16x8*)(Sw + (16 * qi + lr) * 72 + 32 * k2 + 8 * lg);
                    const bf16x8 vf = lds_tr_frag(VN + (32 * k2 + 8 * lg + trq) * 56 + 16 * vn + trp, 56);
                    num[i] = __builtin_amdgcn_mfma_f32_16x16x32_bf16(vf, sf, num[i], 0, 0, 0); }
            }
            if (half == 1 && lg == 0) sc_den[16 * qi + lr] = num[0][0];
            {
                bf16x8 vwf[3][2];
#pragma unroll
                for (int vn = 0; vn < 3; ++vn)
#pragma unroll
                    for (int k2 = 0; k2 < 2; ++k2) vwf[vn][k2] = lds_tr_frag(VW + (32 * k2 + 8 * lg + trq) * 56 + 16 * vn + trp, 56);
#pragma unroll
                for (int dm = 0; dm < 2; ++dm) {
                    bf16x8 kf2[2];
#pragma unroll
                    for (int k2 = 0; k2 < 2; ++k2) kf2[k2] = lds_tr_frag(KN + (32 * k2 + 8 * lg + trq) * 264 + 32 * w + 16 * dm + trp, 264);
#pragma unroll
                    for (int vn = 0; vn < 3; ++vn) { f32x4 c = Cacc[dm][vn] * cdecay;
#pragma unroll
                        for (int k2 = 0; k2 < 2; ++k2) c = __builtin_amdgcn_mfma_f32_16x16x32_bf16(kf2[k2], vwf[vn][k2], c, 0, 0, 0);
                        Cacc[dm][vn] = c; }
                }
            }
            __syncthreads();
            if (half == 0) {
                const float dn = __builtin_amdgcn_rcpf(fmaxf(fabsf(sc_den[16 * qi + lr]), cemr));
#pragma unroll
                for (int i = 0; i < 2; ++i) { u32x2 pk; pk.x = cvt_pk_bf16(num[i][0] * dn, num[i][1] * dn); pk.y = cvt_pk_bf16(num[i][2] * dn, num[i][3] * dn);
                    *(u32x2*)(HC + (tc0 + 16 * qi + lr) * 1024 + h * 256 + vs * 32 + 16 * i + 4 * lg) = pk; }
            }
#pragma unroll
            for (int dm = 0; dm < 2; ++dm)
#pragma unroll
                for (int vn = 0; vn < 3; ++vn) { const f32x4 c = Cacc[dm][vn]; u32x2 pk; pk.x = cvt_pk_bf16(c[0], c[1]); pk.y = cvt_pk_bf16(c[2], c[3]);
                    *(LAS u32x2*)(Cb + (16 * vn + lr) * 264 + 32 * w + 16 * dm + 4 * lg) = pk; }
            ML_LWRITE();
            __syncthreads();
        }
#undef ML_GLOAD
#undef ML_GSCAL
#undef ML_LWRITE
    }
}

__device__ __forceinline__ void phase_aout(const Params& p) {
    const int tid = fresh_tid(), lane = tid & 63, gw = blockIdx.x * 8 + (tid >> 6), NGW = gridDim.x * 8;
    const bf16_t* HC = (const bf16_t*)(p.ws + R1); const bf16_t* SOM = (const bf16_t*)(p.ws + R2); const bf16_t* XC = (const bf16_t*)(p.ws + WS_XC);
    bf16_t* AO = (bf16_t*)(p.ws + R0);
    const float* hg = p.in[9]; const float* sk = p.in[10];
    for (int t = gw; t < T_; t += NGW) {
#pragma unroll
        for (int h = 0; h < 4; ++h) {
            const size_t off = (size_t)t * 1024 + h * 256 + 4 * lane;
            const u32x2 hw = *(const u32x2*)(HC + off), ow = *(const u32x2*)(SOM + off), xw = *(const u32x2*)(XC + off);
            const f32x4 g4 = *(const f32x4*)(hg + h * 256 + 4 * lane), s4 = *(const f32x4*)(sk + h * 256 + 4 * lane);
            float hv[4] = {bflo(hw.x), bfhi(hw.x), bflo(hw.y), bfhi(hw.y)};
            const float ov[4] = {bflo(ow.x), bfhi(ow.x), bflo(ow.y), bfhi(ow.y)}, xv[4] = {bflo(xw.x), bfhi(xw.x), bflo(xw.y), bfhi(xw.y)};
            const float mu = wave_sum((hv[0] + hv[1]) + (hv[2] + hv[3])) * (1.0f / 256.0f);
#pragma unroll
            for (int j = 0; j < 4; ++j) hv[j] -= mu;
            const float var = wave_sum((hv[0] * hv[0] + hv[1] * hv[1]) + (hv[2] * hv[2] + hv[3] * hv[3])) * (1.0f / 256.0f);
            const float rs = rsqrtf(var + EPS_);
            float o[4];
#pragma unroll
            for (int j = 0; j < 4; ++j) o[j] = ov[j] * (hv[j] * rs * g4[j]) + s4[j] * xv[j];
            u32x2 wv; wv.x = cvt_pk_bf16(o[0], o[1]); wv.y = cvt_pk_bf16(o[2], o[3]);
            *(u32x2*)(AO + off) = wv;
        }
    }
}

__device__ __forceinline__ bf16x8 s5_load_af(const bf16_t* US, size_t tokb, int g, int lane) {
    const int lr = lane & 15, lg = lane >> 4;
    bf16x8 af = *(const bf16x8*)(US + (tokb + lr) * 512 + g * 16 + 8 * (lg & 1));
    if (lg >= 2) af = (bf16x8){0, 0, 0, 0, 0, 0, 0, 0};
    return af;
}
template <bool PASS_C>
__device__ __forceinline__ void s5_block16(const bf16x8 af, int lane, const bf16x8 (&bbf)[8], LAS float* but, LAS bf16_t* stb, float ar, float ai, float& sr, float& si) {
    const int lr = lane & 15, lg = lane >> 4;
#pragma unroll
    for (int ct = 0; ct < 8; ++ct) { const f32x4 d = __builtin_amdgcn_mfma_f32_16x16x32_bf16(af, bbf[ct], (f32x4){0.f, 0.f, 0.f, 0.f}, 0, 0, 0);
#pragma unroll
        for (int r = 0; r < 4; ++r) but[(4 * lg + r) * 132 + 16 * ct + lr] = d[r]; }
#pragma unroll 4
    for (int tt = 0; tt < 16; ++tt) { const float br = but[tt * 132 + lane], bi = but[tt * 132 + 64 + lane];
        const float nr = ar * sr - ai * si + br, ni = ar * si + ai * sr + bi; sr = nr; si = ni;
        if (PASS_C) { stb[tt * 136 + lane] = f2bf(sr); stb[tt * 136 + 64 + lane] = f2bf(si); } }
}
__device__ __forceinline__ void phase_s5(const Params& p, LAS unsigned char* lds) {
    const int tid = fresh_tid(), lane = tid & 63, wave = __builtin_amdgcn_readfirstlane(tid >> 6), lr = lane & 15, lg = lane >> 4;
    const bf16_t* US = (const bf16_t*)(p.ws + R5);
    const float* A = (const float*)(p.ws + WS_S5A); const bf16_t* BbT = (const bf16_t*)(p.ws + WS_S5BT); const bf16_t* CmT = (const bf16_t*)(p.ws + WS_S5CT);
    bf16_t* YB = (bf16_t*)(p.ws + R7);
    LAS float* but = (LAS float*)(lds + wave * 16896);
    LAS bf16_t* stb = (LAS bf16_t*)(lds + wave * 16896 + 8448);
    LAS float* Eb = (LAS float*)(lds + 8 * 16896);
    for (int item = blockIdx.x; item < NB_ * SG_; item += gridDim.x) {
        const int b = item & 7, g = item >> 3, gp = g * 64 + lane;
        const float ar = A[gp * 2], ai = A[gp * 2 + 1];
        bf16x8 bbf[8];
#pragma unroll
        for (int ct = 0; ct < 8; ++ct) { bbf[ct] = *(const bf16x8*)(BbT + ((size_t)(g * 128 + 16 * ct + lr)) * 16 + 8 * (lg & 1)); if (lg >= 2) bbf[ct] = (bf16x8){0, 0, 0, 0, 0, 0, 0, 0}; }
        const size_t tokw = (size_t)b * SEQ_ + (size_t)wave * 512;
        float sr = 0.f, si = 0.f;
        { bf16x8 afc = s5_load_af(US, tokw, g, lane);
          for (int blk = 0; blk < 32; ++blk) { const int bn = blk + 1 < 32 ? blk + 1 : blk; const bf16x8 afn = s5_load_af(US, tokw + bn * 16, g, lane);
              s5_block16<false>(afc, lane, bbf, but, stb, ar, ai, sr, si); afc = afn; } }
        Eb[(wave * 64 + lane) * 2] = sr; Eb[(wave * 64 + lane) * 2 + 1] = si;
        __syncthreads();
        float pr = ar, pi = ai;
#pragma unroll
        for (int i = 0; i < 9; ++i) { const float nr = pr * pr - pi * pi, ni = 2.f * pr * pi; pr = nr; pi = ni; }
        sr = 0.f; si = 0.f;
        for (int j = 0; j < wave; ++j) { const float er = Eb[(j * 64 + lane) * 2], ei = Eb[(j * 64 + lane) * 2 + 1]; const float nr = pr * sr - pi * si + er, ni = pr * si + pi * sr + ei; sr = nr; si = ni; }
        bf16x8 cmf[4];
#pragma unroll
        for (int kk = 0; kk < 4; ++kk) cmf[kk] = *(const bf16x8*)(CmT + ((size_t)(g * 16 + lr)) * 128 + 32 * kk + 8 * lg);
        const float dsk = p.in[18][g * 16 + lr];
        bf16x8 afc = s5_load_af(US, tokw, g, lane);
        bf16_t uuc[4];
#pragma unroll
        for (int r = 0; r < 4; ++r) uuc[r] = US[(tokw + 4 * lg + r) * 512 + g * 16 + lr];
        for (int blk = 0; blk < 32; ++blk) {
            const size_t tokb = tokw + blk * 16;
            const int bn = blk + 1 < 32 ? blk + 1 : blk; const bf16x8 afn = s5_load_af(US, tokw + bn * 16, g, lane);
            bf16_t uun[4];
#pragma unroll
            for (int r = 0; r < 4; ++r) uun[r] = US[(tokw + bn * 16 + 4 * lg + r) * 512 + g * 16 + lr];
            s5_block16<true>(afc, lane, bbf, but, stb, ar, ai, sr, si);
            f32x4 y = (f32x4){0.f, 0.f, 0.f, 0.f};
#pragma unroll
            for (int kk = 0; kk < 4; ++kk) { const bf16x8 sf = *(const LAS bf16x8*)(stb + lr * 136 + 32 * kk + 8 * lg); y = __builtin_amdgcn_mfma_f32_16x16x32_bf16(sf, cmf[kk], y, 0, 0, 0); }
#pragma unroll
            for (int r = 0; r < 4; ++r) { const size_t tok = tokb + 4 * lg + r; const float uu = bf2f(uuc[r]);
                const float v = y[r] + dsk * uu;
                const float z = 0.7978845608f * (v + 0.044715f * v * v * v); const float th = 1.0f - 2.0f * __builtin_amdgcn_rcpf(1.0f + __expf(2.0f * z));
                YB[tok * 512 + g * 16 + lr] = f2bf(0.5f * v * (1.0f + th)); }
            afc = afn;
#pragma unroll
            for (int r = 0; r < 4; ++r) uuc[r] = uun[r];
        }
        __syncthreads();
    }
}

__device__ __forceinline__ void phase_ffn_fix(const Params& p) {
    const bf16_t* SIDE = (const bf16_t*)(p.ws + WS_SIDE); bf16_t* ACT = (bf16_t*)(p.ws + WS_ACT);
    const float* cw = p.in[26]; const float* cb = p.in[27];
    const int total = 128 * 2 * 352;
    for (int idx = blockIdx.x * 512 + fresh_tid(); idx < total; idx += gridDim.x * 512) {
        const int fg = idx % 352, s2 = (idx / 352) & 1, pm = idx / 704, f0 = fg * 8;
        float va[8], vb[8], vc[8], vd[8], ga[8], gb[8], gc[8], gd[8];
        const bf16_t* cur = SIDE + (size_t)pm * 8 * F2_ + f0;
        if (s2 == 0) {
            if ((pm & 15) == 0) {
#pragma unroll
                for (int j = 0; j < 8; ++j) { va[j] = 0.f; vb[j] = 0.f; ga[j] = 0.f; gb[j] = 0.f; } }
            else { const bf16_t* prv = SIDE + (size_t)(pm - 1) * 8 * F2_ + f0;
                unpack8(*(const u32x4*)(prv + 6 * F2_), va); unpack8(*(const u32x4*)(prv + 7 * F2_), vb); unpack8(*(const u32x4*)(prv + 6 * F2_ + F_), ga); unpack8(*(const u32x4*)(prv + 7 * F2_ + F_), gb); }
            unpack8(*(const u32x4*)(cur), vc); unpack8(*(const u32x4*)(cur + F2_), vd); unpack8(*(const u32x4*)(cur + F_), gc); unpack8(*(const u32x4*)(cur + F2_ + F_), gd);
        } else {
            unpack8(*(const u32x4*)(cur + 2 * F2_), va); unpack8(*(const u32x4*)(cur + 3 * F2_), vb); unpack8(*(const u32x4*)(cur + 2 * F2_ + F_), ga); unpack8(*(const u32x4*)(cur + 3 * F2_ + F_), gb);
            unpack8(*(const u32x4*)(cur + 4 * F2_), vc); unpack8(*(const u32x4*)(cur + 5 * F2_), vd); unpack8(*(const u32x4*)(cur + 4 * F2_ + F_), gc); unpack8(*(const u32x4*)(cur + 5 * F2_ + F_), gd);
        }
        float o0[8], o1[8];
#pragma unroll
        for (int j = 0; j < 8; ++j) { const int f = f0 + j;
            const float wv0 = cw[f], wv1 = cw[F2_ + f], wv2 = cw[2 * F2_ + f], wg0 = cw[F_ + f], wg1 = cw[F2_ + F_ + f], wg2 = cw[2 * F2_ + F_ + f], bv = cb[f], bg = cb[F_ + f];
            o0[j] = ffn_gate(bg, wg0, wg1, wg2, ga[j], gb[j], gc[j], bv, wv0, wv1, wv2, va[j], vb[j], vc[j]);
            o1[j] = ffn_gate(bg, wg0, wg1, wg2, gb[j], gc[j], gd[j], bv, wv0, wv1, wv2, vb[j], vc[j], vd[j]); }
        bf16_t* op = ACT + ((size_t)pm * 256 + 128 * s2) * F_ + f0;
        *(u32x4*)(op) = pack8(o0); *(u32x4*)(op + F_) = pack8(o1);
    }
}

__device__ __forceinline__ void phase_final(const Params& p) {
    const int tid = fresh_tid(), lane = tid & 63, gw = blockIdx.x * 8 + (tid >> 6), NGW = gridDim.x * 8;
    const float* ss = (const float*)(p.ws + WS_SS2); const float* gf = p.in[29];
    for (int row = gw; row < T_; row += NGW) {
        const float sv = (lane < 16) ? ss[(size_t)row * 16 + lane] : 0.f;
        const float ri = rsqrtf(wave_sum(sv) * (1.0f / 1024.0f) + EPS_);
        f32x4* xr = (f32x4*)(p.out + (size_t)row * 1024) + lane;
#pragma unroll
        for (int j = 0; j < 4; ++j) { const f32x4 g4 = *((const f32x4*)gf + lane + 64 * j); f32x4 v = xr[64 * j]; v = v * ri * g4; xr[64 * j] = v; }
    }
}

#ifndef PHASE_MASK
#define PHASE_MASK 0xffffffffu
#endif
#define PH(k) ((PHASE_MASK >> (k)) & 1u)
#ifndef REP_MASK
#define REP_MASK 0u
#endif
#define REPS(k) for (int rep_ = 0; rep_ < 1 + (int)((REP_MASK >> (k)) & 1u); ++rep_)
__global__ void __launch_bounds__(512, 2) fwd_megakernel(Params p) {
    extern __shared__ __attribute__((aligned(16))) unsigned char lds_raw[];
    LAS unsigned char* lds = (LAS unsigned char*)lds_raw;
    unsigned char* ws = p.ws;
    bf16_t* dq = (bf16_t*)p.out;
    volatile LAS unsigned* bst = (volatile LAS unsigned*)(lds + LDS_BYTES - 64);
    if (threadIdx.x < 2) bst[threadIdx.x] = 0u;
    __syncthreads();
    const XcdBarrier xbar = xcd_barrier_post((unsigned*)(ws + WS_BAR), bst);
    REPS(0) if (PH(0)) phase0(p, lds);
    xcd_barrier(xbar);
    REPS(1) if (PH(1)) { pg8::PlainSched S; S.set(ws + R0, 1024, ws + WS_WIN, 1024, T_ / 256, NP1_ / 256);
      EpiProj E{(const float*)(ws + WS_RINV1), (const float*)(ws + WS_BIASP), ws, (bf16_t*)(ws + R1), (bf16_t*)(ws + WS_XC), p.in[4], p.in[5]};
      pg8::gemm_phase(lds, S, E, 1024, 1024, 1024); }
    xcd_barrier(xbar);
    REPS(2) if (PH(2)) { phase_gates(p, lds); phase_xc_fix(p); }
    REPS(6) if (PH(6)) phase_s5(p, lds);
    xcd_barrier(xbar);
    REPS(3) if (PH(3)) { SchedQKV S; S.init(T_ / 256, 12, gridDim.x, blockIdx.x); S.xc = (const char*)(ws + WS_XC); S.xm = (const char*)(ws + R1); S.wqk = (const char*)(ws + WS_WQK); S.wv = (const char*)(ws + WS_WV);
      EpiQKV E{dq, (bf16_t*)(ws + R0)};
      pg8::gemm_phase(lds, S, E, 256, 1024, 256); }
    REPS(8) if (PH(8)) { pg8::PlainSched S; S.set(ws + R7, 512, ws + WS_WGLU, 512, T_ / 256, 2);
      EpiGate<0> E{(const bf16_t*)(ws + R7), nullptr, p.in[20], (bf16_t*)(ws + R5), 512};
      pg8::gemm_phase(lds, S, E, 512, 512, 512); }
    xcd_barrier(xbar);
    REPS(4) if (PH(4)) phase_mlstm(p, lds);
    xcd_barrier(xbar);
    REPS(5) if (PH(5)) phase_aout(p);
    REPS(9) if (PH(9)) { pg8::PlainSched S; S.set(ws + R5, 512, ws + WS_WB, 512, T_ / 256, 4);
      EpiGate<1> E{(const bf16_t*)(ws + R4), nullptr, nullptr, dq, 1024};
      pg8::gemm_phase(lds, S, E, 512, 512, 512); }
    xcd_barrier(xbar);
    REPS(10) if (PH(10)) { pg8::PlainSched S; S.set(ws + R0, 1024, ws + WS_WA, 1024, T_ / 256, 4);
      EpiGate<2> E{(const bf16_t*)(ws + R3), dq, nullptr, (bf16_t*)(ws + R1), 1024};
      pg8::gemm_phase(lds, S, E, 1024, 1024, 1024); }
    xcd_barrier(xbar);
    REPS(11) if (PH(11)) { pg8::PlainSched S; S.set(ws + R1, 1024, ws + WS_WOUT, 1024, T_ / 256, 4);
      EpiResid<true> E{p.in[0], nullptr, nullptr, (bf16_t*)(ws + WS_X1B), (float*)(ws + WS_SS1)};
      pg8::gemm_phase(lds, S, E, 1024, 1024, 1024); }
    xcd_barrier(xbar);
    REPS(12) if (PH(12)) { pg8::PlainSched S; S.set(ws + WS_X1B, 1024, ws + WS_WUP, 1024, T_ / 256, F_ / 128);
      EpiUpFused E{(const float*)(ws + WS_SS1), p.in[26], p.in[27], (bf16_t*)(ws + WS_ACT), (bf16_t*)(ws + WS_SIDE)};
      pg8::gemm_phase(lds, S, E, 1024, 1024, 1024); }
    xcd_barrier(xbar);
    REPS(13) if (PH(13)) phase_ffn_fix(p);
    xcd_barrier(xbar);
    REPS(14) if (PH(14)) { pg8::PlainSched S; S.set(ws + WS_ACT, F_, ws + WS_WDN, F_, T_ / 256, 4);
      EpiResid<false> E{nullptr, (const bf16_t*)(ws + WS_X1B), p.out, nullptr, (float*)(ws + WS_SS2)};
      pg8::gemm_phase(lds, S, E, F_, F_, F_); }
    xcd_barrier(xbar);
    REPS(15) if (PH(15)) phase_final(p);
}

extern "C" void kernel_launch(void* const* d_in, const int* in_sizes, int n_in, void* d_out, int out_size, void* d_ws, size_t ws_size, hipStream_t stream) {
    static int grid_blocks = 0;
    if (!grid_blocks) {
        int dev = 0, cus = 0, per_cu = 0;
        (void)hipGetDevice(&dev);
        (void)hipDeviceGetAttribute(&cus, hipDeviceAttributeMultiprocessorCount, dev);
        (void)hipFuncSetAttribute((const void*)fwd_megakernel, hipFuncAttributeMaxDynamicSharedMemorySize, LDS_BYTES);
        (void)hipOccupancyMaxActiveBlocksPerMultiprocessor(&per_cu, (const void*)fwd_megakernel, 512, LDS_BYTES);
        if (per_cu < 1) { fprintf(stderr, "kernel_launch: occupancy query returned %d\n", per_cu); }
        grid_blocks = cus;
        if (n_in != 30 || out_size != T_ * D_ || ws_size < 512 * MiB) fprintf(stderr, "kernel_launch: unexpected sizes n_in=%d out=%d ws=%zu\n", n_in, out_size, ws_size);
    }
    Params p{};
    for (int i = 0; i < 30; ++i) p.in[i] = (const float*)d_in[i];
    p.out = (float*)d_out; p.ws = (unsigned char*)d_ws;
    (void)hipMemsetAsync((unsigned char*)d_ws + WS_BAR, 0, XCD_BAR_WORDS * 4, stream);
    void* args[] = {&p};
    hipError_t e = hipLaunchCooperativeKernel((void*)fwd_megakernel, dim3(grid_blocks), dim3(512), args, LDS_BYTES, stream);
    if (e != hipSuccess) fprintf(stderr, "cooperative launch failed: %s (grid %d)\n", hipGetErrorString(e), grid_blocks);
}
```

```cpp
#include <hip/hip_runtime.h>
#include <hip/hip_cooperative_groups.h>
#include <cstdio>
#include <cstdint>
namespace cg = cooperative_groups;

#define LAS __attribute__((address_space(3)))
typedef unsigned short bf16_t;
typedef short bf16x8 __attribute__((ext_vector_type(8)));
typedef float f32x4 __attribute__((ext_vector_type(4)));
typedef float f32x2 __attribute__((ext_vector_type(2)));
typedef unsigned u32x4 __attribute__((ext_vector_type(4)));
typedef unsigned u32x2 __attribute__((ext_vector_type(2)));

constexpr int T_ = 32768, D_ = 1024, SEQ_ = 4096, NB_ = 8;
constexpr int NH_ = 4, DH_ = 256, NCH_ = 64;
constexpr int SW_ = 512, SG_ = 32, SP_ = 64;
constexpr int F_ = 2816, F2_ = 5632, NIN_ = 4616, NP1_ = 4608;
constexpr float EPS_ = 1e-6f;

constexpr size_t MiB = 1ull << 20, KiB = 1024;
constexpr size_t WS_WIN = 0, WS_WQK = 9 * MiB, WS_WV = 10 * MiB, WS_WGLU = 10 * MiB + 512 * KiB, WS_WA = 11 * MiB, WS_WB = 13 * MiB, WS_WOUT = 14 * MiB,
                 WS_WUP = 16 * MiB, WS_WDN = 27 * MiB;
constexpr size_t WS_S5A = 33 * MiB, WS_S5BT = WS_S5A + 32 * KiB, WS_S5CT = WS_S5A + 192 * KiB;
constexpr size_t WS_RINV1 = 34 * MiB, WS_IG = 34 * MiB + 512 * KiB, WS_FG = 35 * MiB, WS_BIASP = 35 * MiB + 512 * KiB;
constexpr size_t WS_GS = 50 * MiB;
constexpr size_t WS_BAR = 49 * MiB;
constexpr size_t WS_SS1 = 36 * MiB, WS_SS2 = 38 * MiB, WS_E = 40 * MiB;
constexpr size_t R0 = 56 * MiB, R1 = 120 * MiB, R2 = 184 * MiB, R3 = 248 * MiB, R4 = 312 * MiB, R5 = 376 * MiB, R6 = 408 * MiB, R7 = 472 * MiB;
constexpr size_t WS_XC = 408 * MiB;
constexpr size_t WS_X1B = 448 * MiB, WS_UH = 56 * MiB, WS_SIDE = 56 * MiB, WS_ACT = 232 * MiB;
constexpr int LDS_BYTES = 147456;

struct Params {
    const float* in[30];
    float* out;
    unsigned char* ws;
};

__device__ __forceinline__ unsigned cvt_pk_bf16(float lo, float hi) { unsigned r; asm volatile("v_cvt_pk_bf16_f32 %0, %1, %2" : "=v"(r) : "v"(lo), "v"(hi)); return r; }
__device__ __forceinline__ bf16_t f2bf(float x) { return (bf16_t)(cvt_pk_bf16(x, x) & 0xffffu); }
__device__ __forceinline__ float bf2f(unsigned short u) { return __uint_as_float(((unsigned)u) << 16); }
__device__ __forceinline__ float bflo(unsigned w) { return __uint_as_float(w << 16); }
__device__ __forceinline__ float bfhi(unsigned w) { return __uint_as_float(w & 0xffff0000u); }
__device__ __forceinline__ float sigmoidf_(float x) { return __builtin_amdgcn_rcpf(1.0f + __expf(-x)); }
__device__ __forceinline__ float siluf_(float x) { return x * sigmoidf_(x); }
__device__ __forceinline__ int fresh_tid() { int t = threadIdx.x; asm volatile("" : "+v"(t)); return t; }
template <int CTRL> __device__ __forceinline__ float dpp_f(float x) { return __int_as_float(__builtin_amdgcn_update_dpp(0, __float_as_int(x), CTRL, 0xf, 0xf, true)); }
__device__ __forceinline__ float wave_sum(float v) {
    v += dpp_f<0x128>(v); v += dpp_f<0x124>(v); v += dpp_f<0x122>(v); v += dpp_f<0x121>(v);
    const int vi = __float_as_int(v);
    const float r0 = __int_as_float(__builtin_amdgcn_readlane(vi, 0)), r1 = __int_as_float(__builtin_amdgcn_readlane(vi, 16)), r2 = __int_as_float(__builtin_amdgcn_readlane(vi, 32)), r3 = __int_as_float(__builtin_amdgcn_readlane(vi, 48));
    return (r0 + r1) + (r2 + r3);
}
__device__ __forceinline__ void unpack8(const u32x4 w, float (&f)[8]) {
    f[0] = bflo(w.x); f[1] = bfhi(w.x); f[2] = bflo(w.y); f[3] = bfhi(w.y); f[4] = bflo(w.z); f[5] = bfhi(w.z); f[6] = bflo(w.w); f[7] = bfhi(w.w);
}
__device__ __forceinline__ u32x4 pack8(const float (&f)[8]) {
    u32x4 w; w.x = cvt_pk_bf16(f[0], f[1]); w.y = cvt_pk_bf16(f[2], f[3]); w.z = cvt_pk_bf16(f[4], f[5]); w.w = cvt_pk_bf16(f[6], f[7]); return w;
}


#define XB_TMO      128
#define XB_XCNT(j)  (256  + 64 * (j))
#define XB_XSUB(j)  (1280 + 64 * (j))
#define XB_XGEN(j)  (2304 + 64 * (j))
#define XB_TOP      3328
#define XB_TOPGEN   3392
#define XCD_BAR_WORDS 3456
#define XB_SPIN_CAP (1u << 18)
__device__ __forceinline__ unsigned xb_ld(unsigned* p)              { return __hip_atomic_load(p, __ATOMIC_RELAXED, __HIP_MEMORY_SCOPE_AGENT); }
__device__ __forceinline__ unsigned xb_add(unsigned* p, unsigned v) { return __hip_atomic_fetch_add(p, v, __ATOMIC_RELAXED, __HIP_MEMORY_SCOPE_AGENT); }
__device__ __forceinline__ unsigned xb_xcc_id() { return (unsigned)__builtin_amdgcn_s_getreg((3 << 11) | 20) & 0xFu; }
#define XB_SPIN(cond, bar) do { unsigned _sp = 0; while (cond) { __builtin_amdgcn_s_sleep(1); \
    if ((++_sp & 255u) == 0u) { if (xb_ld(&(bar)[XB_TMO])) break; if (_sp > XB_SPIN_CAP) { atomicAdd(&(bar)[XB_TMO], 1u); break; } } } } while (0)
struct XcdBarrier { unsigned* bar; unsigned x; volatile LAS unsigned* st; };
__device__ __forceinline__ XcdBarrier xcd_barrier_post(unsigned* bar, volatile LAS unsigned* st) {
    XcdBarrier b; b.bar = bar; b.x = xb_xcc_id(); b.st = st;
    if (threadIdx.x == 0) (void)xb_add(&bar[XB_XCNT(b.x)], 1u);
    return b;
}
__device__ __forceinline__ void xcd_barrier_complete(unsigned* bar, unsigned x, unsigned& nloc, unsigned& nx) {
    const unsigned G = gridDim.x * gridDim.y * gridDim.z;
    unsigned sum, cnt, mine, sp = 0u;
    for (;;) {
        sum = 0u; cnt = 0u; mine = 0u;
#pragma unroll
        for (unsigned j = 0; j < 16; ++j) { const unsigned c = xb_ld(&bar[XB_XCNT(j)]); sum += c; cnt += (c > 0u) ? 1u : 0u; mine = (j == x) ? c : mine; }
        if (sum == G) break;
        __builtin_amdgcn_s_sleep(1);
        if ((++sp & 255u) == 0u) { if (xb_ld(&bar[XB_TMO])) break; if (sp > XB_SPIN_CAP) { atomicAdd(&bar[XB_TMO], 1u); break; } }
    }
    nloc = mine > 0u ? mine : 1u; nx = cnt > 0u ? cnt : 1u;
}
__device__ __forceinline__ void xcd_barrier(const XcdBarrier& b) {
    asm volatile("s_waitcnt vmcnt(0)" ::: "memory");
    __syncthreads();
    if (threadIdx.x == 0) {
        unsigned* bar = b.bar;
        __builtin_amdgcn_s_waitcnt(0);
        unsigned nloc = b.st[0], nx = b.st[1];
        if (nloc == 0u) { xcd_barrier_complete(bar, b.x, nloc, nx); b.st[0] = nloc; b.st[1] = nx; }
        const unsigned old = xb_add(&bar[XB_XSUB(b.x)], 1u);
        const unsigned gen = old / nloc;
        if (old + 1u == (gen + 1u) * nloc) {
            __builtin_amdgcn_fence(__ATOMIC_RELEASE, "agent");
            asm volatile("s_waitcnt vmcnt(0)" ::: "memory");
            const unsigned og = xb_add(&bar[XB_TOP], 1u);
            const unsigned tg = og / nx;
            if (og + 1u == (tg + 1u) * nx) xb_add(&bar[XB_TOPGEN], 1u);
            else XB_SPIN(xb_ld(&bar[XB_TOPGEN]) == tg, bar);
            __builtin_amdgcn_fence(__ATOMIC_ACQUIRE, "agent");
            xb_add(&bar[XB_XGEN(b.x)], 1u);
            asm volatile("s_waitcnt vmcnt(0)" ::: "memory");
        } else {
            XB_SPIN(xb_ld(&bar[XB_XGEN(b.x)]) == gen, bar);
            __builtin_amdgcn_fence(__ATOMIC_ACQUIRE, "agent");
            asm volatile("s_waitcnt vmcnt(0)" ::: "memory");
        }
    }
    __syncthreads();
}

namespace pg8 {
constexpr int BM = 256, BK = 64, HALF = 128, HTB = HALF * BK * 2, STAGE_BYTES = 8 * HTB, NXCD = 8, WGM = 8;
__device__ __forceinline__ int lds_byte(int r, int c) { const int st = (r >> 4) * 2 + (c >> 5), rr = r & 15, cc = c & 31, ob = rr * 64 + cc * 2; return st * 1024 + (ob ^ (((ob >> 9) & 1) << 5)); }
__device__ __forceinline__ void stage_rc(int b, int& R, int& C) { const int st = b / 1024, sb = b % 1024, swz = sb ^ (((sb >> 9) & 1) << 5); R = (st >> 1) * 16 + swz / 64; C = (st & 1) * 32 + (swz % 64) / 2; }
__device__ __forceinline__ int perm32(int rho) { const int n = rho >> 4, i = rho & 15; return 8 * (i >> 2) + 4 * n + (i & 3); }
struct Unit { int pm, pn; };
struct Order {
    int nM, nN, nwg, G, c;
    __device__ __forceinline__ void init(int nM_, int nN_, int G_, int c_) { nM = nM_; nN = nN_; nwg = nM * nN; G = G_; c = c_; }
    __device__ __forceinline__ bool next(int i, Unit& u) const {
        const long L = (long)i * G + c; if (L >= nwg) return false;
        int wgid = (int)L; { const int q = nwg / NXCD, r = nwg % NXCD, xcd = wgid % NXCD, off = wgid / NXCD; wgid = (xcd < r ? xcd * (q + 1) : r * (q + 1) + (xcd - r) * q) + off; }
        const int nig = WGM * nN, gid = wgid / nig, fm = gid * WGM, gsz = (nM - fm) < WGM ? (nM - fm) : WGM;
        u.pm = fm + ((wgid % nig) % gsz); u.pn = (wgid % nig) / gsz; return true;
    }
};
template <class Epi, class Sched>
__device__ __forceinline__ void gemm_phase(LAS unsigned char* lds, const Sched& S, const Epi& E, const int K, const int lda, const int ldb) {
    const int tid = fresh_tid(), wid = __builtin_amdgcn_readfirstlane(tid >> 6), lane = tid & 63, wr = wid >> 2, wc = wid & 3, fr = lane & 15, fq = lane >> 4;
    const int nt = K / BK;
    unsigned voffA[2], voffB[2];
#pragma unroll
    for (int i = 0; i < 2; ++i) { int R, C; stage_rc(tid * 16 + i * 8192, R, C); const int Rb = Epi::PERM ? ((R & ~31) + perm32(R & 31)) : R;
        const int Ra = Epi::ROWPERM ? (((R >> 6) * 16 + (R & 15)) * 8 + ((R >> 4) & 3)) : R;
        voffA[i] = (unsigned)(Ra * lda + C) * 2u; voffB[i] = (unsigned)(Rb * ldb + C) * 2u; }
    const size_t kstep = (size_t)(BK * 2);
    const size_t hstepA = (size_t)(Epi::ROWPERM ? 4 : HALF) * lda * 2, hstepB = (size_t)HALF * ldb * 2;
    const unsigned ldsw = (unsigned)wid * 1024u;
    const int aoff = lds_byte(wr * 64 + fr, fq * 8), boff = lds_byte(wc * 32 + fr, fq * 8);
#define PG8_SA(b, h) (((b) * 2 + (h)) * HTB)
#define PG8_SB(b, h) ((4 + (b) * 2 + (h)) * HTB)
#define PG8_STAGE(bufoff, gbase, voff) do { _Pragma("unroll") for (int _i = 0; _i < 2; ++_i) \
        __builtin_amdgcn_global_load_lds((const unsigned*)((const char*)(gbase) + (voff)[_i]), (LAS unsigned*)(lds + (bufoff) + ldsw + _i * 8192), 16, 0, 0); } while (0)
#define PG8_LDA(dst, b, h) do { _Pragma("unroll") for (int m = 0; m < 4; ++m) _Pragma("unroll") for (int k = 0; k < 2; ++k) dst[m][k] = *(const LAS bf16x8*)(lds + PG8_SA(b, h) + aoff + m * 2048 + k * 1024); } while (0)
#define PG8_LDB(dst, b, h) do { _Pragma("unroll") for (int n = 0; n < 2; ++n) _Pragma("unroll") for (int k = 0; k < 2; ++k) dst[n][k] = *(const LAS bf16x8*)(lds + PG8_SB(b, h) + boff + n * 2048 + k * 1024); } while (0)
#define PG8_MMA(ai, bj, At, Bt) do { __builtin_amdgcn_s_setprio(1); _Pragma("unroll") for (int m = 0; m < 4; ++m) _Pragma("unroll") for (int n = 0; n < 2; ++n) _Pragma("unroll") for (int k = 0; k < 2; ++k) \
        acc[ai][bj][m][n] = __builtin_amdgcn_mfma_f32_16x16x32_bf16(Bt[n][k], At[m][k], acc[ai][bj][m][n], 0, 0, 0); __builtin_amdgcn_s_setprio(0); } while (0)
#define PG8_WAIT_V(n) asm volatile("s_waitcnt vmcnt(" #n ")" ::: "memory")
#define PG8_WAIT_L(n) asm volatile("s_waitcnt lgkmcnt(" #n ")" ::: "memory")
#define PG8_BAR __builtin_amdgcn_s_barrier()
#define PG8_SCHED __builtin_amdgcn_sched_barrier(0)
    Unit cur, nxt; int ui = 0;
    if (!S.next(0, cur)) return;
    f32x4 acc[2][2][4][2];
#pragma unroll
    for (int a = 0; a < 2; ++a)
#pragma unroll
        for (int b = 0; b < 2; ++b)
#pragma unroll
            for (int m = 0; m < 4; ++m)
#pragma unroll
                for (int n = 0; n < 2; ++n) acc[a][b][m][n] = (f32x4){0.f, 0.f, 0.f, 0.f};
    bf16x8 At[4][2], B0[2][2], B1[2][2];
    const char* cA = S.aptr(cur); const char* cB = S.bptr(cur);
    PG8_STAGE(PG8_SB(0, 0), cB, voffB); PG8_STAGE(PG8_SB(0, 1), cB + hstepB, voffB); PG8_STAGE(PG8_SA(0, 0), cA, voffA); PG8_STAGE(PG8_SA(0, 1), cA + hstepA, voffA);
    if (wr == 1) PG8_BAR;
    PG8_WAIT_V(2); PG8_BAR;
    PG8_STAGE(PG8_SB(1, 0), cB + kstep, voffB); PG8_STAGE(PG8_SA(1, 0), cA + kstep, voffA); PG8_STAGE(PG8_SB(1, 1), cB + hstepB + kstep, voffB);
    PG8_WAIT_V(6); PG8_BAR;
    for (;;) {
        const bool has_next = S.next(ui + 1, nxt);
        const char* nA = has_next ? S.aptr(nxt) : cA; const char* nB = has_next ? S.bptr(nxt) : cB;
#pragma unroll 1
        for (int t = 0; t < nt; t += 2) {
            const bool last = (t == nt - 2);
            const char* a1 = cA + (size_t)(t + 1) * kstep;
            const char* a2 = last ? nA : cA + (size_t)(t + 2) * kstep; const char* b2 = last ? nB : cB + (size_t)(t + 2) * kstep;
            const char* a3 = a2 + kstep; const char* b3 = b2 + kstep;
            PG8_LDB(B0, 0, 0); PG8_LDB(B1, 0, 1); PG8_SCHED; PG8_LDA(At, 0, 0); PG8_STAGE(PG8_SA(1, 1), a1 + hstepA, voffA);
            PG8_WAIT_V(8); PG8_WAIT_L(0); PG8_BAR; PG8_MMA(0, 0, At, B0); PG8_MMA(0, 1, At, B1); PG8_BAR; PG8_SCHED;
            PG8_LDA(At, 0, 1); PG8_STAGE(PG8_SB(0, 0), b2, voffB); PG8_STAGE(PG8_SB(0, 1), b2 + hstepB, voffB); PG8_STAGE(PG8_SA(0, 0), a2, voffA);
            PG8_WAIT_V(8); PG8_WAIT_L(0); PG8_BAR; PG8_MMA(1, 0, At, B0); PG8_MMA(1, 1, At, B1); PG8_BAR; PG8_SCHED;
            PG8_LDB(B0, 1, 0); PG8_LDB(B1, 1, 1); PG8_SCHED; PG8_LDA(At, 1, 0); PG8_STAGE(PG8_SA(0, 1), a2 + hstepA, voffA);
            PG8_WAIT_V(8); PG8_WAIT_L(0); PG8_BAR; PG8_MMA(0, 0, At, B0); PG8_MMA(0, 1, At, B1); PG8_BAR; PG8_SCHED;
            PG8_LDA(At, 1, 1); PG8_STAGE(PG8_SB(1, 0), b3, voffB); PG8_STAGE(PG8_SB(1, 1), b3 + hstepB, voffB); PG8_STAGE(PG8_SA(1, 0), a3, voffA);
            PG8_WAIT_V(8); PG8_WAIT_L(0); PG8_BAR; PG8_MMA(1, 0, At, B0); PG8_MMA(1, 1, At, B1); PG8_BAR; PG8_SCHED;
        }
        if (wr == 0) PG8_BAR;
        E(acc, cur, wr, wc, fr, fq);
        if (!has_next) break;
#pragma unroll
        for (int a = 0; a < 2; ++a)
#pragma unroll
            for (int b = 0; b < 2; ++b)
#pragma unroll
                for (int m = 0; m < 4; ++m)
#pragma unroll
                    for (int n = 0; n < 2; ++n) acc[a][b][m][n] = (f32x4){0.f, 0.f, 0.f, 0.f};
        cur = nxt; cA = nA; cB = nB; ++ui;
        if (wr == 1) PG8_BAR;
    }
    PG8_WAIT_V(0);
    PG8_BAR;
#undef PG8_SA
#undef PG8_SB
#undef PG8_STAGE
#undef PG8_LDA
#undef PG8_LDB
#undef PG8_MMA
#undef PG8_WAIT_V
#undef PG8_WAIT_L
#undef PG8_BAR
#undef PG8_SCHED
}
struct PlainSched : Order {
    const char* A; const char* B; size_t astep, bstep;
    __device__ __forceinline__ void set(const void* A_, int lda, const void* B_, int ldb, int nM_, int nN_) { A = (const char*)A_; B = (const char*)B_; astep = (size_t)BM * lda * 2; bstep = (size_t)BM * ldb * 2; init(nM_, nN_, gridDim.x, blockIdx.x); }
    __device__ __forceinline__ const char* aptr(const Unit& u) const { return A + (size_t)u.pm * astep; }
    __device__ __forceinline__ const char* bptr(const Unit& u) const { return B + (size_t)u.pn * bstep; }
};
}
using pg8::Unit;
typedef const f32x4 (&AccRef)[2][2][4][2];

__device__ __forceinline__ float dpp_shr1(float x) { return __int_as_float(__builtin_amdgcn_update_dpp(0, __float_as_int(x), 0x111, 0xf, 0xf, true)); }
struct EpiProj {
    static constexpr bool PERM = true, ROWPERM = true;
    const float* rinv; const float* bias; unsigned char* wsb; bf16_t *xm, *xc; const float* cw; const float* cb;
    __device__ __forceinline__ void operator()(AccRef acc, const Unit& u, int wr, int wc, int fr, int fq) const {
        const int pn = u.pn, tok0 = u.pm * 256 + (wr * 16 + fr) * 8;
        float ri[8];
        { const f32x4 q0 = *(const f32x4*)(rinv + tok0), q1 = *(const f32x4*)(rinv + tok0 + 4);
#pragma unroll
          for (int i = 0; i < 4; ++i) { ri[i] = q0[i]; ri[4 + i] = q1[i]; } }
        if (pn >= 4) {
            const size_t boff = pn < 8 ? R2 : (pn < 10 ? R5 : (pn < 14 ? R3 : R4));
            const int ldc = (pn >= 8 && pn < 10) ? 512 : 1024, colt = (pn < 8 ? pn - 4 : (pn < 10 ? pn - 8 : (pn < 14 ? pn - 10 : pn - 14))) * 256; const bool sig = !(pn >= 8 && pn < 10);
            bf16_t* base = (bf16_t*)(wsb + boff);
            const int col0 = colt + wc * 32 + 8 * fq, bcol0 = pn * 256 + wc * 32 + 8 * fq;
            f32x4 bv[2][2];
#pragma unroll
            for (int bj = 0; bj < 2; ++bj)
#pragma unroll
                for (int n = 0; n < 2; ++n) bv[bj][n] = *(const f32x4*)(bias + bcol0 + bj * 128 + 4 * n);
#pragma unroll
            for (int ai = 0; ai < 2; ++ai)
#pragma unroll
                for (int m = 0; m < 4; ++m) { const int i = ai * 4 + m; bf16_t* rowp = base + (size_t)(tok0 + i) * ldc + col0;
#pragma unroll
                    for (int bj = 0; bj < 2; ++bj) { f32x4 v0 = acc[ai][bj][m][0] * ri[i] + bv[bj][0], v1 = acc[ai][bj][m][1] * ri[i] + bv[bj][1];
                        if (sig) {
#pragma unroll
                            for (int j = 0; j < 4; ++j) { v0[j] = sigmoidf_(v0[j]); v1[j] = sigmoidf_(v1[j]); } }
                        u32x4 w; w.x = cvt_pk_bf16(v0[0], v0[1]); w.y = cvt_pk_bf16(v0[2], v0[3]); w.z = cvt_pk_bf16(v1[0], v1[1]); w.w = cvt_pk_bf16(v1[2], v1[3]);
                        *(u32x4*)(rowp + bj * 128) = w; } }
        } else {
#pragma unroll
            for (int bj = 0; bj < 2; ++bj)
#pragma unroll
                for (int n = 0; n < 2; ++n) {
                    const int c4 = pn * 256 + bj * 128 + wc * 32 + 8 * fq + 4 * n;
                    unsigned pkm[8][2], pkc[8][2];
#pragma unroll
                    for (int jp = 0; jp < 2; ++jp) {
                        const int c = c4 + 2 * jp;
                        const f32x2 bs = *(const f32x2*)(bias + c), w0 = *(const f32x2*)(cw + c), w1 = *(const f32x2*)(cw + 1024 + c), w2 = *(const f32x2*)(cw + 2048 + c), w3 = *(const f32x2*)(cw + 3072 + c), bc = *(const f32x2*)(cb + c);
                        float x0[11], x1[11];
#pragma unroll
                        for (int ai = 0; ai < 2; ++ai)
#pragma unroll
                            for (int m = 0; m < 4; ++m) { const int i = ai * 4 + m; x0[3 + i] = acc[ai][bj][m][n][2 * jp] * ri[i] + bs.x; x1[3 + i] = acc[ai][bj][m][n][2 * jp + 1] * ri[i] + bs.y; }
                        x0[0] = dpp_shr1(x0[8]); x0[1] = dpp_shr1(x0[9]); x0[2] = dpp_shr1(x0[10]);
                        x1[0] = dpp_shr1(x1[8]); x1[1] = dpp_shr1(x1[9]); x1[2] = dpp_shr1(x1[10]);
#pragma unroll
                        for (int i = 0; i < 8; ++i) {
                            const float y0 = bc.x + w0.x * x0[i] + w1.x * x0[i + 1] + w2.x * x0[i + 2] + w3.x * x0[i + 3];
                            const float y1 = bc.y + w0.y * x1[i] + w1.y * x1[i + 1] + w2.y * x1[i + 2] + w3.y * x1[i + 3];
                            pkc[i][jp] = cvt_pk_bf16(siluf_(y0), siluf_(y1)); pkm[i][jp] = cvt_pk_bf16(x0[3 + i], x1[3 + i]); }
                    }
#pragma unroll
                    for (int i = 0; i < 8; ++i) { const size_t o = (size_t)(tok0 + i) * 1024 + c4;
                        u32x2 wm; wm.x = pkm[i][0]; wm.y = pkm[i][1]; *(u32x2*)(xm + o) = wm;
                        if (!(fr == 0 && i < 3)) { u32x2 wx; wx.x = pkc[i][0]; wx.y = pkc[i][1]; *(u32x2*)(xc + o) = wx; } }
                    asm volatile("" ::: "memory");
                }
        }
    }
};
struct EpiQKV {
    static constexpr bool PERM = true, ROWPERM = false;
    bf16_t *qk, *v;
    __device__ __forceinline__ void operator()(AccRef acc, const Unit& u, int wr, int wc, int fr, int fq) const {
        const int head = u.pn & 3, kind = u.pn >> 2; bf16_t* base = (kind < 2) ? qk + (size_t)kind * T_ * 1024 : v;
        const int row0 = u.pm * 256 + wr * 64 + fr, col0 = head * 256 + wc * 32 + 8 * fq;
#pragma unroll
        for (int ai = 0; ai < 2; ++ai)
#pragma unroll
            for (int m = 0; m < 4; ++m) { bf16_t* rowp = base + (size_t)(row0 + ai * 128 + m * 16) * 1024 + col0;
#pragma unroll
                for (int bj = 0; bj < 2; ++bj) { const f32x4 v0 = acc[ai][bj][m][0], v1 = acc[ai][bj][m][1];
                    u32x4 w; w.x = cvt_pk_bf16(v0[0], v0[1]); w.y = cvt_pk_bf16(v0[2], v0[3]); w.z = cvt_pk_bf16(v1[0], v1[1]); w.w = cvt_pk_bf16(v1[2], v1[3]);
                    *(u32x4*)(rowp + bj * 128) = w; } }
    }
};
template <int MODE> struct EpiGate {
    static constexpr bool PERM = true, ROWPERM = false;
    const bf16_t* X; const bf16_t* Y; const float* bias; bf16_t* O; int ldc;
    __device__ __forceinline__ void operator()(AccRef acc, const Unit& u, int wr, int wc, int fr, int fq) const {
        const int row0 = u.pm * 256 + wr * 64 + fr, col0 = u.pn * 256 + wc * 32 + 8 * fq;
        f32x4 bv[2][2];
#pragma unroll
        for (int bj = 0; bj < 2; ++bj)
#pragma unroll
            for (int n = 0; n < 2; ++n) bv[bj][n] = (MODE == 0) ? *(const f32x4*)(bias + col0 + bj * 128 + 4 * n) : (f32x4){0.f, 0.f, 0.f, 0.f};
#pragma unroll
        for (int ai = 0; ai < 2; ++ai)
#pragma unroll
            for (int m = 0; m < 4; ++m) { const size_t off = (size_t)(row0 + ai * 128 + m * 16) * ldc + col0;
#pragma unroll
                for (int bj = 0; bj < 2; ++bj) {
                    float xv[8], a[8], o[8]; unpack8(*(const u32x4*)(X + off + bj * 128), xv);
#pragma unroll
                    for (int j = 0; j < 4; ++j) { a[j] = acc[ai][bj][m][0][j] + bv[bj][0][j]; a[4 + j] = acc[ai][bj][m][1][j] + bv[bj][1][j]; }
                    if (MODE == 0) {
#pragma unroll
                        for (int j = 0; j < 8; ++j) o[j] = xv[j] * sigmoidf_(a[j]); }
                    else if (MODE == 1) {
#pragma unroll
                        for (int j = 0; j < 8; ++j) o[j] = xv[j] * a[j]; }
                    else { float yv[8]; unpack8(*(const u32x4*)(Y + off + bj * 128), yv);
#pragma unroll
                        for (int j = 0; j < 8; ++j) o[j] = xv[j] * a[j] + yv[j]; }
                    *(u32x4*)(O + off + bj * 128) = pack8(o); } }
    }
};
template <bool WB> struct EpiResid {
    static constexpr bool PERM = false, ROWPERM = false;
    const float* Rs; const bf16_t* Rb; float* Of; bf16_t* Ob; float* ss;
    __device__ __forceinline__ void operator()(AccRef acc, const Unit& u, int wr, int wc, int fr, int fq) const {
        const int row0 = u.pm * 256 + wr * 64 + fr, col0 = u.pn * 256 + wc * 32 + 4 * fq;
#pragma unroll
        for (int ai = 0; ai < 2; ++ai)
#pragma unroll
            for (int m = 0; m < 4; ++m) { const int row = row0 + ai * 128 + m * 16; const size_t off = (size_t)row * 1024 + col0; float s = 0.f;
#pragma unroll
                for (int bj = 0; bj < 2; ++bj)
#pragma unroll
                    for (int n = 0; n < 2; ++n) { const size_t o2 = off + bj * 128 + n * 16; f32x4 r;
                        if (WB) r = *(const f32x4*)(Rs + o2); else { const u32x2 rw = *(const u32x2*)(Rb + o2); r = (f32x4){bflo(rw.x), bfhi(rw.x), bflo(rw.y), bfhi(rw.y)}; }
                        const f32x4 v = r + acc[ai][bj][m][n];
                        s += (v[0] * v[0] + v[1] * v[1]) + (v[2] * v[2] + v[3] * v[3]);
                        if (WB) { u32x2 w; w.x = cvt_pk_bf16(v[0], v[1]); w.y = cvt_pk_bf16(v[2], v[3]); *(u32x2*)(Ob + o2) = w; } else *(f32x4*)(Of + o2) = v; }
                s += __shfl_xor(s, 16); s += __shfl_xor(s, 32);
                if (fq == 0) { if (WB) atomicAdd(ss + row, s); else ss[(size_t)row * 16 + u.pn * 4 + wc] = s; } }
    }
};
__device__ __forceinline__ float ffn_gate(float bg, float wg0, float wg1, float wg2, float ga, float gb, float gc, float bv, float wv0, float wv1, float wv2, float va, float vb, float vc) {
    const float g = bg + wg0 * ga + wg1 * gb + wg2 * gc, v = bv + wv0 * va + wv1 * vb + wv2 * vc; return siluf_(g) * v; }
struct EpiUpFused {
    static constexpr bool PERM = true, ROWPERM = true;
    const float* ss; const float* cw; const float* cb; bf16_t* ACT; bf16_t* SIDE;
    __device__ __forceinline__ void operator()(AccRef acc, const Unit& u, int wr, int wc, int fr, int fq) const {
        const int tok0 = u.pm * 256 + (wr * 16 + fr) * 8;
        float ri[8];
        { const f32x4 q0 = *(const f32x4*)(ss + tok0), q1 = *(const f32x4*)(ss + tok0 + 4);
#pragma unroll
          for (int i = 0; i < 4; ++i) { ri[i] = rsqrtf(q0[i] * (1.0f / 1024.0f) + EPS_); ri[4 + i] = rsqrtf(q1[i] * (1.0f / 1024.0f) + EPS_); } }
        const int fb = u.pn * 128 + wc * 32 + 8 * fq;
#pragma unroll
        for (int n = 0; n < 2; ++n) {
            unsigned pk[8][2];
#pragma unroll
            for (int jp = 0; jp < 2; ++jp) {
                const int c = fb + 4 * n + 2 * jp;
                const f32x2 wv0 = *(const f32x2*)(cw + c), wv1 = *(const f32x2*)(cw + F2_ + c), wv2 = *(const f32x2*)(cw + 2 * F2_ + c);
                const f32x2 wg0 = *(const f32x2*)(cw + F_ + c), wg1 = *(const f32x2*)(cw + F2_ + F_ + c), wg2 = *(const f32x2*)(cw + 2 * F2_ + F_ + c);
                const f32x2 bv = *(const f32x2*)(cb + c), bg = *(const f32x2*)(cb + F_ + c);
                float v0[10], v1[10], g0[10], g1[10];
#pragma unroll
                for (int ai = 0; ai < 2; ++ai)
#pragma unroll
                    for (int m = 0; m < 4; ++m) { const int i = ai * 4 + m; v0[2 + i] = acc[ai][0][m][n][2 * jp] * ri[i]; v1[2 + i] = acc[ai][0][m][n][2 * jp + 1] * ri[i];
                        g0[2 + i] = acc[ai][1][m][n][2 * jp] * ri[i]; g1[2 + i] = acc[ai][1][m][n][2 * jp + 1] * ri[i]; }
                v0[0] = dpp_shr1(v0[8]); v0[1] = dpp_shr1(v0[9]); v1[0] = dpp_shr1(v1[8]); v1[1] = dpp_shr1(v1[9]);
                g0[0] = dpp_shr1(g0[8]); g0[1] = dpp_shr1(g0[9]); g1[0] = dpp_shr1(g1[8]); g1[1] = dpp_shr1(g1[9]);
                if (fr == 0 || fr == 15) {
                    const bool lo = fr == 0; const int slot = wr * 4 + (lo ? 0 : 2);
                    bf16_t* sp = SIDE + ((size_t)u.pm * 8 + slot) * F2_ + c;
                    *(unsigned*)(sp) = cvt_pk_bf16(lo ? v0[2] : v0[8], lo ? v1[2] : v1[8]); *(unsigned*)(sp + F2_) = cvt_pk_bf16(lo ? v0[3] : v0[9], lo ? v1[3] : v1[9]);
                    *(unsigned*)(sp + F_) = cvt_pk_bf16(lo ? g0[2] : g0[8], lo ? g1[2] : g1[8]); *(unsigned*)(sp + F2_ + F_) = cvt_pk_bf16(lo ? g0[3] : g0[9], lo ? g1[3] : g1[9]);
                }
#pragma unroll
                for (int i = 0; i < 8; ++i) {
                    const float o0 = ffn_gate(bg.x, wg0.x, wg1.x, wg2.x, g0[i], g0[i + 1], g0[i + 2], bv.x, wv0.x, wv1.x, wv2.x, v0[i], v0[i + 1], v0[i + 2]);
                    const float o1 = ffn_gate(bg.y, wg0.y, wg1.y, wg2.y, g1[i], g1[i + 1], g1[i + 2], bv.y, wv0.y, wv1.y, wv2.y, v1[i], v1[i + 1], v1[i + 2]);
                    pk[i][jp] = cvt_pk_bf16(o0, o1); }
            }
#pragma unroll
            for (int i = 0; i < 8; ++i) if (!(fr == 0 && i < 2)) { u32x2 w; w.x = pk[i][0]; w.y = pk[i][1]; *(u32x2*)(ACT + (size_t)(tok0 + i) * F_ + fb + 4 * n) = w; }
            asm volatile("" ::: "memory");
        }
    }
};
struct SchedQKV : pg8::Order {
    const char *xc, *xm, *wqk, *wv;
    __device__ __forceinline__ const char* aptr(const Unit& u) const { const int head = u.pn & 3, kind = u.pn >> 2; return (kind < 2 ? xc : xm) + ((size_t)u.pm * 256 * 1024 + head * 256) * 2; }
    __device__ __forceinline__ const char* bptr(const Unit& u) const { const int head = u.pn & 3, kind = u.pn >> 2; return kind < 2 ? wqk + ((size_t)(head * 512 + kind * 256) * 256) * 2 : wv + ((size_t)head * 65536) * 2; }
};

__device__ __forceinline__ void transpose_item(const float* W, int ldw, int c0, const float* kscale, float scale, bf16_t* WT, int ldt, int row_off, LAS float* scr, int kb, int nb, int lane) {
    const int k0 = 64 * kb, n0 = 32 * nb;
    float wv[32], kv[32];
#pragma unroll
    for (int i = 0; i < 32; ++i) { const int kk = 2 * i + (lane >> 5); wv[i] = W[(size_t)(k0 + kk) * ldw + c0 + n0 + (lane & 31)]; kv[i] = kscale ? kscale[k0 + kk] : 1.0f; }
#pragma unroll
    for (int i = 0; i < 32; ++i) { const int kk = 2 * i + (lane >> 5); scr[kk * 33 + (lane & 31)] = wv[i] * scale * kv[i]; }
    asm volatile("s_waitcnt lgkmcnt(0)" ::: "memory");
    const int c = lane & 7;
#pragma unroll
    for (int j = 0; j < 4; ++j) { const int n = (lane >> 3) + 8 * j; const LAS float* s = scr + (8 * c) * 33 + n;
        u32x4 o; o.x = cvt_pk_bf16(s[0 * 33], s[1 * 33]); o.y = cvt_pk_bf16(s[2 * 33], s[3 * 33]); o.z = cvt_pk_bf16(s[4 * 33], s[5 * 33]); o.w = cvt_pk_bf16(s[6 * 33], s[7 * 33]);
        *(u32x4*)(WT + (size_t)(row_off + n0 + n) * ldt + k0 + 8 * c) = o; }
    asm volatile("s_waitcnt lgkmcnt(0)" ::: "memory");
}

__device__ __forceinline__ void phase0(const Params& p, LAS unsigned char* lds) {
    const int tid = fresh_tid(), lane = tid & 63, wave = tid >> 6;
    const int gw = blockIdx.x * 8 + wave, NGW = gridDim.x * 8;
    unsigned char* ws = p.ws;
    LAS float* scr = (LAS float*)(lds + wave * 8448);
    LAS float* gwt = (LAS float*)(lds + 8 * 8448);
    { const float* g1 = p.in[1]; const float* w_in = p.in[2];
      for (int i = tid; i < 8192; i += 512) { const int j = i & 7, k = i >> 3; gwt[j * 1024 + k] = g1[k] * w_in[(size_t)k * NIN_ + 2048 + j]; } }
    {
        const int nmat = 63;
        int base = 0;
        for (int mi = 0; mi < nmat; ++mi) {
            const float* W; int ldw, c0, ncols, K; const float* ks = nullptr; float sc = 1.f; bf16_t* WT; int ldt, roff = 0;
            if (mi == 0) { W = p.in[2]; ldw = NIN_; c0 = 0; ncols = 2048; K = 1024; ks = p.in[1]; WT = (bf16_t*)(ws + WS_WIN); ldt = 1024; roff = 0; }
            else if (mi == 1) { W = p.in[2]; ldw = NIN_; c0 = 2056; ncols = 2560; K = 1024; ks = p.in[1]; WT = (bf16_t*)(ws + WS_WIN); ldt = 1024; roff = 2048; }
            else if (mi < 6) { const int h = mi - 2; W = p.in[6] + h * 65536; ldw = 256; c0 = 0; ncols = 256; K = 256; WT = (bf16_t*)(ws + WS_WQK) + h * 512 * 256; ldt = 256; roff = 0; }
            else if (mi < 10) { const int h = mi - 6; W = p.in[7] + h * 65536; ldw = 256; c0 = 0; ncols = 256; K = 256; sc = 0.0625f; WT = (bf16_t*)(ws + WS_WQK) + h * 512 * 256; ldt = 256; roff = 256; }
            else if (mi < 14) { const int h = mi - 10; W = p.in[8] + h * 65536; ldw = 256; c0 = 0; ncols = 256; K = 256; WT = (bf16_t*)(ws + WS_WV) + h * 65536; ldt = 256; roff = 0; }
            else if (mi == 14) { W = p.in[19]; ldw = 512; c0 = 0; ncols = 512; K = 512; WT = (bf16_t*)(ws + WS_WGLU); ldt = 512; }
            else if (mi == 15) { W = p.in[21]; ldw = 1024; c0 = 0; ncols = 1024; K = 1024; WT = (bf16_t*)(ws + WS_WA); ldt = 1024; }
            else if (mi == 16) { W = p.in[22]; ldw = 1024; c0 = 0; ncols = 1024; K = 512; WT = (bf16_t*)(ws + WS_WB); ldt = 512; }
            else if (mi == 17) { W = p.in[23]; ldw = 1024; c0 = 0; ncols = 1024; K = 1024; WT = (bf16_t*)(ws + WS_WOUT); ldt = 1024; }
            else if (mi < 62) { const int qq = mi - 18, pn = qq >> 1, bj = qq & 1;
                W = p.in[25]; ldw = F2_; c0 = bj * F_ + pn * 128; ncols = 128; K = 1024; ks = p.in[24]; WT = (bf16_t*)(ws + WS_WUP); ldt = 1024; roff = pn * 256 + bj * 128; }
            else { W = p.in[28]; ldw = 1024; c0 = 0; ncols = 1024; K = F_; WT = (bf16_t*)(ws + WS_WDN); ldt = F_; }
            const int nblk = ncols / 32, nit = (K / 64) * nblk;
            int it = gw - (base % NGW); if (it < 0) it += NGW;
            for (; it < nit; it += NGW) transpose_item(W, ldw, c0, ks, sc, WT, ldt, roff, scr, it / nblk, it % nblk, lane);
            base += nit;
        }
    }
    {
        const int gt = blockIdx.x * 512 + tid;
        if (gt < SG_ * SP_) {
            const int g = gt >> 6, pp = gt & 63;
            const float ar = p.in[11][gt], ai = p.in[12][gt], dt = expf(p.in[13][g]);
            const float mag = expf(dt * ar); float sn, cs; sincosf(dt * ai, &sn, &cs);
            const float abr = mag * cs, abi = mag * sn;
            const float den = ar * ar + ai * ai, xr = abr - 1.0f, xi = abi;
            const float rre = (xr * ar + xi * ai) / den, rim = (xi * ar - xr * ai) / den;
            float* A = (float*)(ws + WS_S5A); bf16_t* BbT = (bf16_t*)(ws + WS_S5BT);
            A[gt * 2] = abr; A[gt * 2 + 1] = abi;
            const float* bre = p.in[14] + (size_t)gt * 16; const float* bim = p.in[15] + (size_t)gt * 16;
            for (int c = 0; c < 16; ++c) { const float br = bre[c], bi = bim[c];
                BbT[((size_t)(g * 128 + pp)) * 16 + c] = f2bf(rre * br - rim * bi); BbT[((size_t)(g * 128 + 64 + pp)) * 16 + c] = f2bf(rre * bi + rim * br); }
        }
        bf16_t* CmT = (bf16_t*)(ws + WS_S5CT);
        for (int i = blockIdx.x * 512 + tid; i < SG_ * 16 * 128; i += gridDim.x * 512) { const int k = i & 127, gc = i >> 7;
            CmT[i] = f2bf(k < 64 ? p.in[16][(size_t)gc * 64 + k] : -p.in[17][(size_t)gc * 64 + k - 64]); }
    }
    { float* z = (float*)(ws + WS_SS1); for (int i = blockIdx.x * 512 + tid; i < T_; i += gridDim.x * 512) z[i] = 0.f; }
    {
        float* bp = (float*)(ws + WS_BIASP); const float* b_in = p.in[3];
        for (int i = blockIdx.x * 512 + tid; i < NP1_; i += gridDim.x * 512) bp[i] = b_in[i < 2048 ? i : i + 8];
    }
    __syncthreads();
    {
        const float* x = p.in[0]; const float* b_in = p.in[3];
        bf16_t* xb = (bf16_t*)(ws + R0); float* rinv1 = (float*)(ws + WS_RINV1); float* ig = (float*)(ws + WS_IG); float* fg = (float*)(ws + WS_FG);
        f32x4 vn[4];
        { const f32x4* xr0 = (const f32x4*)(x + (size_t)(gw < T_ ? gw : 0) * 1024) + lane;
#pragma unroll
          for (int j = 0; j < 4; ++j) vn[j] = xr0[64 * j]; }
        for (int row = gw; row < T_; row += NGW) {
            f32x4 v[4];
#pragma unroll
            for (int j = 0; j < 4; ++j) v[j] = vn[j];
            { const int rn = row + NGW < T_ ? row + NGW : row; const f32x4* xr1 = (const f32x4*)(x + (size_t)rn * 1024) + lane;
#pragma unroll
              for (int j = 0; j < 4; ++j) vn[j] = xr1[64 * j]; }
            float s = 0.f;
#pragma unroll
            for (int j = 0; j < 4; ++j) s += (v[j][0] * v[j][0] + v[j][1] * v[j][1]) + (v[j][2] * v[j][2] + v[j][3] * v[j][3]);
            float d[8];
#pragma unroll
            for (int g = 0; g < 8; ++g) { float a = 0.f;
#pragma unroll
                for (int j = 0; j < 4; ++j) { const f32x4 w = *(const LAS f32x4*)(gwt + g * 1024 + 256 * j + 4 * lane); a += (v[j][0] * w[0] + v[j][1] * w[1]) + (v[j][2] * w[2] + v[j][3] * w[3]); }
                d[g] = a; }
            s = wave_sum(s);
#pragma unroll
            for (int g = 0; g < 8; ++g) d[g] = wave_sum(d[g]);
            const float ri = rsqrtf(s * (1.0f / 1024.0f) + EPS_);
            u32x2* o8 = (u32x2*)(xb + (size_t)row * 1024) + lane;
#pragma unroll
            for (int j = 0; j < 4; ++j) { u32x2 w; w.x = cvt_pk_bf16(v[j][0], v[j][1]); w.y = cvt_pk_bf16(v[j][2], v[j][3]); o8[64 * j] = w; }
            if (lane == 0) rinv1[row] = ri;
            if (lane < 8) { float val = d[0];
#pragma unroll
                for (int g = 1; g < 8; ++g) val = (lane == g) ? d[g] : val;
                val = val * ri + b_in[2048 + lane];
                if (lane < 4) ig[(size_t)row * 4 + lane] = val; else fg[(size_t)row * 4 + lane - 4] = val; }
        }
    }
}

__device__ __forceinline__ void phase_xc_fix(const Params& p) {
    const bf16_t* xm = (const bf16_t*)(p.ws + R1); bf16_t* xc = (bf16_t*)(p.ws + WS_XC);
    const float* cw = p.in[4]; const float* cb = p.in[5];
    const int total = 128 * 2 * 128;
    for (int idx = blockIdx.x * 512 + fresh_tid(); idx < total; idx += gridDim.x * 512) {
        const int cgi = idx & 127, s2 = (idx >> 7) & 1, pm = idx >> 8, c0 = cgi * 8, t0 = pm * 256 + 128 * s2;
        float w[4][8], b[8];
#pragma unroll
        for (int k = 0; k < 4; ++k) { const f32x4 a = *(const f32x4*)(cw + k * 1024 + c0), bb = *(const f32x4*)(cw + k * 1024 + c0 + 4);
#pragma unroll
            for (int j = 0; j < 4; ++j) { w[k][j] = a[j]; w[k][4 + j] = bb[j]; } }
        { const f32x4 a = *(const f32x4*)(cb + c0), bb = *(const f32x4*)(cb + c0 + 4);
#pragma unroll
          for (int j = 0; j < 4; ++j) { b[j] = a[j]; b[4 + j] = bb[j]; } }
        float r0[8], r1[8], r2[8], r3[8];
        const bool head = (t0 & (SEQ_ - 1)) == 0;
        if (head) {
#pragma unroll
            for (int j = 0; j < 8; ++j) { r0[j] = 0.f; r1[j] = 0.f; r2[j] = 0.f; } }
        else { unpack8(*(const u32x4*)(xm + (size_t)(t0 - 3) * 1024 + c0), r0); unpack8(*(const u32x4*)(xm + (size_t)(t0 - 2) * 1024 + c0), r1); unpack8(*(const u32x4*)(xm + (size_t)(t0 - 1) * 1024 + c0), r2); }
#pragma unroll
        for (int i = 0; i < 3; ++i) {
            unpack8(*(const u32x4*)(xm + (size_t)(t0 + i) * 1024 + c0), r3);
            float o[8];
#pragma unroll
            for (int j = 0; j < 8; ++j) { const float y = b[j] + w[0][j] * r0[j] + w[1][j] * r1[j] + w[2][j] * r2[j] + w[3][j] * r3[j]; o[j] = siluf_(y); }
            *(u32x4*)(xc + (size_t)(t0 + i) * 1024 + c0) = pack8(o);
#pragma unroll
            for (int j = 0; j < 8; ++j) { r0[j] = r1[j]; r1[j] = r2[j]; r2[j] = r3[j]; }
        }
    }
}

__device__ __forceinline__ void phase_gates(const Params& p, LAS unsigned char* lds) {
    const int tid = fresh_tid(), lane = tid & 63, wave = __builtin_amdgcn_readfirstlane(tid >> 6);
    const float* IG = (const float*)(p.ws + WS_IG); const float* FG = (const float*)(p.ws + WS_FG); float* GS = (float*)(p.ws + WS_GS);
    LAS float* LB = (LAS float*)lds; LAS float* LC = LB + 64; LAS float* Lm = LB + 128;
    for (int item = blockIdx.x; item < 32; item += gridDim.x) {
        const int b = item >> 2, h = item & 3;
        float av[8], bv[8], pv[8];
#pragma unroll
        for (int cc = 0; cc < 8; ++cc) {
            const int ch = wave * 8 + cc; const size_t t = (size_t)b * SEQ_ + ch * 64 + lane;
            const float fgv = FG[t * 4 + h], li = IG[t * 4 + h];
            const float lf = fminf(fgv, 0.f) - log1pf(expf(-fabsf(fgv)));
            float bc = lf;
#pragma unroll
            for (int o = 1; o < 64; o <<= 1) { const float x = __shfl_up(bc, o); if (lane >= o) bc += x; }
            const float a = li - bc; float pm = a;
#pragma unroll
            for (int o = 1; o < 64; o <<= 1) { const float x = __shfl_up(pm, o); if (lane >= o) pm = fmaxf(pm, x); }
            av[cc] = a; bv[cc] = bc; pv[cc] = pm;
            if (lane == 63) { LB[ch] = bc; LC[ch] = bc + pm; }
        }
        __syncthreads();
        if (tid == 0) { float m = 0.f; for (int j = 0; j < 64; ++j) { Lm[j] = m; m = fmaxf(m + LB[j], LC[j]); } }
        __syncthreads();
#pragma unroll
        for (int cc = 0; cc < 8; ++cc) {
            const int ch = wave * 8 + cc; const float m = Lm[ch];
            const float Mq = fmaxf(m, pv[cc]); const float M63 = __shfl(Mq, 63);
            float* gs = GS + ((size_t)item * 64 + ch) * 384;
            gs[lane] = av[cc]; gs[64 + lane] = Mq; gs[128 + lane] = expf(m - Mq); gs[192 + lane] = expf(-(bv[cc] + Mq)); gs[256 + lane] = expf(av[cc] - M63);
            if (lane == 0) gs[320] = expf(m - M63);
        }
        __syncthreads();
    }
}

typedef short s16x4 __attribute__((ext_vector_type(4)));
__device__ __forceinline__ bf16x8 lds_tr_frag(const LAS bf16_t* p, int row_stride) {
    const s16x4 lo = __builtin_amdgcn_ds_read_tr16_b64_v4i16((LAS s16x4*)p);
    const s16x4 hi = __builtin_amdgcn_ds_read_tr16_b64_v4i16((LAS s16x4*)(p + 4 * row_stride));
    return (bf16x8){lo[0], lo[1], lo[2], lo[3], hi[0], hi[1], hi[2], hi[3]};
}
constexpr int ML_QN = 0, ML_KN = 33792, ML_VN = 67584, ML_VW = 74752, ML_SW = 81920, ML_CB = 91136, ML_DEN = 116480;
__device__ __forceinline__ void phase_mlstm(const Params& p, LAS unsigned char* lds) {
    const int tid = fresh_tid(), lane = tid & 63, w = __builtin_amdgcn_readfirstlane(tid >> 6), qi = w & 3, half = w >> 2, lr = lane & 15, lg = lane >> 4;
    const bf16_t* Q = (const bf16_t*)p.out; const bf16_t* Kk = (const bf16_t*)p.out + (size_t)T_ * 1024; const bf16_t* V = (const bf16_t*)(p.ws + R0);
    bf16_t* HC = (bf16_t*)(p.ws + R1);
    const float* GS = (const float*)(p.ws + WS_GS);
    LAS bf16_t* QN = (LAS bf16_t*)(lds + ML_QN);
    LAS bf16_t* KN = (LAS bf16_t*)(lds + ML_KN);
    LAS bf16_t* VN = (LAS bf16_t*)(lds + ML_VN);
    LAS bf16_t* VW = (LAS bf16_t*)(lds + ML_VW);
    LAS bf16_t* Sw = (LAS bf16_t*)(lds + ML_SW);
    LAS bf16_t* Cb = (LAS bf16_t*)(lds + ML_CB);
    LAS float* sc_den = (LAS float*)(lds + ML_DEN);
    const int trq = lr >> 2, trp = 4 * (lr & 3);
    for (int item = blockIdx.x; item < 256; item += gridDim.x) {
        const int bh = item & 31, vs = item >> 5, b = bh >> 2, h = bh & 3;
        const size_t tok0 = (size_t)b * SEQ_;
        __syncthreads();
        for (int i = tid; i < 48 * 264 / 2; i += 512) ((LAS unsigned*)Cb)[i] = 0u;
        for (int i = tid; i < 2 * 64 * 56 / 2; i += 512) ((LAS unsigned*)VN)[i] = 0u;
        f32x4 Cacc[2][3];
#pragma unroll
        for (int a_ = 0; a_ < 2; ++a_)
#pragma unroll
            for (int c_ = 0; c_ < 3; ++c_) Cacc[a_][c_] = (f32x4){0.f, 0.f, 0.f, 0.f};
        u32x4 qreg[4], kreg[4], vreg = (u32x4){0u, 0u, 0u, 0u};
        float sMq, swi, semr, swk, sdecay; f32x4 sa[2];
        const int vsel = tid < 256 ? (tid >> 2) : (tid < 320 ? tid - 256 : 0);
#define ML_GLOAD(tc0_) do { _Pragma("unroll") for (int i_ = 0; i_ < 4; ++i_) { const int pi = tid + 512 * i_; const size_t go = ((tc0_) + (pi >> 5)) * 1024 + h * 256 + (pi & 31) * 8; \
            qreg[i_] = *(const u32x4*)(Q + go); kreg[i_] = *(const u32x4*)(Kk + go); } \
            if (tid < 256) vreg = *(const u32x4*)(V + ((tc0_) + (tid >> 2)) * 1024 + h * 256 + vs * 32 + (tid & 3) * 8); } while (0)
#define ML_GSCAL(gs_) do { sMq = (gs_)[64 + 16 * qi + lr]; swi = (gs_)[128 + 16 * qi + lr]; semr = (gs_)[192 + 16 * qi + lr]; swk = (gs_)[256 + vsel]; sdecay = (gs_)[320]; \
            sa[0] = *(const f32x4*)((gs_) + 16 * (2 * half) + 4 * lg); sa[1] = *(const f32x4*)((gs_) + 16 * (2 * half + 1) + 4 * lg); } while (0)
#define ML_LWRITE() do { _Pragma("unroll") for (int i_ = 0; i_ < 4; ++i_) { const int pi = tid + 512 * i_; const int lo_ = (pi >> 5) * 264 + (pi & 31) * 8; \
            *(LAS u32x4*)(QN + lo_) = qreg[i_]; *(LAS u32x4*)(KN + lo_) = kreg[i_]; } \
            if (tid < 256) { float vv[8], vw[8]; unpack8(vreg, vv); _Pragma("unroll") for (int j = 0; j < 8; ++j) vw[j] = vv[j] * swk; \
                *(LAS u32x4*)(VN + (tid >> 2) * 56 + (tid & 3) * 8) = vreg; *(LAS u32x4*)(VW + (tid >> 2) * 56 + (tid & 3) * 8) = pack8(vw); } \
            else if (tid < 320) { VN[(tid - 256) * 56 + 32] = (bf16_t)0x3f80; VW[(tid - 256) * 56 + 32] = f2bf(swk); } } while (0)
        { ML_GLOAD(tok0); const float* gs = GS + ((size_t)bh * 64) * 384; ML_GSCAL(gs); }
        __syncthreads();
        ML_LWRITE();
        __syncthreads();
        for (int ch = 0; ch < NCH_; ++ch) {
            const size_t tc0 = tok0 + (size_t)ch * 64;
            const int chn = ch + 1 < NCH_ ? ch + 1 : ch; const size_t tcn = tok0 + (size_t)chn * 64;
            const float* gsn = GS + ((size_t)bh * 64 + chn) * 384;
            const float cMq = sMq, cwi = swi, cemr = semr, cdecay = sdecay; const f32x4 ca0 = sa[0], ca1 = sa[1];
            ML_GLOAD(tcn); ML_GSCAL(gsn);
            bf16x8 qf[8];
#pragma unroll
            for (int ks = 0; ks < 8; ++ks) qf[ks] = *(const LAS bf16x8*)(QN + (16 * qi + lr) * 264 + 32 * ks + 8 * lg);
            f32x4 St[2];
#pragma unroll
            for (int jj = 0; jj < 2; ++jj) { St[jj] = (f32x4){0.f, 0.f, 0.f, 0.f};
#pragma unroll
                for (int ks = 0; ks < 8; ++ks) { const bf16x8 kfr = *(const LAS bf16x8*)(KN + (16 * (2 * half + jj) + lr) * 264 + 32 * ks + 8 * lg);
                    St[jj] = __builtin_amdgcn_mfma_f32_16x16x32_bf16(kfr, qf[ks], St[jj], 0, 0, 0); } }
#pragma unroll
            for (int jj = 0; jj < 2; ++jj) { const int kt = 2 * half + jj; const int qtok = 16 * qi + lr, k0 = 16 * kt + 4 * lg; const f32x4 av = jj == 0 ? ca0 : ca1;
                float o[4];
#pragma unroll
                for (int r = 0; r < 4; ++r) { const float wgt = (k0 + r <= qtok) ? __expf(av[r] - cMq) : 0.f; o[r] = St[jj][r] * wgt; }
                u32x2 pk; pk.x = cvt_pk_bf16(o[0], o[1]); pk.y = cvt_pk_bf16(o[2], o[3]);
                *(LAS u32x2*)(Sw + qtok * 72 + k0) = pk; }
            __syncthreads();
            f32x4 num[2]; num[0] = (f32x4){0.f, 0.f, 0.f, 0.f}; num[1] = (f32x4){0.f, 0.f, 0.f, 0.f};
            const int nvt = half == 0 ? 2 : 1, vt0 = half == 0 ? 0 : 2;
#pragma unroll
            for (int i = 0; i < 2; ++i) if (i < nvt) {
                const int vn = vt0 + i;
#pragma unroll
                for (int ks = 0; ks < 8; ++ks) { const bf16x8 cf = *(const LAS bf16x8*)(Cb + (16 * vn + lr) * 264 + 32 * ks + 8 * lg);
                    num[i] = __builtin_amdgcn_mfma_f32_16x16x32_bf16(cf, qf[ks], num[i], 0, 0, 0); }
                num[i] *= cwi;
#pragma unroll
                for (int k2 = 0; k2 < 2; ++k2) { const bf16x8 sf = *(const LAS bf16x8*)(Sw + (16 * qi + lr) * 72 + 32 * k2 + 8 * lg);
                    const bf16x8 vf = lds_tr_frag(VN + (32 * k2 + 8 * lg + trq) * 56 + 16 * vn + trp, 56);
                    num[i] = __builtin_amdgcn_mfma_f32_16x16x32_bf16(vf, sf, num[i], 0, 0, 0); }
            }
            if (half == 1 && lg == 0) sc_den[16 * qi + lr] = num[0][0];
            {
                bf16x8 vwf[3][2];
#pragma unroll
                for (int vn = 0; vn < 3; ++vn)
#pragma unroll
                    for (int k2 = 0; k2 < 2; ++k2) vwf[vn][k2] = lds_tr_frag(VW + (32 * k2 + 8 * lg + trq) * 56 + 16 * vn + trp, 56);
#pragma unroll
                for (int dm = 0; dm < 2; ++dm) {
                    bf16x8 kf2[2];
#pragma unroll
                    for (int k2 = 0; k2 < 2; ++k2) kf2[k2] = lds_tr_frag(KN + (32 * k2 + 8 * lg + trq) * 264 + 32 * w + 16 * dm + trp, 264);
#pragma unroll
                    for (int vn = 0; vn < 3; ++vn) { f32x4 c = Cacc[dm][vn] * cdecay;
#pragma unroll
                        for (int k2 = 0; k2 < 2; ++k2) c = __builtin_amdgcn_mfma_f32_16x16x32_bf16(kf2[k2], vwf[vn][k2], c, 0, 0, 0);
                        Cacc[dm][vn] = c; }
                }
            }
            __syncthreads();
            if (half == 0) {
                const float dn = __builtin_amdgcn_rcpf(fmaxf(fabsf(sc_den[16 * qi + lr]), cemr));
#pragma unroll
                for (int i = 0; i < 2; ++i) { u32x2 pk; pk.x = cvt_pk_bf16(num[i][0] * dn, num[i][1] * dn); pk.y = cvt_pk_bf16(num[i][2] * dn, num[i][3] * dn);
                    *(u32x2*)(HC + (tc0 + 16 * qi + lr) * 1024 + h * 256 + vs * 32 + 16 * i + 4 * lg) = pk; }
            }
#pragma unroll
            for (int dm = 0; dm < 2; ++dm)
#pragma unroll
                for (int vn = 0; vn < 3; ++vn) { const f32x4 c = Cacc[dm][vn]; u32x2 pk; pk.x = cvt_pk_bf16(c[0], c[1]); pk.y = cvt_pk_bf16(c[2], c[3]);
                    *(LAS u32x2*)(Cb + (16 * vn + lr) * 264 + 32 * w + 16 * dm + 4 * lg) = pk; }
            ML_LWRITE();
            __syncthreads();
        }
#undef ML_GLOAD
#undef ML_GSCAL
#undef ML_LWRITE
    }
}

__device__ __forceinline__ void phase_aout(const Params& p) {
    const int tid = fresh_tid(), lane = tid & 63, gw = blockIdx.x * 8 + (tid >> 6), NGW = gridDim.x * 8;
    const bf16_t* HC = (const bf16_t*)(p.ws + R1); const bf16_t* SOM = (const bf16_t*)(p.ws + R2); const bf16_t* XC = (const bf16_t*)(p.ws + WS_XC);
    bf16_t* AO = (bf16_t*)(p.ws + R0);
    const float* hg = p.in[9]; const float* sk = p.in[10];
    for (int t = gw; t < T_; t += NGW) {
#pragma unroll
        for (int h = 0; h < 4; ++h) {
            const size_t off = (size_t)t * 1024 + h * 256 + 4 * lane;
            const u32x2 hw = *(const u32x2*)(HC + off), ow = *(const u32x2*)(SOM + off), xw = *(const u32x2*)(XC + off);
            const f32x4 g4 = *(const f32x4*)(hg + h * 256 + 4 * lane), s4 = *(const f32x4*)(sk + h * 256 + 4 * lane);
            float hv[4] = {bflo(hw.x), bfhi(hw.x), bflo(hw.y), bfhi(hw.y)};
            const float ov[4] = {bflo(ow.x), bfhi(ow.x), bflo(ow.y), bfhi(ow.y)}, xv[4] = {bflo(xw.x), bfhi(xw.x), bflo(xw.y), bfhi(xw.y)};
            const float mu = wave_sum((hv[0] + hv[1]) + (hv[2] + hv[3])) * (1.0f / 256.0f);
#pragma unroll
            for (int j = 0; j < 4; ++j) hv[j] -= mu;
            const float var = wave_sum((hv[0] * hv[0] + hv[1] * hv[1]) + (hv[2] * hv[2] + hv[3] * hv[3])) * (1.0f / 256.0f);
            const float rs = rsqrtf(var + EPS_);
            float o[4];
#pragma unroll
            for (int j = 0; j < 4; ++j) o[j] = ov[j] * (hv[j] * rs * g4[j]) + s4[j] * xv[j];
            u32x2 wv; wv.x = cvt_pk_bf16(o[0], o[1]); wv.y = cvt_pk_bf16(o[2], o[3]);
            *(u32x2*)(AO + off) = wv;
        }
    }
}

__device__ __forceinline__ bf16x8 s5_load_af(const bf16_t* US, size_t tokb, int g, int lane) {
    const int lr = lane & 15, lg = lane >> 4;
    bf16x8 af = *(const bf16x8*)(US + (tokb + lr) * 512 + g * 16 + 8 * (lg & 1));
    if (lg >= 2) af = (bf16x8){0, 0, 0, 0, 0, 0, 0, 0};
    return af;
}
template <bool PASS_C>
__device__ __forceinline__ void s5_block16(const bf16x8 af, int lane, const bf16x8 (&bbf)[8], LAS float* but, LAS bf16_t* stb, float ar, float ai, float& sr, float& si) {
    const int lr = lane & 15, lg = lane >> 4;
#pragma unroll
    for (int ct = 0; ct < 8; ++ct) { const f32x4 d = __builtin_amdgcn_mfma_f32_16x16x32_bf16(af, bbf[ct], (f32x4){0.f, 0.f, 0.f, 0.f}, 0, 0, 0);
#pragma unroll
        for (int r = 0; r < 4; ++r) but[(4 * lg + r) * 132 + 16 * ct + lr] = d[r]; }
#pragma unroll 4
    for (int tt = 0; tt < 16; ++tt) { const float br = but[tt * 132 + lane], bi = but[tt * 132 + 64 + lane];
        const float nr = ar * sr - ai * si + br, ni = ar * si + ai * sr + bi; sr = nr; si = ni;
        if (PASS_C) { stb[tt * 136 + lane] = f2bf(sr); stb[tt * 136 + 64 + lane] = f2bf(si); } }
}
__device__ __forceinline__ void phase_s5(const Params& p, LAS unsigned char* lds) {
    const int tid = fresh_tid(), lane = tid & 63, wave = __builtin_amdgcn_readfirstlane(tid >> 6), lr = lane & 15, lg = lane >> 4;
    const bf16_t* US = (const bf16_t*)(p.ws + R5);
    const float* A = (const float*)(p.ws + WS_S5A); const bf16_t* BbT = (const bf16_t*)(p.ws + WS_S5BT); const bf16_t* CmT = (const bf16_t*)(p.ws + WS_S5CT);
    bf16_t* YB = (bf16_t*)(p.ws + R7);
    LAS float* but = (LAS float*)(lds + wave * 16896);
    LAS bf16_t* stb = (LAS bf16_t*)(lds + wave * 16896 + 8448);
    LAS float* Eb = (LAS float*)(lds + 8 * 16896);
    for (int item = blockIdx.x; item < NB_ * SG_; item += gridDim.x) {
        const int b = item & 7, g = item >> 3, gp = g * 64 + lane;
        const float ar = A[gp * 2], ai = A[gp * 2 + 1];
        bf16x8 bbf[8];
#pragma unroll
        for (int ct = 0; ct < 8; ++ct) { bbf[ct] = *(const bf16x8*)(BbT + ((size_t)(g * 128 + 16 * ct + lr)) * 16 + 8 * (lg & 1)); if (lg >= 2) bbf[ct] = (bf16x8){0, 0, 0, 0, 0, 0, 0, 0}; }
        const size_t tokw = (size_t)b * SEQ_ + (size_t)wave * 512;
        float sr = 0.f, si = 0.f;
        { bf16x8 afc = s5_load_af(US, tokw, g, lane);
          for (int blk = 0; blk < 32; ++blk) { const int bn = blk + 1 < 32 ? blk + 1 : blk; const bf16x8 afn = s5_load_af(US, tokw + bn * 16, g, lane);
              s5_block16<false>(afc, lane, bbf, but, stb, ar, ai, sr, si); afc = afn; } }
        Eb[(wave * 64 + lane) * 2] = sr; Eb[(wave * 64 + lane) * 2 + 1] = si;
        __syncthreads();
        float pr = ar, pi = ai;
#pragma unroll
        for (int i = 0; i < 9; ++i) { const float nr = pr * pr - pi * pi, ni = 2.f * pr * pi; pr = nr; pi = ni; }
        sr = 0.f; si = 0.f;
        for (int j = 0; j < wave; ++j) { const float er = Eb[(j * 64 + lane) * 2], ei = Eb[(j * 64 + lane) * 2 + 1]; const float nr = pr * sr - pi * si + er, ni = pr * si + pi * sr + ei; sr = nr; si = ni; }
        bf16x8 cmf[4];
#pragma unroll
        for (int kk = 0; kk < 4; ++kk) cmf[kk] = *(const bf16x8*)(CmT + ((size_t)(g * 16 + lr)) * 128 + 32 * kk + 8 * lg);
        const float dsk = p.in[18][g * 16 + lr];
        bf16x8 afc = s5_load_af(US, tokw, g, lane);
        bf16_t uuc[4];
#pragma unroll
        for (int r = 0; r < 4; ++r) uuc[r] = US[(tokw + 4 * lg + r) * 512 + g * 16 + lr];
        for (int blk = 0; blk < 32; ++blk) {
            const size_t tokb = tokw + blk * 16;
            const int bn = blk + 1 < 32 ? blk + 1 : blk; const bf16x8 afn = s5_load_af(US, tokw + bn * 16, g, lane);
            bf16_t uun[4];
#pragma unroll
            for (int r = 0; r < 4; ++r) uun[r] = US[(tokw + bn * 16 + 4 * lg + r) * 512 + g * 16 + lr];
            s5_block16<true>(afc, lane, bbf, but, stb, ar, ai, sr, si);
            f32x4 y = (f32x4){0.f, 0.f, 0.f, 0.f};
#pragma unroll
            for (int kk = 0; kk < 4; ++kk) { const bf16x8 sf = *(const LAS bf16x8*)(stb + lr * 136 + 32 * kk + 8 * lg); y = __builtin_amdgcn_mfma_f32_16x16x32_bf16(sf, cmf[kk], y, 0, 0, 0); }
#pragma unroll
            for (int r = 0; r < 4; ++r) { const size_t tok = tokb + 4 * lg + r; const float uu = bf2f(uuc[r]);
                const float v = y[r] + dsk * uu;
                const float z = 0.7978845608f * (v + 0.044715f * v * v * v); const float th = 1.0f - 2.0f * __builtin_amdgcn_rcpf(1.0f + __expf(2.0f * z));
                YB[tok * 512 + g * 16 + lr] = f2bf(0.5f * v * (1.0f + th)); }
            afc = afn;
#pragma unroll
            for (int r = 0; r < 4; ++r) uuc[r] = uun[r];
        }
        __syncthreads();
    }
}

__device__ __forceinline__ void phase_ffn_fix(const Params& p) {
    const bf16_t* SIDE = (const bf16_t*)(p.ws + WS_SIDE); bf16_t* ACT = (bf16_t*)(p.ws + WS_ACT);
    const float* cw = p.in[26]; const float* cb = p.in[27];
    const int total = 128 * 2 * 352;
    for (int idx = blockIdx.x * 512 + fresh_tid(); idx < total; idx += gridDim.x * 512) {
        const int fg = idx % 352, s2 = (idx / 352) & 1, pm = idx / 704, f0 = fg * 8;
        float va[8], vb[8], vc[8], vd[8], ga[8], gb[8], gc[8], gd[8];
        const bf16_t* cur = SIDE + (size_t)pm * 8 * F2_ + f0;
        if (s2 == 0) {
            if ((pm & 15) == 0) {
#pragma unroll
                for (int j = 0; j < 8; ++j) { va[j] = 0.f; vb[j] = 0.f; ga[j] = 0.f; gb[j] = 0.f; } }
            else { const bf16_t* prv = SIDE + (size_t)(pm - 1) * 8 * F2_ + f0;
                unpack8(*(const u32x4*)(prv + 6 * F2_), va); unpack8(*(const u32x4*)(prv + 7 * F2_), vb); unpack8(*(const u32x4*)(prv + 6 * F2_ + F_), ga); unpack8(*(const u32x4*)(prv + 7 * F2_ + F_), gb); }
            unpack8(*(const u32x4*)(cur), vc); unpack8(*(const u32x4*)(cur + F2_), vd); unpack8(*(const u32x4*)(cur + F_), gc); unpack8(*(const u32x4*)(cur + F2_ + F_), gd);
        } else {
            unpack8(*(const u32x4*)(cur + 2 * F2_), va); unpack8(*(const u32x4*)(cur + 3 * F2_), vb); unpack8(*(const u32x4*)(cur + 2 * F2_ + F_), ga); unpack8(*(const u32x4*)(cur + 3 * F2_ + F_), gb);
            unpack8(*(const u32x4*)(cur + 4 * F2_), vc); unpack8(*(const u32x4*)(cur + 5 * F2_), vd); unpack8(*(const u32x4*)(cur + 4 * F2_ + F_), gc); unpack8(*(const u32x4*)(cur + 5 * F2_ + F_), gd);
        }
        float o0[8], o1[8];
#pragma unroll
        for (int j = 0; j < 8; ++j) { const int f = f0 + j;
            const float wv0 = cw[f], wv1 = cw[F2_ + f], wv2 = cw[2 * F2_ + f], wg0 = cw[F_ + f], wg1 = cw[F2_ + F_ + f], wg2 = cw[2 * F2_ + F_ + f], bv = cb[f], bg = cb[F_ + f];
            o0[j] = ffn_gate(bg, wg0, wg1, wg2, ga[j], gb[j], gc[j], bv, wv0, wv1, wv2, va[j], vb[j], vc[j]);
            o1[j] = ffn_gate(bg, wg0, wg1, wg2, gb[j], gc[j], gd[j], bv, wv0, wv1, wv2, vb[j], vc[j], vd[j]); }
        bf16_t* op = ACT + ((size_t)pm * 256 + 128 * s2) * F_ + f0;
        *(u32x4*)(op) = pack8(o0); *(u32x4*)(op + F_) = pack8(o1);
    }
}

__device__ __forceinline__ void phase_final(const Params& p) {
    const int tid = fresh_tid(), lane = tid & 63, gw = blockIdx.x * 8 + (tid >> 6), NGW = gridDim.x * 8;
    const float* ss = (const float*)(p.ws + WS_SS2); const float* gf = p.in[29];
    for (int row = gw; row < T_; row += NGW) {
        const float sv = (lane < 16) ? ss[(size_t)row * 16 + lane] : 0.f;
        const float ri = rsqrtf(wave_sum(sv) * (1.0f / 1024.0f) + EPS_);
        f32x4* xr = (f32x4*)(p.out + (size_t)row * 1024) + lane;
#pragma unroll
        for (int j = 0; j < 4; ++j) { const f32x4 g4 = *((const f32x4*)gf + lane + 64 * j); f32x4 v = xr[64 * j]; v = v * ri * g4; xr[64 * j] = v; }
    }
}

#ifndef PHASE_MASK
#define PHASE_MASK 0xffffffffu
#endif
#define PH(k) ((PHASE_MASK >> (k)) & 1u)
#ifndef REP_MASK
#define REP_MASK 0u
#endif
#define REPS(k) for (int rep_ = 0; rep_ < 1 + (int)((REP_MASK >> (k)) & 1u); ++rep_)
__global__ void __launch_bounds__(512, 2) fwd_megakernel(Params p) {
    extern __shared__ __attribute__((aligned(16))) unsigned char lds_raw[];
    LAS unsigned char* lds = (LAS unsigned char*)lds_raw;
    unsigned char* ws = p.ws;
    bf16_t* dq = (bf16_t*)p.out;
    volatile LAS unsigned* bst = (volatile LAS unsigned*)(lds + LDS_BYTES - 64);
    if (threadIdx.x < 2) bst[threadIdx.x] = 0u;
    __syncthreads();
    const XcdBarrier xbar = xcd_barrier_post((unsigned*)(ws + WS_BAR), bst);
    REPS(0) if (PH(0)) phase0(p, lds);
    xcd_barrier(xbar);
    REPS(1) if (PH(1)) { pg8::PlainSched S; S.set(ws + R0, 1024, ws + WS_WIN, 1024, T_ / 256, NP1_ / 256);
      EpiProj E{(const float*)(ws + WS_RINV1), (const float*)(ws + WS_BIASP), ws, (bf16_t*)(ws + R1), (bf16_t*)(ws + WS_XC), p.in[4], p.in[5]};
      pg8::gemm_phase(lds, S, E, 1024, 1024, 1024); }
    xcd_barrier(xbar);
    REPS(2) if (PH(2)) { phase_gates(p, lds); phase_xc_fix(p); }
    REPS(6) if (PH(6)) phase_s5(p, lds);
    xcd_barrier(xbar);
    REPS(3) if (PH(3)) { SchedQKV S; S.init(T_ / 256, 12, gridDim.x, blockIdx.x); S.xc = (const char*)(ws + WS_XC); S.xm = (const char*)(ws + R1); S.wqk = (const char*)(ws + WS_WQK); S.wv = (const char*)(ws + WS_WV);
      EpiQKV E{dq, (bf16_t*)(ws + R0)};
      pg8::gemm_phase(lds, S, E, 256, 1024, 256); }
    REPS(8) if (PH(8)) { pg8::PlainSched S; S.set(ws + R7, 512, ws + WS_WGLU, 512, T_ / 256, 2);
      EpiGate<0> E{(const bf16_t*)(ws + R7), nullptr, p.in[20], (bf16_t*)(ws + R5), 512};
      pg8::gemm_phase(lds, S, E, 512, 512, 512); }
    xcd_barrier(xbar);
    REPS(4) if (PH(4)) phase_mlstm(p, lds);
    xcd_barrier(xbar);
    REPS(5) if (PH(5)) phase_aout(p);
    REPS(9) if (PH(9)) { pg8::PlainSched S; S.set(ws + R5, 512, ws + WS_WB, 512, T_ / 256, 4);
      EpiGate<1> E{(const bf16_t*)(ws + R4), nullptr, nullptr, dq, 1024};
      pg8::gemm_phase(lds, S, E, 512, 512, 512); }
    xcd_barrier(xbar);
    REPS(10) if (PH(10)) { pg8::PlainSched S; S.set(ws + R0, 1024, ws + WS_WA, 1024, T_ / 256, 4);
      EpiGate<2> E{(const bf16_t*)(ws + R3), dq, nullptr, (bf16_t*)(ws + R1), 1024};
      pg8::gemm_phase(lds, S, E, 1024, 1024, 1024); }
    xcd_barrier(xbar);
    REPS(11) if (PH(11)) { pg8::PlainSched S; S.set(ws + R1, 1024, ws + WS_WOUT, 1024, T_ / 256, 4);
      EpiResid<true> E{p.in[0], nullptr, nullptr, (bf16_t*)(ws + WS_X1B), (float*)(ws + WS_SS1)};
      pg8::gemm_phase(lds, S, E, 1024, 1024, 1024); }
    xcd_barrier(xbar);
    REPS(12) if (PH(12)) { pg8::PlainSched S; S.set(ws + WS_X1B, 1024, ws + WS_WUP, 1024, T_ / 256, F_ / 128);
      EpiUpFused E{(const float*)(ws + WS_SS1), p.in[26], p.in[27], (bf16_t*)(ws + WS_ACT), (bf16_t*)(ws + WS_SIDE)};
      pg8::gemm_phase(lds, S, E, 1024, 1024, 1024); }
    xcd_barrier(xbar);
    REPS(13) if (PH(13)) phase_ffn_fix(p);
    xcd_barrier(xbar);
    REPS(14) if (PH(14)) { pg8::PlainSched S; S.set(ws + WS_ACT, F_, ws + WS_WDN, F_, T_ / 256, 4);
      EpiResid<false> E{nullptr, (const bf16_t*)(ws + WS_X1B), p.out, nullptr, (float*)(ws + WS_SS2)};
      pg8::gemm_phase(lds, S, E, F_, F_, F_); }
    xcd_barrier(xbar);
    REPS(15) if (PH(15)) phase_final(p);
}

extern "C" void kernel_launch(void* const* d_in, const int* in_sizes, int n_in, void* d_out, int out_size, void* d_ws, size_t ws_size, hipStream_t stream) {
    static int grid_blocks = 0;
    if (!grid_blocks) {
        int dev = 0, cus = 0, per_cu = 0;
        (void)hipGetDevice(&dev);
        (void)hipDeviceGetAttribute(&cus, hipDeviceAttributeMultiprocessorCount, dev);
        (void)hipFuncSetAttribute((const void*)fwd_megakernel, hipFuncAttributeMaxDynamicSharedMemorySize, LDS_BYTES);
        (void)hipOccupancyMaxActiveBlocksPerMultiprocessor(&per_cu, (const void*)fwd_megakernel, 512, LDS_BYTES);
        if (per_cu < 1) { fprintf(stderr, "kernel_launch: occupancy query returned %d\n", per_cu); }
        grid_blocks = cus;
        if (n_in != 30 || out_size != T_ * D_ || ws_size < 512 * MiB) fprintf(stderr, "kernel_launch: unexpected sizes n_in=%d out=%d ws=%zu\n", n_in, out_size, ws_size);
    }
    Params p{};
    for (int i = 0; i < 30; ++i) p.in[i] = (const float*)d_in[i];
    p.out = (float*)d_out; p.ws = (unsigned char*)d_ws;
    (void)hipMemsetAsync((unsigned char*)d_ws + WS_BAR, 0, XCD_BAR_WORDS * 4, stream);
    void* args[] = {&p};
    hipError_t e = hipLaunchCooperativeKernel((void*)fwd_megakernel, dim3(grid_blocks), dim3(512), args, LDS_BYTES, stream);
    if (e != hipSuccess) fprintf(stderr, "cooperative launch failed: %s (grid %d)\n", hipGetErrorString(e), grid_blocks);
}
```
